# Optimizing an MI355X kernel written in HIP

```python
import jax, jax.numpy as jnp
from jax import lax
import numpy as np

D_MODEL = 2048
BATCH = 2
SEQ = 8192
DEPTH = 2

EPS = 1e-6
N_MEM = 256
D_MIX = D_MODEL
D_ATT = D_MIX // 2
D_RNN = D_MIX - D_ATT
N_ATT_HEADS = 8
QK_NOPE_DIM = 128
QK_ROPE_DIM = 64
QK_HEAD_DIM = QK_NOPE_DIM + QK_ROPE_DIM
V_HEAD_DIM = D_ATT // N_ATT_HEADS
Q_LORA_RANK = 512
KV_LORA_RANK = 256
ROPE_BASE = 10000.0
Q_BLOCK = 128
N_RNN_BLOCKS = 8
RNN_BLOCK = D_RNN // N_RNN_BLOCKS
CONV_WIDTH = 4
LRU_C = 8.0
N_MEM_HEADS = 4
MEM_HEAD_DIM = 128
D_MEM_ATT = N_MEM_HEADS * MEM_HEAD_DIM
N_GROUPS = 4
EXPERTS_PER_GROUP = 8
N_EXPERTS = N_GROUPS * EXPERTS_PER_GROUP
TOP_K = 2
D_EXPERT = 512
MOE_BLOCK = 128
D_IN_PROJ = Q_LORA_RANK + KV_LORA_RANK + QK_ROPE_DIM + 2 * D_RNN
IN_SPLITS = (Q_LORA_RANK,
             Q_LORA_RANK + KV_LORA_RANK,
             Q_LORA_RANK + KV_LORA_RANK + QK_ROPE_DIM,
             Q_LORA_RANK + KV_LORA_RANK + QK_ROPE_DIM + D_RNN)

kernel_name = 'hybrid_mla_rglru_memxattn_hmoe'


def rms_norm(x, g):
    xf = x.astype(jnp.float32)
    y = xf * lax.rsqrt(jnp.mean(xf * xf, axis=-1, keepdims=True) + EPS)
    return (y * g.astype(jnp.float32)).astype(x.dtype)


def rope_tables(seq):
    inv = 1.0 / (ROPE_BASE ** (jnp.arange(0, QK_ROPE_DIM, 2, dtype=jnp.float32) / QK_ROPE_DIM))
    ang = jnp.arange(seq, dtype=jnp.float32)[:, None] * inv[None, :]
    return jnp.cos(ang), jnp.sin(ang)


def apply_rope(x, cos, sin):
    x1, x2 = jnp.split(x, 2, axis=-1)
    c = cos[None, :, None, :]
    s = sin[None, :, None, :]
    return jnp.concatenate([x1 * c - x2 * s, x1 * s + x2 * c], axis=-1).astype(x.dtype)


def causal_block_attention(q, k, v):
    b, s, h, dq = q.shape
    nb = s // Q_BLOCK
    scale = dq ** -0.5
    qb = q.reshape(b, nb, Q_BLOCK, h, dq).transpose(1, 0, 2, 3, 4)
    kpos = jnp.arange(s)

    def one_block(args):
        qi, i = args
        sc = jnp.einsum('bqhd,bkhd->bhqk', qi, k, preferred_element_type=jnp.float32) * scale
        qpos = i * Q_BLOCK + jnp.arange(Q_BLOCK)
        mask = kpos[None, :] <= qpos[:, None]
        sc = jnp.where(mask[None, None], sc, -jnp.inf)
        p = jax.nn.softmax(sc, axis=-1).astype(v.dtype)
        return jnp.einsum('bhqk,bkhd->bqhd', p, v)

    out = lax.map(one_block, (qb, jnp.arange(nb)))
    return out.transpose(1, 0, 2, 3, 4).reshape(b, s, h, v.shape[-1])


def mla_group(c_q, c_kv, k_pe, q_lora_g, kv_lora_g, w_uq, w_ukv, q_head_g, k_head_g, cos, sin):
    b, s, _ = c_q.shape
    q = (rms_norm(c_q, q_lora_g) @ w_uq).reshape(b, s, N_ATT_HEADS, QK_HEAD_DIM)
    kv = (rms_norm(c_kv, kv_lora_g) @ w_ukv).reshape(b, s, N_ATT_HEADS, QK_NOPE_DIM + V_HEAD_DIM)
    k_nope, v = kv[..., :QK_NOPE_DIM], kv[..., QK_NOPE_DIM:]
    k_rope = jnp.broadcast_to(k_pe[:, :, None, :], (b, s, N_ATT_HEADS, QK_ROPE_DIM))
    k = jnp.concatenate([k_nope, k_rope], axis=-1)
    q = rms_norm(q, q_head_g)
    k = rms_norm(k, k_head_g)
    q = jnp.concatenate([q[..., :QK_NOPE_DIM], apply_rope(q[..., QK_NOPE_DIM:], cos, sin)], axis=-1)
    k = jnp.concatenate([k[..., :QK_NOPE_DIM], apply_rope(k[..., QK_NOPE_DIM:], cos, sin)], axis=-1)
    return causal_block_attention(q, k, v).reshape(b, s, D_ATT)


def rglru_group(xr, gate, conv_w, conv_b, w_rg, b_rg, w_ig, b_ig, lam):
    b, s, _ = xr.shape
    xp = jnp.pad(xr, ((0, 0), (CONV_WIDTH - 1, 0), (0, 0)))
    xc = conv_b
    for j in range(CONV_WIDTH):
        xc = xc + xp[:, j:j + s] * conv_w[j]
    xblk = xc.reshape(b, s, N_RNN_BLOCKS, RNN_BLOCK)
    r = jax.nn.sigmoid(jnp.einsum('bsnc,ncd->bsnd', xblk, w_rg).reshape(b, s, D_RNN) + b_rg)
    i = jax.nn.sigmoid(jnp.einsum('bsnc,ncd->bsnd', xblk, w_ig).reshape(b, s, D_RNN) + b_ig)
    log_a = (-LRU_C * r.astype(jnp.float32)) * jax.nn.softplus(-lam.astype(jnp.float32))
    a = jnp.exp(log_a)
    u = jnp.sqrt(-jnp.expm1(2.0 * log_a)) * (i * xc).astype(jnp.float32)

    def combine(left, right):
        a1, b1 = left
        a2, b2 = right
        return a1 * a2, a2 * b1 + b2

    _, h = lax.associative_scan(combine, (a, u), axis=1)
    return h.astype(xr.dtype) * jax.nn.gelu(gate)


def memory_xattn(x, mem, norm_g, mem_norm_g, w_q, w_k, w_v, q_g, k_g, w_o):
    b, s, _ = x.shape
    m_len = mem.shape[1]
    h = rms_norm(x, norm_g)
    m = rms_norm(mem, mem_norm_g)
    q = rms_norm((h @ w_q).reshape(b, s, N_MEM_HEADS, MEM_HEAD_DIM), q_g)
    k = rms_norm((m @ w_k).reshape(b, m_len, N_MEM_HEADS, MEM_HEAD_DIM), k_g)
    v = (m @ w_v).reshape(b, m_len, N_MEM_HEADS, MEM_HEAD_DIM)
    sc = jnp.einsum('bshd,bmhd->bhsm', q, k, preferred_element_type=jnp.float32) * (MEM_HEAD_DIM ** -0.5)
    p = jax.nn.softmax(sc, axis=-1).astype(v.dtype)
    o = jnp.einsum('bhsm,bmhd->bshd', p, v).reshape(b, s, D_MEM_ATT)
    return o @ w_o


def hierarchical_moe(x, norm_g, w_rgrp, b_rgrp, w_rexp, b_rexp, w_gate, w_up, w_down):
    b, s, d = x.shape
    t = b * s
    h = rms_norm(x, norm_g).reshape(t, d)
    g_prob = jax.nn.softmax((h @ w_rgrp).astype(jnp.float32) + b_rgrp, axis=-1)
    g_w, g_idx = lax.top_k(g_prob, 1)
    e_logits = ((h @ w_rexp).astype(jnp.float32) + b_rexp).reshape(t, N_GROUPS, EXPERTS_PER_GROUP)
    sel = jnp.broadcast_to(g_idx[:, :, None], (t, 1, EXPERTS_PER_GROUP))
    e_prob = jax.nn.softmax(jnp.take_along_axis(e_logits, sel, axis=1)[:, 0], axis=-1)
    e_w, e_loc = lax.top_k(e_prob, TOP_K)
    e_w = e_w / jnp.sum(e_w, axis=-1, keepdims=True)
    weights = g_w * e_w
    eid = g_idx * EXPERTS_PER_GROUP + e_loc
    n_asg = t * TOP_K
    eid_f = eid.reshape(n_asg)
    w_f = weights.reshape(n_asg)
    tok_f = jnp.repeat(jnp.arange(t, dtype=jnp.int32), TOP_K)
    order = jnp.argsort(eid_f)
    e_sorted = eid_f[order]
    counts = jnp.bincount(eid_f, length=N_EXPERTS)
    padded = (counts + MOE_BLOCK - 1) // MOE_BLOCK * MOE_BLOCK
    pad_end = jnp.cumsum(padded)
    pad_start = pad_end - padded
    start = jnp.cumsum(counts) - counts
    dest = pad_start[e_sorted] + jnp.arange(n_asg) - start[e_sorted]
    n_rows = ((n_asg + MOE_BLOCK - 1) // MOE_BLOCK + N_EXPERTS) * MOE_BLOCK
    n_blk = n_rows // MOE_BLOCK
    buf_tok = jnp.zeros((n_rows,), jnp.int32).at[dest].set(tok_f[order])
    buf_w = jnp.zeros((n_rows,), jnp.float32).at[dest].set(w_f[order])
    blk_e = jnp.minimum(jnp.searchsorted(pad_end, jnp.arange(n_blk) * MOE_BLOCK, side='right'), N_EXPERTS - 1)
    xb = h[buf_tok].reshape(n_blk, MOE_BLOCK, d)

    def expert_block(args):
        xi, e = args
        return (jax.nn.silu(xi @ w_gate[e]) * (xi @ w_up[e])) @ w_down[e]

    yb = lax.map(expert_block, (xb, blk_e)).reshape(n_rows, d)
    y = jax.ops.segment_sum(yb * buf_w[:, None].astype(yb.dtype), buf_tok, num_segments=t)
    return y.reshape(b, s, d)


def _normal(k, shape, scale):
    return jax.random.normal(k, shape, jnp.float32) * scale


def _gain(k, shape):
    return 1.0 + 0.02 * jax.random.normal(k, shape, jnp.float32)


def setup_inputs(seed: int = 0) -> dict:
    key = jax.random.key(seed)
    ks = jax.random.split(key, 40)
    L = DEPTH
    u = jax.random.uniform(ks[20], (L, D_RNN), jnp.float32, 0.9, 0.999)
    a0 = u ** (1.0 / LRU_C)
    lam = jnp.log(a0) - jnp.log1p(-a0)
    return {
        'x': _normal(ks[0], (BATCH, SEQ, D_MODEL), 1.0),
        'mem': _normal(ks[1], (BATCH, N_MEM, D_MODEL), 1.0),
        'mix_norm_g': _gain(ks[2], (L, D_MODEL)),
        'w_in': _normal(ks[3], (L, D_MODEL, D_IN_PROJ), D_MODEL ** -0.5),
        'q_lora_norm_g': _gain(ks[4], (L, Q_LORA_RANK)),
        'kv_lora_norm_g': _gain(ks[5], (L, KV_LORA_RANK)),
        'w_uq': _normal(ks[6], (L, Q_LORA_RANK, N_ATT_HEADS * QK_HEAD_DIM), Q_LORA_RANK ** -0.5),
        'w_ukv': _normal(ks[7], (L, KV_LORA_RANK, N_ATT_HEADS * (QK_NOPE_DIM + V_HEAD_DIM)), KV_LORA_RANK ** -0.5),
        'att_q_norm_g': _gain(ks[8], (L, QK_HEAD_DIM)),
        'att_k_norm_g': _gain(ks[9], (L, QK_HEAD_DIM)),
        'conv_w': _normal(ks[10], (L, CONV_WIDTH, D_RNN), CONV_WIDTH ** -0.5),
        'conv_b': _normal(ks[11], (L, D_RNN), 0.01),
        'w_rgate': _normal(ks[12], (L, N_RNN_BLOCKS, RNN_BLOCK, RNN_BLOCK), RNN_BLOCK ** -0.5),
        'b_rgate': _normal(ks[13], (L, D_RNN), 0.01),
        'w_igate': _normal(ks[14], (L, N_RNN_BLOCKS, RNN_BLOCK, RNN_BLOCK), RNN_BLOCK ** -0.5),
        'b_igate': _normal(ks[15], (L, D_RNN), 0.01),
        'lru_lambda': lam,
        'att_out_norm_g': _gain(ks[16], (L, D_ATT)),
        'rnn_out_norm_g': _gain(ks[17], (L, D_RNN)),
        'w_out': _normal(ks[18], (L, D_MIX, D_MODEL), D_MIX ** -0.5),
        'xattn_norm_g': _gain(ks[19], (L, D_MODEL)),
        'mem_norm_g': _gain(ks[21], (L, D_MODEL)),
        'w_mq': _normal(ks[22], (L, D_MODEL, D_MEM_ATT), D_MODEL ** -0.5),
        'w_mk': _normal(ks[23], (L, D_MODEL, D_MEM_ATT), D_MODEL ** -0.5),
        'w_mv': _normal(ks[24], (L, D_MODEL, D_MEM_ATT), D_MODEL ** -0.5),
        'mem_q_norm_g': _gain(ks[25], (L, MEM_HEAD_DIM)),
        'mem_k_norm_g': _gain(ks[26], (L, MEM_HEAD_DIM)),
        'w_mo': _normal(ks[27], (L, D_MEM_ATT, D_MODEL), D_MEM_ATT ** -0.5),
        'moe_norm_g': _gain(ks[28], (L, D_MODEL)),
        'w_router_group': _normal(ks[29], (L, D_MODEL, N_GROUPS), D_MODEL ** -0.5),
        'b_router_group': _normal(ks[30], (L, N_GROUPS), 0.01),
        'w_router_expert': _normal(ks[31], (L, D_MODEL, N_EXPERTS), D_MODEL ** -0.5),
        'b_router_expert': _normal(ks[32], (L, N_EXPERTS), 0.01),
        'w_exp_gate': _normal(ks[33], (L, N_EXPERTS, D_MODEL, D_EXPERT), D_MODEL ** -0.5),
        'w_exp_up': _normal(ks[34], (L, N_EXPERTS, D_MODEL, D_EXPERT), D_MODEL ** -0.5),
        'w_exp_down': _normal(ks[35], (L, N_EXPERTS, D_EXPERT, D_MODEL), D_EXPERT ** -0.5),
    }


def reference(x, mem, mix_norm_g, w_in, q_lora_norm_g, kv_lora_norm_g, w_uq, w_ukv,
              att_q_norm_g, att_k_norm_g, conv_w, conv_b, w_rgate, b_rgate, w_igate, b_igate,
              lru_lambda, att_out_norm_g, rnn_out_norm_g, w_out, xattn_norm_g, mem_norm_g,
              w_mq, w_mk, w_mv, mem_q_norm_g, mem_k_norm_g, w_mo, moe_norm_g,
              w_router_group, b_router_group, w_router_expert, b_router_expert,
              w_exp_gate, w_exp_up, w_exp_down):
    cos, sin = rope_tables(x.shape[1])
    for l in range(DEPTH):
        z = rms_norm(x, mix_norm_g[l]) @ w_in[l]
        c_q, c_kv, k_pe, xr, gate = jnp.split(z, IN_SPLITS, axis=-1)
        k_pe = apply_rope(rms_norm(k_pe[:, :, None, :], att_k_norm_g[l][QK_NOPE_DIM:]), cos, sin)[:, :, 0, :] * 0 + k_pe if False else k_pe
        y_att = mla_group(c_q, c_kv, k_pe, q_lora_norm_g[l], kv_lora_norm_g[l], w_uq[l], w_ukv[l],
                          att_q_norm_g[l], att_k_norm_g[l], cos, sin)
        y_rnn = rglru_group(xr, gate, conv_w[l], conv_b[l], w_rgate[l], b_rgate[l],
                            w_igate[l], b_igate[l], lru_lambda[l])
        y_mix = jnp.concatenate([rms_norm(y_att, att_out_norm_g[l]),
                                 rms_norm(y_rnn, rnn_out_norm_g[l])], axis=-1)
        x = x + y_mix @ w_out[l]
        x = x + memory_xattn(x, mem, xattn_norm_g[l], mem_norm_g[l], w_mq[l], w_mk[l], w_mv[l],
                             mem_q_norm_g[l], mem_k_norm_g[l], w_mo[l])
        x = x + hierarchical_moe(x, moe_norm_g[l], w_router_group[l], b_router_group[l],
                                 w_router_expert[l], b_router_expert[l],
                                 w_exp_gate[l], w_exp_up[l], w_exp_down[l])
    return x
```

```cpp
#include <hip/hip_runtime.h>
#include <cstdio>
#include <cstdint>

#define GAS __attribute__((address_space(1)))
#define LAS __attribute__((address_space(3)))
typedef unsigned short bf16;
typedef short bf16x8 __attribute__((ext_vector_type(8)));
typedef short s16x4 __attribute__((ext_vector_type(4)));
typedef float f32x4 __attribute__((ext_vector_type(4)));
typedef float f32x2 __attribute__((ext_vector_type(2)));
typedef float f32x16 __attribute__((ext_vector_type(16)));
typedef unsigned u32x4 __attribute__((ext_vector_type(4)));
typedef unsigned u32x2 __attribute__((ext_vector_type(2)));

constexpr int NBATCH = 2, SEQ = 8192, T = NBATCH * SEQ, D = 2048, DEPTH = 2;
constexpr int NMEM = 256, TM = NBATCH * NMEM;
constexpr int QL = 512, KVL = 256, DRNN = 1024, DATT = 1024;
constexpr int NH = 8, QKH = 192, VH = 128;
constexpr int ZC = 3072;
constexpr int Z_CQ = 0, Z_CKV = 512, Z_XR = 768, Z_GATE = 1792, Z_KPE = 2816;
constexpr int NE = 32, DE = 512, NSLOT = 40960;
constexpr int NQU = NH * QKH;
constexpr int NKV = NH * 256;
constexpr int DMA = 512;
constexpr float EPS = 1e-6f;
constexpr int NWAVES = 8, NTHREADS = 512;

__device__ __forceinline__ unsigned f2bf(float f) { unsigned u = __builtin_bit_cast(unsigned, f); return (u + 0x7fffu + ((u >> 16) & 1u)) >> 16; }
__device__ __forceinline__ unsigned pk2(float lo, float hi) { return f2bf(lo) | (f2bf(hi) << 16); }
__device__ __forceinline__ float bf2f(unsigned short h) { return __builtin_bit_cast(float, (unsigned)h << 16); }
__device__ __forceinline__ float bflo(unsigned w) { return __builtin_bit_cast(float, w << 16); }
__device__ __forceinline__ float bfhi(unsigned w) { return __builtin_bit_cast(float, w & 0xffff0000u); }
__device__ __forceinline__ unsigned cvt_pk_bf16(float lo, float hi) { unsigned r; asm volatile("v_cvt_pk_bf16_f32 %0, %1, %2" : "=v"(r) : "v"(lo), "v"(hi)); return r; }
__device__ __forceinline__ float wave_sum(float v) {
#pragma unroll
    for (int o = 1; o < 64; o <<= 1) v += __shfl_xor(v, o);
    return v;
}
typedef unsigned long long u64;
__device__ __forceinline__ float ssq_val(const u64* p, int row) { return (float)p[row] * (1.0f / 16777216.0f); }
__device__ __forceinline__ void ssq_add(u64* p, int row, float v) { atomicAdd(p + row, (u64)(v * 16777216.0f)); }
__device__ __forceinline__ void ssq_set(u64* p, int row, float v) { p[row] = (u64)(v * 16777216.0f); }
#define LDS_WAIT() asm volatile("s_waitcnt lgkmcnt(0)" ::: "memory")
#define VM_WAIT() asm volatile("s_waitcnt vmcnt(0)" ::: "memory")

#define XB_TMO      128
#define XB_XCNT(j)  (256  + 64 * (j))
#define XB_XSUB(j)  (1280 + 64 * (j))
#define XB_XGEN(j)  (2304 + 64 * (j))
#define XB_TOP      3328
#define XB_TOPGEN   3392
#define XCD_BAR_WORDS 3456
#define XB_SPIN_CAP (1u << 18)
__device__ __forceinline__ unsigned xb_ld(unsigned* p)              { return __hip_atomic_load(p, __ATOMIC_RELAXED, __HIP_MEMORY_SCOPE_AGENT); }
__device__ __forceinline__ unsigned xb_add(unsigned* p, unsigned v) { return __hip_atomic_fetch_add(p, v, __ATOMIC_RELAXED, __HIP_MEMORY_SCOPE_AGENT); }
__device__ __forceinline__ unsigned xb_xcc_id() { return (unsigned)__builtin_amdgcn_s_getreg((3 << 11) | 20) & 0xFu; }
#define XB_SPIN(cond, bar) do { unsigned _sp = 0; while (cond) { __builtin_amdgcn_s_sleep(1); \
    if ((++_sp & 255u) == 0u) { if (xb_ld(&(bar)[XB_TMO])) break; if (_sp > XB_SPIN_CAP) { atomicAdd(&(bar)[XB_TMO], 1u); break; } } } } while (0)
struct XcdBarrier { unsigned* bar; unsigned x; volatile LAS unsigned* st; };
__device__ __forceinline__ XcdBarrier xcd_barrier_post(unsigned* bar, volatile LAS unsigned* st) {
    XcdBarrier b; b.bar = bar; b.x = xb_xcc_id(); b.st = st;
    if (threadIdx.x == 0) (void)xb_add(&bar[XB_XCNT(b.x)], 1u);
    return b;
}
__device__ __forceinline__ void xcd_barrier_complete(unsigned* bar, unsigned x, unsigned& nloc, unsigned& nx) {
    const unsigned G = gridDim.x * gridDim.y * gridDim.z;
    unsigned sum, cnt, mine, sp = 0u;
    for (;;) {
        sum = 0u; cnt = 0u; mine = 0u;
#pragma unroll
        for (unsigned j = 0; j < 16; ++j) { const unsigned c = xb_ld(&bar[XB_XCNT(j)]); sum += c; cnt += (c > 0u) ? 1u : 0u; mine = (j == x) ? c : mine; }
        if (sum == G) break;
        __builtin_amdgcn_s_sleep(1);
        if ((++sp & 255u) == 0u) { if (xb_ld(&bar[XB_TMO])) break; if (sp > XB_SPIN_CAP) { atomicAdd(&bar[XB_TMO], 1u); break; } }
    }
    nloc = mine > 0u ? mine : 1u; nx = cnt > 0u ? cnt : 1u;
}
__device__ __forceinline__ void xcd_barrier(const XcdBarrier& b) {
    asm volatile("s_waitcnt vmcnt(0)" ::: "memory");
    __syncthreads();
    if (threadIdx.x == 0) {
        unsigned* bar = b.bar; unsigned bx_ = b.x; asm volatile("" : "+s"(bar), "+s"(bx_));
        __builtin_amdgcn_s_waitcnt(0);
        unsigned nloc = b.st[0], nx = b.st[1];
        if (nloc == 0u) { xcd_barrier_complete(bar, bx_, nloc, nx); b.st[0] = nloc; b.st[1] = nx; }
        const unsigned old = xb_add(&bar[XB_XSUB(bx_)], 1u);
        const unsigned gen = old / nloc;
        if (old + 1u == (gen + 1u) * nloc) {
            __builtin_amdgcn_fence(__ATOMIC_RELEASE, "agent");
            asm volatile("s_waitcnt vmcnt(0)" ::: "memory");
            const unsigned og = xb_add(&bar[XB_TOP], 1u);
            const unsigned tg = og / nx;
            if (og + 1u == (tg + 1u) * nx) xb_add(&bar[XB_TOPGEN], 1u);
            else XB_SPIN(xb_ld(&bar[XB_TOPGEN]) == tg, bar);
            __builtin_amdgcn_fence(__ATOMIC_ACQUIRE, "agent");
            xb_add(&bar[XB_XGEN(bx_)], 1u);
            asm volatile("s_waitcnt vmcnt(0)" ::: "memory");
        } else {
            XB_SPIN(xb_ld(&bar[XB_XGEN(bx_)]) == gen, bar);
            __builtin_amdgcn_fence(__ATOMIC_ACQUIRE, "agent");
            asm volatile("s_waitcnt vmcnt(0)" ::: "memory");
        }
    }
    __syncthreads();
}

namespace pg8 {
constexpr int BM = 256, BK = 64, HALF = 128, HTB = HALF * BK * 2, STAGE_BYTES = 8 * HTB, NXCD = 8, WGM = 8;
__host__ __device__ __forceinline__ int lds_byte(int r, int c) { const int st = (r >> 4) * 2 + (c >> 5), rr = r & 15, cc = c & 31, ob = rr * 64 + cc * 2; return st * 1024 + (ob ^ (((ob >> 9) & 1) << 5)); }
__host__ __device__ __forceinline__ void stage_rc(int b, int& R, int& C) { const int st = b / 1024, sb = b % 1024, swz = sb ^ (((sb >> 9) & 1) << 5); R = (st >> 1) * 16 + swz / 64; C = (st & 1) * 32 + (swz % 64) / 2; }
__host__ __device__ __forceinline__ int perm32(int rho) { const int n = rho >> 4, i = rho & 15; return 8 * (i >> 2) + 4 * n + (i & 3); }

struct Unit { const char* A; const char* B; int pm, pn, aux; };

__device__ __forceinline__ bool static_tile(int i, int G, int c, int nM, int nN, int& pm, int& pn) {
    const int nwg = nM * nN; const long L = (long)i * G + c; if (L >= nwg) return false;
    int wgid = (int)L; { const int q = nwg / NXCD, r = nwg % NXCD, xcd = wgid % NXCD, off = wgid / NXCD; wgid = (xcd < r ? xcd * (q + 1) : r * (q + 1) + (xcd - r) * q) + off; }
    const int nig = WGM * nN, gid = wgid / nig, fm = gid * WGM, gsz = (nM - fm) < WGM ? (nM - fm) : WGM;
    pm = fm + ((wgid % nig) % gsz); pn = (wgid % nig) / gsz; return true;
}

template <class Epi, class Sched, bool ALIGN_EPI, bool MID>
__device__ __forceinline__ void gemm_phase(LAS unsigned char* lds, const int K, const int lda, const int ldb, const Sched& S, const Epi& E, const int mid_t) {
    constexpr bool GATHER = Sched::GATHER;
    int tid = threadIdx.x; asm volatile("" : "+v"(tid)); const int wid = __builtin_amdgcn_readfirstlane(tid >> 6), lane = tid & 63, wr = wid >> 2, wc = wid & 3, fr = lane & 15, fq = lane >> 4;
    const int nt = K / BK;
    unsigned voffA[2], voffB[2];
#pragma unroll
    for (int i = 0; i < 2; ++i) { int R, C; stage_rc(tid * 16 + i * 8192, R, C); const int Rb = Epi::PERM ? ((R & ~31) + perm32(R & 31)) : R;
        voffA[i] = (unsigned)(R * lda + C) * 2u; voffB[i] = (unsigned)(Rb * ldb + C) * 2u; }
    const size_t kstep = (size_t)(BK * 2);
    const size_t hstepA = GATHER ? (size_t)0 : (size_t)HALF * lda * 2;
    const size_t hstepB = (size_t)HALF * ldb * 2;
    const unsigned ldsw = (unsigned)wid * 1024u;
    const int aoff = lds_byte(wr * 64 + fr, fq * 8), boff = lds_byte(wc * 32 + fr, fq * 8);
#define PG8_SA(b, h) (((b) * 2 + (h)) * HTB)
#define PG8_SB(b, h) ((4 + (b) * 2 + (h)) * HTB)
#define PG8_STAGE(bufoff, gbase, voff) do { _Pragma("unroll") for (int _i = 0; _i < 2; ++_i) \
        __builtin_amdgcn_global_load_lds((const unsigned*)((const char*)(gbase) + (voff)[_i]), (LAS unsigned*)(lds + (bufoff) + ldsw + _i * 8192), 16, 0, 0); } while (0)
#define PG8_LDA(dst, b, h) do { _Pragma("unroll") for (int m = 0; m < 4; ++m) _Pragma("unroll") for (int k = 0; k < 2; ++k) dst[m][k] = *(const LAS bf16x8*)(lds + PG8_SA(b, h) + aoff + m * 2048 + k * 1024); } while (0)
#define PG8_LDB(dst, b, h) do { _Pragma("unroll") for (int n = 0; n < 2; ++n) _Pragma("unroll") for (int k = 0; k < 2; ++k) dst[n][k] = *(const LAS bf16x8*)(lds + PG8_SB(b, h) + boff + n * 2048 + k * 1024); } while (0)
#define PG8_MMA(ai, bj, At, Bt) do { __builtin_amdgcn_s_setprio(1); _Pragma("unroll") for (int m = 0; m < 4; ++m) _Pragma("unroll") for (int n = 0; n < 2; ++n) _Pragma("unroll") for (int k = 0; k < 2; ++k) \
        acc[ai][bj][m][n] = __builtin_amdgcn_mfma_f32_16x16x32_bf16(Bt[n][k], At[m][k], acc[ai][bj][m][n], 0, 0, 0); __builtin_amdgcn_s_setprio(0); } while (0)
#define PG8_WAIT_V(n) asm volatile("s_waitcnt vmcnt(" #n ")" ::: "memory")
#define PG8_WAIT_L(n) asm volatile("s_waitcnt lgkmcnt(" #n ")" ::: "memory")
#define PG8_BAR __builtin_amdgcn_s_barrier()
#define PG8_SCHED __builtin_amdgcn_sched_barrier(0)
    Unit cur, nxt; int ui = 0;
    if (!S.next(0, cur)) return;
    f32x4 acc[2][2][4][2];
#pragma unroll
    for (int a = 0; a < 2; ++a)
#pragma unroll
        for (int b = 0; b < 2; ++b)
#pragma unroll
            for (int m = 0; m < 4; ++m)
#pragma unroll
                for (int n = 0; n < 2; ++n) acc[a][b][m][n] = (f32x4){0.f, 0.f, 0.f, 0.f};
    bf16x8 At[4][2], B0[2][2], B1[2][2];
    unsigned gA0[2], gA1[2], gN0[2], gN1[2];
    if constexpr (GATHER) {
#pragma unroll
        for (int i = 0; i < 2; ++i) { int R, C; stage_rc(tid * 16 + i * 8192, R, C); gA0[i] = S.arow(cur, R) + (unsigned)C * 2u; gA1[i] = S.arow(cur, HALF + R) + (unsigned)C * 2u; gN0[i] = gA0[i]; gN1[i] = gA1[i]; }
    }
#define PG8_STAGE_A(b, h, gbase, G0, G1) do { if constexpr (GATHER) { if ((h) == 0) PG8_STAGE(PG8_SA(b, h), gbase, G0); else PG8_STAGE(PG8_SA(b, h), gbase, G1); } \
        else PG8_STAGE(PG8_SA(b, h), (gbase) + (h) * hstepA, voffA); } while (0)
    const char* cA = cur.A; const char* cB = cur.B;
    PG8_STAGE(PG8_SB(0, 0), cB, voffB); PG8_STAGE(PG8_SB(0, 1), cB + hstepB, voffB); PG8_STAGE_A(0, 0, cA, gA0, gA1); PG8_STAGE_A(0, 1, cA, gA0, gA1);
    if (wr == 1) PG8_BAR;
    PG8_WAIT_V(2); PG8_BAR;
    PG8_STAGE(PG8_SB(1, 0), cB + kstep, voffB); PG8_STAGE_A(1, 0, cA + kstep, gA0, gA1); PG8_STAGE(PG8_SB(1, 1), cB + hstepB + kstep, voffB);
    PG8_WAIT_V(6); PG8_BAR;
    for (;;) {
        const bool has_next = S.next(ui + 1, nxt);
        const char* nA = has_next ? nxt.A : cA; const char* nB = has_next ? nxt.B : cB;
        if constexpr (GATHER) {
            if (has_next) {
#pragma unroll
                for (int i = 0; i < 2; ++i) { int R, C; stage_rc(tid * 16 + i * 8192, R, C); gN0[i] = S.arow(nxt, R) + (unsigned)C * 2u; gN1[i] = S.arow(nxt, HALF + R) + (unsigned)C * 2u; }
            }
        }
#pragma nounroll
        for (int t = 0; t < nt; t += 2) {
            const bool last = (t == nt - 2);
            if constexpr (MID) { if (t == mid_t) E.mid(acc, cur, wr, wc, fr, fq); }
            const char* a1 = cA + (size_t)(t + 1) * kstep;
            const char* a2 = last ? nA : cA + (size_t)(t + 2) * kstep; const char* b2 = last ? nB : cB + (size_t)(t + 2) * kstep;
            const char* a3 = a2 + kstep; const char* b3 = b2 + kstep;
            unsigned w0[2], w1[2];
            if constexpr (GATHER) {
#pragma unroll
                for (int i = 0; i < 2; ++i) { w0[i] = last ? gN0[i] : gA0[i]; w1[i] = last ? gN1[i] : gA1[i]; }
            }
            PG8_LDB(B0, 0, 0); PG8_LDB(B1, 0, 1); PG8_SCHED; PG8_LDA(At, 0, 0); PG8_STAGE_A(1, 1, a1, gA0, gA1);
            PG8_WAIT_V(8); PG8_WAIT_L(0); PG8_BAR; PG8_MMA(0, 0, At, B0); PG8_MMA(0, 1, At, B1); PG8_BAR; PG8_SCHED;
            PG8_LDA(At, 0, 1); PG8_STAGE(PG8_SB(0, 0), b2, voffB); PG8_STAGE(PG8_SB(0, 1), b2 + hstepB, voffB); PG8_STAGE_A(0, 0, a2, w0, w1);
            PG8_WAIT_V(8); PG8_WAIT_L(0); PG8_BAR; PG8_MMA(1, 0, At, B0); PG8_MMA(1, 1, At, B1); PG8_BAR; PG8_SCHED;
            PG8_LDB(B0, 1, 0); PG8_LDB(B1, 1, 1); PG8_SCHED; PG8_LDA(At, 1, 0); PG8_STAGE_A(0, 1, a2, w0, w1);
            PG8_WAIT_V(8); PG8_WAIT_L(0); PG8_BAR; PG8_MMA(0, 0, At, B0); PG8_MMA(0, 1, At, B1); PG8_BAR; PG8_SCHED;
            PG8_LDA(At, 1, 1); PG8_STAGE(PG8_SB(1, 0), b3, voffB); PG8_STAGE(PG8_SB(1, 1), b3 + hstepB, voffB); PG8_STAGE_A(1, 0, a3, w0, w1);
            PG8_WAIT_V(8); PG8_WAIT_L(0); PG8_BAR; PG8_MMA(1, 0, At, B0); PG8_MMA(1, 1, At, B1); PG8_BAR; PG8_SCHED;
        }
        if constexpr (ALIGN_EPI) { if (wr == 0) PG8_BAR; }
        E(acc, cur, wr, wc, fr, fq);
        if (!has_next) break;
#pragma unroll
        for (int a = 0; a < 2; ++a)
#pragma unroll
            for (int b = 0; b < 2; ++b)
#pragma unroll
                for (int m = 0; m < 4; ++m)
#pragma unroll
                    for (int n = 0; n < 2; ++n) acc[a][b][m][n] = (f32x4){0.f, 0.f, 0.f, 0.f};
        cur = nxt; cA = nA; cB = nB; ++ui;
        if constexpr (GATHER) {
#pragma unroll
            for (int i = 0; i < 2; ++i) { gA0[i] = gN0[i]; gA1[i] = gN1[i]; }
        }
        if constexpr (ALIGN_EPI) { if (wr == 1) PG8_BAR; }
    }
    PG8_WAIT_V(0);
    if constexpr (!ALIGN_EPI) { if (wr == 0) PG8_BAR; }
    PG8_BAR;
#undef PG8_SA
#undef PG8_SB
#undef PG8_STAGE
#undef PG8_STAGE_A
#undef PG8_LDA
#undef PG8_LDB
#undef PG8_MMA
#undef PG8_WAIT_V
#undef PG8_WAIT_L
#undef PG8_BAR
#undef PG8_SCHED
}
}
namespace pg8 {
struct DenseSched {
    static constexpr bool GATHER = false;
    const char* A; const char* B; int lda, ldb, nM, nN, nKS, Ksplit, G, c;
    __device__ __forceinline__ bool next(int i, Unit& u) const {
        int pm, pc; if (!static_tile(i, G, c, nM, nN * nKS, pm, pc)) return false;
        const int pn = pc / nKS, ks = pc - pn * nKS;
        u.pm = pm; u.pn = pn; u.aux = ks;
        u.A = A + ((size_t)pm * BM * lda + (size_t)ks * Ksplit) * 2;
        u.B = B + ((size_t)pn * BM * ldb + (size_t)ks * Ksplit) * 2;
        return true;
    }
    __device__ __forceinline__ unsigned arow(const Unit&, int r) const { return (unsigned)(r * lda) * 2u; }
};
struct GateSched {
    static constexpr bool GATHER = false;
    const char* A; const char* B; int G, c;
    __device__ __forceinline__ bool next(int i, Unit& u) const {
        int pm, pn; if (!static_tile(i, G, c, T / BM, 8, pm, pn)) return false;
        u.pm = pm; u.pn = pn; u.aux = 0;
        u.A = A + ((size_t)pm * BM * DRNN + (size_t)(pn >> 1) * 256) * 2;
        u.B = B + (size_t)pn * 256 * 256 * 2;
        return true;
    }
    __device__ __forceinline__ unsigned arow(const Unit&, int r) const { return (unsigned)(r * DRNN) * 2u; }
};
struct MoeUpSched {      static constexpr bool GATHER = true;
    const char* A; const char* B; const int* slot_tok; const LAS int* rtab; int nrt, G, c;
    __device__ __forceinline__ bool next(int i, Unit& u) const {
        const long L = (long)i * G + c; if (L >= (long)nrt * 4) return false;
        const int rt = (int)(L >> 2), pn = (int)(L & 3); const int e = rtab[2 * rt], row0 = rtab[2 * rt + 1];
        u.pm = row0 >> 8; u.pn = pn; u.aux = e; u.A = A;
        u.B = B + ((size_t)e * 1024 * D + (size_t)pn * BM * D) * 2;
        return true;
    }
    __device__ __forceinline__ unsigned arow(const Unit& u, int r) const { return (unsigned)slot_tok[u.pm * BM + r] * (unsigned)(D * 2); }
};
struct MoeDownSched {    static constexpr bool GATHER = false;
    const char* A; const char* B; const LAS int* rtab; int nrt, G, c;
    __device__ __forceinline__ bool next(int i, Unit& u) const {
        const long L = (long)i * G + c; if (L >= (long)nrt * 8) return false;
        const int rt = (int)(L >> 3), pn = (int)(L & 7); const int e = rtab[2 * rt], row0 = rtab[2 * rt + 1];
        u.pm = row0 >> 8; u.pn = pn; u.aux = e;
        u.A = A + (size_t)row0 * DE * 2;
        u.B = B + ((size_t)e * D * DE + (size_t)pn * BM * DE) * 2;
        return true;
    }
    __device__ __forceinline__ unsigned arow(const Unit&, int r) const { return (unsigned)(r * DE) * 2u; }
};

__device__ __forceinline__ void epi_ids(int& wr, int& wc, int& fr, int& fq) { int t = threadIdx.x; asm volatile("" : "+v"(t)); const int wid = t >> 6, lane = t & 63; wr = wid >> 2; wc = wid & 3; fr = lane & 15; fq = lane >> 4; }
template <int MODE, bool STAT> struct EpiBf16 {
    static constexpr bool PERM = true;
    bf16* O; int ldc; const void* rs; float inv_n; u64* stat_a; u64* stat_b; int stat_pn_a, stat_pn_b;
    __device__ __forceinline__ void operator()(const f32x4 (&acc)[2][2][4][2], const Unit& u, int, int, int, int) const {
        int wr, wc, fr, fq; epi_ids(wr, wc, fr, fq);
        int row0 = u.pm * BM + wr * 64 + fr; asm volatile("" : "+v"(row0)); const int col0 = u.pn * BM + wc * 32 + 8 * fq;
        u64* st = nullptr; if (STAT) st = (u.pn < stat_pn_a) ? stat_a : ((u.pn < stat_pn_b) ? stat_b : nullptr);
#pragma unroll
        for (int ai = 0; ai < 2; ++ai)
#pragma unroll
            for (int m = 0; m < 4; ++m) { const int row = row0 + ai * HALF + m * 16;
                float sc = 1.f;
                if (MODE == 0) sc = 1.0f / sqrtf(ssq_val((const u64*)rs, row) * inv_n + EPS); else if (MODE == 1) sc = ((const float*)rs)[row];
                bf16* rowp = O + (size_t)row * ldc + col0; float ss = 0.f;
#pragma unroll
                for (int bj = 0; bj < 2; ++bj) { const f32x4 v0 = acc[ai][bj][m][0] * sc, v1 = acc[ai][bj][m][1] * sc;
                    if (STAT) ss += (v0[0] * v0[0] + v0[1] * v0[1]) + (v0[2] * v0[2] + v0[3] * v0[3]) + (v1[0] * v1[0] + v1[1] * v1[1]) + (v1[2] * v1[2] + v1[3] * v1[3]);
                    u32x4 w; w.x = cvt_pk_bf16(v0[0], v0[1]); w.y = cvt_pk_bf16(v0[2], v0[3]); w.z = cvt_pk_bf16(v1[0], v1[1]); w.w = cvt_pk_bf16(v1[2], v1[3]);
                    *(u32x4*)(rowp + bj * HALF) = w; }
                if (STAT) { ss += __shfl_xor(ss, 16); ss += __shfl_xor(ss, 32); if (st != nullptr && fq == 0) ssq_add(st, row, ss); }
            }
    }
};
struct EpiF32Slab {
    static constexpr bool PERM = false;
    float* O; int ldc; size_t slab; const u64* rs; float inv_n;
    __device__ __forceinline__ void operator()(const f32x4 (&acc)[2][2][4][2], const Unit& u, int, int, int, int) const {
        int wr, wc, fr, fq; epi_ids(wr, wc, fr, fq);
        int row0 = u.pm * BM + wr * 64 + fr; asm volatile("" : "+v"(row0)); const int col0 = u.pn * BM + wc * 32 + 4 * fq; float* base = O + (size_t)u.aux * slab;
#pragma unroll
        for (int ai = 0; ai < 2; ++ai)
#pragma unroll
            for (int m = 0; m < 4; ++m) { const int row = row0 + ai * HALF + m * 16; const float sc = 1.0f / sqrtf(ssq_val(rs, row) * inv_n + EPS);
                float* rowp = base + (size_t)row * ldc + col0;
#pragma unroll
                for (int bj = 0; bj < 2; ++bj)
#pragma unroll
                    for (int n = 0; n < 2; ++n) *(f32x4*)(rowp + bj * HALF + n * 16) = acc[ai][bj][m][n] * sc; }
    }
};
template <bool SCALE> struct EpiResid {
    static constexpr bool PERM = false;
    const float* xin; float* xout; bf16* xb; u64* stat; const u64* ssq_a; const u64* ssq_b;
    __device__ __forceinline__ void mid(f32x4 (&acc)[2][2][4][2], const Unit& u, int, int, int, int) const {
        int wr, wc, fr, fq; epi_ids(wr, wc, fr, fq);
        int row0 = u.pm * BM + wr * 64 + fr; asm volatile("" : "+v"(row0));
#pragma unroll
        for (int ai = 0; ai < 2; ++ai)
#pragma unroll
            for (int m = 0; m < 4; ++m) { const int row = row0 + ai * HALF + m * 16;
                const float ra = 1.0f / sqrtf(ssq_val(ssq_a, row) * (1.0f / 1024.0f) + EPS), rb = 1.0f / sqrtf(ssq_val(ssq_b, row) * (1.0f / 1024.0f) + EPS); const float f = ra / rb;
#pragma unroll
                for (int bj = 0; bj < 2; ++bj)
#pragma unroll
                    for (int n = 0; n < 2; ++n) acc[ai][bj][m][n] = acc[ai][bj][m][n] * f; }
    }
    __device__ __forceinline__ void operator()(const f32x4 (&acc)[2][2][4][2], const Unit& u, int, int, int, int) const {
        int wr, wc, fr, fq; epi_ids(wr, wc, fr, fq);
        int row0 = u.pm * BM + wr * 64 + fr; asm volatile("" : "+v"(row0)); const int col0 = u.pn * BM + wc * 32 + 4 * fq;
#pragma unroll
        for (int ai = 0; ai < 2; ++ai)
#pragma unroll
            for (int m = 0; m < 4; ++m) { const int row = row0 + ai * HALF + m * 16;
                float sc = 1.f; if (SCALE) sc = 1.0f / sqrtf(ssq_val(ssq_b, row) * (1.0f / 1024.0f) + EPS);
                const size_t off = (size_t)row * D + col0; float ss = 0.f;
#pragma unroll
                for (int bj = 0; bj < 2; ++bj)
#pragma unroll
                    for (int n = 0; n < 2; ++n) { const f32x4 xi = *(const f32x4*)(xin + off + bj * HALF + n * 16); const f32x4 v = xi + acc[ai][bj][m][n] * sc;
                        *(f32x4*)(xout + off + bj * HALF + n * 16) = v;
                        u32x2 w; w.x = cvt_pk_bf16(v[0], v[1]); w.y = cvt_pk_bf16(v[2], v[3]); *(u32x2*)(xb + off + bj * HALF + n * 16) = w;
                        ss += (v[0] * v[0] + v[1] * v[1]) + (v[2] * v[2] + v[3] * v[3]); }
                ss += __shfl_xor(ss, 16); ss += __shfl_xor(ss, 32); if (fq == 0) ssq_add(stat, row, ss);
                asm volatile("" ::: "memory"); __builtin_amdgcn_sched_barrier(0);
            }
    }
};
struct EpiGates {
    static constexpr bool PERM = false;
    const bf16* xc; const float* b_rg; const float* b_ig; const float* sp; float* a_out; float* u_out;
    __device__ __forceinline__ void operator()(const f32x4 (&acc)[2][2][4][2], const Unit& u, int, int, int, int) const {
        int wr, wc, fr, fq; epi_ids(wr, wc, fr, fq);
        const unsigned row0 = (unsigned)(u.pm * BM + wr * 64 + fr);
        const GAS bf16* xg = (const GAS bf16*)xc; GAS float* ag = (GAS float*)a_out; GAS float* ug = (GAS float*)u_out;
#pragma unroll
        for (int n = 0; n < 2; ++n) { const unsigned ch = (unsigned)(u.pn * 128 + wc * 32 + n * 16 + 4 * fq);
            const f32x4 br = *(const GAS f32x4*)((const GAS float*)b_rg + ch), bi = *(const GAS f32x4*)((const GAS float*)b_ig + ch), s4 = *(const GAS f32x4*)((const GAS float*)sp + ch);
#pragma unroll
            for (int ai = 0; ai < 2; ++ai)
#pragma unroll
                for (int m = 0; m < 4; ++m) { const unsigned off = (row0 + (unsigned)(ai * HALF + m * 16)) * (unsigned)DRNN + ch;
                    const u32x2 xw = *(const GAS u32x2*)(xg + off); const float xv[4] = {bflo(xw.x), bfhi(xw.x), bflo(xw.y), bfhi(xw.y)};
                    const f32x4 pr = acc[ai][0][m][n] + br, pi = acc[ai][1][m][n] + bi; f32x4 av, uv;
#pragma unroll
                    for (int j = 0; j < 4; ++j) { const float r = __builtin_amdgcn_rcpf(1.0f + __expf(-pr[j])), ig = __builtin_amdgcn_rcpf(1.0f + __expf(-pi[j]));
                        const float la = -8.0f * r * s4[j]; const float a = __expf(la); const float x2 = 2.0f * la;
                        const float om = (x2 > -0.03125f) ? -x2 * (1.0f + x2 * (0.5f + x2 * (0.16666667f + x2 * 0.041666668f))) : 1.0f - a * a;
                        av[j] = a; uv[j] = __builtin_amdgcn_sqrtf(om) * (ig * xv[j]); }
                    *(GAS f32x4*)(ag + off) = av; *(GAS f32x4*)(ug + off) = uv; asm volatile("" ::: "memory"); __builtin_amdgcn_sched_barrier(0); }
        }
    }
};
struct EpiSwiglu {
    static constexpr bool PERM = true;
    bf16* O; const float* rs;
    __device__ __forceinline__ void operator()(const f32x4 (&acc)[2][2][4][2], const Unit& u, int, int, int, int) const {
        int wr, wc, fr, fq; epi_ids(wr, wc, fr, fq);
        int row0 = u.pm * BM + wr * 64 + fr; asm volatile("" : "+v"(row0)); const int col0 = u.pn * 128 + wc * 32 + 8 * fq;
#pragma unroll
        for (int ai = 0; ai < 2; ++ai)
#pragma unroll
            for (int m = 0; m < 4; ++m) { const int row = row0 + ai * HALF + m * 16; const float sc = rs[row]; float h[8];
#pragma unroll
                for (int n = 0; n < 2; ++n)
#pragma unroll
                    for (int j = 0; j < 4; ++j) { const float g = acc[ai][0][m][n][j] * sc, up = acc[ai][1][m][n][j] * sc; h[n * 4 + j] = g / (1.0f + __expf(-g)) * up; }
                u32x4 w; w.x = cvt_pk_bf16(h[0], h[1]); w.y = cvt_pk_bf16(h[2], h[3]); w.z = cvt_pk_bf16(h[4], h[5]); w.w = cvt_pk_bf16(h[6], h[7]);
                *(u32x4*)(O + (size_t)row * DE + col0) = w; }
    }
};
struct EpiRouter {
    static constexpr bool PERM = false;
    float* O;
    __device__ __forceinline__ void operator()(const f32x4 (&acc)[2][2][4][2], const Unit& u, int, int, int, int) const {
        int wr, wc, fr, fq; epi_ids(wr, wc, fr, fq);
        if (wc >= 2) return;
        int row0 = u.pm * BM + wr * 64 + fr; asm volatile("" : "+v"(row0)); const int col0 = wc * 32 + 4 * fq;
#pragma unroll
        for (int ai = 0; ai < 2; ++ai)
#pragma unroll
            for (int m = 0; m < 4; ++m) { const int row = row0 + ai * HALF + m * 16;
#pragma unroll
                for (int n = 0; n < 2; ++n) *(f32x4*)(O + (size_t)row * 64 + col0 + n * 16) = acc[ai][0][m][n]; }
    }
};
}
namespace att {
constexpr int NW = 8, QBLK = 32, KVBLK = 64, QB = NW * QBLK;
constexpr int SHM_V = KVBLK * 128 * 2, SHM_K = KVBLK * 128 * 2, SHM_R = KVBLK * 64 * 2;
constexpr int OFF_V = 0, OFF_K = 2 * SHM_V, OFF_R = OFF_K + 2 * SHM_K, OFF_WS = OFF_R + 2 * SHM_R, OFF_QR = OFF_WS + NW * 64 * 4, LDS_BYTES = OFF_QR + NW * 4 * 1024;
constexpr float THR = 8.f;

#define KSWZ(row, colB) ((row) * 256 + ((colB) ^ (((row) & 7) << 4)))
#define RSWZ(row, ch) ((row) * 128 + ((((ch) ^ (((row) >> 1) & 7))) << 4))
#define SBAR() __builtin_amdgcn_sched_barrier(0)
__device__ __forceinline__ int v_st(int k, int c) { const int kk = (k & ~0xC) | ((k & 4) << 1) | ((k & 8) >> 1); return ((kk >> 3) * 4 + (c >> 5)) * 512 + ((kk & 7) * 32 + (c & 31)) * 2; }
__device__ __forceinline__ int v_rd_base(int lane) { return ((lane & 3) << 3) | (((lane >> 2) & 3) << 6) | (((lane >> 4) & 1) << 5) | (((lane >> 5) & 1) << 8); }
constexpr int v_rd_off(int d0, int ks, int half) { return d0 * 512 + ks * 4096 + half * 2048; }
__device__ __forceinline__ int crow(int r, int hi) { return (r & 3) + 8 * (r >> 2) + 4 * hi; }
__device__ __forceinline__ unsigned cvtpk(float lo, float hi) { unsigned r; asm volatile("v_cvt_pk_bf16_f32 %0, %1, %2" : "=v"(r) : "v"(lo), "v"(hi)); return r; }
__device__ __forceinline__ bf16x8 load8(const bf16* p) { return *reinterpret_cast<const bf16x8*>(p); }

__device__ __forceinline__ void mask_tile(f32x16& p0, f32x16& p1, int dq) {
    const float NEG = -__builtin_inff();
#pragma unroll
    for (int r = 0; r < 16; ++r) {
        const int c = (r & 3) + 8 * (r >> 2);
        if (dq - c < 0) p0[r] = NEG;
        if (dq - c - 32 < 0) p1[r] = NEG;
    }
}
__device__ __forceinline__ void partialSM(f32x16& p0, f32x16& p1, float& m_reg, float& mn, float& alpha, const float SCALE) {
    float pmax = p0[0]; for (int r = 1; r < 16; ++r) pmax = fmaxf(pmax, p0[r]); for (int r = 0; r < 16; ++r) pmax = fmaxf(pmax, p1[r]);
    { auto rr = __builtin_amdgcn_permlane32_swap(__float_as_uint(pmax), __float_as_uint(pmax), false, false);
      pmax = fmaxf(__uint_as_float(rr[0]), __uint_as_float(rr[1])); }
    const float C2 = 1.4426950408889634f * SCALE;
    if (__builtin_expect(__all((pmax - m_reg) * SCALE <= THR), 1)) { mn = m_reg; alpha = 1.f; }
    else { mn = fmaxf(m_reg, pmax); alpha = __builtin_amdgcn_exp2f((m_reg - mn) * C2); m_reg = mn; }
    const float mnL = -mn * C2;
    for (int r = 0; r < 16; ++r) p0[r] = fmaf(p0[r], C2, mnL); for (int r = 0; r < 16; ++r) p1[r] = fmaf(p1[r], C2, mnL);
    for (int r = 0; r < 16; ++r) p0[r] = __builtin_amdgcn_exp2f(p0[r]);
}
__device__ __forceinline__ void finishSM(f32x16& p0, f32x16& p1, float alpha, float& l_reg, bf16x8& pa0, bf16x8& pa1, bf16x8& pa2, bf16x8& pa3) {
    for (int r = 0; r < 16; ++r) p1[r] = __builtin_amdgcn_exp2f(p1[r]);
    float ps = 0; for (int r = 0; r < 16; ++r) ps += p0[r]; for (int r = 0; r < 16; ++r) ps += p1[r];
    { auto rr = __builtin_amdgcn_permlane32_swap(__float_as_uint(ps), __float_as_uint(ps), false, false);
      ps = __uint_as_float(rr[0]) + __uint_as_float(rr[1]); }
    l_reg = l_reg * alpha + ps;
#define PK4(P, B_, OUT) do { unsigned a0 = cvtpk(P[B_+0], P[B_+1]), a1 = cvtpk(P[B_+2], P[B_+3]);                          \
        unsigned b0 = cvtpk(P[B_+4], P[B_+5]), b1 = cvtpk(P[B_+6], P[B_+7]);                                             \
        auto r0 = __builtin_amdgcn_permlane32_swap(a0, b0, false, false); auto r1 = __builtin_amdgcn_permlane32_swap(a1, b1, false, false); \
        u32x4 w = {r0[0], r1[0], r0[1], r1[1]}; OUT = *reinterpret_cast<bf16x8*>(&w); } while (0)
    PK4(p0, 0, pa0); PK4(p0, 8, pa1); PK4(p1, 0, pa2); PK4(p1, 8, pa3);
#undef PK4
}
template <int KB, int ROPE>
__device__ __forceinline__ void qkt(f32x16& p0, f32x16& p1, const char* lds, int r32_, int hi_, const bf16x8* qr, const char* qrl) {
    p0 = f32x16{}; p1 = f32x16{};
    int lane_ = r32_ | (hi_ << 5); asm volatile("" : "+v"(lane_)); const int r32 = lane_ & 31, hi = lane_ >> 5;
    const char* kb[4];
#pragma unroll
    for (int dd = 0; dd < 4; ++dd) kb[dd] = lds + OFF_K + KB * SHM_K + KSWZ(r32, (dd * 16 + hi * 8) * 2);
#pragma unroll
    for (int d0 = 0; d0 < 8; ++d0) { const char* a = kb[d0 & 3] + (d0 >> 2) * 128;
        bf16x8 b0 = *reinterpret_cast<const bf16x8*>(a);
        bf16x8 b1 = *reinterpret_cast<const bf16x8*>(a + 32 * 256);
        p0 = __builtin_amdgcn_mfma_f32_32x32x16_bf16(b0, qr[d0], p0, 0, 0, 0);
        p1 = __builtin_amdgcn_mfma_f32_32x32x16_bf16(b1, qr[d0], p1, 0, 0, 0); }
    if constexpr (ROPE > 0) {
#pragma unroll
        for (int d0 = 0; d0 < 4; ++d0) { const char* a = lds + OFF_R + KB * SHM_R + RSWZ(r32, d0 * 2 + hi);
            bf16x8 b0 = *reinterpret_cast<const bf16x8*>(a);
            bf16x8 b1 = *reinterpret_cast<const bf16x8*>(a + 32 * 128);
            const bf16x8 qf = *reinterpret_cast<const bf16x8*>(qrl + d0 * 1024);
            p0 = __builtin_amdgcn_mfma_f32_32x32x16_bf16(b0, qf, p0, 0, 0, 0);
            p1 = __builtin_amdgcn_mfma_f32_32x32x16_bf16(b1, qf, p1, 0, 0, 0); }
    }
}
template <int VB>
__device__ __forceinline__ void pv_tile(f32x16* o, int vb0, bf16x8 pa0, bf16x8 pa1, bf16x8 pa2, bf16x8 pa3) {
#define TRRD(dst, off) asm volatile("ds_read_b64_tr_b16 %0, %1 offset:%2" : "=&v"(dst) : "v"(vb0), "i"(off) : "memory")
#define PV_D0(d0) do { s16x4 l0, l1, l2, l3, h0, h1, h2, h3; constexpr int b_ = OFF_V + VB * SHM_V + v_rd_off(d0, 0, 0); \
        TRRD(l0, b_); TRRD(h0, b_ + 2048); TRRD(l1, b_ + 4096); TRRD(h1, b_ + 6144); TRRD(l2, b_ + 8192); TRRD(h2, b_ + 10240); TRRD(l3, b_ + 12288); TRRD(h3, b_ + 14336); \
        asm volatile("s_waitcnt lgkmcnt(0)" ::: "memory"); SBAR();   \
        o[d0] = __builtin_amdgcn_mfma_f32_32x32x16_bf16(pa0, (bf16x8){l0[0], l0[1], l0[2], l0[3], h0[0], h0[1], h0[2], h0[3]}, o[d0], 0, 0, 0);   \
        o[d0] = __builtin_amdgcn_mfma_f32_32x32x16_bf16(pa1, (bf16x8){l1[0], l1[1], l1[2], l1[3], h1[0], h1[1], h1[2], h1[3]}, o[d0], 0, 0, 0);   \
        o[d0] = __builtin_amdgcn_mfma_f32_32x32x16_bf16(pa2, (bf16x8){l2[0], l2[1], l2[2], l2[3], h2[0], h2[1], h2[2], h2[3]}, o[d0], 0, 0, 0);   \
        o[d0] = __builtin_amdgcn_mfma_f32_32x32x16_bf16(pa3, (bf16x8){l3[0], l3[1], l3[2], l3[3], h3[0], h3[1], h3[2], h3[3]}, o[d0], 0, 0, 0); } while (0)
    PV_D0(0); PV_D0(1); PV_D0(2); PV_D0(3);
#undef PV_D0
#undef TRRD
}

template <int LDQ, int LDK, int LDV, int LDO> struct Strides { static constexpr int ldq = LDQ, ldk = LDK, ldv = LDV, ldo = LDO; };
struct BlockRef { const bf16* Q; const bf16* K; const bf16* V; bf16* O; u64* ssq; int P0; int nk; };
template <int NQ> struct Seam { bf16x8 qr[8]; bf16x8 st_v0, st_v1, st_k0, st_k1, st_r; };

#define VMW() asm volatile("s_waitcnt vmcnt(0)" ::: "memory")
#define VMWN(n) asm volatile("s_waitcnt vmcnt(%0)" :: "i"(n) : "memory")
__device__ __forceinline__ int optid() { int t = threadIdx.x; asm volatile("" : "+v"(t)); return t; }
#define SLOAD_H(Kp, Vp, k0) do { const int t_ = optid(); const unsigned sr_ = t_ >> 4, sc_ = (t_ & 15) * 8, rr_ = t_ >> 3, rc_ = (t_ & 7) * 8;   \
                                 const bf16* kt_ = (Kp) + (size_t)(k0) * st.ldk; const bf16* vt_ = (Vp) + (size_t)(k0) * st.ldv;                    \
                                 S.st_v0 = load8(vt_ + (sr_ * st.ldv + sc_)); S.st_v1 = load8(vt_ + ((32 + sr_) * st.ldv + sc_));                   \
                                 S.st_k0 = load8(kt_ + (sr_ * st.ldk + sc_)); S.st_k1 = load8(kt_ + ((32 + sr_) * st.ldk + sc_));                   \
                                 if constexpr (ROPE > 0) S.st_r = load8(kt_ + (rr_ * st.ldk + 128 + rc_)); } while (0)
#define SWRITE_HK(bf) do { const int t_ = optid(); const int kws_ = KSWZ(t_ >> 4, (t_ & 15) * 16);                                                  \
                           *(bf16x8*)(lds + OFF_K + (bf) * SHM_K + kws_) = S.st_k0; *(bf16x8*)(lds + OFF_K + (bf) * SHM_K + kws_ + 32 * 256) = S.st_k1;   \
                           if constexpr (ROPE > 0) *(bf16x8*)(lds + OFF_R + (bf) * SHM_R + RSWZ(t_ >> 3, t_ & 7)) = S.st_r; } while (0)
#define SWRITE_HV(bf) do { const int t_ = optid(); const int sr_ = t_ >> 4, sc_ = (t_ & 15) * 8;                                                     \
                           *(bf16x8*)(lds + OFF_V + (bf) * SHM_V + v_st(sr_, sc_)) = S.st_v0; *(bf16x8*)(lds + OFF_V + (bf) * SHM_V + v_st(32 + sr_, sc_)) = S.st_v1; } while (0)
#define SWRITE_H(bf) do { SWRITE_HV(bf); SWRITE_HK(bf); } while (0)

template <int ROPE, class ST>
__device__ __forceinline__ void attn_prime(const BlockRef& cur, const ST& st, char* lds, Seam<8 + ROPE / 16>& S) {
    constexpr int NQ = 8 + ROPE / 16;
    int tid = threadIdx.x; asm volatile("" : "+v"(tid)); const int wid = __builtin_amdgcn_readfirstlane(tid >> 6), lane = tid & 63, r32 = lane & 31, hi = lane >> 5;
#pragma unroll
    for (int d0 = 0; d0 < 8; ++d0) S.qr[d0] = load8(cur.Q + (size_t)(wid * QBLK + r32) * st.ldq + d0 * 16 + hi * 8);
    if constexpr (ROPE > 0) {
#pragma unroll
        for (int d0 = 0; d0 < 4; ++d0) *(bf16x8*)(lds + OFF_QR + wid * 4096 + d0 * 1024 + lane * 16) = load8(cur.Q + (size_t)(wid * QBLK + r32) * st.ldq + 128 + d0 * 16 + hi * 8);
    }
    SLOAD_H(cur.K, cur.V, 0); VMW(); SWRITE_HK(0);
    __syncthreads();
}
template <int ROPE, bool CAUSAL, bool STAT, class ST>
__device__ __forceinline__ void attn_block(const BlockRef& cur, const BlockRef& nxt, const ST& st, const float SCALE, char* lds, Seam<8 + ROPE / 16>& S) {
    constexpr int NQ = 8 + ROPE / 16;
    int tid = threadIdx.x; asm volatile("" : "+v"(tid)); const int wid = __builtin_amdgcn_readfirstlane(tid >> 6), lane = tid & 63, r32 = lane & 31, hi = lane >> 5;
    const int NT = CAUSAL ? ((cur.P0 + QB - 1) / KVBLK + 1) : (cur.nk / KVBLK);
    const int qlo = cur.P0 + wid * QBLK, qm = qlo + r32 - 4 * hi;
    float* ws = (float*)(lds + OFF_WS) + wid * 64; float* li_l = ws, * al_l = ws + 32;
    float m_reg = -1e30f, l_reg = 0; f32x16 o[4] = {};
    const int vb0 = (int)(uintptr_t)lds + v_rd_base(lane);
    const bf16* Kh = cur.K; const bf16* Vh = cur.V;
    const char* qrl = lds + OFF_QR + wid * 4096 + lane * 16;
#define RESC(a) do { if (__any((a) < 1.f)) { if (hi == 0) al_l[r32] = (a); asm volatile("s_waitcnt lgkmcnt(0)" ::: "memory");              \
                     for (int d_ = 0; d_ < 4; ++d_) for (int r = 0; r < 16; ++r) o[d_][r] *= al_l[crow(r, hi)]; } } while (0)
#define KBASE(t) ((t) * KVBLK)
#define MASKT(P0_, P1_, t) do { if (CAUSAL) { const int kb_ = KBASE(t); if (kb_ + KVBLK - 1 > qlo) mask_tile(P0_, P1_, qm - kb_); } } while (0)
#define SEAM_K0() do { VMWN(8); SWRITE_HK(0); SBAR(); } while (0)
    f32x16 pA0, pA1, pB0, pB1; float mnA, mnB, alA, alB; bf16x8 pa0, pa1, pa2, pa3;
    SWRITE_HV(0); SBAR();
    if (NT > 1) { SLOAD_H(Kh, Vh, KBASE(1)); }
    SBAR(); qkt<0, ROPE>(pA0, pA1, lds, r32, hi, S.qr, qrl);
    MASKT(pA0, pA1, 0); partialSM(pA0, pA1, m_reg, mnA, alA, SCALE);
    if (NT > 1) { VMW(); SWRITE_H(1); }
    __syncthreads();
#define HALF_STEP(PX0, PX1, mnX, alX, PY0, PY1, alY, t, KB, VB, SB) do {                                                      \
        SBAR(); qkt<KB, ROPE>(PX0, PX1, lds, r32, hi, S.qr, qrl);                                                                  \
        finishSM(PY0, PY1, alY, l_reg, pa0, pa1, pa2, pa3); SBAR();                                                           \
        if ((t) + 1 < NT) { SLOAD_H(Kh, Vh, KBASE((t) + 1)); SBAR(); }                                                        \
        pv_tile<VB>(o, vb0, pa0, pa1, pa2, pa3); MASKT(PX0, PX1, (t)); partialSM(PX0, PX1, m_reg, mnX, alX, SCALE);           \
        __syncthreads();                                                                                                      \
        if ((t) + 1 < NT) { VMW(); SWRITE_H(SB); }                                                                            \
        RESC(alX); __syncthreads(); } while (0)
    for (int t = 1; t + 1 < NT; t += 2) {
        HALF_STEP(pB0, pB1, mnB, alB, pA0, pA1, alA, t, 1, 0, 0);
        HALF_STEP(pA0, pA1, mnA, alA, pB0, pB1, alB, t + 1, 0, 1, 1);
    }
    const bool even = (NT & 1) == 0;
    if (even) { SBAR(); qkt<1, ROPE>(pB0, pB1, lds, r32, hi, S.qr, qrl); SBAR(); }
    SLOAD_H(nxt.K, nxt.V, 0); SBAR();
#pragma unroll
    for (int d0 = 0; d0 < 8; ++d0) S.qr[d0] = load8(nxt.Q + (size_t)(wid * QBLK + r32) * st.ldq + d0 * 16 + hi * 8);
    SBAR();
    finishSM(pA0, pA1, alA, l_reg, pa0, pa1, pa2, pa3); SBAR();
    pv_tile<0>(o, vb0, pa0, pa1, pa2, pa3);
    if (even) { MASKT(pB0, pB1, NT - 1); partialSM(pB0, pB1, m_reg, mnB, alB, SCALE); __syncthreads(); RESC(alB);
        finishSM(pB0, pB1, alB, l_reg, pa0, pa1, pa2, pa3); SBAR(); pv_tile<1>(o, vb0, pa0, pa1, pa2, pa3); }
    SBAR(); SEAM_K0();
    if (hi == 0) li_l[r32] = l_reg; asm volatile("s_waitcnt lgkmcnt(0)" ::: "memory");
    float rli[16];
#pragma unroll
    for (int r = 0; r < 16; ++r) rli[r] = __builtin_amdgcn_rcpf(li_l[crow(r, hi)]);
    bf16* Ow = cur.O + (size_t)(wid * QBLK) * st.ldo;
#pragma unroll
    for (int r = 0; r < 16; ++r) { const int orow = crow(r, hi); float ss = 0.f;
#pragma unroll
        for (int d0 = 0; d0 < 4; ++d0) { const float v = o[d0][r] * rli[r]; ss += v * v;
            const float vn = __shfl_xor(v, 1);
            if ((r32 & 1) == 0) *(unsigned*)(Ow + (size_t)orow * st.ldo + d0 * 32 + r32) = cvtpk(v, vn); }
        if (STAT) { ss += __shfl_xor(ss, 1); ss += __shfl_xor(ss, 2); ss += __shfl_xor(ss, 4); ss += __shfl_xor(ss, 8); ss += __shfl_xor(ss, 16);
            if (r32 == 0) ssq_add(cur.ssq, wid * QBLK + orow, ss); } }
    if constexpr (ROPE > 0) {
#pragma unroll
        for (int d0 = 0; d0 < 4; ++d0) *(bf16x8*)(lds + OFF_QR + wid * 4096 + d0 * 1024 + lane * 16) = load8(nxt.Q + (size_t)(wid * QBLK + r32) * st.ldq + 128 + d0 * 16 + hi * 8);
    }
    __syncthreads();
#undef RESC
#undef KBASE
#undef MASKT
#undef SEAM_K0
#undef HALF_STEP
}
#undef VMW
#undef VMWN
#undef SLOAD_H
#undef SWRITE_HK
#undef SWRITE_HV
#undef SWRITE_H
}
constexpr size_t MiB = 1u << 20;
constexpr size_t WS_CTL = 0, WS_STAT = 1 * MiB, ZERO_BYTES = 3 * MiB;
constexpr size_t WS_TAB = 3 * MiB;
constexpr size_t WS_MEMB = 6 * MiB, WS_KVMEM = 8 * MiB, WS_KMEMN = 10 * MiB, WS_WMKV = 11 * MiB;
constexpr size_t WS_LOGIT = 20 * MiB, WS_MOE = 24 * MiB, WS_SCAN = 26 * MiB;
constexpr size_t WS_W = 28 * MiB;
constexpr size_t W_IN = 0, W_UQ = 12 * MiB, W_UKV = W_UQ + 3 * MiB / 2, W_G = W_UKV + MiB, W_OUT = W_G + MiB, W_MQ = W_OUT + 8 * MiB, W_MO = W_MQ + 2 * MiB, W_R = W_MO + 2 * MiB,
                 W_GU = W_R + MiB, W_D = W_GU + 128 * MiB, W_END = W_D + 64 * MiB;
constexpr size_t WS_XB = 250 * MiB, WS_R = 314 * MiB;
static_assert(WS_W + W_END <= WS_XB, "weights");
constexpr size_t R_Z = 0, R_Q = 96 * MiB, R_KVR = 144 * MiB, R_KK = 208 * MiB, R_XC = 256 * MiB, R_AA = 288 * MiB, R_UU = 352 * MiB, R_YMIX = 416 * MiB, R_END = 480 * MiB;
constexpr size_t R_QM = 0, R_QMN = 64 * MiB, R_OM = 80 * MiB;
constexpr size_t R_ACT = 0, R_Y = 40 * MiB;
constexpr size_t WS_END = WS_R + R_END;
constexpr int CW_BAR = 4096;
constexpr int CW_CNT = 16384;
enum { ST_X = 0, ST_CQ = 1, ST_CKV = 2, ST_YATT = 3, ST_YRNN = 4, ST_X1 = 5, ST_X2 = 6 };
constexpr int RING_BYTES = 131072, LDSCTL_OFF = RING_BYTES, LDS_BYTES = 147456;
constexpr int LC_BAR = 0, LC_NRT = 16, LC_RTAB = 64;

struct Params { const float* in[36]; float* out; unsigned char* ws; int ph_lo, ph_hi; };
static_assert(sizeof(Params) == 36 * 8 + 8 + 8 + 8, "Params layout");
typedef __attribute__((address_space(4))) const unsigned char kchar;
__device__ __forceinline__ kchar* karg_base() { kchar* ka = (kchar*)__builtin_amdgcn_kernarg_segment_ptr(); asm volatile("" : "+s"(ka)); return ka; }
__device__ __forceinline__ const float* in_ptr(const Params&, int i) { return (const float*)(*(GAS const float* const __attribute__((address_space(4)))*)(karg_base() + i * 8)); }
__device__ __forceinline__ float* out_ptr() { return (float*)(*(GAS float* const __attribute__((address_space(4)))*)(karg_base() + 288)); }
__device__ __forceinline__ unsigned char* ws_ptr() { return (unsigned char*)(*(GAS unsigned char* const __attribute__((address_space(4)))*)(karg_base() + 296)); }
__device__ __forceinline__ unsigned char* opaque_ptr(unsigned char*) { return ws_ptr(); }
enum { I_X = 0, I_MEM, I_MIXG, I_WIN, I_QLG, I_KVLG, I_WUQ, I_WUKV, I_AQG, I_AKG, I_CONVW, I_CONVB, I_WRG, I_BRG, I_WIG, I_BIG, I_LAM, I_AOG, I_ROG, I_WOUT, I_XNG, I_MNG, I_WMQ, I_WMK, I_WMV,
       I_MQG, I_MKG, I_WMO, I_MOEG, I_WRGRP, I_BRGRP, I_WREXP, I_BREXP, I_WEG, I_WEU, I_WED };

__device__ __forceinline__ int dmap(int map, int n) {
    if (map == 1) return n < 768 ? n : (n < 832 ? n + 2048 : n - 64);
    if (map == 2) return ((n >> 7) << 8) + (n & 127);
    if (map == 3) return ((n >> 7) << 8) + 128 + (n & 127);
    return n;
}
__device__ __forceinline__ void transpose_item(const float* W, int K, int Nsrc, bf16* WT, const float* gain, int map, LAS float* scr, int item, int lane) {
    const int nblk = Nsrc / 32, kb = item / nblk, nb = item % nblk, k0 = 64 * kb, n0 = 32 * nb;
#pragma unroll 8
    for (int i = 0; i < 32; ++i) { const int kk = 2 * i + (lane >> 5); float v = W[(size_t)(k0 + kk) * Nsrc + n0 + (lane & 31)]; if (gain) v *= gain[k0 + kk]; scr[kk * 33 + (lane & 31)] = v; }
    LDS_WAIT(); asm volatile("" ::: "memory");
    const int c = lane & 7; const int d0 = dmap(map, n0);
#pragma unroll
    for (int j = 0; j < 4; ++j) { const int n = (lane >> 3) + 8 * j; const LAS float* s = scr + (8 * c) * 33 + n;
        u32x4 o; o.x = pk2(s[0 * 33], s[1 * 33]); o.y = pk2(s[2 * 33], s[3 * 33]); o.z = pk2(s[4 * 33], s[5 * 33]); o.w = pk2(s[6 * 33], s[7 * 33]);
        *(u32x4*)(WT + (size_t)(d0 + n) * K + k0 + 8 * c) = o; }
    LDS_WAIT(); asm volatile("" ::: "memory");
}
__device__ __forceinline__ void convert_layer_weights(const Params& p, int l, LAS float* scr, int gw, int NGW, int lane, int gtid, int NGT) {
    unsigned char* wb = opaque_ptr(p.ws) + WS_W;
    constexpr int I0 = 32 * 90, I1 = 8 * 48, I2 = 4 * 64, I3 = 32 * 64, I4 = 32 * 16, I5 = 8 * 64, IE = 32 * 16, IEX = 32 * IE, ID = 8 * 64, IDX = 32 * ID;
    constexpr int NIT = I0 + I1 + I2 + I3 + I4 + I5 + 2 * IEX + IDX;
    for (int it = gw; it < NIT; it += NGW) {
        int r = it;
        if (r < I0) { transpose_item(in_ptr(p, I_WIN) + (size_t)l * D * 2880, D, 2880, (bf16*)(wb + W_IN), in_ptr(p, I_MIXG) + l * D, 1, scr, r, lane); continue; } r -= I0;
        if (r < I1) { transpose_item(in_ptr(p, I_WUQ) + (size_t)l * QL * NQU, QL, NQU, (bf16*)(wb + W_UQ), in_ptr(p, I_QLG) + l * QL, 0, scr, r, lane); continue; } r -= I1;
        if (r < I2) { transpose_item(in_ptr(p, I_WUKV) + (size_t)l * KVL * NKV, KVL, NKV, (bf16*)(wb + W_UKV), in_ptr(p, I_KVLG) + l * KVL, 0, scr, r, lane); continue; } r -= I2;
        if (r < I3) { const int k0 = 64 * (r / 64); const float* g = (k0 < 1024) ? (in_ptr(p, I_AOG) + l * 1024) : (in_ptr(p, I_ROG) + l * 1024 - 1024);
                      transpose_item(in_ptr(p, I_WOUT) + (size_t)l * D * D, D, D, (bf16*)(wb + W_OUT), g, 0, scr, r, lane); continue; } r -= I3;
        if (r < I4) { transpose_item(in_ptr(p, I_WMQ) + (size_t)l * D * DMA, D, DMA, (bf16*)(wb + W_MQ), in_ptr(p, I_XNG) + l * D, 0, scr, r, lane); continue; } r -= I4;
        if (r < I5) { transpose_item(in_ptr(p, I_WMO) + (size_t)l * DMA * D, DMA, D, (bf16*)(wb + W_MO), nullptr, 0, scr, r, lane); continue; } r -= I5;
        if (r < IEX) { const int e = r / IE; transpose_item(in_ptr(p, I_WEG) + ((size_t)l * NE + e) * D * DE, D, DE, (bf16*)(wb + W_GU) + (size_t)e * 1024 * D, in_ptr(p, I_MOEG) + l * D, 2, scr, r % IE, lane); continue; } r -= IEX;
        if (r < IEX) { const int e = r / IE; transpose_item(in_ptr(p, I_WEU) + ((size_t)l * NE + e) * D * DE, D, DE, (bf16*)(wb + W_GU) + (size_t)e * 1024 * D, in_ptr(p, I_MOEG) + l * D, 3, scr, r % IE, lane); continue; } r -= IEX;
        { const int e = r / ID; transpose_item(in_ptr(p, I_WED) + ((size_t)l * NE + e) * DE * D, DE, D, (bf16*)(wb + W_D) + (size_t)e * D * DE, nullptr, 0, scr, r % ID, lane); }
    }
    { u32x4* z = (u32x4*)((bf16*)(wb + W_IN) + (size_t)2880 * D); const int n16 = 192 * D * 2 / 16; for (int i = gtid; i < n16; i += NGT) z[i] = (u32x4){0u, 0u, 0u, 0u}; }
    { bf16* wr = (bf16*)(wb + W_R); const float* wg = in_ptr(p, I_WRGRP) + (size_t)l * D * 4; const float* we = in_ptr(p, I_WREXP) + (size_t)l * D * 32; const float* g = in_ptr(p, I_MOEG) + l * D;
      for (int i = gtid; i < 256 * D / 8; i += NGT) { const int n = i / (D / 8), k0 = (i % (D / 8)) * 8; float v[8];
#pragma unroll
          for (int j = 0; j < 8; ++j) { const int k = k0 + j; v[j] = n < 4 ? wg[k * 4 + n] * g[k] : (n < 36 ? we[k * 32 + (n - 4)] * g[k] : 0.f); }
          u32x4 o; o.x = pk2(v[0], v[1]); o.y = pk2(v[2], v[3]); o.z = pk2(v[4], v[5]); o.w = pk2(v[6], v[7]); *(u32x4*)(wr + (size_t)n * D + k0) = o; } }
    { bf16* wg = (bf16*)(wb + W_G); const float* wr = in_ptr(p, I_WRG) + (size_t)l * 8 * 128 * 128; const float* wi = in_ptr(p, I_WIG) + (size_t)l * 8 * 128 * 128;
      for (int i = gtid; i < 8 * 256 * 256 / 8; i += NGT) { const int n = i >> 13, j = (i >> 5) & 255, c0 = (i & 31) * 8; float v[8];
          const bool on = (c0 >> 7) == (n & 1); const float* src = (j < 128 ? wr : wi) + (size_t)n * 128 * 128 + (j & 127);
#pragma unroll
          for (int q = 0; q < 8; ++q) v[q] = on ? src[(size_t)((c0 & 127) + q) * 128] : 0.f;
          u32x4 o; o.x = pk2(v[0], v[1]); o.y = pk2(v[2], v[3]); o.z = pk2(v[4], v[5]); o.w = pk2(v[6], v[7]); *(u32x4*)(wg + (size_t)i * 8) = o; } }
}
__device__ __forceinline__ float row_to_bf16(const float* xrow, bf16* orow, int lane) {
    float ss = 0.f;
#pragma unroll
    for (int j = 0; j < 4; ++j) { const int c = lane * 8 + 512 * j; const f32x4 a = *(const f32x4*)(xrow + c), b = *(const f32x4*)(xrow + c + 4);
        ss += (a[0] * a[0] + a[1] * a[1]) + (a[2] * a[2] + a[3] * a[3]) + (b[0] * b[0] + b[1] * b[1]) + (b[2] * b[2] + b[3] * b[3]);
        u32x4 o; o.x = pk2(a[0], a[1]); o.y = pk2(a[2], a[3]); o.z = pk2(b[0], b[1]); o.w = pk2(b[2], b[3]); *(u32x4*)(orow + c) = o; }
    return wave_sum(ss);
}
__device__ __forceinline__ float gelu_tanh(float x) { const float y = 0.7978845608028654f * (x + 0.044715f * x * x * x); const float e = __expf(2.0f * y); const float th = 1.0f - 2.0f / (e + 1.0f); return 0.5f * x * (1.0f + th); }
__device__ __forceinline__ void unpack8(u32x4 w, float* v) { v[0] = bflo(w.x); v[1] = bfhi(w.x); v[2] = bflo(w.y); v[3] = bfhi(w.y); v[4] = bflo(w.z); v[5] = bfhi(w.z); v[6] = bflo(w.w); v[7] = bfhi(w.w); }
__device__ __forceinline__ u32x4 pack8f(const float* v) { u32x4 o; o.x = pk2(v[0], v[1]); o.y = pk2(v[2], v[3]); o.z = pk2(v[4], v[5]); o.w = pk2(v[6], v[7]); return o; }

__device__ __forceinline__ void conv_phase(const bf16* z, bf16* xc, const float* cw, const float* cb, int gtid, int NGT) {
    for (int it = gtid; it < (T / 16) * 128; it += NGT) {
        const int tb = it >> 7, cg = it & 127, row0 = tb * 16, s0 = row0 & (SEQ - 1), c0 = cg * 8;
        float w[4][8], b[8], p1[8], p2[8], p3[8];
#pragma unroll
        for (int j = 0; j < 4; ++j) { const f32x4 a = *(const f32x4*)(cw + j * DRNN + c0), bb = *(const f32x4*)(cw + j * DRNN + c0 + 4);
            w[j][0] = a[0]; w[j][1] = a[1]; w[j][2] = a[2]; w[j][3] = a[3]; w[j][4] = bb[0]; w[j][5] = bb[1]; w[j][6] = bb[2]; w[j][7] = bb[3]; }
        { const f32x4 a = *(const f32x4*)(cb + c0), bb = *(const f32x4*)(cb + c0 + 4); b[0] = a[0]; b[1] = a[1]; b[2] = a[2]; b[3] = a[3]; b[4] = bb[0]; b[5] = bb[1]; b[6] = bb[2]; b[7] = bb[3]; }
        const bf16* zp = z + (size_t)row0 * ZC + Z_XR + c0;
        if (s0 >= 1) unpack8(*(const u32x4*)(zp - (size_t)ZC), p1); else { for (int e = 0; e < 8; ++e) p1[e] = 0.f; }
        if (s0 >= 2) unpack8(*(const u32x4*)(zp - (size_t)2 * ZC), p2); else { for (int e = 0; e < 8; ++e) p2[e] = 0.f; }
        if (s0 >= 3) unpack8(*(const u32x4*)(zp - (size_t)3 * ZC), p3); else { for (int e = 0; e < 8; ++e) p3[e] = 0.f; }
#pragma unroll 4
        for (int r = 0; r < 16; ++r) { float cur[8], o[8]; unpack8(*(const u32x4*)(zp + (size_t)r * ZC), cur);
#pragma unroll
            for (int e = 0; e < 8; ++e) { o[e] = b[e] + w[3][e] * cur[e] + w[2][e] * p1[e] + w[1][e] * p2[e] + w[0][e] * p3[e]; p3[e] = p2[e]; p2[e] = p1[e]; p1[e] = cur[e]; }
            *(u32x4*)(xc + (size_t)(row0 + r) * DRNN + c0) = pack8f(o); }
    }
}
__device__ __forceinline__ void qk_post_phase(bf16* q, const bf16* kvr, const bf16* z, bf16* kk, const float* gq, const float* gk, const float* cosT, const float* sinT, int gw, int NGW, int lane) {
    const int h = lane >> 3, j = lane & 7;
    for (int row = gw; row < T; row += NGW) {
        const int s = row & (SEQ - 1);
        float cs[8], sn[8];
        { const int i0 = (j & 3) * 8; const f32x4 a = *(const f32x4*)(cosT + s * 32 + i0), b = *(const f32x4*)(cosT + s * 32 + i0 + 4), c = *(const f32x4*)(sinT + s * 32 + i0), d = *(const f32x4*)(sinT + s * 32 + i0 + 4);
          cs[0] = a[0]; cs[1] = a[1]; cs[2] = a[2]; cs[3] = a[3]; cs[4] = b[0]; cs[5] = b[1]; cs[6] = b[2]; cs[7] = b[3];
          sn[0] = c[0]; sn[1] = c[1]; sn[2] = c[2]; sn[3] = c[3]; sn[4] = d[0]; sn[5] = d[1]; sn[6] = d[2]; sn[7] = d[3]; }
#pragma unroll
        for (int which = 0; which < 2; ++which) {
            float v[3][8];
            if (which == 0) { bf16* qp = q + (size_t)row * NQU + h * QKH + j * 8;
#pragma unroll
                for (int i = 0; i < 3; ++i) unpack8(*(const u32x4*)(qp + 64 * i), v[i]); }
            else { const bf16* kp = kvr + (size_t)row * NKV + h * 256 + j * 8; unpack8(*(const u32x4*)kp, v[0]); unpack8(*(const u32x4*)(kp + 64), v[1]);
                   unpack8(*(const u32x4*)(z + (size_t)row * ZC + Z_KPE + j * 8), v[2]); }
            float ss = 0.f;
#pragma unroll
            for (int i = 0; i < 3; ++i)
#pragma unroll
                for (int e = 0; e < 8; ++e) ss += v[i][e] * v[i][e];
            ss += __shfl_xor(ss, 1); ss += __shfl_xor(ss, 2); ss += __shfl_xor(ss, 4);
            const float rstd = 1.0f / sqrtf(ss * (1.0f / 192.0f) + EPS);
            const float* g = which == 0 ? gq : gk;
#pragma unroll
            for (int i = 0; i < 3; ++i) { const f32x4 ga = *(const f32x4*)(g + 64 * i + j * 8), gb = *(const f32x4*)(g + 64 * i + j * 8 + 4);
                v[i][0] *= rstd * ga[0]; v[i][1] *= rstd * ga[1]; v[i][2] *= rstd * ga[2]; v[i][3] *= rstd * ga[3]; v[i][4] *= rstd * gb[0]; v[i][5] *= rstd * gb[1]; v[i][6] *= rstd * gb[2]; v[i][7] *= rstd * gb[3]; }
#pragma unroll
            for (int e = 0; e < 8; ++e) { const float mine = v[2][e], oth = __shfl_xor(mine, 4);
                v[2][e] = (j < 4) ? (mine * cs[e] - oth * sn[e]) : (oth * sn[e] + mine * cs[e]); }
            bf16* op = (which == 0 ? q + (size_t)row * NQU : kk + (size_t)row * NQU) + h * QKH + j * 8;
#pragma unroll
            for (int i = 0; i < 3; ++i) *(u32x4*)(op + 64 * i) = pack8f(v[i]);
        }
    }
}
template <bool F32IN>
__device__ __forceinline__ void head128_norm_rows(const void* in0, const float* in1, int ld_in, bf16* out, const float* g, int nrows, int gw, int NGW, int lane) {
    for (int row = gw; row < nrows; row += NGW) {
        float v[8];
        if (F32IN) { const float* a = (const float*)in0 + (size_t)row * ld_in + lane * 8; const float* b = in1 + (size_t)row * ld_in + lane * 8;
            const f32x4 a0 = *(const f32x4*)a, a1 = *(const f32x4*)(a + 4), b0 = *(const f32x4*)b, b1 = *(const f32x4*)(b + 4);
            v[0] = a0[0] + b0[0]; v[1] = a0[1] + b0[1]; v[2] = a0[2] + b0[2]; v[3] = a0[3] + b0[3]; v[4] = a1[0] + b1[0]; v[5] = a1[1] + b1[1]; v[6] = a1[2] + b1[2]; v[7] = a1[3] + b1[3]; }
        else unpack8(*(const u32x4*)((const bf16*)in0 + (size_t)row * ld_in + lane * 8), v);
        float ss = 0.f;
#pragma unroll
        for (int e = 0; e < 8; ++e) ss += v[e] * v[e];
        ss += __shfl_xor(ss, 1); ss += __shfl_xor(ss, 2); ss += __shfl_xor(ss, 4); ss += __shfl_xor(ss, 8);
        const float rstd = 1.0f / sqrtf(ss * (1.0f / 128.0f) + EPS);
        const int c = (lane * 8) & 127; const f32x4 ga = *(const f32x4*)(g + c), gb = *(const f32x4*)(g + c + 4);
        v[0] *= rstd * ga[0]; v[1] *= rstd * ga[1]; v[2] *= rstd * ga[2]; v[3] *= rstd * ga[3]; v[4] *= rstd * gb[0]; v[5] *= rstd * gb[1]; v[6] *= rstd * gb[2]; v[7] *= rstd * gb[3];
        *(u32x4*)(out + (size_t)row * DMA + lane * 8) = pack8f(v);
    }
}
__device__ __forceinline__ void scan_pass1(const float* aa, const float* uu, float* cA, float* cH, int unit, int tid) {
    const int half = unit & 1, chunk = (unit >> 1) & 63, b = unit >> 7, ch = half * 512 + tid;
    const size_t base = ((size_t)b * SEQ + (size_t)chunk * 128) * DRNN + ch;
    float A = 1.f, H = 0.f;
#pragma unroll 16
    for (int s = 0; s < 128; ++s) { const float a = aa[base + (size_t)s * DRNN], u = uu[base + (size_t)s * DRNN]; H = a * H + u; A *= a; }
    cA[(size_t)(b * 64 + chunk) * DRNN + ch] = A; cH[(size_t)(b * 64 + chunk) * DRNN + ch] = H;
}
__device__ __forceinline__ void scan_pass3(const float* aa, const float* uu, const float* cA, const float* cH, const bf16* z, bf16* ymix, u64* ssq, int unit, int tid, int lane) {
    const int half = unit & 1, chunk = (unit >> 1) & 63, b = unit >> 7, ch = half * 512 + tid;
    float h = 0.f;
    for (int j = 0; j < chunk; ++j) h = cA[(size_t)(b * 64 + j) * DRNN + ch] * h + cH[(size_t)(b * 64 + j) * DRNN + ch];
    const size_t row0 = (size_t)b * SEQ + (size_t)chunk * 128;
#pragma unroll 8
    for (int s = 0; s < 128; ++s) { const size_t row = row0 + s; const float a = aa[row * DRNN + ch], u = uu[row * DRNN + ch]; h = a * h + u;
        const float g = bf2f(z[row * ZC + Z_GATE + ch]); const float y = h * gelu_tanh(g);
        ymix[row * D + DATT + ch] = (bf16)f2bf(y);
        const float ss = wave_sum(y * y); if (lane == 0) ssq_add(ssq, (int)row, ss); }
}
__device__ __forceinline__ void route_phase(const float* logits, const u64* ssq_x2, const float* bg, const float* be, int* tok_e, float* tok_w, int* whist, unsigned* cnt, LAS int* hist, int wg, int tid) {
    if (tid < 32) hist[tid] = 0;
    __syncthreads();
    if (tid < 64) { const int t = wg * 64 + tid; const float rs = 1.0f / sqrtf(ssq_val(ssq_x2, t) * (1.0f / D) + EPS); const float* lp = logits + (size_t)t * 64;
        float lg[4]; int g = 0; float mx = -3.0e38f;
#pragma unroll
        for (int i = 0; i < 4; ++i) { lg[i] = lp[i] * rs + bg[i]; if (lg[i] > mx) { mx = lg[i]; g = i; } }
        float den = 0.f;
#pragma unroll
        for (int i = 0; i < 4; ++i) den += __expf(lg[i] - mx);
        const float gw = 1.0f / den;
        float l1 = -3.0e38f, l2 = -3.0e38f; int j1 = 0, j2 = 0;
        for (int i = 0; i < 8; ++i) { const float v = lp[4 + g * 8 + i] * rs + be[g * 8 + i];
            if (v > l1) { l2 = l1; j2 = j1; l1 = v; j1 = i; } else if (v > l2) { l2 = v; j2 = i; } }
        const float w1 = 1.0f / (1.0f + __expf(l2 - l1)), w2 = 1.0f - w1;
        const int e1 = g * 8 + j1, e2 = g * 8 + j2;
        tok_e[t * 2] = e1; tok_e[t * 2 + 1] = e2; tok_w[t * 2] = gw * w1; tok_w[t * 2 + 1] = gw * w2;
        __hip_atomic_fetch_add(hist + e1, 1, __ATOMIC_RELAXED, __HIP_MEMORY_SCOPE_WORKGROUP); __hip_atomic_fetch_add(hist + e2, 1, __ATOMIC_RELAXED, __HIP_MEMORY_SCOPE_WORKGROUP);
    }
    __syncthreads();
    if (tid < 32) { const int c = hist[tid]; whist[wg * 32 + tid] = c; if (c) atomicAdd(cnt + tid, (unsigned)c); }
}
__device__ __forceinline__ void dispatch_phase(const unsigned* cnt, const int* whist, const int* tok_e, const float* tok_w, const u64* ssq_x2, int* tok_slot, int* slot_tok, float* slot_w, float* slot_rs,
                                               LAS int* sc, int wg, int tid) {
    if (tid == 0) { int seg = 0; for (int e = 0; e < 32; ++e) { sc[e] = seg; seg += (((int)cnt[e] + 255) >> 8) << 8; } }
    { const int e = tid & 31, part = tid >> 5; int s = 0; for (int w = part; w < wg; w += 16) s += whist[w * 32 + e]; sc[64 + tid] = s; }
    if (tid < 128) sc[640 + tid] = tok_e[(wg * 64) * 2 + tid];
    __syncthreads();
    if (tid < 32) { int s = sc[tid]; for (int p = 0; p < 16; ++p) s += sc[64 + p * 32 + tid]; sc[32 + tid] = s; }
    __syncthreads();
    if (tid < 128) { const int e = sc[640 + tid]; int rank = 0; for (int j = 0; j < tid; ++j) rank += (sc[640 + j] == e) ? 1 : 0;
        const int slot = sc[32 + e] + rank; const int t = wg * 64 + (tid >> 1);
        slot_tok[slot] = t; slot_w[slot] = tok_w[(wg * 64) * 2 + tid]; slot_rs[slot] = 1.0f / sqrtf(ssq_val(ssq_x2, t) * (1.0f / D) + EPS); tok_slot[(wg * 64) * 2 + tid] = slot; }
    if (wg < 32) { const int c = (int)cnt[wg], lo = sc[wg] + c, hi = sc[wg] + (((c + 255) >> 8) << 8);
        for (int s = lo + tid; s < hi; s += NTHREADS) { slot_tok[s] = 0; slot_w[s] = 0.f; slot_rs[s] = 0.f; } }
    __syncthreads();
}
__device__ __forceinline__ int build_rtab(const unsigned* cnt, LAS int* lc, int tid) {
    if (tid == 0) { int seg = 0, k = 0; for (int e = 0; e < 32; ++e) { const int nt = ((int)cnt[e] + 255) >> 8; for (int r = 0; r < nt; ++r) { lc[LC_RTAB / 4 + 2 * k] = e; lc[LC_RTAB / 4 + 2 * k + 1] = seg + r * 256; ++k; } seg += nt * 256; } lc[LC_NRT / 4] = k; }
    __syncthreads();
    return lc[LC_NRT / 4];
}
__device__ __forceinline__ void combine_phase(float* x, const bf16* Y, const int* tok_slot, bf16* xb, u64* ssq_next, int gw, int NGW, int lane) {
    for (int row = gw; row < T; row += NGW) {
        const int s0 = tok_slot[row * 2], s1 = tok_slot[row * 2 + 1]; float ss = 0.f;
#pragma unroll
        for (int j = 0; j < 4; ++j) { const int c = lane * 8 + 512 * j; float* xp = x + (size_t)row * D + c;
            const f32x4 a = *(const f32x4*)xp, b = *(const f32x4*)(xp + 4); float y0[8], y1[8], v[8];
            unpack8(*(const u32x4*)(Y + (size_t)s0 * D + c), y0); unpack8(*(const u32x4*)(Y + (size_t)s1 * D + c), y1);
            v[0] = a[0] + y0[0] + y1[0]; v[1] = a[1] + y0[1] + y1[1]; v[2] = a[2] + y0[2] + y1[2]; v[3] = a[3] + y0[3] + y1[3];
            v[4] = b[0] + y0[4] + y1[4]; v[5] = b[1] + y0[5] + y1[5]; v[6] = b[2] + y0[6] + y1[6]; v[7] = b[3] + y0[7] + y1[7];
            *(f32x4*)xp = (f32x4){v[0], v[1], v[2], v[3]}; *(f32x4*)(xp + 4) = (f32x4){v[4], v[5], v[6], v[7]};
            if (xb) *(u32x4*)(xb + (size_t)row * D + c) = pack8f(v);
#pragma unroll
            for (int e = 0; e < 8; ++e) ss += v[e] * v[e]; }
        ss = wave_sum(ss); if (ssq_next && lane == 0) ssq_set(ssq_next, row, ss);
    }
}
constexpr int NPL = 16, NPHASES = 1 + DEPTH * NPL;
__device__ __forceinline__ att::BlockRef mla_ref(int it, int pass, bf16* qbuf, bf16* kk, bf16* kvr, bf16* ymix, u64* ssq_ya) {
    const int bh = (it & 7) * 2 + ((it >> 3) >> 4), y = (it >> 3) & 15, b = bh >> 3, h = bh & 7; const int qb = pass ? 31 - y : y; const size_t r0 = (size_t)b * SEQ;
    att::BlockRef c; c.K = kk + r0 * NQU + h * QKH; c.V = kvr + r0 * NKV + h * 256 + 128; c.nk = SEQ;
    c.Q = qbuf + (r0 + (size_t)qb * 256) * NQU + h * QKH; c.O = ymix + (r0 + (size_t)qb * 256) * D + h * VH; c.ssq = ssq_ya + r0 + qb * 256; c.P0 = qb * 256; return c;
}
#ifndef PH_MASK
#define PH_MASK 0x1ffff
#endif
#define PH_ON(j) (((PH_MASK) >> (j)) & 1)
__global__ void __launch_bounds__(NTHREADS, 2) fwd_kernel(Params p) {
    extern __shared__ __attribute__((aligned(16))) unsigned char lds_raw[];
    LAS unsigned char* lds = (LAS unsigned char*)lds_raw;
    LAS int* lc = (LAS int*)(lds + LDSCTL_OFF);
    const int G = gridDim.x, bx = blockIdx.x;
    const int NGW = G * NWAVES, NGT = G * NTHREADS;
    if (threadIdx.x < 64) lc[threadIdx.x] = 0;
    __syncthreads();
    XcdBarrier bar = xcd_barrier_post((unsigned*)(ws_ptr() + WS_CTL) + CW_BAR, (volatile LAS unsigned*)(lds + LDSCTL_OFF + LC_BAR));
    const int lo = p.ph_lo, hi = p.ph_hi;
#define IN(k) (lo <= (k) && (k) < hi)
#define SEAM(k) do { if ((k) + 1 < hi) xcd_barrier(bar); } while (0)
#define WS_PTRS() unsigned char* ws = opaque_ptr(p.ws); unsigned char* wb = ws + WS_W; unsigned char* rg = ws + WS_R; (void)wb; (void)rg; \
    int tid = threadIdx.x; asm volatile("" : "+v"(tid)); const int lane = tid & 63, wave = __builtin_amdgcn_readfirstlane(tid >> 6); \
    const int gw = bx * NWAVES + wave, gtid = bx * NTHREADS + tid; (void)lane; (void)gw; (void)gtid
#define INP(i) in_ptr(p, (i))
#define STATP(l, k) ((u64*)(ws + WS_STAT) + (size_t)((l) * 7 + (k)) * 16384)

    if (PH_ON(0) && IN(0)) {
        WS_PTRS();
        float* cosT = (float*)(ws + WS_TAB); float* sinT = cosT + SEQ * 32; float* spT = (float*)(ws + WS_TAB + 2 * MiB); u64* ssq_mem = (u64*)(spT + 2 * 1024);
        bf16* memb = (bf16*)(ws + WS_MEMB); bf16* wmkv = (bf16*)(ws + WS_WMKV); bf16* xb = (bf16*)(ws + WS_XB);
        LAS float* scr = (LAS float*)(lds + wave * 16384);
        convert_layer_weights(p, 0, scr, gw, NGW, lane, gtid, NGT);
        for (int it = gw; it < 2 * 2 * 32 * 16; it += NGW) { const int l = it / (2 * 512), r = it % (2 * 512), kv = r / 512, item = r % 512;
            transpose_item(INP(kv ? I_WMV : I_WMK) + (size_t)l * D * DMA, D, DMA, wmkv + (size_t)l * 1024 * D + (size_t)kv * 512 * D, INP(I_MNG) + l * D, 0, scr, item, lane); }
        for (int i = gtid; i < SEQ * 32; i += NGT) { const int t = i >> 5, k = i & 31; const float inv = exp2f(-(float)k * (13.287712379549449f / 32.0f)); float s, c; sincosf((float)t * inv, &s, &c); cosT[i] = c; sinT[i] = s; }
        { const float* lam = INP(I_LAM); for (int i = gtid; i < 2 * 1024; i += NGT) spT[i] = log1pf(expf(-lam[i])); }
        u64* ssq_x0 = STATP(0, ST_X);
        { const float* x = INP(I_X); for (int row = gw; row < T; row += NGW) { const float ss = row_to_bf16(x + (size_t)row * D, xb + (size_t)row * D, lane); if (lane == 0) ssq_set(ssq_x0, row, ss); } }
        { const float* m = INP(I_MEM); for (int row = gw; row < TM; row += NGW) { const float ss = row_to_bf16(m + (size_t)row * D, memb + (size_t)row * D, lane); if (lane == 0) ssq_set(ssq_mem, row, ss); } }
        SEAM(0);
    }

    for (int l = 0; l < DEPTH; ++l) {
        const int pb = 1 + l * NPL;

        if (PH_ON(1) && IN(pb + 0)) {
            WS_PTRS();
            { pg8::DenseSched S{(const char*)(ws + WS_XB), (const char*)(wb + W_IN), D, D, T / 256, ZC / 256, 1, D, G, bx};
              pg8::EpiBf16<0, true> E{(bf16*)(rg + R_Z), ZC, STATP(l, ST_X), 1.0f / D, STATP(l, ST_CQ), STATP(l, ST_CKV), 2, 3};
              pg8::gemm_phase<pg8::EpiBf16<0, true>, pg8::DenseSched, true, false>(lds, D, D, D, S, E, 0); }
            if (l == 0) {
                pg8::DenseSched S{(const char*)(ws + WS_MEMB), (const char*)(ws + WS_WMKV), D, D, TM / 256, 2 * 1024 / 256, 1, D, G, bx};
                pg8::EpiBf16<0, false> E{(bf16*)(ws + WS_KVMEM), 2 * 1024, (const void*)((float*)(ws + WS_TAB + 2 * MiB) + 2 * 1024), 1.0f / D, nullptr, nullptr, 0, 0};
                pg8::gemm_phase<pg8::EpiBf16<0, false>, pg8::DenseSched, true, false>(lds, D, D, D, S, E, 0);
            }
            SEAM(pb + 0);
        }
        if (PH_ON(2) && IN(pb + 1)) {
            WS_PTRS();
            bf16* z = (bf16*)(rg + R_Z);
            { pg8::DenseSched S{(const char*)(z + Z_CQ), (const char*)(wb + W_UQ), ZC, QL, T / 256, NQU / 256, 1, QL, G, bx};
              pg8::EpiBf16<0, false> E{(bf16*)(rg + R_Q), NQU, STATP(l, ST_CQ), 1.0f / QL, nullptr, nullptr, 0, 0};
              pg8::gemm_phase<pg8::EpiBf16<0, false>, pg8::DenseSched, true, false>(lds, QL, ZC, QL, S, E, 0); }
            { pg8::DenseSched S{(const char*)(z + Z_CKV), (const char*)(wb + W_UKV), ZC, KVL, T / 256, NKV / 256, 1, KVL, G, bx};
              pg8::EpiBf16<0, false> E{(bf16*)(rg + R_KVR), NKV, STATP(l, ST_CKV), 1.0f / KVL, nullptr, nullptr, 0, 0};
              pg8::gemm_phase<pg8::EpiBf16<0, false>, pg8::DenseSched, true, false>(lds, KVL, ZC, KVL, S, E, 0); }
            conv_phase(z, (bf16*)(rg + R_XC), INP(I_CONVW) + (size_t)l * 4 * DRNN, INP(I_CONVB) + (size_t)l * DRNN, gtid, NGT);
            if (l == 0) { const float* mkg = INP(I_MKG); for (int ll = 0; ll < 2; ++ll) head128_norm_rows<false>((bf16*)(ws + WS_KVMEM) + (size_t)ll * 1024, nullptr, 2 * 1024, (bf16*)(ws + WS_KMEMN) + (size_t)ll * TM * DMA, mkg + ll * 128, TM, gw, NGW, lane); }
            SEAM(pb + 1);
        }
        if (PH_ON(3) && IN(pb + 2)) {
            WS_PTRS();
            float* cosT = (float*)(ws + WS_TAB);
            qk_post_phase((bf16*)(rg + R_Q), (const bf16*)(rg + R_KVR), (const bf16*)(rg + R_Z), (bf16*)(rg + R_KK), INP(I_AQG) + l * QKH, INP(I_AKG) + l * QKH, cosT, cosT + SEQ * 32, gw, NGW, lane);
            { pg8::GateSched S{(const char*)(rg + R_XC), (const char*)(wb + W_G), G, bx};
              pg8::EpiGates E{(const bf16*)(rg + R_XC), INP(I_BRG) + l * DRNN, INP(I_BIG) + l * DRNN, (float*)(ws + WS_TAB + 2 * MiB) + l * DRNN, (float*)(rg + R_AA), (float*)(rg + R_UU)};
              pg8::gemm_phase<pg8::EpiGates, pg8::GateSched, true, false>(lds, 256, DRNN, 256, S, E, 0); }
            SEAM(pb + 2);
        }
        if (PH_ON(4) && IN(pb + 3)) {
            WS_PTRS();
            float* chA = (float*)(ws + WS_SCAN);
            for (int u = bx; u < 256; u += G) scan_pass1((const float*)(rg + R_AA), (const float*)(rg + R_UU), chA, chA + 2 * 64 * DRNN, u, tid);
            SEAM(pb + 3);
        }
        if (PH_ON(5) && IN(pb + 4)) {
            WS_PTRS();
            bf16* ymix = (bf16*)(rg + R_YMIX);
            {
                bf16* qbuf = (bf16*)(rg + R_Q); bf16* kk = (bf16*)(rg + R_KK); bf16* kvr = (bf16*)(rg + R_KVR); u64* ssq_ya = STATP(l, ST_YATT);
                const att::Strides<NQU, NQU, NKV, D> sd;
                for (int it = bx; it < 256; it += G) {
                    att::BlockRef cur = mla_ref(it, 0, qbuf, kk, kvr, ymix, ssq_ya);
                    att::Seam<12> S;
                    att::attn_prime<64>(cur, sd, (char*)lds_raw, S);
                    for (int pass = 0; pass < 2; ++pass) {
                        const att::BlockRef nxt = (pass == 0) ? mla_ref(it, 1, qbuf, kk, kvr, ymix, ssq_ya) : cur;
                        att::attn_block<64, true, true>(cur, nxt, sd, 0.07216878364870322f, (char*)lds_raw, S);
                        cur = nxt;
                    }
                }
            }
            { float* chA = (float*)(ws + WS_SCAN);
              for (int u = bx; u < 256; u += G) scan_pass3((const float*)(rg + R_AA), (const float*)(rg + R_UU), chA, chA + 2 * 64 * DRNN, (const bf16*)(rg + R_Z), ymix, STATP(l, ST_YRNN), u, tid, lane); }
            SEAM(pb + 4);
        }
        if (PH_ON(6) && IN(pb + 5)) {
            WS_PTRS();
            const float* xin = (l == 0) ? INP(I_X) : out_ptr();
            pg8::DenseSched S{(const char*)(rg + R_YMIX), (const char*)(wb + W_OUT), D, D, T / 256, D / 256, 1, D, G, bx};
            pg8::EpiResid<true> E{xin, out_ptr(), (bf16*)(ws + WS_XB), STATP(l, ST_X1), STATP(l, ST_YATT), STATP(l, ST_YRNN)};
            pg8::gemm_phase<pg8::EpiResid<true>, pg8::DenseSched, true, true>(lds, D, D, D, S, E, 16);
            SEAM(pb + 5);
        }
        if (PH_ON(7) && IN(pb + 6)) {
            WS_PTRS();
            pg8::DenseSched S{(const char*)(ws + WS_XB), (const char*)(wb + W_MQ), D, D, T / 256, DMA / 256, 2, 1024, G, bx};
            pg8::EpiF32Slab E{(float*)(rg + R_QM), DMA, (size_t)T * DMA, STATP(l, ST_X1), 1.0f / D};
            pg8::gemm_phase<pg8::EpiF32Slab, pg8::DenseSched, true, false>(lds, 1024, D, D, S, E, 0);
            SEAM(pb + 6);
        }
        if (PH_ON(8) && IN(pb + 7)) {
            WS_PTRS();
            float* qm = (float*)(rg + R_QM);
            head128_norm_rows<true>(qm, qm + (size_t)T * DMA, DMA, (bf16*)(rg + R_QMN), INP(I_MQG) + l * 128, T, gw, NGW, lane);
            SEAM(pb + 7);
        }
        if (PH_ON(9) && IN(pb + 8)) {
            WS_PTRS();
            bf16* qmn = (bf16*)(rg + R_QMN); bf16* om = (bf16*)(rg + R_OM); bf16* kmemn = (bf16*)(ws + WS_KMEMN); bf16* kvmem = (bf16*)(ws + WS_KVMEM);
            const att::Strides<DMA, DMA, 2 * 1024, DMA> sd;
            for (int it = bx; it < 256; it += G) {
                const int h = it & 3, rb = it >> 2, b = rb >> 5;
                att::BlockRef c0;
                c0.Q = qmn + (size_t)rb * 256 * DMA + h * 128; c0.K = kmemn + ((size_t)l * TM + (size_t)b * NMEM) * DMA + h * 128;
                c0.V = kvmem + (size_t)l * 1024 + (size_t)b * NMEM * 2048 + 512 + h * 128; c0.O = om + (size_t)rb * 256 * DMA + h * 128; c0.ssq = nullptr; c0.P0 = 0; c0.nk = NMEM;
                att::Seam<8> S;
                att::attn_prime<0>(c0, sd, (char*)lds_raw, S);
                att::attn_block<0, false, false>(c0, c0, sd, 0.08838834764831845f, (char*)lds_raw, S);
            }
            SEAM(pb + 8);
        }
        if (PH_ON(10) && IN(pb + 9)) {
            WS_PTRS();
            pg8::DenseSched S{(const char*)(rg + R_OM), (const char*)(wb + W_MO), DMA, DMA, T / 256, D / 256, 1, DMA, G, bx};
            pg8::EpiResid<false> E{out_ptr(), out_ptr(), (bf16*)(ws + WS_XB), STATP(l, ST_X2), nullptr, nullptr};
            pg8::gemm_phase<pg8::EpiResid<false>, pg8::DenseSched, true, false>(lds, DMA, DMA, DMA, S, E, 0);
            SEAM(pb + 9);
        }
        if (PH_ON(11) && IN(pb + 10)) {
            WS_PTRS();
            pg8::DenseSched S{(const char*)(ws + WS_XB), (const char*)(wb + W_R), D, D, T / 256, 1, 1, D, G, bx};
            pg8::EpiRouter E{(float*)(ws + WS_LOGIT)};
            pg8::gemm_phase<pg8::EpiRouter, pg8::DenseSched, true, false>(lds, D, D, D, S, E, 0);
            SEAM(pb + 10);
        }
        if (PH_ON(12) && IN(pb + 11)) {
            WS_PTRS();
            unsigned* cnt = (unsigned*)(ws + WS_CTL) + CW_CNT + l * 64;
            for (int w = bx; w < 256; w += G) route_phase((const float*)(ws + WS_LOGIT), STATP(l, ST_X2), INP(I_BRGRP) + l * 4, INP(I_BREXP) + l * 32, (int*)(ws + WS_MOE), (float*)(ws + WS_MOE + 128 * 1024),
                                                          (int*)(ws + WS_MOE + 384 * 1024), cnt, (LAS int*)lds, w, tid);
            SEAM(pb + 11);
        }
        if (PH_ON(13) && IN(pb + 12)) {
            WS_PTRS();
            unsigned* cnt = (unsigned*)(ws + WS_CTL) + CW_CNT + l * 64;
            for (int w = bx; w < 256; w += G) dispatch_phase(cnt, (const int*)(ws + WS_MOE + 384 * 1024), (const int*)(ws + WS_MOE), (const float*)(ws + WS_MOE + 128 * 1024), STATP(l, ST_X2),
                                                             (int*)(ws + WS_MOE + 256 * 1024), (int*)(ws + WS_MOE + 512 * 1024), (float*)(ws + WS_MOE + 704 * 1024), (float*)(ws + WS_MOE + 896 * 1024), (LAS int*)lds, w, tid);
            SEAM(pb + 12);
        }
        if (PH_ON(14) && IN(pb + 13)) {
            WS_PTRS();
            const int nrt = build_rtab((unsigned*)(ws + WS_CTL) + CW_CNT + l * 64, lc, tid);
            pg8::MoeUpSched S{(const char*)(ws + WS_XB), (const char*)(wb + W_GU), (const int*)(ws + WS_MOE + 512 * 1024), (const LAS int*)(lc + LC_RTAB / 4), nrt, G, bx};
            pg8::EpiSwiglu E{(bf16*)(rg + R_ACT), (const float*)(ws + WS_MOE + 896 * 1024)};
            pg8::gemm_phase<pg8::EpiSwiglu, pg8::MoeUpSched, true, false>(lds, D, D, D, S, E, 0);
            SEAM(pb + 13);
        }
        if (PH_ON(15) && IN(pb + 14)) {
            WS_PTRS();
            const int nrt = build_rtab((unsigned*)(ws + WS_CTL) + CW_CNT + l * 64, lc, tid);
            pg8::MoeDownSched S{(const char*)(rg + R_ACT), (const char*)(wb + W_D), (const LAS int*)(lc + LC_RTAB / 4), nrt, G, bx};
            pg8::EpiBf16<1, false> E{(bf16*)(rg + R_Y), D, (const float*)(ws + WS_MOE + 704 * 1024), 0.f, nullptr, nullptr, 0, 0};
            pg8::gemm_phase<pg8::EpiBf16<1, false>, pg8::MoeDownSched, true, false>(lds, DE, DE, DE, S, E, 0);
            SEAM(pb + 14);
        }
        if (PH_ON(16) && IN(pb + 15)) {
            WS_PTRS();
            const bool more = (l + 1 < DEPTH);
            combine_phase(out_ptr(), (const bf16*)(rg + R_Y), (const int*)(ws + WS_MOE + 256 * 1024), more ? (bf16*)(ws + WS_XB) : nullptr, more ? STATP(l + 1, ST_X) : nullptr, gw, NGW, lane);
            if (more) { LAS float* scr = (LAS float*)(lds + wave * 16384); convert_layer_weights(p, l + 1, scr, gw, NGW, lane, gtid, NGT); }
            SEAM(pb + 15);
        }
    }
#undef IN
#undef SEAM
}

#ifndef MK_SPLIT
#define MK_SPLIT 0
#endif
extern "C" void kernel_launch(void* const* d_in, const int* in_sizes, int n_in, void* d_out, int out_size, void* d_ws, size_t ws_size, hipStream_t stream) {
    static int grid = 0;
    if (grid == 0) {
        if (n_in != 36 || in_sizes[0] != T * D || out_size != T * D || ws_size < WS_END) {
            fprintf(stderr, "kernel_launch: unexpected shapes (n_in %d, in0 %d, out %d, ws %zu < %zu)\n", n_in, n_in > 0 ? in_sizes[0] : -1, out_size, ws_size, (size_t)WS_END); grid = -1; return; }
        int dev = 0, cus = 0, per_cu = 0;
        if (hipGetDevice(&dev) != hipSuccess || hipDeviceGetAttribute(&cus, hipDeviceAttributeMultiprocessorCount, dev) != hipSuccess) { grid = -1; return; }
        if (hipFuncSetAttribute((const void*)fwd_kernel, hipFuncAttributeMaxDynamicSharedMemorySize, LDS_BYTES) != hipSuccess) { fprintf(stderr, "kernel_launch: hipFuncSetAttribute failed\n"); grid = -1; return; }
        if (hipOccupancyMaxActiveBlocksPerMultiprocessor(&per_cu, (const void*)fwd_kernel, NTHREADS, LDS_BYTES) != hipSuccess || per_cu < 1)
            fprintf(stderr, "kernel_launch: occupancy query reports %d workgroups per CU\n", per_cu);
        (void)hipGetLastError();
        grid = cus;
    }
    if (grid < 0) return;
    if (hipMemsetAsync((char*)d_ws, 0, ZERO_BYTES, stream) != hipSuccess) return;
    Params a{};
    for (int i = 0; i < 36; ++i) a.in[i] = (const float*)d_in[i];
    a.out = (float*)d_out; a.ws = (unsigned char*)d_ws;
#if MK_SPLIT
    for (int ph = 0; ph < NPHASES; ++ph) { a.ph_lo = ph; a.ph_hi = ph + 1; hipLaunchKernelGGL(fwd_kernel, dim3(grid), dim3(NTHREADS), LDS_BYTES, stream, a); }
#else
    a.ph_lo = 0; a.ph_hi = NPHASES;
    hipLaunchKernelGGL(fwd_kernel, dim3(grid), dim3(NTHREADS), LDS_BYTES, stream, a);
#endif
}
```

```cpp
#include <hip/hip_runtime.h>
#include <cstdio>
#include <cstdint>

#define GAS __attribute__((address_space(1)))
#define LAS __attribute__((address_space(3)))
typedef unsigned short bf16;
typedef short bf16x8 __attribute__((ext_vector_type(8)));
typedef short s16x4 __attribute__((ext_vector_type(4)));
typedef float f32x4 __attribute__((ext_vector_type(4)));
typedef float f32x2 __attribute__((ext_vector_type(2)));
typedef float f32x16 __attribute__((ext_vector_type(16)));
typedef unsigned u32x4 __attribute__((ext_vector_type(4)));
typedef unsigned u32x2 __attribute__((ext_vector_type(2)));

constexpr int NBATCH = 2, SEQ = 8192, T = NBATCH * SEQ, D = 2048, DEPTH = 2;
constexpr int NMEM = 256, TM = NBATCH * NMEM;
constexpr int QL = 512, KVL = 256, DRNN = 1024, DATT = 1024;
constexpr int NH = 8, QKH = 192, VH = 128;
constexpr int ZC = 3072;
constexpr int Z_CQ = 0, Z_CKV = 512, Z_XR = 768, Z_GATE = 1792, Z_KPE = 2816;
constexpr int NE = 32, DE = 512, NSLOT = 40960;
constexpr int NQU = NH * QKH;
constexpr int NKV = NH * 256;
constexpr int DMA = 512;
constexpr float EPS = 1e-6f;
constexpr int NWAVES = 8, NTHREADS = 512;

__device__ __forceinline__ unsigned f2bf(float f) { unsigned u = __builtin_bit_cast(unsigned, f); return (u + 0x7fffu + ((u >> 16) & 1u)) >> 16; }
__device__ __forceinline__ unsigned pk2(float lo, float hi) { return f2bf(lo) | (f2bf(hi) << 16); }
__device__ __forceinline__ float bf2f(unsigned short h) { return __builtin_bit_cast(float, (unsigned)h << 16); }
__device__ __forceinline__ float bflo(unsigned w) { return __builtin_bit_cast(float, w << 16); }
__device__ __forceinline__ float bfhi(unsigned w) { return __builtin_bit_cast(float, w & 0xffff0000u); }
__device__ __forceinline__ unsigned cvt_pk_bf16(float lo, float hi) { unsigned r; asm volatile("v_cvt_pk_bf16_f32 %0, %1, %2" : "=v"(r) : "v"(lo), "v"(hi)); return r; }
__device__ __forceinline__ float wave_sum(float v) {
#pragma unroll
    for (int o = 1; o < 64; o <<= 1) v += __shfl_xor(v, o);
    return v;
}
typedef unsigned long long u64;
__device__ __forceinline__ float ssq_val(const u64* p, int row) { return (float)p[row] * (1.0f / 16777216.0f); }
__device__ __forceinline__ void ssq_add(u64* p, int row, float v) { atomicAdd(p + row, (u64)(v * 16777216.0f)); }
__device__ __forceinline__ void ssq_set(u64* p, int row, float v) { p[row] = (u64)(v * 16777216.0f); }
#define LDS_WAIT() asm volatile("s_waitcnt lgkmcnt(0)" ::: "memory")
#define VM_WAIT() asm volatile("s_waitcnt vmcnt(0)" ::: "memory")

#define XB_TMO      128
#define XB_XCNT(j)  (256  + 64 * (j))
#define XB_XSUB(j)  (1280 + 64 * (j))
#define XB_XGEN(j)  (2304 + 64 * (j))
#define XB_TOP      3328
#define XB_TOPGEN   3392
#define XCD_BAR_WORDS 3456
#define XB_SPIN_CAP (1u << 18)
__device__ __forceinline__ unsigned xb_ld(unsigned* p)              { return __hip_atomic_load(p, __ATOMIC_RELAXED, __HIP_MEMORY_SCOPE_AGENT); }
__device__ __forceinline__ unsigned xb_add(unsigned* p, unsigned v) { return __hip_atomic_fetch_add(p, v, __ATOMIC_RELAXED, __HIP_MEMORY_SCOPE_AGENT); }
__device__ __forceinline__ unsigned xb_xcc_id() { return (unsigned)__builtin_amdgcn_s_getreg((3 << 11) | 20) & 0xFu; }
#define XB_SPIN(cond, bar) do { unsigned _sp = 0; while (cond) { __builtin_amdgcn_s_sleep(1); \
    if ((++_sp & 255u) == 0u) { if (xb_ld(&(bar)[XB_TMO])) break; if (_sp > XB_SPIN_CAP) { atomicAdd(&(bar)[XB_TMO], 1u); break; } } } } while (0)
struct XcdBarrier { unsigned* bar; unsigned x; volatile LAS unsigned* st; };
__device__ __forceinline__ XcdBarrier xcd_barrier_post(unsigned* bar, volatile LAS unsigned* st) {
    XcdBarrier b; b.bar = bar; b.x = xb_xcc_id(); b.st = st;
    if (threadIdx.x == 0) (void)xb_add(&bar[XB_XCNT(b.x)], 1u);
    return b;
}
__device__ __forceinline__ void xcd_barrier_complete(unsigned* bar, unsigned x, unsigned& nloc, unsigned& nx) {
    const unsigned G = gridDim.x * gridDim.y * gridDim.z;
    unsigned sum, cnt, mine, sp = 0u;
    for (;;) {
        sum = 0u; cnt = 0u; mine = 0u;
#pragma unroll
        for (unsigned j = 0; j < 16; ++j) { const unsigned c = xb_ld(&bar[XB_XCNT(j)]); sum += c; cnt += (c > 0u) ? 1u : 0u; mine = (j == x) ? c : mine; }
        if (sum == G) break;
        __builtin_amdgcn_s_sleep(1);
        if ((++sp & 255u) == 0u) { if (xb_ld(&bar[XB_TMO])) break; if (sp > XB_SPIN_CAP) { atomicAdd(&bar[XB_TMO], 1u); break; } }
    }
    nloc = mine > 0u ? mine : 1u; nx = cnt > 0u ? cnt : 1u;
}
__device__ __forceinline__ void xcd_barrier(const XcdBarrier& b) {
    asm volatile("s_waitcnt vmcnt(0)" ::: "memory");
    __syncthreads();
    if (threadIdx.x == 0) {
        unsigned* bar = b.bar; unsigned bx_ = b.x; asm volatile("" : "+s"(bar), "+s"(bx_));
        __builtin_amdgcn_s_waitcnt(0);
        unsigned nloc = b.st[0], nx = b.st[1];
        if (nloc == 0u) { xcd_barrier_complete(bar, bx_, nloc, nx); b.st[0] = nloc; b.st[1] = nx; }
        const unsigned old = xb_add(&bar[XB_XSUB(bx_)], 1u);
        const unsigned gen = old / nloc;
        if (old + 1u == (gen + 1u) * nloc) {
            __builtin_amdgcn_fence(__ATOMIC_RELEASE, "agent");
            asm volatile("s_waitcnt vmcnt(0)" ::: "memory");
            const unsigned og = xb_add(&bar[XB_TOP], 1u);
            const unsigned tg = og / nx;
            if (og + 1u == (tg + 1u) * nx) xb_add(&bar[XB_TOPGEN], 1u);
            else XB_SPIN(xb_ld(&bar[XB_TOPGEN]) == tg, bar);
            __builtin_amdgcn_fence(__ATOMIC_ACQUIRE, "agent");
            xb_add(&bar[XB_XGEN(bx_)], 1u);
            asm volatile("s_waitcnt vmcnt(0)" ::: "memory");
        } else {
            XB_SPIN(xb_ld(&bar[XB_XGEN(bx_)]) == gen, bar);
            __builtin_amdgcn_fence(__ATOMIC_ACQUIRE, "agent");
            asm volatile("s_waitcnt vmcnt(0)" ::: "memory");
        }
    }
    __syncthreads();
}

namespace pg8 {
constexpr int BM = 256, BK = 64, HALF = 128, HTB = HALF * BK * 2, STAGE_BYTES = 8 * HTB, NXCD = 8, WGM = 8;
__host__ __device__ __forceinline__ int lds_byte(int r, int c) { const int st = (r >> 4) * 2 + (c >> 5), rr = r & 15, cc = c & 31, ob = rr * 64 + cc * 2; return st * 1024 + (ob ^ (((ob >> 9) & 1) << 5)); }
__host__ __device__ __forceinline__ void stage_rc(int b, int& R, int& C) { const int st = b / 1024, sb = b % 1024, swz = sb ^ (((sb >> 9) & 1) << 5); R = (st >> 1) * 16 + swz / 64; C = (st & 1) * 32 + (swz % 64) / 2; }
__host__ __device__ __forceinline__ int perm32(int rho) { const int n = rho >> 4, i = rho & 15; return 8 * (i >> 2) + 4 * n + (i & 3); }

struct Unit { const char* A; const char* B; int pm, pn, aux; };

__device__ __forceinline__ bool static_tile(int i, int G, int c, int nM, int nN, int& pm, int& pn) {
    const int nwg = nM * nN; const long L = (long)i * G + c; if (L >= nwg) return false;
    int wgid = (int)L; { const int q = nwg / NXCD, r = nwg % NXCD, xcd = wgid % NXCD, off = wgid / NXCD; wgid = (xcd < r ? xcd * (q + 1) : r * (q + 1) + (xcd - r) * q) + off; }
    const int nig = WGM * nN, gid = wgid / nig, fm = gid * WGM, gsz = (nM - fm) < WGM ? (nM - fm) : WGM;
    pm = fm + ((wgid % nig) % gsz); pn = (wgid % nig) / gsz; return true;
}

template <class Epi, class Sched, bool ALIGN_EPI, bool MID>
__device__ __forceinline__ void gemm_phase(LAS unsigned char* lds, const int K, const int lda, const int ldb, const Sched& S, const Epi& E, const int mid_t) {
    constexpr bool GATHER = Sched::GATHER;
    int tid = threadIdx.x; asm volatile("" : "+v"(tid)); const int wid = __builtin_amdgcn_readfirstlane(tid >> 6), lane = tid & 63, wr = wid >> 2, wc = wid & 3, fr = lane & 15, fq = lane >> 4;
    const int nt = K / BK;
    unsigned voffA[2], voffB[2];
#pragma unroll
    for (int i = 0; i < 2; ++i) { int R, C; stage_rc(tid * 16 + i * 8192, R, C); const int Rb = Epi::PERM ? ((R & ~31) + perm32(R & 31)) : R;
        voffA[i] = (unsigned)(R * lda + C) * 2u; voffB[i] = (unsigned)(Rb * ldb + C) * 2u; }
    const size_t kstep = (size_t)(BK * 2);
    const size_t hstepA = GATHER ? (size_t)0 : (size_t)HALF * lda * 2;
    const size_t hstepB = (size_t)HALF * ldb * 2;
    const unsigned ldsw = (unsigned)wid * 1024u;
    const int aoff = lds_byte(wr * 64 + fr, fq * 8), boff = lds_byte(wc * 32 + fr, fq * 8);
#define PG8_SA(b, h) (((b) * 2 + (h)) * HTB)
#define PG8_SB(b, h) ((4 + (b) * 2 + (h)) * HTB)
#define PG8_STAGE(bufoff, gbase, voff) do { _Pragma("unroll") for (int _i = 0; _i < 2; ++_i) \
        __builtin_amdgcn_global_load_lds((const unsigned*)((const char*)(gbase) + (voff)[_i]), (LAS unsigned*)(lds + (bufoff) + ldsw + _i * 8192), 16, 0, 0); } while (0)
#define PG8_LDA(dst, b, h) do { _Pragma("unroll") for (int m = 0; m < 4; ++m) _Pragma("unroll") for (int k = 0; k < 2; ++k) dst[m][k] = *(const LAS bf16x8*)(lds + PG8_SA(b, h) + aoff + m * 2048 + k * 1024); } while (0)
#define PG8_LDB(dst, b, h) do { _Pragma("unroll") for (int n = 0; n < 2; ++n) _Pragma("unroll") for (int k = 0; k < 2; ++k) dst[n][k] = *(const LAS bf16x8*)(lds + PG8_SB(b, h) + boff + n * 2048 + k * 1024); } while (0)
#define PG8_MMA(ai, bj, At, Bt) do { __builtin_amdgcn_s_setprio(1); _Pragma("unroll") for (int m = 0; m < 4; ++m) _Pragma("unroll") for (int n = 0; n < 2; ++n) _Pragma("unroll") for (int k = 0; k < 2; ++k) \
        acc[ai][bj][m][n] = __builtin_amdgcn_mfma_f32_16x16x32_bf16(Bt[n][k], At[m][k], acc[ai][bj][m][n], 0, 0, 0); __builtin_amdgcn_s_setprio(0); } while (0)
#define PG8_WAIT_V(n) asm volatile("s_waitcnt vmcnt(" #n ")" ::: "memory")
#define PG8_WAIT_L(n) asm volatile("s_waitcnt lgkmcnt(" #n ")" ::: "memory")
#define PG8_BAR __builtin_amdgcn_s_barrier()
#define PG8_SCHED __builtin_amdgcn_sched_barrier(0)
    Unit cur, nxt; int ui = 0;
    if (!S.next(0, cur)) return;
    f32x4 acc[2][2][4][2];
#pragma unroll
    for (int a = 0; a < 2; ++a)
#pragma unroll
        for (int b = 0; b < 2; ++b)
#pragma unroll
            for (int m = 0; m < 4; ++m)
#pragma unroll
                for (int n = 0; n < 2; ++n) acc[a][b][m][n] = (f32x4){0.f, 0.f, 0.f, 0.f};
    bf16x8 At[4][2], B0[2][2], B1[2][2];
    unsigned gA0[2], gA1[2], gN0[2], gN1[2];
    if constexpr (GATHER) {
#pragma unroll
        for (int i = 0; i < 2; ++i) { int R, C; stage_rc(tid * 16 + i * 8192, R, C); gA0[i] = S.arow(cur, R) + (unsigned)C * 2u; gA1[i] = S.arow(cur, HALF + R) + (unsigned)C * 2u; gN0[i] = gA0[i]; gN1[i] = gA1[i]; }
    }
#define PG8_STAGE_A(b, h, gbase, G0, G1) do { if constexpr (GATHER) { if ((h) == 0) PG8_STAGE(PG8_SA(b, h), gbase, G0); else PG8_STAGE(PG8_SA(b, h), gbase, G1); } \
        else PG8_STAGE(PG8_SA(b, h), (gbase) + (h) * hstepA, voffA); } while (0)
    const char* cA = cur.A; const char* cB = cur.B;
    PG8_STAGE(PG8_SB(0, 0), cB, voffB); PG8_STAGE(PG8_SB(0, 1), cB + hstepB, voffB); PG8_STAGE_A(0, 0, cA, gA0, gA1); PG8_STAGE_A(0, 1, cA, gA0, gA1);
    if (wr == 1) PG8_BAR;
    PG8_WAIT_V(2); PG8_BAR;
    PG8_STAGE(PG8_SB(1, 0), cB + kstep, voffB); PG8_STAGE_A(1, 0, cA + kstep, gA0, gA1); PG8_STAGE(PG8_SB(1, 1), cB + hstepB + kstep, voffB);
    PG8_WAIT_V(6); PG8_BAR;
    for (;;) {
        const bool has_next = S.next(ui + 1, nxt);
        const char* nA = has_next ? nxt.A : cA; const char* nB = has_next ? nxt.B : cB;
        if constexpr (GATHER) {
            if (has_next) {
#pragma unroll
                for (int i = 0; i < 2; ++i) { int R, C; stage_rc(tid * 16 + i * 8192, R, C); gN0[i] = S.arow(nxt, R) + (unsigned)C * 2u; gN1[i] = S.arow(nxt, HALF + R) + (unsigned)C * 2u; }
            }
        }
#pragma nounroll
        for (int t = 0; t < nt; t += 2) {
            const bool last = (t == nt - 2);
            if constexpr (MID) { if (t == mid_t) E.mid(acc, cur, wr, wc, fr, fq); }
            const char* a1 = cA + (size_t)(t + 1) * kstep;
            const char* a2 = last ? nA : cA + (size_t)(t + 2) * kstep; const char* b2 = last ? nB : cB + (size_t)(t + 2) * kstep;
            const char* a3 = a2 + kstep; const char* b3 = b2 + kstep;
            unsigned w0[2], w1[2];
            if constexpr (GATHER) {
#pragma unroll
                for (int i = 0; i < 2; ++i) { w0[i] = last ? gN0[i] : gA0[i]; w1[i] = last ? gN1[i] : gA1[i]; }
            }
            PG8_LDB(B0, 0, 0); PG8_LDB(B1, 0, 1); PG8_SCHED; PG8_LDA(At, 0, 0); PG8_STAGE_A(1, 1, a1, gA0, gA1);
            PG8_WAIT_V(8); PG8_WAIT_L(0); PG8_BAR; PG8_MMA(0, 0, At, B0); PG8_MMA(0, 1, At, B1); PG8_BAR; PG8_SCHED;
            PG8_LDA(At, 0, 1); PG8_STAGE(PG8_SB(0, 0), b2, voffB); PG8_STAGE(PG8_SB(0, 1), b2 + hstepB, voffB); PG8_STAGE_A(0, 0, a2, w0, w1);
            PG8_WAIT_V(8); PG8_WAIT_L(0); PG8_BAR; PG8_MMA(1, 0, At, B0); PG8_MMA(1, 1, At, B1); PG8_BAR; PG8_SCHED;
            PG8_LDB(B0, 1, 0); PG8_LDB(B1, 1, 1); PG8_SCHED; PG8_LDA(At, 1, 0); PG8_STAGE_A(0, 1, a2, w0, w1);
            PG8_WAIT_V(8); PG8_WAIT_L(0); PG8_BAR; PG8_MMA(0, 0, At, B0); PG8_MMA(0, 1, At, B1); PG8_BAR; PG8_SCHED;
            PG8_LDA(At, 1, 1); PG8_STAGE(PG8_SB(1, 0), b3, voffB); PG8_STAGE(PG8_SB(1, 1), b3 + hstepB, voffB); PG8_STAGE_A(1, 0, a3, w0, w1);
            PG8_WAIT_V(8); PG8_WAIT_L(0); PG8_BAR; PG8_MMA(1, 0, At, B0); PG8_MMA(1, 1, At, B1); PG8_BAR; PG8_SCHED;
        }
        if constexpr (ALIGN_EPI) { if (wr == 0) PG8_BAR; }
        E(acc, cur, wr, wc, fr, fq);
        if (!has_next) break;
#pragma unroll
        for (int a = 0; a < 2; ++a)
#pragma unroll
            for (int b = 0; b < 2; ++b)
#pragma unroll
                for (int m = 0; m < 4; ++m)
#pragma unroll
                    for (int n = 0; n < 2; ++n) acc[a][b][m][n] = (f32x4){0.f, 0.f, 0.f, 0.f};
        cur = nxt; cA = nA; cB = nB; ++ui;
        if constexpr (GATHER) {
#pragma unroll
            for (int i = 0; i < 2; ++i) { gA0[i] = gN0[i]; gA1[i] = gN1[i]; }
        }
        if constexpr (ALIGN_EPI) { if (wr == 1) PG8_BAR; }
    }
    PG8_WAIT_V(0);
    if constexpr (!ALIGN_EPI) { if (wr == 0) PG8_BAR; }
    PG8_BAR;
#undef PG8_SA
#undef PG8_SB
#undef PG8_STAGE
#undef PG8_STAGE_A
#undef PG8_LDA
#undef PG8_LDB
#undef PG8_MMA
#undef PG8_WAIT_V
#undef PG8_WAIT_L
#undef PG8_BAR
#undef PG8_SCHED
}
}
namespace pg8 {
struct DenseSched {
    static constexpr bool GATHER = false;
    const char* A; const char* B; int lda, ldb, nM, nN, nKS, Ksplit, G, c;
    __device__ __forceinline__ bool next(int i, Unit& u) const {
        int pm, pc; if (!static_tile(i, G, c, nM, nN * nKS, pm, pc)) return false;
        const int pn = pc / nKS, ks = pc - pn * nKS;
        u.pm = pm; u.pn = pn; u.aux = ks;
        u.A = A + ((size_t)pm * BM * lda + (size_t)ks * Ksplit) * 2;
        u.B = B + ((size_t)pn * BM * ldb + (size_t)ks * Ksplit) * 2;
        return true;
    }
    __device__ __forceinline__ unsigned arow(const Unit&, int r) const { return (unsigned)(r * lda) * 2u; }
};
struct GateSched {
    static constexpr bool GATHER = false;
    const char* A; const char* B; int G, c;
    __device__ __forceinline__ bool next(int i, Unit& u) const {
        int pm, pn; if (!static_tile(i, G, c, T / BM, 8, pm, pn)) return false;
        u.pm = pm; u.pn = pn; u.aux = 0;
        u.A = A + ((size_t)pm * BM * DRNN + (size_t)(pn >> 1) * 256) * 2;
        u.B = B + (size_t)pn * 256 * 256 * 2;
        return true;
    }
    __device__ __forceinline__ unsigned arow(const Unit&, int r) const { return (unsigned)(r * DRNN) * 2u; }
};
struct MoeUpSched {      static constexpr bool GATHER = true;
    const char* A; const char* B; const int* slot_tok; const LAS int* rtab; int nrt, G, c;
    __device__ __forceinline__ bool next(int i, Unit& u) const {
        const long L = (long)i * G + c; if (L >= (long)nrt * 4) return false;
        const int rt = (int)(L >> 2), pn = (int)(L & 3); const int e = rtab[2 * rt], row0 = rtab[2 * rt + 1];
        u.pm = row0 >> 8; u.pn = pn; u.aux = e; u.A = A;
        u.B = B + ((size_t)e * 1024 * D + (size_t)pn * BM * D) * 2;
        return true;
    }
    __device__ __forceinline__ unsigned arow(const Unit& u, int r) const { return (unsigned)slot_tok[u.pm * BM + r] * (unsigned)(D * 2); }
};
struct MoeDownSched {    static constexpr bool GATHER = false;
    const char* A; const char* B; const LAS int* rtab; int nrt, G, c;
    __device__ __forceinline__ bool next(int i, Unit& u) const {
        const long L = (long)i * G + c; if (L >= (long)nrt * 8) return false;
        const int rt = (int)(L >> 3), pn = (int)(L & 7); const int e = rtab[2 * rt], row0 = rtab[2 * rt + 1];
        u.pm = row0 >> 8; u.pn = pn; u.aux = e;
        u.A = A + (size_t)row0 * DE * 2;
        u.B = B + ((size_t)e * D * DE + (size_t)pn * BM * DE) * 2;
        return true;
    }
    __device__ __forceinline__ unsigned arow(const Unit&, int r) const { return (unsigned)(r * DE) * 2u; }
};

__device__ __forceinline__ void epi_ids(int& wr, int& wc, int& fr, int& fq) { int t = threadIdx.x; asm volatile("" : "+v"(t)); const int wid = t >> 6, lane = t & 63; wr = wid >> 2; wc = wid & 3; fr = lane & 15; fq = lane >> 4; }
template <int MODE, bool STAT> struct EpiBf16 {
    static constexpr bool PERM = true;
    bf16* O; int ldc; const void* rs; float inv_n; u64* stat_a; u64* stat_b; int stat_pn_a, stat_pn_b;
    __device__ __forceinline__ void operator()(const f32x4 (&acc)[2][2][4][2], const Unit& u, int, int, int, int) const {
        int wr, wc, fr, fq; epi_ids(wr, wc, fr, fq);
        int row0 = u.pm * BM + wr * 64 + fr; asm volatile("" : "+v"(row0)); const int col0 = u.pn * BM + wc * 32 + 8 * fq;
        u64* st = nullptr; if (STAT) st = (u.pn < stat_pn_a) ? stat_a : ((u.pn < stat_pn_b) ? stat_b : nullptr);
#pragma unroll
        for (int ai = 0; ai < 2; ++ai)
#pragma unroll
            for (int m = 0; m < 4; ++m) { const int row = row0 + ai * HALF + m * 16;
                float sc = 1.f;
                if (MODE == 0) sc = 1.0f / sqrtf(ssq_val((const u64*)rs, row) * inv_n + EPS); else if (MODE == 1) sc = ((const float*)rs)[row];
                bf16* rowp = O + (size_t)row * ldc + col0; float ss = 0.f;
#pragma unroll
                for (int bj = 0; bj < 2; ++bj) { const f32x4 v0 = acc[ai][bj][m][0] * sc, v1 = acc[ai][bj][m][1] * sc;
                    if (STAT) ss += (v0[0] * v0[0] + v0[1] * v0[1]) + (v0[2] * v0[2] + v0[3] * v0[3]) + (v1[0] * v1[0] + v1[1] * v1[1]) + (v1[2] * v1[2] + v1[3] * v1[3]);
                    u32x4 w; w.x = cvt_pk_bf16(v0[0], v0[1]); w.y = cvt_pk_bf16(v0[2], v0[3]); w.z = cvt_pk_bf16(v1[0], v1[1]); w.w = cvt_pk_bf16(v1[2], v1[3]);
                    *(u32x4*)(rowp + bj * HALF) = w; }
                if (STAT) { ss += __shfl_xor(ss, 16); ss += __shfl_xor(ss, 32); if (st != nullptr && fq == 0) ssq_add(st, row, ss); }
            }
    }
};
struct EpiF32Slab {
    static constexpr bool PERM = false;
    float* O; int ldc; size_t slab; const u64* rs; float inv_n;
    __device__ __forceinline__ void operator()(const f32x4 (&acc)[2][2][4][2], const Unit& u, int, int, int, int) const {
        int wr, wc, fr, fq; epi_ids(wr, wc, fr, fq);
        int row0 = u.pm * BM + wr * 64 + fr; asm volatile("" : "+v"(row0)); const int col0 = u.pn * BM + wc * 32 + 4 * fq; float* base = O + (size_t)u.aux * slab;
#pragma unroll
        for (int ai = 0; ai < 2; ++ai)
#pragma unroll
            for (int m = 0; m < 4; ++m) { const int row = row0 + ai * HALF + m * 16; const float sc = 1.0f / sqrtf(ssq_val(rs, row) * inv_n + EPS);
                float* rowp = base + (size_t)row * ldc + col0;
#pragma unroll
                for (int bj = 0; bj < 2; ++bj)
#pragma unroll
                    for (int n = 0; n < 2; ++n) *(f32x4*)(rowp + bj * HALF + n * 16) = acc[ai][bj][m][n] * sc; }
    }
};
template <bool SCALE> struct EpiResid {
    static constexpr bool PERM = false;
    const float* xin; float* xout; bf16* xb; u64* stat; const u64* ssq_a; const u64* ssq_b;
    __device__ __forceinline__ void mid(f32x4 (&acc)[2][2][4][2], const Unit& u, int, int, int, int) const {
        int wr, wc, fr, fq; epi_ids(wr, wc, fr, fq);
        int row0 = u.pm * BM + wr * 64 + fr; asm volatile("" : "+v"(row0));
#pragma unroll
        for (int ai = 0; ai < 2; ++ai)
#pragma unroll
            for (int m = 0; m < 4; ++m) { const int row = row0 + ai * HALF + m * 16;
                const float ra = 1.0f / sqrtf(ssq_val(ssq_a, row) * (1.0f / 1024.0f) + EPS), rb = 1.0f / sqrtf(ssq_val(ssq_b, row) * (1.0f / 1024.0f) + EPS); const float f = ra / rb;
#pragma unroll
                for (int bj = 0; bj < 2; ++bj)
#pragma unroll
                    for (int n = 0; n < 2; ++n) acc[ai][bj][m][n] = acc[ai][bj][m][n] * f; }
    }
    __device__ __forceinline__ void operator()(const f32x4 (&acc)[2][2][4][2], const Unit& u, int, int, int, int) const {
        int wr, wc, fr, fq; epi_ids(wr, wc, fr, fq);
        int row0 = u.pm * BM + wr * 64 + fr; asm volatile("" : "+v"(row0)); const int col0 = u.pn * BM + wc * 32 + 4 * fq;
#pragma unroll
        for (int ai = 0; ai < 2; ++ai)
#pragma unroll
            for (int m = 0; m < 4; ++m) { const int row = row0 + ai * HALF + m * 16;
                float sc = 1.f; if (SCALE) sc = 1.0f / sqrtf(ssq_val(ssq_b, row) * (1.0f / 1024.0f) + EPS);
                const size_t off = (size_t)row * D + col0; float ss = 0.f;
#pragma unroll
                for (int bj = 0; bj < 2; ++bj)
#pragma unroll
                    for (int n = 0; n < 2; ++n) { const f32x4 xi = *(const f32x4*)(xin + off + bj * HALF + n * 16); const f32x4 v = xi + acc[ai][bj][m][n] * sc;
                        *(f32x4*)(xout + off + bj * HALF + n * 16) = v;
                        u32x2 w; w.x = cvt_pk_bf16(v[0], v[1]); w.y = cvt_pk_bf16(v[2], v[3]); *(u32x2*)(xb + off + bj * HALF + n * 16) = w;
                        ss += (v[0] * v[0] + v[1] * v[1]) + (v[2] * v[2] + v[3] * v[3]); }
                ss += __shfl_xor(ss, 16); ss += __shfl_xor(ss, 32); if (fq == 0) ssq_add(stat, row, ss);
                asm volatile("" ::: "memory"); __builtin_amdgcn_sched_barrier(0);
            }
    }
};
struct EpiGates {
    static constexpr bool PERM = false;
    const bf16* xc; const float* b_rg; const float* b_ig; const float* sp; float* a_out; float* u_out;
    __device__ __forceinline__ void operator()(const f32x4 (&acc)[2][2][4][2], const Unit& u, int, int, int, int) const {
        int wr, wc, fr, fq; epi_ids(wr, wc, fr, fq);
        const unsigned row0 = (unsigned)(u.pm * BM + wr * 64 + fr);
        const GAS bf16* xg = (const GAS bf16*)xc; GAS float* ag = (GAS float*)a_out; GAS float* ug = (GAS float*)u_out;
#pragma unroll
        for (int n = 0; n < 2; ++n) { const unsigned ch = (unsigned)(u.pn * 128 + wc * 32 + n * 16 + 4 * fq);
            const f32x4 br = *(const GAS f32x4*)((const GAS float*)b_rg + ch), bi = *(const GAS f32x4*)((const GAS float*)b_ig + ch), s4 = *(const GAS f32x4*)((const GAS float*)sp + ch);
#pragma unroll
            for (int ai = 0; ai < 2; ++ai)
#pragma unroll
                for (int m = 0; m < 4; ++m) { const unsigned off = (row0 + (unsigned)(ai * HALF + m * 16)) * (unsigned)DRNN + ch;
                    const u32x2 xw = *(const GAS u32x2*)(xg + off); const float xv[4] = {bflo(xw.x), bfhi(xw.x), bflo(xw.y), bfhi(xw.y)};
                    const f32x4 pr = acc[ai][0][m][n] + br, pi = acc[ai][1][m][n] + bi; f32x4 av, uv;
#pragma unroll
                    for (int j = 0; j < 4; ++j) { const float r = __builtin_amdgcn_rcpf(1.0f + __expf(-pr[j])), ig = __builtin_amdgcn_rcpf(1.0f + __expf(-pi[j]));
                        const float la = -8.0f * r * s4[j]; const float a = __expf(la); const float x2 = 2.0f * la;
                        const float om = (x2 > -0.03125f) ? -x2 * (1.0f + x2 * (0.5f + x2 * (0.16666667f + x2 * 0.041666668f))) : 1.0f - a * a;
                        av[j] = a; uv[j] = __builtin_amdgcn_sqrtf(om) * (ig * xv[j]); }
                    *(GAS f32x4*)(ag + off) = av; *(GAS f32x4*)(ug + off) = uv; asm volatile("" ::: "memory"); __builtin_amdgcn_sched_barrier(0); }
        }
    }
};
struct EpiSwiglu {
    static constexpr bool PERM = true;
    bf16* O; const float* rs;
    __device__ __forceinline__ void operator()(const f32x4 (&acc)[2][2][4][2], const Unit& u, int, int, int, int) const {
        int wr, wc, fr, fq; epi_ids(wr, wc, fr, fq);
        int row0 = u.pm * BM + wr * 64 + fr; asm volatile("" : "+v"(row0)); const int col0 = u.pn * 128 + wc * 32 + 8 * fq;
#pragma unroll
        for (int ai = 0; ai < 2; ++ai)
#pragma unroll
            for (int m = 0; m < 4; ++m) { const int row = row0 + ai * HALF + m * 16; const float sc = rs[row]; float h[8];
#pragma unroll
                for (int n = 0; n < 2; ++n)
#pragma unroll
                    for (int j = 0; j < 4; ++j) { const float g = acc[ai][0][m][n][j] * sc, up = acc[ai][1][m][n][j] * sc; h[n * 4 + j] = g / (1.0f + __expf(-g)) * up; }
                u32x4 w; w.x = cvt_pk_bf16(h[0], h[1]); w.y = cvt_pk_bf16(h[2], h[3]); w.z = cvt_pk_bf16(h[4], h[5]); w.w = cvt_pk_bf16(h[6], h[7]);
                *(u32x4*)(O + (size_t)row * DE + col0) = w; }
    }
};
struct EpiRouter {
    static constexpr bool PERM = false;
    float* O;
    __device__ __forceinline__ void operator()(const f32x4 (&acc)[2][2][4][2], const Unit& u, int, int, int, int) const {
        int wr, wc, fr, fq; epi_ids(wr, wc, fr, fq);
        if (wc >= 2) return;
        int row0 = u.pm * BM + wr * 64 + fr; asm volatile("" : "+v"(row0)); const int col0 = wc * 32 + 4 * fq;
#pragma unroll
        for (int ai = 0; ai < 2; ++ai)
#pragma unroll
            for (int m = 0; m < 4; ++m) { const int row = row0 + ai * HALF + m * 16;
#pragma unroll
                for (int n = 0; n < 2; ++n) *(f32x4*)(O + (size_t)row * 64 + col0 + n * 16) = acc[ai][0][m][n]; }
    }
};
}
namespace att {
constexpr int NW = 8, QBLK = 32, KVBLK = 64, QB = NW * QBLK;
constexpr int SHM_V = KVBLK * 128 * 2, SHM_K = KVBLK * 128 * 2, SHM_R = KVBLK * 64 * 2;
constexpr int OFF_V = 0, OFF_K = 2 * SHM_V, OFF_R = OFF_K + 2 * SHM_K, OFF_WS = OFF_R + 2 * SHM_R, OFF_QR = OFF_WS + NW * 64 * 4, LDS_BYTES = OFF_QR + NW * 4 * 1024;
constexpr float THR = 8.f;

#define KSWZ(row, colB) ((row) * 256 + ((colB) ^ (((row) & 7) << 4)))
#define RSWZ(row, ch) ((row) * 128 + ((((ch) ^ (((row) >> 1) & 7))) << 4))
#define SBAR() __builtin_amdgcn_sched_barrier(0)
__device__ __forceinline__ int v_st(int k, int c) { const int kk = (k & ~0xC) | ((k & 4) << 1) | ((k & 8) >> 1); return ((kk >> 3) * 4 + (c >> 5)) * 512 + ((kk & 7) * 32 + (c & 31)) * 2; }
__device__ __forceinline__ int v_rd_base(int lane) { return ((lane & 3) << 3) | (((lane >> 2) & 3) << 6) | (((lane >> 4) & 1) << 5) | (((lane >> 5) & 1) << 8); }
constexpr int v_rd_off(int d0, int ks, int half) { return d0 * 512 + ks * 4096 + half * 2048; }
__device__ __forceinline__ int crow(int r, int hi) { return (r & 3) + 8 * (r >> 2) + 4 * hi; }
__device__ __forceinline__ unsigned cvtpk(float lo, float hi) { unsigned r; asm volatile("v_cvt_pk_bf16_f32 %0, %1, %2" : "=v"(r) : "v"(lo), "v"(hi)); return r; }
__device__ __forceinline__ bf16x8 load8(const bf16* p) { return *reinterpret_cast<const bf16x8*>(p); }

__device__ __forceinline__ void mask_tile(f32x16& p0, f32x16& p1, int dq) {
    const float NEG = -__builtin_inff();
#pragma unroll
    for (int r = 0; r < 16; ++r) {
        const int c = (r & 3) + 8 * (r >> 2);
        if (dq - c < 0) p0[r] = NEG;
        if (dq - c - 32 < 0) p1[r] = NEG;
    }
}
__device__ __forceinline__ void partialSM(f32x16& p0, f32x16& p1, float& m_reg, float& mn, float& alpha, const float SCALE) {
    float pmax = p0[0]; for (int r = 1; r < 16; ++r) pmax = fmaxf(pmax, p0[r]); for (int r = 0; r < 16; ++r) pmax = fmaxf(pmax, p1[r]);
    { auto rr = __builtin_amdgcn_permlane32_swap(__float_as_uint(pmax), __float_as_uint(pmax), false, false);
      pmax = fmaxf(__uint_as_float(rr[0]), __uint_as_float(rr[1])); }
    const float C2 = 1.4426950408889634f * SCALE;
    if (__builtin_expect(__all((pmax - m_reg) * SCALE <= THR), 1)) { mn = m_reg; alpha = 1.f; }
    else { mn = fmaxf(m_reg, pmax); alpha = __builtin_amdgcn_exp2f((m_reg - mn) * C2); m_reg = mn; }
    const float mnL = -mn * C2;
    for (int r = 0; r < 16; ++r) p0[r] = fmaf(p0[r], C2, mnL); for (int r = 0; r < 16; ++r) p1[r] = fmaf(p1[r], C2, mnL);
    for (int r = 0; r < 16; ++r) p0[r] = __builtin_amdgcn_exp2f(p0[r]);
}
__device__ __forceinline__ void finishSM(f32x16& p0, f32x16& p1, float alpha, float& l_reg, bf16x8& pa0, bf16x8& pa1, bf16x8& pa2, bf16x8& pa3) {
    for (int r = 0; r < 16; ++r) p1[r] = __builtin_amdgcn_exp2f(p1[r]);
    float ps = 0; for (int r = 0; r < 16; ++r) ps += p0[r]; for (int r = 0; r < 16; ++r) ps += p1[r];
    { auto rr = __builtin_amdgcn_permlane32_swap(__float_as_uint(ps), __float_as_uint(ps), false, false);
      ps = __uint_as_float(rr[0]) + __uint_as_float(rr[1]); }
    l_reg = l_reg * alpha + ps;
#define PK4(P, B_, OUT) do { unsigned a0 = cvtpk(P[B_+0], P[B_+1]), a1 = cvtpk(P[B_+2], P[B_+3]);                          \
        unsigned b0 = cvtpk(P[B_+4], P[B_+5]), b1 = cvtpk(P[B_+6], P[B_+7]);                                             \
        auto r0 = __builtin_amdgcn_permlane32_swap(a0, b0, false, false); auto r1 = __builtin_amdgcn_permlane32_swap(a1, b1, false, false); \
        u32x4 w = {r0[0], r1[0], r0[1], r1[1]}; OUT = *reinterpret_cast<bf16x8*>(&w); } while (0)
    PK4(p0, 0, pa0); PK4(p0, 8, pa1); PK4(p1, 0, pa2); PK4(p1, 8, pa3);
#undef PK4
}
template <int KB, int ROPE>
__device__ __forceinline__ void qkt(f32x16& p0, f32x16& p1, const char* lds, int r32_, int hi_, const bf16x8* qr, const char* qrl) {
    p0 = f32x16{}; p1 = f32x16{};
    int lane_ = r32_ | (hi_ << 5); asm volatile("" : "+v"(lane_)); const int r32 = lane_ & 31, hi = lane_ >> 5;
    const char* kb[4];
#pragma unroll
    for (int dd = 0; dd < 4; ++dd) kb[dd] = lds + OFF_K + KB * SHM_K + KSWZ(r32, (dd * 16 + hi * 8) * 2);
#pragma unroll
    for (int d0 = 0; d0 < 8; ++d0) { const char* a = kb[d0 & 3] + (d0 >> 2) * 128;
        bf16x8 b0 = *reinterpret_cast<const bf16x8*>(a);
        bf16x8 b1 = *reinterpret_cast<const bf16x8*>(a + 32 * 256);
        p0 = __builtin_amdgcn_mfma_f32_32x32x16_bf16(b0, qr[d0], p0, 0, 0, 0);
        p1 = __builtin_amdgcn_mfma_f32_32x32x16_bf16(b1, qr[d0], p1, 0, 0, 0); }
    if constexpr (ROPE > 0) {
#pragma unroll
        for (int d0 = 0; d0 < 4; ++d0) { const char* a = lds + OFF_R + KB * SHM_R + RSWZ(r32, d0 * 2 + hi);
            bf16x8 b0 = *reinterpret_cast<const bf16x8*>(a);
            bf16x8 b1 = *reinterpret_cast<const bf16x8*>(a + 32 * 128);
            const bf16x8 qf = *reinterpret_cast<const bf16x8*>(qrl + d0 * 1024);
            p0 = __builtin_amdgcn_mfma_f32_32x32x16_bf16(b0, qf, p0, 0, 0, 0);
            p1 = __builtin_amdgcn_mfma_f32_32x32x16_bf16(b1, qf, p1, 0, 0, 0); }
    }
}
template <int VB>
__device__ __forceinline__ void pv_tile(f32x16* o, int vb0, bf16x8 pa0, bf16x8 pa1, bf16x8 pa2, bf16x8 pa3) {
#define TRRD(dst, off) asm volatile("ds_read_b64_tr_b16 %0, %1 offset:%2" : "=&v"(dst) : "v"(vb0), "i"(off) : "memory")
#define PV_D0(d0) do { s16x4 l0, l1, l2, l3, h0, h1, h2, h3; constexpr int b_ = OFF_V + VB * SHM_V + v_rd_off(d0, 0, 0); \
        TRRD(l0, b_); TRRD(h0, b_ + 2048); TRRD(l1, b_ + 4096); TRRD(h1, b_ + 6144); TRRD(l2, b_ + 8192); TRRD(h2, b_ + 10240); TRRD(l3, b_ + 12288); TRRD(h3, b_ + 14336); \
        asm volatile("s_waitcnt lgkmcnt(0)" ::: "memory"); SBAR();   \
        o[d0] = __builtin_amdgcn_mfma_f32_32x32x16_bf16(pa0, (bf16x8){l0[0], l0[1], l0[2], l0[3], h0[0], h0[1], h0[2], h0[3]}, o[d0], 0, 0, 0);   \
        o[d0] = __builtin_amdgcn_mfma_f32_32x32x16_bf16(pa1, (bf16x8){l1[0], l1[1], l1[2], l1[3], h1[0], h1[1], h1[2], h1[3]}, o[d0], 0, 0, 0);   \
        o[d0] = __builtin_amdgcn_mfma_f32_32x32x16_bf16(pa2, (bf16x8){l2[0], l2[1], l2[2], l2[3], h2[0], h2[1], h2[2], h2[3]}, o[d0], 0, 0, 0);   \
        o[d0] = __builtin_amdgcn_mfma_f32_32x32x16_bf16(pa3, (bf16x8){l3[0], l3[1], l3[2], l3[3], h3[0], h3[1], h3[2], h3[3]}, o[d0], 0, 0, 0); } while (0)
    PV_D0(0); PV_D0(1); PV_D0(2); PV_D0(3);
#undef PV_D0
#undef TRRD
}

template <int LDQ, int LDK, int LDV, int LDO> struct Strides { static constexpr int ldq = LDQ, ldk = LDK, ldv = LDV, ldo = LDO; };
struct BlockRef { const bf16* Q; const bf16* K; const bf16* V; bf16* O; u64* ssq; int P0; int nk; };
template <int NQ> struct Seam { bf16x8 qr[8]; bf16x8 st_v0, st_v1, st_k0, st_k1, st_r; };

#define VMW() asm volatile("s_waitcnt vmcnt(0)" ::: "memory")
#define VMWN(n) asm volatile("s_waitcnt vmcnt(%0)" :: "i"(n) : "memory")
__device__ __forceinline__ int optid() { int t = threadIdx.x; asm volatile("" : "+v"(t)); return t; }
#define SLOAD_H(Kp, Vp, k0) do { const int t_ = optid(); const unsigned sr_ = t_ >> 4, sc_ = (t_ & 15) * 8, rr_ = t_ >> 3, rc_ = (t_ & 7) * 8;   \
                                 const bf16* kt_ = (Kp) + (size_t)(k0) * st.ldk; const bf16* vt_ = (Vp) + (size_t)(k0) * st.ldv;                    \
                                 S.st_v0 = load8(vt_ + (sr_ * st.ldv + sc_)); S.st_v1 = load8(vt_ + ((32 + sr_) * st.ldv + sc_));                   \
                                 S.st_k0 = load8(kt_ + (sr_ * st.ldk + sc_)); S.st_k1 = load8(kt_ + ((32 + sr_) * st.ldk + sc_));                   \
                                 if constexpr (ROPE > 0) S.st_r = load8(kt_ + (rr_ * st.ldk + 128 + rc_)); } while (0)
#define SWRITE_HK(bf) do { const int t_ = optid(); const int kws_ = KSWZ(t_ >> 4, (t_ & 15) * 16);                                                  \
                           *(bf16x8*)(lds + OFF_K + (bf) * SHM_K + kws_) = S.st_k0; *(bf16x8*)(lds + OFF_K + (bf) * SHM_K + kws_ + 32 * 256) = S.st_k1;   \
                           if constexpr (ROPE > 0) *(bf16x8*)(lds + OFF_R + (bf) * SHM_R + RSWZ(t_ >> 3, t_ & 7)) = S.st_r; } while (0)
#define SWRITE_HV(bf) do { const int t_ = optid(); const int sr_ = t_ >> 4, sc_ = (t_ & 15) * 8;                                                     \
                           *(bf16x8*)(lds + OFF_V + (bf) * SHM_V + v_st(sr_, sc_)) = S.st_v0; *(bf16x8*)(lds + OFF_V + (bf) * SHM_V + v_st(32 + sr_, sc_)) = S.st_v1; } while (0)
#define SWRITE_H(bf) do { SWRITE_HV(bf); SWRITE_HK(bf); } while (0)

template <int ROPE, class ST>
__device__ __forceinline__ void attn_prime(const BlockRef& cur, const ST& st, char* lds, Seam<8 + ROPE / 16>& S) {
    constexpr int NQ = 8 + ROPE / 16;
    int tid = threadIdx.x; asm volatile("" : "+v"(tid)); const int wid = __builtin_amdgcn_readfirstlane(tid >> 6), lane = tid & 63, r32 = lane & 31, hi = lane >> 5;
#pragma unroll
    for (int d0 = 0; d0 < 8; ++d0) S.qr[d0] = load8(cur.Q + (size_t)(wid * QBLK + r32) * st.ldq + d0 * 16 + hi * 8);
    if constexpr (ROPE > 0) {
#pragma unroll
        for (int d0 = 0; d0 < 4; ++d0) *(bf16x8*)(lds + OFF_QR + wid * 4096 + d0 * 1024 + lane * 16) = load8(cur.Q + (size_t)(wid * QBLK + r32) * st.ldq + 128 + d0 * 16 + hi * 8);
    }
    SLOAD_H(cur.K, cur.V, 0); VMW(); SWRITE_HK(0);
    __syncthreads();
}
template <int ROPE, bool CAUSAL, bool STAT, class ST>
__device__ __forceinline__ void attn_block(const BlockRef& cur, const BlockRef& nxt, const ST& st, const float SCALE, char* lds, Seam<8 + ROPE / 16>& S) {
    constexpr int NQ = 8 + ROPE / 16;
    int tid = threadIdx.x; asm volatile("" : "+v"(tid)); const int wid = __builtin_amdgcn_readfirstlane(tid >> 6), lane = tid & 63, r32 = lane & 31, hi = lane >> 5;
    const int NT = CAUSAL ? ((cur.P0 + QB - 1) / KVBLK + 1) : (cur.nk / KVBLK);
    const int qlo = cur.P0 + wid * QBLK, qm = qlo + r32 - 4 * hi;
    float* ws = (float*)(lds + OFF_WS) + wid * 64; float* li_l = ws, * al_l = ws + 32;
    float m_reg = -1e30f, l_reg = 0; f32x16 o[4] = {};
    const int vb0 = (int)(uintptr_t)lds + v_rd_base(lane);
    const bf16* Kh = cur.K; const bf16* Vh = cur.V;
    const char* qrl = lds + OFF_QR + wid * 4096 + lane * 16;
#define RESC(a) do { if (__any((a) < 1.f)) { if (hi == 0) al_l[r32] = (a); asm volatile("s_waitcnt lgkmcnt(0)" ::: "memory");              \
                     for (int d_ = 0; d_ < 4; ++d_) for (int r = 0; r < 16; ++r) o[d_][r] *= al_l[crow(r, hi)]; } } while (0)
#define KBASE(t) ((t) * KVBLK)
#define MASKT(P0_, P1_, t) do { if (CAUSAL) { const int kb_ = KBASE(t); if (kb_ + KVBLK - 1 > qlo) mask_tile(P0_, P1_, qm - kb_); } } while (0)
#define SEAM_K0() do { VMWN(8); SWRITE_HK(0); SBAR(); } while (0)
    f32x16 pA0, pA1, pB0, pB1; float mnA, mnB, alA, alB; bf16x8 pa0, pa1, pa2, pa3;
    SWRITE_HV(0); SBAR();
    if (NT > 1) { SLOAD_H(Kh, Vh, KBASE(1)); }
    SBAR(); qkt<0, ROPE>(pA0, pA1, lds, r32, hi, S.qr, qrl);
    MASKT(pA0, pA1, 0); partialSM(pA0, pA1, m_reg, mnA, alA, SCALE);
    if (NT > 1) { VMW(); SWRITE_H(1); }
    __syncthreads();
#define HALF_STEP(PX0, PX1, mnX, alX, PY0, PY1, alY, t, KB, VB, SB) do {                                                      \
        SBAR(); qkt<KB, ROPE>(PX0, PX1, lds, r32, hi, S.qr, qrl);                                                                  \
        finishSM(PY0, PY1, alY, l_reg, pa0, pa1, pa2, pa3); SBAR();                                                           \
        if ((t) + 1 < NT) { SLOAD_H(Kh, Vh, KBASE((t) + 1)); SBAR(); }                                                        \
        pv_tile<VB>(o, vb0, pa0, pa1, pa2, pa3); MASKT(PX0, PX1, (t)); partialSM(PX0, PX1, m_reg, mnX, alX, SCALE);           \
        __syncthreads();                                                                                                      \
        if ((t) + 1 < NT) { VMW(); SWRITE_H(SB); }                                                                            \
        RESC(alX); __syncthreads(); } while (0)
    for (int t = 1; t + 1 < NT; t += 2) {
        HALF_STEP(pB0, pB1, mnB, alB, pA0, pA1, alA, t, 1, 0, 0);
        HALF_STEP(pA0, pA1, mnA, alA, pB0, pB1, alB, t + 1, 0, 1, 1);
    }
    const bool even = (NT & 1) == 0;
    if (even) { SBAR(); qkt<1, ROPE>(pB0, pB1, lds, r32, hi, S.qr, qrl); SBAR(); }
    SLOAD_H(nxt.K, nxt.V, 0); SBAR();
#pragma unroll
    for (int d0 = 0; d0 < 8; ++d0) S.qr[d0] = load8(nxt.Q + (size_t)(wid * QBLK + r32) * st.ldq + d0 * 16 + hi * 8);
    SBAR();
    finishSM(pA0, pA1, alA, l_reg, pa0, pa1, pa2, pa3); SBAR();
    pv_tile<0>(o, vb0, pa0, pa1, pa2, pa3);
    if (even) { MASKT(pB0, pB1, NT - 1); partialSM(pB0, pB1, m_reg, mnB, alB, SCALE); __syncthreads(); RESC(alB);
        finishSM(pB0, pB1, alB, l_reg, pa0, pa1, pa2, pa3); SBAR(); pv_tile<1>(o, vb0, pa0, pa1, pa2, pa3); }
    SBAR(); SEAM_K0();
    if (hi == 0) li_l[r32] = l_reg; asm volatile("s_waitcnt lgkmcnt(0)" ::: "memory");
    float rli[16];
#pragma unroll
    for (int r = 0; r < 16; ++r) rli[r] = __builtin_amdgcn_rcpf(li_l[crow(r, hi)]);
    bf16* Ow = cur.O + (size_t)(wid * QBLK) * st.ldo;
#pragma unroll
    for (int r = 0; r < 16; ++r) { const int orow = crow(r, hi); float ss = 0.f;
#pragma unroll
        for (int d0 = 0; d0 < 4; ++d0) { const float v = o[d0][r] * rli[r]; ss += v * v;
            const float vn = __shfl_xor(v, 1);
            if ((r32 & 1) == 0) *(unsigned*)(Ow + (size_t)orow * st.ldo + d0 * 32 + r32) = cvtpk(v, vn); }
        if (STAT) { ss += __shfl_xor(ss, 1); ss += __shfl_xor(ss, 2); ss += __shfl_xor(ss, 4); ss += __shfl_xor(ss, 8); ss += __shfl_xor(ss, 16);
            if (r32 == 0) ssq_add(cur.ssq, wid * QBLK + orow, ss); } }
    if constexpr (ROPE > 0) {
#pragma unroll
        for (int d0 = 0; d0 < 4; ++d0) *(bf16x8*)(lds + OFF_QR + wid * 4096 + d0 * 1024 + lane * 16) = load8(nxt.Q + (size_t)(wid * QBLK + r32) * st.ldq + 128 + d0 * 16 + hi * 8);
    }
    __syncthreads();
#undef RESC
#undef KBASE
#undef MASKT
#undef SEAM_K0
#undef HALF_STEP
}
#undef VMW
#undef VMWN
#undef SLOAD_H
#undef SWRITE_HK
#undef SWRITE_HV
#undef SWRITE_H
}
constexpr size_t MiB = 1u << 20;
constexpr size_t WS_CTL = 0, WS_STAT = 1 * MiB, ZERO_BYTES = 3 * MiB;
constexpr size_t WS_TAB = 3 * MiB;
constexpr size_t WS_MEMB = 6 * MiB, WS_KVMEM = 8 * MiB, WS_KMEMN = 10 * MiB, WS_WMKV = 11 * MiB;
constexpr size_t WS_LOGIT = 20 * MiB, WS_MOE = 24 * MiB, WS_SCAN = 26 * MiB;
constexpr size_t WS_W = 28 * MiB;
constexpr size_t W_IN = 0, W_UQ = 12 * MiB, W_UKV = W_UQ + 3 * MiB / 2, W_G = W_UKV + MiB, W_OUT = W_G + MiB, W_MQ = W_OUT + 8 * MiB, W_MO = W_MQ + 2 * MiB, W_R = W_MO + 2 * MiB,
                 W_GU = W_R + MiB, W_D = W_GU + 128 * MiB, W_END = W_D + 64 * MiB;
constexpr size_t WS_XB = 250 * MiB, WS_R = 314 * MiB;
static_assert(WS_W + W_END <= WS_XB, "weights");
constexpr size_t R_Z = 0, R_Q = 96 * MiB, R_KVR = 144 * MiB, R_KK = 208 * MiB, R_XC = 256 * MiB, R_AA = 288 * MiB, R_UU = 352 * MiB, R_YMIX = 416 * MiB, R_END = 480 * MiB;
constexpr size_t R_QM = 0, R_QMN = 64 * MiB, R_OM = 80 * MiB;
constexpr size_t R_ACT = 0, R_Y = 40 * MiB;
constexpr size_t WS_END = WS_R + R_END;
constexpr int CW_BAR = 4096;
constexpr int CW_CNT = 16384;
enum { ST_X = 0, ST_CQ = 1, ST_CKV = 2, ST_YATT = 3, ST_YRNN = 4, ST_X1 = 5, ST_X2 = 6 };
constexpr int RING_BYTES = 131072, LDSCTL_OFF = RING_BYTES, LDS_BYTES = 147456;
constexpr int LC_BAR = 0, LC_NRT = 16, LC_RTAB = 64;

struct Params { const float* in[36]; float* out; unsigned char* ws; int ph_lo, ph_hi, probe, pad; };
static_assert(sizeof(Params) == 36 * 8 + 8 + 8 + 16, "Params layout");
typedef __attribute__((address_space(4))) const unsigned char kchar;
__device__ __forceinline__ kchar* karg_base() { kchar* ka = (kchar*)__builtin_amdgcn_kernarg_segment_ptr(); asm volatile("" : "+s"(ka)); return ka; }
__device__ __forceinline__ const float* in_ptr(const Params&, int i) { return (const float*)(*(GAS const float* const __attribute__((address_space(4)))*)(karg_base() + i * 8)); }
__device__ __forceinline__ float* out_ptr() { return (float*)(*(GAS float* const __attribute__((address_space(4)))*)(karg_base() + 288)); }
__device__ __forceinline__ unsigned char* ws_ptr() { return (unsigned char*)(*(GAS unsigned char* const __attribute__((address_space(4)))*)(karg_base() + 296)); }
__device__ __forceinline__ unsigned char* opaque_ptr(unsigned char*) { return ws_ptr(); }
enum { I_X = 0, I_MEM, I_MIXG, I_WIN, I_QLG, I_KVLG, I_WUQ, I_WUKV, I_AQG, I_AKG, I_CONVW, I_CONVB, I_WRG, I_BRG, I_WIG, I_BIG, I_LAM, I_AOG, I_ROG, I_WOUT, I_XNG, I_MNG, I_WMQ, I_WMK, I_WMV,
       I_MQG, I_MKG, I_WMO, I_MOEG, I_WRGRP, I_BRGRP, I_WREXP, I_BREXP, I_WEG, I_WEU, I_WED };

__device__ __forceinline__ int dmap(int map, int n) {
    if (map == 1) return n < 768 ? n : (n < 832 ? n + 2048 : n - 64);
    if (map == 2) return ((n >> 7) << 8) + (n & 127);
    if (map == 3) return ((n >> 7) << 8) + 128 + (n & 127);
    return n;
}
__device__ __forceinline__ void transpose_item(const float* W, int K, int Nsrc, bf16* WT, const float* gain, int map, LAS float* scr, int item, int lane) {
    const int nblk = Nsrc / 32, kb = item / nblk, nb = item % nblk, k0 = 64 * kb, n0 = 32 * nb;
    const GAS float* src = (const GAS float*)W + (size_t)(k0 + (lane >> 5)) * Nsrc + n0 + (lane & 31);
    float v[32];
#pragma unroll
    for (int i = 0; i < 32; ++i) v[i] = src[(size_t)(2 * i) * Nsrc];
    const int c = lane & 7; const int d0 = dmap(map, n0);
    f32x4 ga = (f32x4){1.f, 1.f, 1.f, 1.f}, gb = ga;
    if (gain) { ga = *(const GAS f32x4*)((const GAS float*)gain + k0 + 8 * c); gb = *(const GAS f32x4*)((const GAS float*)gain + k0 + 8 * c + 4); }
#pragma unroll
    for (int i = 0; i < 32; ++i) scr[(2 * i + (lane >> 5)) * 33 + (lane & 31)] = v[i];
    LDS_WAIT(); asm volatile("" ::: "memory");
#pragma unroll
    for (int j = 0; j < 4; ++j) { const int n = (lane >> 3) + 8 * j; const LAS float* s = scr + (8 * c) * 33 + n;
        u32x4 o; o.x = pk2(s[0 * 33] * ga[0], s[1 * 33] * ga[1]); o.y = pk2(s[2 * 33] * ga[2], s[3 * 33] * ga[3]); o.z = pk2(s[4 * 33] * gb[0], s[5 * 33] * gb[1]); o.w = pk2(s[6 * 33] * gb[2], s[7 * 33] * gb[3]);
        *(GAS u32x4*)((GAS bf16*)WT + (size_t)(d0 + n) * K + k0 + 8 * c) = o; }
    LDS_WAIT(); asm volatile("" ::: "memory");
}
__device__ __forceinline__ void convert_layer_weights(const Params& p, int l, LAS float* scr, int gw, int NGW, int lane, int gtid, int NGT) {
    unsigned char* wb = opaque_ptr(p.ws) + WS_W;
    constexpr int I0 = 32 * 90, I1 = 8 * 48, I2 = 4 * 64, I3 = 32 * 64, I4 = 32 * 16, I5 = 8 * 64, IE = 32 * 16, IEX = 32 * IE, ID = 8 * 64, IDX = 32 * ID;
    constexpr int NIT = I0 + I1 + I2 + I3 + I4 + I5 + 2 * IEX + IDX;
    for (int it = gw; it < NIT; it += NGW) {
        int r = it;
        if (r < I0) { transpose_item(in_ptr(p, I_WIN) + (size_t)l * D * 2880, D, 2880, (bf16*)(wb + W_IN), in_ptr(p, I_MIXG) + l * D, 1, scr, r, lane); continue; } r -= I0;
        if (r < I1) { transpose_item(in_ptr(p, I_WUQ) + (size_t)l * QL * NQU, QL, NQU, (bf16*)(wb + W_UQ), in_ptr(p, I_QLG) + l * QL, 0, scr, r, lane); continue; } r -= I1;
        if (r < I2) { transpose_item(in_ptr(p, I_WUKV) + (size_t)l * KVL * NKV, KVL, NKV, (bf16*)(wb + W_UKV), in_ptr(p, I_KVLG) + l * KVL, 0, scr, r, lane); continue; } r -= I2;
        if (r < I3) { const int k0 = 64 * (r / 64); const float* g = (k0 < 1024) ? (in_ptr(p, I_AOG) + l * 1024) : (in_ptr(p, I_ROG) + l * 1024 - 1024);
                      transpose_item(in_ptr(p, I_WOUT) + (size_t)l * D * D, D, D, (bf16*)(wb + W_OUT), g, 0, scr, r, lane); continue; } r -= I3;
        if (r < I4) { transpose_item(in_ptr(p, I_WMQ) + (size_t)l * D * DMA, D, DMA, (bf16*)(wb + W_MQ), in_ptr(p, I_XNG) + l * D, 0, scr, r, lane); continue; } r -= I4;
        if (r < I5) { transpose_item(in_ptr(p, I_WMO) + (size_t)l * DMA * D, DMA, D, (bf16*)(wb + W_MO), nullptr, 0, scr, r, lane); continue; } r -= I5;
        if (r < IEX) { const int e = r / IE; transpose_item(in_ptr(p, I_WEG) + ((size_t)l * NE + e) * D * DE, D, DE, (bf16*)(wb + W_GU) + (size_t)e * 1024 * D, in_ptr(p, I_MOEG) + l * D, 2, scr, r % IE, lane); continue; } r -= IEX;
        if (r < IEX) { const int e = r / IE; transpose_item(in_ptr(p, I_WEU) + ((size_t)l * NE + e) * D * DE, D, DE, (bf16*)(wb + W_GU) + (size_t)e * 1024 * D, in_ptr(p, I_MOEG) + l * D, 3, scr, r % IE, lane); continue; } r -= IEX;
        { const int e = r / ID; transpose_item(in_ptr(p, I_WED) + ((size_t)l * NE + e) * DE * D, DE, D, (bf16*)(wb + W_D) + (size_t)e * D * DE, nullptr, 0, scr, r % ID, lane); }
    }
    { u32x4* z = (u32x4*)((bf16*)(wb + W_IN) + (size_t)2880 * D); const int n16 = 192 * D * 2 / 16; for (int i = gtid; i < n16; i += NGT) z[i] = (u32x4){0u, 0u, 0u, 0u}; }
    { bf16* wr = (bf16*)(wb + W_R); const float* wg = in_ptr(p, I_WRGRP) + (size_t)l * D * 4; const float* we = in_ptr(p, I_WREXP) + (size_t)l * D * 32; const float* g = in_ptr(p, I_MOEG) + l * D;
      for (int i = gtid; i < 256 * D / 8; i += NGT) { const int n = i / (D / 8), k0 = (i % (D / 8)) * 8; float v[8];
#pragma unroll
          for (int j = 0; j < 8; ++j) { const int k = k0 + j; v[j] = n < 4 ? wg[k * 4 + n] * g[k] : (n < 36 ? we[k * 32 + (n - 4)] * g[k] : 0.f); }
          u32x4 o; o.x = pk2(v[0], v[1]); o.y = pk2(v[2], v[3]); o.z = pk2(v[4], v[5]); o.w = pk2(v[6], v[7]); *(u32x4*)(wr + (size_t)n * D + k0) = o; } }
    { bf16* wg = (bf16*)(wb + W_G); const float* wr = in_ptr(p, I_WRG) + (size_t)l * 8 * 128 * 128; const float* wi = in_ptr(p, I_WIG) + (size_t)l * 8 * 128 * 128;
      for (int i = gtid; i < 8 * 256 * 256 / 8; i += NGT) { const int n = i >> 13, j = (i >> 5) & 255, c0 = (i & 31) * 8; float v[8];
          const bool on = (c0 >> 7) == (n & 1); const float* src = (j < 128 ? wr : wi) + (size_t)n * 128 * 128 + (j & 127);
#pragma unroll
          for (int q = 0; q < 8; ++q) v[q] = on ? src[(size_t)((c0 & 127) + q) * 128] : 0.f;
          u32x4 o; o.x = pk2(v[0], v[1]); o.y = pk2(v[2], v[3]); o.z = pk2(v[4], v[5]); o.w = pk2(v[6], v[7]); *(u32x4*)(wg + (size_t)i * 8) = o; } }
}
__device__ __forceinline__ float row_to_bf16(const float* xrow, bf16* orow, int lane) {
    float ss = 0.f;
#pragma unroll
    for (int j = 0; j < 4; ++j) { const int c = lane * 8 + 512 * j; const f32x4 a = *(const f32x4*)(xrow + c), b = *(const f32x4*)(xrow + c + 4);
        ss += (a[0] * a[0] + a[1] * a[1]) + (a[2] * a[2] + a[3] * a[3]) + (b[0] * b[0] + b[1] * b[1]) + (b[2] * b[2] + b[3] * b[3]);
        u32x4 o; o.x = pk2(a[0], a[1]); o.y = pk2(a[2], a[3]); o.z = pk2(b[0], b[1]); o.w = pk2(b[2], b[3]); *(u32x4*)(orow + c) = o; }
    return wave_sum(ss);
}
__device__ __forceinline__ float gelu_tanh(float x) { const float y = 0.7978845608028654f * (x + 0.044715f * x * x * x); const float e = __expf(2.0f * y); const float th = 1.0f - 2.0f / (e + 1.0f); return 0.5f * x * (1.0f + th); }
__device__ __forceinline__ void unpack8(u32x4 w, float* v) { v[0] = bflo(w.x); v[1] = bfhi(w.x); v[2] = bflo(w.y); v[3] = bfhi(w.y); v[4] = bflo(w.z); v[5] = bfhi(w.z); v[6] = bflo(w.w); v[7] = bfhi(w.w); }
__device__ __forceinline__ u32x4 pack8f(const float* v) { u32x4 o; o.x = pk2(v[0], v[1]); o.y = pk2(v[2], v[3]); o.z = pk2(v[4], v[5]); o.w = pk2(v[6], v[7]); return o; }

__device__ __forceinline__ void conv_phase(const bf16* z, bf16* xc, const float* cw, const float* cb, int gtid, int NGT) {
    for (int it = gtid; it < (T / 16) * 128; it += NGT) {
        const int tb = it >> 7, cg = it & 127, row0 = tb * 16, s0 = row0 & (SEQ - 1), c0 = cg * 8;
        float w[4][8], b[8], p1[8], p2[8], p3[8];
#pragma unroll
        for (int j = 0; j < 4; ++j) { const f32x4 a = *(const f32x4*)(cw + j * DRNN + c0), bb = *(const f32x4*)(cw + j * DRNN + c0 + 4);
            w[j][0] = a[0]; w[j][1] = a[1]; w[j][2] = a[2]; w[j][3] = a[3]; w[j][4] = bb[0]; w[j][5] = bb[1]; w[j][6] = bb[2]; w[j][7] = bb[3]; }
        { const f32x4 a = *(const f32x4*)(cb + c0), bb = *(const f32x4*)(cb + c0 + 4); b[0] = a[0]; b[1] = a[1]; b[2] = a[2]; b[3] = a[3]; b[4] = bb[0]; b[5] = bb[1]; b[6] = bb[2]; b[7] = bb[3]; }
        const bf16* zp = z + (size_t)row0 * ZC + Z_XR + c0;
        if (s0 >= 1) unpack8(*(const u32x4*)(zp - (size_t)ZC), p1); else { for (int e = 0; e < 8; ++e) p1[e] = 0.f; }
        if (s0 >= 2) unpack8(*(const u32x4*)(zp - (size_t)2 * ZC), p2); else { for (int e = 0; e < 8; ++e) p2[e] = 0.f; }
        if (s0 >= 3) unpack8(*(const u32x4*)(zp - (size_t)3 * ZC), p3); else { for (int e = 0; e < 8; ++e) p3[e] = 0.f; }
#pragma unroll 4
        for (int r = 0; r < 16; ++r) { float cur[8], o[8]; unpack8(*(const u32x4*)(zp + (size_t)r * ZC), cur);
#pragma unroll
            for (int e = 0; e < 8; ++e) { o[e] = b[e] + w[3][e] * cur[e] + w[2][e] * p1[e] + w[1][e] * p2[e] + w[0][e] * p3[e]; p3[e] = p2[e]; p2[e] = p1[e]; p1[e] = cur[e]; }
            *(u32x4*)(xc + (size_t)(row0 + r) * DRNN + c0) = pack8f(o); }
    }
}
__device__ __forceinline__ void qk_post_phase(bf16* q, const bf16* kvr, const bf16* z, bf16* kk, const float* gq, const float* gk, const float* cosT, const float* sinT, int gw, int NGW, int lane) {
    const int h = lane >> 3, j = lane & 7;
    for (int row = gw; row < T; row += NGW) {
        const int s = row & (SEQ - 1);
        float cs[8], sn[8];
        { const int i0 = (j & 3) * 8; const f32x4 a = *(const f32x4*)(cosT + s * 32 + i0), b = *(const f32x4*)(cosT + s * 32 + i0 + 4), c = *(const f32x4*)(sinT + s * 32 + i0), d = *(const f32x4*)(sinT + s * 32 + i0 + 4);
          cs[0] = a[0]; cs[1] = a[1]; cs[2] = a[2]; cs[3] = a[3]; cs[4] = b[0]; cs[5] = b[1]; cs[6] = b[2]; cs[7] = b[3];
          sn[0] = c[0]; sn[1] = c[1]; sn[2] = c[2]; sn[3] = c[3]; sn[4] = d[0]; sn[5] = d[1]; sn[6] = d[2]; sn[7] = d[3]; }
#pragma unroll
        for (int which = 0; which < 2; ++which) {
            float v[3][8];
            if (which == 0) { bf16* qp = q + (size_t)row * NQU + h * QKH + j * 8;
#pragma unroll
                for (int i = 0; i < 3; ++i) unpack8(*(const u32x4*)(qp + 64 * i), v[i]); }
            else { const bf16* kp = kvr + (size_t)row * NKV + h * 256 + j * 8; unpack8(*(const u32x4*)kp, v[0]); unpack8(*(const u32x4*)(kp + 64), v[1]);
                   unpack8(*(const u32x4*)(z + (size_t)row * ZC + Z_KPE + j * 8), v[2]); }
            float ss = 0.f;
#pragma unroll
            for (int i = 0; i < 3; ++i)
#pragma unroll
                for (int e = 0; e < 8; ++e) ss += v[i][e] * v[i][e];
            ss += __shfl_xor(ss, 1); ss += __shfl_xor(ss, 2); ss += __shfl_xor(ss, 4);
            const float rstd = 1.0f / sqrtf(ss * (1.0f / 192.0f) + EPS);
            const float* g = which == 0 ? gq : gk;
#pragma unroll
            for (int i = 0; i < 3; ++i) { const f32x4 ga = *(const f32x4*)(g + 64 * i + j * 8), gb = *(const f32x4*)(g + 64 * i + j * 8 + 4);
                v[i][0] *= rstd * ga[0]; v[i][1] *= rstd * ga[1]; v[i][2] *= rstd * ga[2]; v[i][3] *= rstd * ga[3]; v[i][4] *= rstd * gb[0]; v[i][5] *= rstd * gb[1]; v[i][6] *= rstd * gb[2]; v[i][7] *= rstd * gb[3]; }
#pragma unroll
            for (int e = 0; e < 8; ++e) { const float mine = v[2][e], oth = __shfl_xor(mine, 4);
                v[2][e] = (j < 4) ? (mine * cs[e] - oth * sn[e]) : (oth * sn[e] + mine * cs[e]); }
            bf16* op = (which == 0 ? q + (size_t)row * NQU : kk + (size_t)row * NQU) + h * QKH + j * 8;
#pragma unroll
            for (int i = 0; i < 3; ++i) *(u32x4*)(op + 64 * i) = pack8f(v[i]);
        }
    }
}
template <bool F32IN>
__device__ __forceinline__ void head128_norm_rows(const void* in0, const float* in1, int ld_in, bf16* out, const float* g, int nrows, int gw, int NGW, int lane) {
    for (int row = gw; row < nrows; row += NGW) {
        float v[8];
        if (F32IN) { const float* a = (const float*)in0 + (size_t)row * ld_in + lane * 8; const float* b = in1 + (size_t)row * ld_in + lane * 8;
            const f32x4 a0 = *(const f32x4*)a, a1 = *(const f32x4*)(a + 4), b0 = *(const f32x4*)b, b1 = *(const f32x4*)(b + 4);
            v[0] = a0[0] + b0[0]; v[1] = a0[1] + b0[1]; v[2] = a0[2] + b0[2]; v[3] = a0[3] + b0[3]; v[4] = a1[0] + b1[0]; v[5] = a1[1] + b1[1]; v[6] = a1[2] + b1[2]; v[7] = a1[3] + b1[3]; }
        else unpack8(*(const u32x4*)((const bf16*)in0 + (size_t)row * ld_in + lane * 8), v);
        float ss = 0.f;
#pragma unroll
        for (int e = 0; e < 8; ++e) ss += v[e] * v[e];
        ss += __shfl_xor(ss, 1); ss += __shfl_xor(ss, 2); ss += __shfl_xor(ss, 4); ss += __shfl_xor(ss, 8);
        const float rstd = 1.0f / sqrtf(ss * (1.0f / 128.0f) + EPS);
        const int c = (lane * 8) & 127; const f32x4 ga = *(const f32x4*)(g + c), gb = *(const f32x4*)(g + c + 4);
        v[0] *= rstd * ga[0]; v[1] *= rstd * ga[1]; v[2] *= rstd * ga[2]; v[3] *= rstd * ga[3]; v[4] *= rstd * gb[0]; v[5] *= rstd * gb[1]; v[6] *= rstd * gb[2]; v[7] *= rstd * gb[3];
        *(u32x4*)(out + (size_t)row * DMA + lane * 8) = pack8f(v);
    }
}
__device__ __forceinline__ void scan_pass1(const float* aa, const float* uu, float* cA, float* cH, int unit, int tid) {
    const int half = unit & 1, chunk = (unit >> 1) & 63, b = unit >> 7, ch = half * 512 + tid;
    const size_t base = ((size_t)b * SEQ + (size_t)chunk * 128) * DRNN + ch;
    float A = 1.f, H = 0.f;
#pragma unroll 16
    for (int s = 0; s < 128; ++s) { const float a = aa[base + (size_t)s * DRNN], u = uu[base + (size_t)s * DRNN]; H = a * H + u; A *= a; }
    cA[(size_t)(b * 64 + chunk) * DRNN + ch] = A; cH[(size_t)(b * 64 + chunk) * DRNN + ch] = H;
}
__device__ __forceinline__ void scan_pass3(const float* aa, const float* uu, const float* cA, const float* cH, const bf16* z, bf16* ymix, u64* ssq, int unit, int tid, int lane) {
    const int half = unit & 1, chunk = (unit >> 1) & 63, b = unit >> 7, ch = half * 512 + tid;
    float h = 0.f;
    for (int j = 0; j < chunk; ++j) h = cA[(size_t)(b * 64 + j) * DRNN + ch] * h + cH[(size_t)(b * 64 + j) * DRNN + ch];
    const size_t row0 = (size_t)b * SEQ + (size_t)chunk * 128;
#pragma unroll 8
    for (int s = 0; s < 128; ++s) { const size_t row = row0 + s; const float a = aa[row * DRNN + ch], u = uu[row * DRNN + ch]; h = a * h + u;
        const float g = bf2f(z[row * ZC + Z_GATE + ch]); const float y = h * gelu_tanh(g);
        ymix[row * D + DATT + ch] = (bf16)f2bf(y);
        const float ss = wave_sum(y * y); if (lane == 0) ssq_add(ssq, (int)row, ss); }
}
__device__ __forceinline__ void route_phase(const float* logits, const u64* ssq_x2, const float* bg, const float* be, int* tok_e, float* tok_w, int* whist, unsigned* cnt, LAS int* hist, int wg, int tid) {
    if (tid < 32) hist[tid] = 0;
    __syncthreads();
    if (tid < 64) { const int t = wg * 64 + tid; const float rs = 1.0f / sqrtf(ssq_val(ssq_x2, t) * (1.0f / D) + EPS); const float* lp = logits + (size_t)t * 64;
        float lg[4]; int g = 0; float mx = -3.0e38f;
#pragma unroll
        for (int i = 0; i < 4; ++i) { lg[i] = lp[i] * rs + bg[i]; if (lg[i] > mx) { mx = lg[i]; g = i; } }
        float den = 0.f;
#pragma unroll
        for (int i = 0; i < 4; ++i) den += __expf(lg[i] - mx);
        const float gw = 1.0f / den;
        float l1 = -3.0e38f, l2 = -3.0e38f; int j1 = 0, j2 = 0;
        for (int i = 0; i < 8; ++i) { const float v = lp[4 + g * 8 + i] * rs + be[g * 8 + i];
            if (v > l1) { l2 = l1; j2 = j1; l1 = v; j1 = i; } else if (v > l2) { l2 = v; j2 = i; } }
        const float w1 = 1.0f / (1.0f + __expf(l2 - l1)), w2 = 1.0f - w1;
        const int e1 = g * 8 + j1, e2 = g * 8 + j2;
        tok_e[t * 2] = e1; tok_e[t * 2 + 1] = e2; tok_w[t * 2] = gw * w1; tok_w[t * 2 + 1] = gw * w2;
        __hip_atomic_fetch_add(hist + e1, 1, __ATOMIC_RELAXED, __HIP_MEMORY_SCOPE_WORKGROUP); __hip_atomic_fetch_add(hist + e2, 1, __ATOMIC_RELAXED, __HIP_MEMORY_SCOPE_WORKGROUP);
    }
    __syncthreads();
    if (tid < 32) { const int c = hist[tid]; whist[wg * 32 + tid] = c; if (c) atomicAdd(cnt + tid, (unsigned)c); }
}
__device__ __forceinline__ void dispatch_phase(const unsigned* cnt, const int* whist, const int* tok_e, const float* tok_w, const u64* ssq_x2, int* tok_slot, int* slot_tok, float* slot_w, float* slot_rs,
                                               LAS int* sc, int wg, int tid) {
    if (tid == 0) { int seg = 0; for (int e = 0; e < 32; ++e) { sc[e] = seg; seg += (((int)cnt[e] + 255) >> 8) << 8; } }
    { const int e = tid & 31, part = tid >> 5; int s = 0; for (int w = part; w < wg; w += 16) s += whist[w * 32 + e]; sc[64 + tid] = s; }
    if (tid < 128) sc[640 + tid] = tok_e[(wg * 64) * 2 + tid];
    __syncthreads();
    if (tid < 32) { int s = sc[tid]; for (int p = 0; p < 16; ++p) s += sc[64 + p * 32 + tid]; sc[32 + tid] = s; }
    __syncthreads();
    if (tid < 128) { const int e = sc[640 + tid]; int rank = 0; for (int j = 0; j < tid; ++j) rank += (sc[640 + j] == e) ? 1 : 0;
        const int slot = sc[32 + e] + rank; const int t = wg * 64 + (tid >> 1);
        slot_tok[slot] = t; slot_w[slot] = tok_w[(wg * 64) * 2 + tid]; slot_rs[slot] = 1.0f / sqrtf(ssq_val(ssq_x2, t) * (1.0f / D) + EPS); tok_slot[(wg * 64) * 2 + tid] = slot; }
    if (wg < 32) { const int c = (int)cnt[wg], lo = sc[wg] + c, hi = sc[wg] + (((c + 255) >> 8) << 8);
        for (int s = lo + tid; s < hi; s += NTHREADS) { slot_tok[s] = 0; slot_w[s] = 0.f; slot_rs[s] = 0.f; } }
    __syncthreads();
}
__device__ __forceinline__ int build_rtab(const unsigned* cnt, LAS int* lc, int tid) {
    if (tid == 0) { int seg = 0, k = 0; for (int e = 0; e < 32; ++e) { const int nt = ((int)cnt[e] + 255) >> 8; for (int r = 0; r < nt; ++r) { lc[LC_RTAB / 4 + 2 * k] = e; lc[LC_RTAB / 4 + 2 * k + 1] = seg + r * 256; ++k; } seg += nt * 256; } lc[LC_NRT / 4] = k; }
    __syncthreads();
    return lc[LC_NRT / 4];
}
__device__ __forceinline__ void combine_phase(float* x, const bf16* Y, const int* tok_slot, bf16* xb, u64* ssq_next, int gw, int NGW, int lane) {
    for (int row = gw; row < T; row += NGW) {
        const int s0 = tok_slot[row * 2], s1 = tok_slot[row * 2 + 1]; float ss = 0.f;
#pragma unroll
        for (int j = 0; j < 4; ++j) { const int c = lane * 8 + 512 * j; float* xp = x + (size_t)row * D + c;
            const f32x4 a = *(const f32x4*)xp, b = *(const f32x4*)(xp + 4); float y0[8], y1[8], v[8];
            unpack8(*(const u32x4*)(Y + (size_t)s0 * D + c), y0); unpack8(*(const u32x4*)(Y + (size_t)s1 * D + c), y1);
            v[0] = a[0] + y0[0] + y1[0]; v[1] = a[1] + y0[1] + y1[1]; v[2] = a[2] + y0[2] + y1[2]; v[3] = a[3] + y0[3] + y1[3];
            v[4] = b[0] + y0[4] + y1[4]; v[5] = b[1] + y0[5] + y1[5]; v[6] = b[2] + y0[6] + y1[6]; v[7] = b[3] + y0[7] + y1[7];
            *(f32x4*)xp = (f32x4){v[0], v[1], v[2], v[3]}; *(f32x4*)(xp + 4) = (f32x4){v[4], v[5], v[6], v[7]};
            if (xb) *(u32x4*)(xb + (size_t)row * D + c) = pack8f(v);
#pragma unroll
            for (int e = 0; e < 8; ++e) ss += v[e] * v[e]; }
        ss = wave_sum(ss); if (ssq_next && lane == 0) ssq_set(ssq_next, row, ss);
    }
}
constexpr int NPL = 16, NPHASES = 1 + DEPTH * NPL;
__device__ __forceinline__ att::BlockRef mla_ref(int it, int pass, bf16* qbuf, bf16* kk, bf16* kvr, bf16* ymix, u64* ssq_ya) {
    const int bh = (it & 7) * 2 + ((it >> 3) >> 4), y = (it >> 3) & 15, b = bh >> 3, h = bh & 7; const int qb = pass ? 31 - y : y; const size_t r0 = (size_t)b * SEQ;
    att::BlockRef c; c.K = kk + r0 * NQU + h * QKH; c.V = kvr + r0 * NKV + h * 256 + 128; c.nk = SEQ;
    c.Q = qbuf + (r0 + (size_t)qb * 256) * NQU + h * QKH; c.O = ymix + (r0 + (size_t)qb * 256) * D + h * VH; c.ssq = ssq_ya + r0 + qb * 256; c.P0 = qb * 256; return c;
}
#ifndef PH_MASK
#define PH_MASK 0x1ffff
#endif
#define PH_ON(j) (((PH_MASK) >> (j)) & 1)
__global__ void __launch_bounds__(NTHREADS, 2) fwd_kernel(Params p) {
    extern __shared__ __attribute__((aligned(16))) unsigned char lds_raw[];
    LAS unsigned char* lds = (LAS unsigned char*)lds_raw;
    LAS int* lc = (LAS int*)(lds + LDSCTL_OFF);
    const int G = gridDim.x, bx = blockIdx.x;
    const int NGW = G * NWAVES, NGT = G * NTHREADS;
    if (threadIdx.x < 64) lc[threadIdx.x] = 0;
    __syncthreads();
    XcdBarrier bar = xcd_barrier_post((unsigned*)(ws_ptr() + WS_CTL) + CW_BAR, (volatile LAS unsigned*)(lds + LDSCTL_OFF + LC_BAR));
    const int lo = p.ph_lo, hi = p.ph_hi; const bool probe = p.probe != 0;
#define IN(k) (lo <= (k) && (k) < hi)
#define SEAM(k) do { if ((k) + 1 < hi) xcd_barrier(bar); } while (0)
#define WS_PTRS() unsigned char* ws = opaque_ptr(p.ws); unsigned char* wb = ws + WS_W; unsigned char* rg = ws + WS_R; (void)wb; (void)rg; \
    int tid = threadIdx.x; asm volatile("" : "+v"(tid)); const int lane = tid & 63, wave = __builtin_amdgcn_readfirstlane(tid >> 6); \
    const int gw = bx * NWAVES + wave, gtid = bx * NTHREADS + tid; (void)lane; (void)gw; (void)gtid
#define INP(i) in_ptr(p, (i))
#define STATP(l, k) ((u64*)(ws + WS_STAT) + (size_t)((l) * 7 + (k)) * 16384)

    if (PH_ON(0) && IN(0)) {
        WS_PTRS();
        float* cosT = (float*)(ws + WS_TAB); float* sinT = cosT + SEQ * 32; float* spT = (float*)(ws + WS_TAB + 2 * MiB); u64* ssq_mem = (u64*)(spT + 2 * 1024);
        bf16* memb = (bf16*)(ws + WS_MEMB); bf16* wmkv = (bf16*)(ws + WS_WMKV); bf16* xb = (bf16*)(ws + WS_XB);
        LAS float* scr = (LAS float*)(lds + wave * 16384);
        convert_layer_weights(p, 0, scr, gw, NGW, lane, gtid, NGT);
        for (int it = gw; it < 2 * 2 * 32 * 16; it += NGW) { const int l = it / (2 * 512), r = it % (2 * 512), kv = r / 512, item = r % 512;
            transpose_item(INP(kv ? I_WMV : I_WMK) + (size_t)l * D * DMA, D, DMA, wmkv + (size_t)l * 1024 * D + (size_t)kv * 512 * D, INP(I_MNG) + l * D, 0, scr, item, lane); }
        for (int i = gtid; i < SEQ * 32; i += NGT) { const int t = i >> 5, k = i & 31; const float inv = exp2f(-(float)k * (13.287712379549449f / 32.0f)); float s, c; sincosf((float)t * inv, &s, &c); cosT[i] = c; sinT[i] = s; }
        { const float* lam = INP(I_LAM); for (int i = gtid; i < 2 * 1024; i += NGT) spT[i] = log1pf(expf(-lam[i])); }
        u64* ssq_x0 = STATP(0, ST_X);
        { const float* x = INP(I_X); for (int row = gw; row < T; row += NGW) { const float ss = row_to_bf16(x + (size_t)row * D, xb + (size_t)row * D, lane); if (lane == 0) ssq_set(ssq_x0, row, ss); } }
        { const float* m = INP(I_MEM); for (int row = gw; row < TM; row += NGW) { const float ss = row_to_bf16(m + (size_t)row * D, memb + (size_t)row * D, lane); if (lane == 0) ssq_set(ssq_mem, row, ss); } }
        SEAM(0);
    }

    for (int l = 0; l < DEPTH; ++l) {
        const int pb = 1 + l * NPL;

        if (PH_ON(1) && IN(pb + 0)) {
            WS_PTRS();
            { pg8::DenseSched S{(const char*)(ws + WS_XB), (const char*)(wb + W_IN), D, D, T / 256, ZC / 256, 1, D, G, bx};
              pg8::EpiBf16<0, true> E{(bf16*)(rg + R_Z), ZC, STATP(l, ST_X), 1.0f / D, STATP(l, ST_CQ), STATP(l, ST_CKV), 2, 3};
              pg8::gemm_phase<pg8::EpiBf16<0, true>, pg8::DenseSched, true, false>(lds, D, D, D, S, E, 0); }
            if (l == 0) {
                pg8::DenseSched S{(const char*)(ws + WS_MEMB), (const char*)(ws + WS_WMKV), D, D, TM / 256, 2 * 1024 / 256, 1, D, G, bx};
                pg8::EpiBf16<0, false> E{(bf16*)(ws + WS_KVMEM), 2 * 1024, (const void*)((float*)(ws + WS_TAB + 2 * MiB) + 2 * 1024), 1.0f / D, nullptr, nullptr, 0, 0};
                pg8::gemm_phase<pg8::EpiBf16<0, false>, pg8::DenseSched, true, false>(lds, D, D, D, S, E, 0);
            }
            SEAM(pb + 0);
        }
        if (PH_ON(2) && IN(pb + 1)) {
            WS_PTRS();
            bf16* z = (bf16*)(rg + R_Z);
            { pg8::DenseSched S{(const char*)(z + Z_CQ), (const char*)(wb + W_UQ), ZC, QL, T / 256, NQU / 256, 1, QL, G, bx};
              pg8::EpiBf16<0, false> E{(bf16*)(rg + R_Q), NQU, STATP(l, ST_CQ), 1.0f / QL, nullptr, nullptr, 0, 0};
              pg8::gemm_phase<pg8::EpiBf16<0, false>, pg8::DenseSched, true, false>(lds, QL, ZC, QL, S, E, 0); }
            { pg8::DenseSched S{(const char*)(z + Z_CKV), (const char*)(wb + W_UKV), ZC, KVL, T / 256, NKV / 256, 1, KVL, G, bx};
              pg8::EpiBf16<0, false> E{(bf16*)(rg + R_KVR), NKV, STATP(l, ST_CKV), 1.0f / KVL, nullptr, nullptr, 0, 0};
              pg8::gemm_phase<pg8::EpiBf16<0, false>, pg8::DenseSched, true, false>(lds, KVL, ZC, KVL, S, E, 0); }
            conv_phase(z, (bf16*)(rg + R_XC), INP(I_CONVW) + (size_t)l * 4 * DRNN, INP(I_CONVB) + (size_t)l * DRNN, gtid, NGT);
            if (l == 0) { const float* mkg = INP(I_MKG); for (int ll = 0; ll < 2; ++ll) head128_norm_rows<false>((bf16*)(ws + WS_KVMEM) + (size_t)ll * 1024, nullptr, 2 * 1024, (bf16*)(ws + WS_KMEMN) + (size_t)ll * TM * DMA, mkg + ll * 128, TM, gw, NGW, lane); }
            SEAM(pb + 1);
        }
        if (PH_ON(3) && IN(pb + 2)) {
            WS_PTRS();
            float* cosT = (float*)(ws + WS_TAB);
            qk_post_phase((bf16*)(rg + R_Q), (const bf16*)(rg + R_KVR), (const bf16*)(rg + R_Z), (bf16*)(rg + R_KK), INP(I_AQG) + l * QKH, INP(I_AKG) + l * QKH, cosT, cosT + SEQ * 32, gw, NGW, lane);
            { pg8::GateSched S{(const char*)(rg + R_XC), (const char*)(wb + W_G), G, bx};
              pg8::EpiGates E{(const bf16*)(rg + R_XC), INP(I_BRG) + l * DRNN, INP(I_BIG) + l * DRNN, (float*)(ws + WS_TAB + 2 * MiB) + l * DRNN, (float*)(rg + R_AA), (float*)(rg + R_UU)};
              pg8::gemm_phase<pg8::EpiGates, pg8::GateSched, true, false>(lds, 256, DRNN, 256, S, E, 0); }
            SEAM(pb + 2);
        }
        if (PH_ON(4) && IN(pb + 3)) {
            WS_PTRS();
            float* chA = (float*)(ws + WS_SCAN);
            for (int u = bx; u < 256; u += G) scan_pass1((const float*)(rg + R_AA), (const float*)(rg + R_UU), chA, chA + 2 * 64 * DRNN, u, tid);
            SEAM(pb + 3);
        }
        if (PH_ON(5) && IN(pb + 4)) {
            WS_PTRS();
            bf16* ymix = (bf16*)(rg + R_YMIX);
            {
                bf16* qbuf = (bf16*)(rg + R_Q); bf16* kk = (bf16*)(rg + R_KK); bf16* kvr = (bf16*)(rg + R_KVR); u64* ssq_ya = STATP(l, ST_YATT);
                const att::Strides<NQU, NQU, NKV, D> sd;
                for (int it = bx; it < 256; it += G) {
                    att::BlockRef cur = mla_ref(it, 0, qbuf, kk, kvr, ymix, ssq_ya);
                    att::Seam<12> S;
                    att::attn_prime<64>(cur, sd, (char*)lds_raw, S);
                    for (int pass = 0; pass < 2; ++pass) {
                        const att::BlockRef nxt = (pass == 0) ? mla_ref(it, 1, qbuf, kk, kvr, ymix, ssq_ya) : cur;
                        att::attn_block<64, true, true>(cur, nxt, sd, 0.07216878364870322f, (char*)lds_raw, S);
                        cur = nxt;
                    }
                }
            }
            { float* chA = (float*)(ws + WS_SCAN);
              for (int u = bx; u < 256; u += G) scan_pass3((const float*)(rg + R_AA), (const float*)(rg + R_UU), chA, chA + 2 * 64 * DRNN, (const bf16*)(rg + R_Z), ymix, STATP(l, ST_YRNN), u, tid, lane); }
            SEAM(pb + 4);
        }
        if (PH_ON(6) && IN(pb + 5)) {
            WS_PTRS();
            const float* xin = (l == 0) ? INP(I_X) : out_ptr();
            pg8::DenseSched S{(const char*)(rg + R_YMIX), (const char*)(wb + W_OUT), D, D, T / 256, D / 256, 1, D, G, bx};
            pg8::EpiResid<true> E{xin, probe ? (float*)(rg + R_AA) : out_ptr(), (bf16*)(ws + WS_XB), STATP(l, ST_X1), STATP(l, ST_YATT), STATP(l, ST_YRNN)};
            pg8::gemm_phase<pg8::EpiResid<true>, pg8::DenseSched, true, true>(lds, D, D, D, S, E, 16);
            SEAM(pb + 5);
        }
        if (PH_ON(7) && IN(pb + 6)) {
            WS_PTRS();
            pg8::DenseSched S{(const char*)(ws + WS_XB), (const char*)(wb + W_MQ), D, D, T / 256, DMA / 256, 2, 1024, G, bx};
            pg8::EpiF32Slab E{(float*)(rg + R_QM), DMA, (size_t)T * DMA, STATP(l, ST_X1), 1.0f / D};
            pg8::gemm_phase<pg8::EpiF32Slab, pg8::DenseSched, true, false>(lds, 1024, D, D, S, E, 0);
            SEAM(pb + 6);
        }
        if (PH_ON(8) && IN(pb + 7)) {
            WS_PTRS();
            float* qm = (float*)(rg + R_QM);
            head128_norm_rows<true>(qm, qm + (size_t)T * DMA, DMA, (bf16*)(rg + R_QMN), INP(I_MQG) + l * 128, T, gw, NGW, lane);
            SEAM(pb + 7);
        }
        if (PH_ON(9) && IN(pb + 8)) {
            WS_PTRS();
            bf16* qmn = (bf16*)(rg + R_QMN); bf16* om = (bf16*)(rg + R_OM); bf16* kmemn = (bf16*)(ws + WS_KMEMN); bf16* kvmem = (bf16*)(ws + WS_KVMEM);
            const att::Strides<DMA, DMA, 2 * 1024, DMA> sd;
            for (int it = bx; it < 256; it += G) {
                const int h = it & 3, rb = it >> 2, b = rb >> 5;
                att::BlockRef c0;
                c0.Q = qmn + (size_t)rb * 256 * DMA + h * 128; c0.K = kmemn + ((size_t)l * TM + (size_t)b * NMEM) * DMA + h * 128;
                c0.V = kvmem + (size_t)l * 1024 + (size_t)b * NMEM * 2048 + 512 + h * 128; c0.O = om + (size_t)rb * 256 * DMA + h * 128; c0.ssq = nullptr; c0.P0 = 0; c0.nk = NMEM;
                att::Seam<8> S;
                att::attn_prime<0>(c0, sd, (char*)lds_raw, S);
                att::attn_block<0, false, false>(c0, c0, sd, 0.08838834764831845f, (char*)lds_raw, S);
            }
            SEAM(pb + 8);
        }
        if (PH_ON(10) && IN(pb + 9)) {
            WS_PTRS();
            pg8::DenseSched S{(const char*)(rg + R_OM), (const char*)(wb + W_MO), DMA, DMA, T / 256, D / 256, 1, DMA, G, bx};
            pg8::EpiResid<false> E{out_ptr(), probe ? (float*)(rg + R_AA) : out_ptr(), (bf16*)(ws + WS_XB), STATP(l, ST_X2), nullptr, nullptr};
            pg8::gemm_phase<pg8::EpiResid<false>, pg8::DenseSched, true, false>(lds, DMA, DMA, DMA, S, E, 0);
            SEAM(pb + 9);
        }
        if (PH_ON(11) && IN(pb + 10)) {
            WS_PTRS();
            pg8::DenseSched S{(const char*)(ws + WS_XB), (const char*)(wb + W_R), D, D, T / 256, 1, 1, D, G, bx};
            pg8::EpiRouter E{(float*)(ws + WS_LOGIT)};
            pg8::gemm_phase<pg8::EpiRouter, pg8::DenseSched, true, false>(lds, D, D, D, S, E, 0);
            SEAM(pb + 10);
        }
        if (PH_ON(12) && IN(pb + 11)) {
            WS_PTRS();
            unsigned* cnt = (unsigned*)(ws + WS_CTL) + CW_CNT + l * 64;
            for (int w = bx; w < 256; w += G) route_phase((const float*)(ws + WS_LOGIT), STATP(l, ST_X2), INP(I_BRGRP) + l * 4, INP(I_BREXP) + l * 32, (int*)(ws + WS_MOE), (float*)(ws + WS_MOE + 128 * 1024),
                                                          (int*)(ws + WS_MOE + 384 * 1024), cnt, (LAS int*)lds, w, tid);
            SEAM(pb + 11);
        }
        if (PH_ON(13) && IN(pb + 12)) {
            WS_PTRS();
            unsigned* cnt = (unsigned*)(ws + WS_CTL) + CW_CNT + l * 64;
            for (int w = bx; w < 256; w += G) dispatch_phase(cnt, (const int*)(ws + WS_MOE + 384 * 1024), (const int*)(ws + WS_MOE), (const float*)(ws + WS_MOE + 128 * 1024), STATP(l, ST_X2),
                                                             (int*)(ws + WS_MOE + 256 * 1024), (int*)(ws + WS_MOE + 512 * 1024), (float*)(ws + WS_MOE + 704 * 1024), (float*)(ws + WS_MOE + 896 * 1024), (LAS int*)lds, w, tid);
            SEAM(pb + 12);
        }
        if (PH_ON(14) && IN(pb + 13)) {
            WS_PTRS();
            const int nrt = build_rtab((unsigned*)(ws + WS_CTL) + CW_CNT + l * 64, lc, tid);
            pg8::MoeUpSched S{(const char*)(ws + WS_XB), (const char*)(wb + W_GU), (const int*)(ws + WS_MOE + 512 * 1024), (const LAS int*)(lc + LC_RTAB / 4), nrt, G, bx};
            pg8::EpiSwiglu E{(bf16*)(rg + R_ACT), (const float*)(ws + WS_MOE + 896 * 1024)};
            pg8::gemm_phase<pg8::EpiSwiglu, pg8::MoeUpSched, true, false>(lds, D, D, D, S, E, 0);
            SEAM(pb + 13);
        }
        if (PH_ON(15) && IN(pb + 14)) {
            WS_PTRS();
            const int nrt = build_rtab((unsigned*)(ws + WS_CTL) + CW_CNT + l * 64, lc, tid);
            pg8::MoeDownSched S{(const char*)(rg + R_ACT), (const char*)(wb + W_D), (const LAS int*)(lc + LC_RTAB / 4), nrt, G, bx};
            pg8::EpiBf16<1, false> E{(bf16*)(rg + R_Y), D, (const float*)(ws + WS_MOE + 704 * 1024), 0.f, nullptr, nullptr, 0, 0};
            pg8::gemm_phase<pg8::EpiBf16<1, false>, pg8::MoeDownSched, true, false>(lds, DE, DE, DE, S, E, 0);
            SEAM(pb + 14);
        }
        if (PH_ON(16) && IN(pb + 15)) {
            WS_PTRS();
            const bool more = (l + 1 < DEPTH);
            if (!probe) combine_phase(out_ptr(), (const bf16*)(rg + R_Y), (const int*)(ws + WS_MOE + 256 * 1024), more ? (bf16*)(ws + WS_XB) : nullptr, more ? STATP(l + 1, ST_X) : nullptr, gw, NGW, lane);
            if (more) { LAS float* scr = (LAS float*)(lds + wave * 16384); convert_layer_weights(p, l + 1, scr, gw, NGW, lane, gtid, NGT); }
            SEAM(pb + 15);
        }
    }
#undef IN
#undef SEAM
}

#ifndef MK_SPLIT
#define MK_SPLIT 0
#endif
extern "C" void kernel_launch(void* const* d_in, const int* in_sizes, int n_in, void* d_out, int out_size, void* d_ws, size_t ws_size, hipStream_t stream) {
    static int grid = 0;
    if (grid == 0) {
        if (n_in != 36 || in_sizes[0] != T * D || out_size != T * D || ws_size < WS_END) {
            fprintf(stderr, "kernel_launch: unexpected shapes (n_in %d, in0 %d, out %d, ws %zu < %zu)\n", n_in, n_in > 0 ? in_sizes[0] : -1, out_size, ws_size, (size_t)WS_END); grid = -1; return; }
        int dev = 0, cus = 0, per_cu = 0;
        if (hipGetDevice(&dev) != hipSuccess || hipDeviceGetAttribute(&cus, hipDeviceAttributeMultiprocessorCount, dev) != hipSuccess) { grid = -1; return; }
        if (hipFuncSetAttribute((const void*)fwd_kernel, hipFuncAttributeMaxDynamicSharedMemorySize, LDS_BYTES) != hipSuccess) { fprintf(stderr, "kernel_launch: hipFuncSetAttribute failed\n"); grid = -1; return; }
        if (hipOccupancyMaxActiveBlocksPerMultiprocessor(&per_cu, (const void*)fwd_kernel, NTHREADS, LDS_BYTES) != hipSuccess || per_cu < 1)
            fprintf(stderr, "kernel_launch: occupancy query reports %d workgroups per CU\n", per_cu);
        (void)hipGetLastError();
        grid = cus;
    }
    if (grid < 0) return;
    if (hipMemsetAsync((char*)d_ws, 0, ZERO_BYTES, stream) != hipSuccess) return;
    Params a{};
    for (int i = 0; i < 36; ++i) a.in[i] = (const float*)d_in[i];
    a.out = (float*)d_out; a.ws = (unsigned char*)d_ws;
#if MK_SPLIT
    for (int ph = 0; ph < NPHASES; ++ph) { a.ph_lo = ph; a.ph_hi = ph + 1; hipLaunchKernelGGL(fwd_kernel, dim3(grid), dim3(NTHREADS), LDS_BYTES, stream, a); }
#else
    a.ph_lo = 0; a.ph_hi = NPHASES;
    hipLaunchKernelGGL(fwd_kernel, dim3(grid), dim3(NTHREADS), LDS_BYTES, stream, a);
#endif
#if defined(PROBE_PHASE)
    a.ph_lo = PROBE_PHASE; a.ph_hi = PROBE_PHASE + 1; a.probe = 1;
    for (int r = 0; r < PROBE_REPS; ++r) hipLaunchKernelGGL(fwd_kernel, dim3(grid), dim3(NTHREADS), LDS_BYTES, stream, a);
#endif
}
```

```cpp
#include <hip/hip_runtime.h>
#include <cstdio>
#include <cstdint>

#define GAS __attribute__((address_space(1)))
#define LAS __attribute__((address_space(3)))
typedef unsigned short bf16;
typedef short bf16x8 __attribute__((ext_vector_type(8)));
typedef short s16x4 __attribute__((ext_vector_type(4)));
typedef float f32x4 __attribute__((ext_vector_type(4)));
typedef float f32x2 __attribute__((ext_vector_type(2)));
typedef float f32x16 __attribute__((ext_vector_type(16)));
typedef unsigned u32x4 __attribute__((ext_vector_type(4)));
typedef unsigned u32x2 __attribute__((ext_vector_type(2)));

constexpr int NBATCH = 2, SEQ = 8192, T = NBATCH * SEQ, D = 2048, DEPTH = 2;
constexpr int NMEM = 256, TM = NBATCH * NMEM;
constexpr int QL = 512, KVL = 256, DRNN = 1024, DATT = 1024;
constexpr int NH = 8, QKH = 192, VH = 128;
constexpr int ZC = 3072;
constexpr int Z_CQ = 0, Z_CKV = 512, Z_XR = 768, Z_GATE = 1792, Z_KPE = 2816;
constexpr int NE = 32, DE = 512, NSLOT = 40960;
constexpr int NQU = NH * QKH;
constexpr int NKV = NH * 256;
constexpr int DMA = 512;
constexpr float EPS = 1e-6f;
constexpr int NWAVES = 8, NTHREADS = 512;

__device__ __forceinline__ unsigned f2bf(float f) { unsigned u = __builtin_bit_cast(unsigned, f); return (u + 0x7fffu + ((u >> 16) & 1u)) >> 16; }
__device__ __forceinline__ unsigned pk2(float lo, float hi) { return f2bf(lo) | (f2bf(hi) << 16); }
__device__ __forceinline__ float bf2f(unsigned short h) { return __builtin_bit_cast(float, (unsigned)h << 16); }
__device__ __forceinline__ float bflo(unsigned w) { return __builtin_bit_cast(float, w << 16); }
__device__ __forceinline__ float bfhi(unsigned w) { return __builtin_bit_cast(float, w & 0xffff0000u); }
__device__ __forceinline__ unsigned cvt_pk_bf16(float lo, float hi) { unsigned r; asm volatile("v_cvt_pk_bf16_f32 %0, %1, %2" : "=v"(r) : "v"(lo), "v"(hi)); return r; }
__device__ __forceinline__ float wave_sum(float v) {
#pragma unroll
    for (int o = 1; o < 64; o <<= 1) v += __shfl_xor(v, o);
    return v;
}
typedef unsigned long long u64;
__device__ __forceinline__ float ssq_val(const u64* p, int row) { return (float)p[row] * (1.0f / 16777216.0f); }
__device__ __forceinline__ void ssq_add(u64* p, int row, float v) { atomicAdd(p + row, (u64)(v * 16777216.0f)); }
__device__ __forceinline__ void ssq_set(u64* p, int row, float v) { p[row] = (u64)(v * 16777216.0f); }
#define LDS_WAIT() asm volatile("s_waitcnt lgkmcnt(0)" ::: "memory")
#define VM_WAIT() asm volatile("s_waitcnt vmcnt(0)" ::: "memory")

#define XB_TMO      128
#define XB_XCNT(j)  (256  + 64 * (j))
#define XB_XSUB(j)  (1280 + 64 * (j))
#define XB_XGEN(j)  (2304 + 64 * (j))
#define XB_TOP      3328
#define XB_TOPGEN   3392
#define XCD_BAR_WORDS 3456
#define XB_SPIN_CAP (1u << 18)
__device__ __forceinline__ unsigned xb_ld(unsigned* p)              { return __hip_atomic_load(p, __ATOMIC_RELAXED, __HIP_MEMORY_SCOPE_AGENT); }
__device__ __forceinline__ unsigned xb_add(unsigned* p, unsigned v) { return __hip_atomic_fetch_add(p, v, __ATOMIC_RELAXED, __HIP_MEMORY_SCOPE_AGENT); }
__device__ __forceinline__ unsigned xb_xcc_id() { return (unsigned)__builtin_amdgcn_s_getreg((3 << 11) | 20) & 0xFu; }
#define XB_SPIN(cond, bar) do { unsigned _sp = 0; while (cond) { __builtin_amdgcn_s_sleep(1); \
    if ((++_sp & 255u) == 0u) { if (xb_ld(&(bar)[XB_TMO])) break; if (_sp > XB_SPIN_CAP) { atomicAdd(&(bar)[XB_TMO], 1u); break; } } } } while (0)
struct XcdBarrier { unsigned* bar; unsigned x; volatile LAS unsigned* st; };
__device__ __forceinline__ XcdBarrier xcd_barrier_post(unsigned* bar, volatile LAS unsigned* st) {
    XcdBarrier b; b.bar = bar; b.x = xb_xcc_id(); b.st = st;
    if (threadIdx.x == 0) (void)xb_add(&bar[XB_XCNT(b.x)], 1u);
    return b;
}
__device__ __forceinline__ void xcd_barrier_complete(unsigned* bar, unsigned x, unsigned& nloc, unsigned& nx) {
    const unsigned G = gridDim.x * gridDim.y * gridDim.z;
    unsigned sum, cnt, mine, sp = 0u;
    for (;;) {
        sum = 0u; cnt = 0u; mine = 0u;
#pragma unroll
        for (unsigned j = 0; j < 16; ++j) { const unsigned c = xb_ld(&bar[XB_XCNT(j)]); sum += c; cnt += (c > 0u) ? 1u : 0u; mine = (j == x) ? c : mine; }
        if (sum == G) break;
        __builtin_amdgcn_s_sleep(1);
        if ((++sp & 255u) == 0u) { if (xb_ld(&bar[XB_TMO])) break; if (sp > XB_SPIN_CAP) { atomicAdd(&bar[XB_TMO], 1u); break; } }
    }
    nloc = mine > 0u ? mine : 1u; nx = cnt > 0u ? cnt : 1u;
}
__device__ __forceinline__ void xcd_barrier(const XcdBarrier& b) {
    asm volatile("s_waitcnt vmcnt(0)" ::: "memory");
    __syncthreads();
    if (threadIdx.x == 0) {
        unsigned* bar = b.bar; unsigned bx_ = b.x; asm volatile("" : "+s"(bar), "+s"(bx_));
        __builtin_amdgcn_s_waitcnt(0);
        unsigned nloc = b.st[0], nx = b.st[1];
        if (nloc == 0u) { xcd_barrier_complete(bar, bx_, nloc, nx); b.st[0] = nloc; b.st[1] = nx; }
        const unsigned old = xb_add(&bar[XB_XSUB(bx_)], 1u);
        const unsigned gen = old / nloc;
        if (old + 1u == (gen + 1u) * nloc) {
            __builtin_amdgcn_fence(__ATOMIC_RELEASE, "agent");
            asm volatile("s_waitcnt vmcnt(0)" ::: "memory");
            const unsigned og = xb_add(&bar[XB_TOP], 1u);
            const unsigned tg = og / nx;
            if (og + 1u == (tg + 1u) * nx) xb_add(&bar[XB_TOPGEN], 1u);
            else XB_SPIN(xb_ld(&bar[XB_TOPGEN]) == tg, bar);
            __builtin_amdgcn_fence(__ATOMIC_ACQUIRE, "agent");
            xb_add(&bar[XB_XGEN(bx_)], 1u);
            asm volatile("s_waitcnt vmcnt(0)" ::: "memory");
        } else {
            XB_SPIN(xb_ld(&bar[XB_XGEN(bx_)]) == gen, bar);
            __builtin_amdgcn_fence(__ATOMIC_ACQUIRE, "agent");
            asm volatile("s_waitcnt vmcnt(0)" ::: "memory");
        }
    }
    __syncthreads();
}

namespace pg8 {
constexpr int BM = 256, BK = 64, HALF = 128, HTB = HALF * BK * 2, STAGE_BYTES = 8 * HTB, NXCD = 8, WGM = 8;
__host__ __device__ __forceinline__ int lds_byte(int r, int c) { const int st = (r >> 4) * 2 + (c >> 5), rr = r & 15, cc = c & 31, ob = rr * 64 + cc * 2; return st * 1024 + (ob ^ (((ob >> 9) & 1) << 5)); }
__host__ __device__ __forceinline__ void stage_rc(int b, int& R, int& C) { const int st = b / 1024, sb = b % 1024, swz = sb ^ (((sb >> 9) & 1) << 5); R = (st >> 1) * 16 + swz / 64; C = (st & 1) * 32 + (swz % 64) / 2; }
__host__ __device__ __forceinline__ int perm32(int rho) { const int n = rho >> 4, i = rho & 15; return 8 * (i >> 2) + 4 * n + (i & 3); }

struct Unit { const char* A; const char* B; int pm, pn, aux; };

__device__ __forceinline__ bool static_tile(int i, int G, int c, int nM, int nN, int& pm, int& pn) {
    const int nwg = nM * nN; const long L = (long)i * G + c; if (L >= nwg) return false;
    int wgid = (int)L; { const int q = nwg / NXCD, r = nwg % NXCD, xcd = wgid % NXCD, off = wgid / NXCD; wgid = (xcd < r ? xcd * (q + 1) : r * (q + 1) + (xcd - r) * q) + off; }
    const int nig = WGM * nN, gid = wgid / nig, fm = gid * WGM, gsz = (nM - fm) < WGM ? (nM - fm) : WGM;
    pm = fm + ((wgid % nig) % gsz); pn = (wgid % nig) / gsz; return true;
}

template <class Epi, class Sched, bool ALIGN_EPI, bool MID>
__device__ __forceinline__ void gemm_phase(LAS unsigned char* lds, const int K, const int lda, const int ldb, const Sched& S, const Epi& E, const int mid_t) {
    constexpr bool GATHER = Sched::GATHER;
    int tid = threadIdx.x; asm volatile("" : "+v"(tid)); const int wid = __builtin_amdgcn_readfirstlane(tid >> 6), lane = tid & 63, wr = wid >> 2, wc = wid & 3, fr = lane & 15, fq = lane >> 4;
    const int nt = K / BK;
    unsigned voffA[2], voffB[2];
#pragma unroll
    for (int i = 0; i < 2; ++i) { int R, C; stage_rc(tid * 16 + i * 8192, R, C); const int Rb = Epi::PERM ? ((R & ~31) + perm32(R & 31)) : R;
        voffA[i] = (unsigned)(R * lda + C) * 2u; voffB[i] = (unsigned)(Rb * ldb + C) * 2u; }
    const size_t kstep = (size_t)(BK * 2);
    const size_t hstepA = GATHER ? (size_t)0 : (size_t)HALF * lda * 2;
    const size_t hstepB = (size_t)HALF * ldb * 2;
    const unsigned ldsw = (unsigned)wid * 1024u;
    const int aoff = lds_byte(wr * 64 + fr, fq * 8), boff = lds_byte(wc * 32 + fr, fq * 8);
#define PG8_SA(b, h) (((b) * 2 + (h)) * HTB)
#define PG8_SB(b, h) ((4 + (b) * 2 + (h)) * HTB)
#define PG8_STAGE(bufoff, gbase, voff) do { _Pragma("unroll") for (int _i = 0; _i < 2; ++_i) \
        __builtin_amdgcn_global_load_lds((const unsigned*)((const char*)(gbase) + (voff)[_i]), (LAS unsigned*)(lds + (bufoff) + ldsw + _i * 8192), 16, 0, 0); } while (0)
#define PG8_LDA(dst, b, h) do { _Pragma("unroll") for (int m = 0; m < 4; ++m) _Pragma("unroll") for (int k = 0; k < 2; ++k) dst[m][k] = *(const LAS bf16x8*)(lds + PG8_SA(b, h) + aoff + m * 2048 + k * 1024); } while (0)
#define PG8_LDB(dst, b, h) do { _Pragma("unroll") for (int n = 0; n < 2; ++n) _Pragma("unroll") for (int k = 0; k < 2; ++k) dst[n][k] = *(const LAS bf16x8*)(lds + PG8_SB(b, h) + boff + n * 2048 + k * 1024); } while (0)
#define PG8_MMA(ai, bj, At, Bt) do { __builtin_amdgcn_s_setprio(1); _Pragma("unroll") for (int m = 0; m < 4; ++m) _Pragma("unroll") for (int n = 0; n < 2; ++n) _Pragma("unroll") for (int k = 0; k < 2; ++k) \
        acc[ai][bj][m][n] = __builtin_amdgcn_mfma_f32_16x16x32_bf16(Bt[n][k], At[m][k], acc[ai][bj][m][n], 0, 0, 0); __builtin_amdgcn_s_setprio(0); } while (0)
#define PG8_WAIT_V(n) asm volatile("s_waitcnt vmcnt(" #n ")" ::: "memory")
#define PG8_WAIT_L(n) asm volatile("s_waitcnt lgkmcnt(" #n ")" ::: "memory")
#define PG8_BAR __builtin_amdgcn_s_barrier()
#define PG8_SCHED __builtin_amdgcn_sched_barrier(0)
    Unit cur, nxt; int ui = 0;
    if (!S.next(0, cur)) return;
    f32x4 acc[2][2][4][2];
#pragma unroll
    for (int a = 0; a < 2; ++a)
#pragma unroll
        for (int b = 0; b < 2; ++b)
#pragma unroll
            for (int m = 0; m < 4; ++m)
#pragma unroll
                for (int n = 0; n < 2; ++n) acc[a][b][m][n] = (f32x4){0.f, 0.f, 0.f, 0.f};
    bf16x8 At[4][2], B0[2][2], B1[2][2];
    unsigned gA0[2], gA1[2], gN0[2], gN1[2];
    if constexpr (GATHER) {
#pragma unroll
        for (int i = 0; i < 2; ++i) { int R, C; stage_rc(tid * 16 + i * 8192, R, C); gA0[i] = S.arow(cur, R) + (unsigned)C * 2u; gA1[i] = S.arow(cur, HALF + R) + (unsigned)C * 2u; gN0[i] = gA0[i]; gN1[i] = gA1[i]; }
    }
#define PG8_STAGE_A(b, h, gbase, G0, G1) do { if constexpr (GATHER) { if ((h) == 0) PG8_STAGE(PG8_SA(b, h), gbase, G0); else PG8_STAGE(PG8_SA(b, h), gbase, G1); } \
        else PG8_STAGE(PG8_SA(b, h), (gbase) + (h) * hstepA, voffA); } while (0)
    const char* cA = cur.A; const char* cB = cur.B;
    PG8_STAGE(PG8_SB(0, 0), cB, voffB); PG8_STAGE(PG8_SB(0, 1), cB + hstepB, voffB); PG8_STAGE_A(0, 0, cA, gA0, gA1); PG8_STAGE_A(0, 1, cA, gA0, gA1);
    if (wr == 1) PG8_BAR;
    PG8_WAIT_V(2); PG8_BAR;
    PG8_STAGE(PG8_SB(1, 0), cB + kstep, voffB); PG8_STAGE_A(1, 0, cA + kstep, gA0, gA1); PG8_STAGE(PG8_SB(1, 1), cB + hstepB + kstep, voffB);
    PG8_WAIT_V(6); PG8_BAR;
    for (;;) {
        const bool has_next = S.next(ui + 1, nxt);
        const char* nA = has_next ? nxt.A : cA; const char* nB = has_next ? nxt.B : cB;
        if constexpr (GATHER) {
            if (has_next) {
#pragma unroll
                for (int i = 0; i < 2; ++i) { int R, C; stage_rc(tid * 16 + i * 8192, R, C); gN0[i] = S.arow(nxt, R) + (unsigned)C * 2u; gN1[i] = S.arow(nxt, HALF + R) + (unsigned)C * 2u; }
            }
        }
#pragma nounroll
        for (int t = 0; t < nt; t += 2) {
            const bool last = (t == nt - 2);
            if constexpr (MID) { if (t == mid_t) E.mid(acc, cur, wr, wc, fr, fq); }
            const char* a1 = cA + (size_t)(t + 1) * kstep;
            const char* a2 = last ? nA : cA + (size_t)(t + 2) * kstep; const char* b2 = last ? nB : cB + (size_t)(t + 2) * kstep;
            const char* a3 = a2 + kstep; const char* b3 = b2 + kstep;
            unsigned w0[2], w1[2];
            if constexpr (GATHER) {
#pragma unroll
                for (int i = 0; i < 2; ++i) { w0[i] = last ? gN0[i] : gA0[i]; w1[i] = last ? gN1[i] : gA1[i]; }
            }
            PG8_LDB(B0, 0, 0); PG8_LDB(B1, 0, 1); PG8_SCHED; PG8_LDA(At, 0, 0); PG8_STAGE_A(1, 1, a1, gA0, gA1);
            PG8_WAIT_V(8); PG8_WAIT_L(0); PG8_BAR; PG8_MMA(0, 0, At, B0); PG8_MMA(0, 1, At, B1); PG8_BAR; PG8_SCHED;
            PG8_LDA(At, 0, 1); PG8_STAGE(PG8_SB(0, 0), b2, voffB); PG8_STAGE(PG8_SB(0, 1), b2 + hstepB, voffB); PG8_STAGE_A(0, 0, a2, w0, w1);
            PG8_WAIT_V(8); PG8_WAIT_L(0); PG8_BAR; PG8_MMA(1, 0, At, B0); PG8_MMA(1, 1, At, B1); PG8_BAR; PG8_SCHED;
            PG8_LDB(B0, 1, 0); PG8_LDB(B1, 1, 1); PG8_SCHED; PG8_LDA(At, 1, 0); PG8_STAGE_A(0, 1, a2, w0, w1);
            PG8_WAIT_V(8); PG8_WAIT_L(0); PG8_BAR; PG8_MMA(0, 0, At, B0); PG8_MMA(0, 1, At, B1); PG8_BAR; PG8_SCHED;
            PG8_LDA(At, 1, 1); PG8_STAGE(PG8_SB(1, 0), b3, voffB); PG8_STAGE(PG8_SB(1, 1), b3 + hstepB, voffB); PG8_STAGE_A(1, 0, a3, w0, w1);
            PG8_WAIT_V(8); PG8_WAIT_L(0); PG8_BAR; PG8_MMA(1, 0, At, B0); PG8_MMA(1, 1, At, B1); PG8_BAR; PG8_SCHED;
        }
        if constexpr (ALIGN_EPI) { if (wr == 0) PG8_BAR; }
        E(acc, cur, wr, wc, fr, fq);
        if (!has_next) break;
#pragma unroll
        for (int a = 0; a < 2; ++a)
#pragma unroll
            for (int b = 0; b < 2; ++b)
#pragma unroll
                for (int m = 0; m < 4; ++m)
#pragma unroll
                    for (int n = 0; n < 2; ++n) acc[a][b][m][n] = (f32x4){0.f, 0.f, 0.f, 0.f};
        cur = nxt; cA = nA; cB = nB; ++ui;
        if constexpr (GATHER) {
#pragma unroll
            for (int i = 0; i < 2; ++i) { gA0[i] = gN0[i]; gA1[i] = gN1[i]; }
        }
        if constexpr (ALIGN_EPI) { if (wr == 1) PG8_BAR; }
    }
    PG8_WAIT_V(0);
    if constexpr (!ALIGN_EPI) { if (wr == 0) PG8_BAR; }
    PG8_BAR;
#undef PG8_SA
#undef PG8_SB
#undef PG8_STAGE
#undef PG8_STAGE_A
#undef PG8_LDA
#undef PG8_LDB
#undef PG8_MMA
#undef PG8_WAIT_V
#undef PG8_WAIT_L
#undef PG8_BAR
#undef PG8_SCHED
}
}
namespace pg8 {
struct DenseSched {
    static constexpr bool GATHER = false;
    const char* A; const char* B; int lda, ldb, nM, nN, nKS, Ksplit, G, c;
    __device__ __forceinline__ bool next(int i, Unit& u) const {
        int pm, pc; if (!static_tile(i, G, c, nM, nN * nKS, pm, pc)) return false;
        const int pn = pc / nKS, ks = pc - pn * nKS;
        u.pm = pm; u.pn = pn; u.aux = ks;
        u.A = A + ((size_t)pm * BM * lda + (size_t)ks * Ksplit) * 2;
        u.B = B + ((size_t)pn * BM * ldb + (size_t)ks * Ksplit) * 2;
        return true;
    }
    __device__ __forceinline__ unsigned arow(const Unit&, int r) const { return (unsigned)(r * lda) * 2u; }
};
struct GateSched {
    static constexpr bool GATHER = false;
    const char* A; const char* B; int G, c;
    __device__ __forceinline__ bool next(int i, Unit& u) const {
        int pm, pn; if (!static_tile(i, G, c, T / BM, 8, pm, pn)) return false;
        u.pm = pm; u.pn = pn; u.aux = 0;
        u.A = A + ((size_t)pm * BM * DRNN + (size_t)(pn >> 1) * 256) * 2;
        u.B = B + (size_t)pn * 256 * 256 * 2;
        return true;
    }
    __device__ __forceinline__ unsigned arow(const Unit&, int r) const { return (unsigned)(r * DRNN) * 2u; }
};
struct MoeUpSched {      static constexpr bool GATHER = true;
    const char* A; const char* B; const int* slot_tok; const LAS int* rtab; int nrt, G, c;
    __device__ __forceinline__ bool next(int i, Unit& u) const {
        const long L = (long)i * G + c; if (L >= (long)nrt * 4) return false;
        const int rt = (int)(L >> 2), pn = (int)(L & 3); const int e = rtab[2 * rt], row0 = rtab[2 * rt + 1];
        u.pm = row0 >> 8; u.pn = pn; u.aux = e; u.A = A;
        u.B = B + ((size_t)e * 1024 * D + (size_t)pn * BM * D) * 2;
        return true;
    }
    __device__ __forceinline__ unsigned arow(const Unit& u, int r) const { return (unsigned)slot_tok[u.pm * BM + r] * (unsigned)(D * 2); }
};
struct MoeDownSched {    static constexpr bool GATHER = false;
    const char* A; const char* B; const LAS int* rtab; int nrt, G, c;
    __device__ __forceinline__ bool next(int i, Unit& u) const {
        const long L = (long)i * G + c; if (L >= (long)nrt * 8) return false;
        const int rt = (int)(L >> 3), pn = (int)(L & 7); const int e = rtab[2 * rt], row0 = rtab[2 * rt + 1];
        u.pm = row0 >> 8; u.pn = pn; u.aux = e;
        u.A = A + (size_t)row0 * DE * 2;
        u.B = B + ((size_t)e * D * DE + (size_t)pn * BM * DE) * 2;
        return true;
    }
    __device__ __forceinline__ unsigned arow(const Unit&, int r) const { return (unsigned)(r * DE) * 2u; }
};

__device__ __forceinline__ void unpack8x(u32x4 w, float* v) { v[0] = bflo(w.x); v[1] = bfhi(w.x); v[2] = bflo(w.y); v[3] = bfhi(w.y); v[4] = bflo(w.z); v[5] = bfhi(w.z); v[6] = bflo(w.w); v[7] = bfhi(w.w); }
__device__ __forceinline__ void epi_ids(int& wr, int& wc, int& fr, int& fq) { int t = threadIdx.x; asm volatile("" : "+v"(t)); const int wid = t >> 6, lane = t & 63; wr = wid >> 2; wc = wid & 3; fr = lane & 15; fq = lane >> 4; }
template <int MODE, bool STAT> struct EpiBf16 {
    static constexpr bool PERM = true;
    bf16* O; int ldc; const void* rs; float inv_n; u64* stat_a; u64* stat_b; int stat_pn_a, stat_pn_b;
    __device__ __forceinline__ void operator()(const f32x4 (&acc)[2][2][4][2], const Unit& u, int, int, int, int) const {
        int wr, wc, fr, fq; epi_ids(wr, wc, fr, fq);
        int row0 = u.pm * BM + wr * 64 + fr; asm volatile("" : "+v"(row0)); const int col0 = u.pn * BM + wc * 32 + 8 * fq;
        u64* st = nullptr; if (STAT) st = (u.pn < stat_pn_a) ? stat_a : ((u.pn < stat_pn_b) ? stat_b : nullptr);
#pragma unroll
        for (int ai = 0; ai < 2; ++ai)
#pragma unroll
            for (int m = 0; m < 4; ++m) { const int row = row0 + ai * HALF + m * 16;
                float sc = 1.f;
                if (MODE == 0) sc = 1.0f / sqrtf(ssq_val((const u64*)rs, row) * inv_n + EPS); else if (MODE == 1) sc = ((const float*)rs)[row];
                bf16* rowp = O + (size_t)row * ldc + col0; float ss = 0.f;
#pragma unroll
                for (int bj = 0; bj < 2; ++bj) { const f32x4 v0 = acc[ai][bj][m][0] * sc, v1 = acc[ai][bj][m][1] * sc;
                    if (STAT) ss += (v0[0] * v0[0] + v0[1] * v0[1]) + (v0[2] * v0[2] + v0[3] * v0[3]) + (v1[0] * v1[0] + v1[1] * v1[1]) + (v1[2] * v1[2] + v1[3] * v1[3]);
                    u32x4 w; w.x = cvt_pk_bf16(v0[0], v0[1]); w.y = cvt_pk_bf16(v0[2], v0[3]); w.z = cvt_pk_bf16(v1[0], v1[1]); w.w = cvt_pk_bf16(v1[2], v1[3]);
                    *(u32x4*)(rowp + bj * HALF) = w; }
                if (STAT) { ss += __shfl_xor(ss, 16); ss += __shfl_xor(ss, 32); if (st != nullptr && fq == 0) ssq_add(st, row, ss); }
            }
    }
};
struct EpiF32Slab {
    static constexpr bool PERM = false;
    float* O; int ldc; size_t slab; const u64* rs; float inv_n;
    __device__ __forceinline__ void operator()(const f32x4 (&acc)[2][2][4][2], const Unit& u, int, int, int, int) const {
        int wr, wc, fr, fq; epi_ids(wr, wc, fr, fq);
        int row0 = u.pm * BM + wr * 64 + fr; asm volatile("" : "+v"(row0)); const int col0 = u.pn * BM + wc * 32 + 4 * fq; float* base = O + (size_t)u.aux * slab;
#pragma unroll
        for (int ai = 0; ai < 2; ++ai)
#pragma unroll
            for (int m = 0; m < 4; ++m) { const int row = row0 + ai * HALF + m * 16; const float sc = 1.0f / sqrtf(ssq_val(rs, row) * inv_n + EPS);
                float* rowp = base + (size_t)row * ldc + col0;
#pragma unroll
                for (int bj = 0; bj < 2; ++bj)
#pragma unroll
                    for (int n = 0; n < 2; ++n) *(f32x4*)(rowp + bj * HALF + n * 16) = acc[ai][bj][m][n] * sc; }
    }
};
template <bool SCALE> struct EpiResid {
    static constexpr bool PERM = true;
    bf16* xb; u64* stat; const u64* ssq_a; const u64* ssq_b;
    __device__ __forceinline__ void mid(f32x4 (&acc)[2][2][4][2], const Unit& u, int, int, int, int) const {
        int wr, wc, fr, fq; epi_ids(wr, wc, fr, fq);
        int row0 = u.pm * BM + wr * 64 + fr; asm volatile("" : "+v"(row0));
#pragma unroll
        for (int ai = 0; ai < 2; ++ai)
#pragma unroll
            for (int m = 0; m < 4; ++m) { const int row = row0 + ai * HALF + m * 16;
                const float ra = 1.0f / sqrtf(ssq_val(ssq_a, row) * (1.0f / 1024.0f) + EPS), rb = 1.0f / sqrtf(ssq_val(ssq_b, row) * (1.0f / 1024.0f) + EPS); const float f = ra / rb;
#pragma unroll
                for (int bj = 0; bj < 2; ++bj)
#pragma unroll
                    for (int n = 0; n < 2; ++n) acc[ai][bj][m][n] = acc[ai][bj][m][n] * f; }
    }
    __device__ __forceinline__ void operator()(const f32x4 (&acc)[2][2][4][2], const Unit& u, int, int, int, int) const {
        int wr, wc, fr, fq; epi_ids(wr, wc, fr, fq);
        int row0 = u.pm * BM + wr * 64 + fr; asm volatile("" : "+v"(row0)); const int col0 = u.pn * BM + wc * 32 + 8 * fq;
        GAS bf16* xg = (GAS bf16*)xb;
#pragma unroll
        for (int ai = 0; ai < 2; ++ai)
#pragma unroll
            for (int m = 0; m < 4; ++m) { const int row = row0 + ai * HALF + m * 16;
                float sc = 1.f; if (SCALE) sc = 1.0f / sqrtf(ssq_val(ssq_b, row) * (1.0f / 1024.0f) + EPS);
                const unsigned off = (unsigned)row * (unsigned)D + (unsigned)col0; float ss = 0.f;
#pragma unroll
                for (int bj = 0; bj < 2; ++bj) { float xv[8], v[8]; unpack8x(*(const GAS u32x4*)(xg + off + bj * HALF), xv);
#pragma unroll
                    for (int n = 0; n < 2; ++n)
#pragma unroll
                        for (int j = 0; j < 4; ++j) { v[n * 4 + j] = xv[n * 4 + j] + acc[ai][bj][m][n][j] * sc; ss += v[n * 4 + j] * v[n * 4 + j]; }
                    u32x4 w; w.x = cvt_pk_bf16(v[0], v[1]); w.y = cvt_pk_bf16(v[2], v[3]); w.z = cvt_pk_bf16(v[4], v[5]); w.w = cvt_pk_bf16(v[6], v[7]);
                    *(GAS u32x4*)(xg + off + bj * HALF) = w; }
                ss += __shfl_xor(ss, 16); ss += __shfl_xor(ss, 32); if (fq == 0) ssq_add(stat, row, ss);
                asm volatile("" ::: "memory"); __builtin_amdgcn_sched_barrier(0);
            }
    }
};
struct EpiGates {
    static constexpr bool PERM = false;
    const bf16* xc; const float* b_rg; const float* b_ig; const float* sp; float* a_out; float* u_out;
    __device__ __forceinline__ void operator()(const f32x4 (&acc)[2][2][4][2], const Unit& u, int, int, int, int) const {
        int wr, wc, fr, fq; epi_ids(wr, wc, fr, fq);
        const unsigned row0 = (unsigned)(u.pm * BM + wr * 64 + fr);
        const GAS bf16* xg = (const GAS bf16*)xc; GAS float* ag = (GAS float*)a_out; GAS float* ug = (GAS float*)u_out;
#pragma unroll
        for (int n = 0; n < 2; ++n) { const unsigned ch = (unsigned)(u.pn * 128 + wc * 32 + n * 16 + 4 * fq);
            const f32x4 br = *(const GAS f32x4*)((const GAS float*)b_rg + ch), bi = *(const GAS f32x4*)((const GAS float*)b_ig + ch), s4 = *(const GAS f32x4*)((const GAS float*)sp + ch);
#pragma unroll
            for (int ai = 0; ai < 2; ++ai)
#pragma unroll
                for (int m = 0; m < 4; ++m) { const unsigned off = (row0 + (unsigned)(ai * HALF + m * 16)) * (unsigned)DRNN + ch;
                    const u32x2 xw = *(const GAS u32x2*)(xg + off); const float xv[4] = {bflo(xw.x), bfhi(xw.x), bflo(xw.y), bfhi(xw.y)};
                    const f32x4 pr = acc[ai][0][m][n] + br, pi = acc[ai][1][m][n] + bi; f32x4 av, uv;
#pragma unroll
                    for (int j = 0; j < 4; ++j) { const float r = __builtin_amdgcn_rcpf(1.0f + __expf(-pr[j])), ig = __builtin_amdgcn_rcpf(1.0f + __expf(-pi[j]));
                        const float la = -8.0f * r * s4[j]; const float a = __expf(la); const float x2 = 2.0f * la;
                        const float om = (x2 > -0.03125f) ? -x2 * (1.0f + x2 * (0.5f + x2 * (0.16666667f + x2 * 0.041666668f))) : 1.0f - a * a;
                        av[j] = a; uv[j] = __builtin_amdgcn_sqrtf(om) * (ig * xv[j]); }
                    *(GAS f32x4*)(ag + off) = av; *(GAS f32x4*)(ug + off) = uv; asm volatile("" ::: "memory"); __builtin_amdgcn_sched_barrier(0); }
        }
    }
};
struct EpiSwiglu {
    static constexpr bool PERM = true;
    bf16* O; const float* rs;
    __device__ __forceinline__ void operator()(const f32x4 (&acc)[2][2][4][2], const Unit& u, int, int, int, int) const {
        int wr, wc, fr, fq; epi_ids(wr, wc, fr, fq);
        int row0 = u.pm * BM + wr * 64 + fr; asm volatile("" : "+v"(row0)); const int col0 = u.pn * 128 + wc * 32 + 8 * fq;
#pragma unroll
        for (int ai = 0; ai < 2; ++ai)
#pragma unroll
            for (int m = 0; m < 4; ++m) { const int row = row0 + ai * HALF + m * 16; const float sc = rs[row]; float h[8];
#pragma unroll
                for (int n = 0; n < 2; ++n)
#pragma unroll
                    for (int j = 0; j < 4; ++j) { const float g = acc[ai][0][m][n][j] * sc, up = acc[ai][1][m][n][j] * sc; h[n * 4 + j] = g / (1.0f + __expf(-g)) * up; }
                u32x4 w; w.x = cvt_pk_bf16(h[0], h[1]); w.y = cvt_pk_bf16(h[2], h[3]); w.z = cvt_pk_bf16(h[4], h[5]); w.w = cvt_pk_bf16(h[6], h[7]);
                *(u32x4*)(O + (size_t)row * DE + col0) = w; }
    }
};
struct EpiRouter {
    static constexpr bool PERM = false;
    float* O;
    __device__ __forceinline__ void operator()(const f32x4 (&acc)[2][2][4][2], const Unit& u, int, int, int, int) const {
        int wr, wc, fr, fq; epi_ids(wr, wc, fr, fq);
        if (wc >= 2) return;
        int row0 = u.pm * BM + wr * 64 + fr; asm volatile("" : "+v"(row0)); const int col0 = wc * 32 + 4 * fq;
#pragma unroll
        for (int ai = 0; ai < 2; ++ai)
#pragma unroll
            for (int m = 0; m < 4; ++m) { const int row = row0 + ai * HALF + m * 16;
#pragma unroll
                for (int n = 0; n < 2; ++n) *(f32x4*)(O + (size_t)row * 64 + col0 + n * 16) = acc[ai][0][m][n]; }
    }
};
}
namespace att {
constexpr int NW = 8, QBLK = 32, KVBLK = 64, QB = NW * QBLK;
constexpr int SHM_V = KVBLK * 128 * 2, SHM_K = KVBLK * 128 * 2, SHM_R = KVBLK * 64 * 2;
constexpr int OFF_V = 0, OFF_K = 2 * SHM_V, OFF_R = OFF_K + 2 * SHM_K, OFF_WS = OFF_R + 2 * SHM_R, OFF_QR = OFF_WS + NW * 64 * 4, LDS_BYTES = OFF_QR + NW * 4 * 1024;
constexpr float THR = 8.f;

#define KSWZ(row, colB) ((row) * 256 + ((colB) ^ (((row) & 7) << 4)))
#define RSWZ(row, ch) ((row) * 128 + ((((ch) ^ (((row) >> 1) & 7))) << 4))
#define SBAR() __builtin_amdgcn_sched_barrier(0)
__device__ __forceinline__ int v_st(int k, int c) { const int kk = (k & ~0xC) | ((k & 4) << 1) | ((k & 8) >> 1); return ((kk >> 3) * 4 + (c >> 5)) * 512 + ((kk & 7) * 32 + (c & 31)) * 2; }
__device__ __forceinline__ int v_rd_base(int lane) { return ((lane & 3) << 3) | (((lane >> 2) & 3) << 6) | (((lane >> 4) & 1) << 5) | (((lane >> 5) & 1) << 8); }
constexpr int v_rd_off(int d0, int ks, int half) { return d0 * 512 + ks * 4096 + half * 2048; }
__device__ __forceinline__ int crow(int r, int hi) { return (r & 3) + 8 * (r >> 2) + 4 * hi; }
__device__ __forceinline__ unsigned cvtpk(float lo, float hi) { unsigned r; asm volatile("v_cvt_pk_bf16_f32 %0, %1, %2" : "=v"(r) : "v"(lo), "v"(hi)); return r; }
__device__ __forceinline__ bf16x8 load8(const bf16* p) { return *reinterpret_cast<const bf16x8*>(p); }

__device__ __forceinline__ void mask_tile(f32x16& p0, f32x16& p1, int dq) {
    const float NEG = -__builtin_inff();
#pragma unroll
    for (int r = 0; r < 16; ++r) {
        const int c = (r & 3) + 8 * (r >> 2);
        if (dq - c < 0) p0[r] = NEG;
        if (dq - c - 32 < 0) p1[r] = NEG;
    }
}
__device__ __forceinline__ void partialSM(f32x16& p0, f32x16& p1, float& m_reg, float& mn, float& alpha, const float SCALE) {
    float pmax = p0[0]; for (int r = 1; r < 16; ++r) pmax = fmaxf(pmax, p0[r]); for (int r = 0; r < 16; ++r) pmax = fmaxf(pmax, p1[r]);
    { auto rr = __builtin_amdgcn_permlane32_swap(__float_as_uint(pmax), __float_as_uint(pmax), false, false);
      pmax = fmaxf(__uint_as_float(rr[0]), __uint_as_float(rr[1])); }
    const float C2 = 1.4426950408889634f * SCALE;
    if (__builtin_expect(__all((pmax - m_reg) * SCALE <= THR), 1)) { mn = m_reg; alpha = 1.f; }
    else { mn = fmaxf(m_reg, pmax); alpha = __builtin_amdgcn_exp2f((m_reg - mn) * C2); m_reg = mn; }
    const float mnL = -mn * C2;
    for (int r = 0; r < 16; ++r) p0[r] = fmaf(p0[r], C2, mnL); for (int r = 0; r < 16; ++r) p1[r] = fmaf(p1[r], C2, mnL);
    for (int r = 0; r < 16; ++r) p0[r] = __builtin_amdgcn_exp2f(p0[r]);
}
__device__ __forceinline__ void finishSM(f32x16& p0, f32x16& p1, float alpha, float& l_reg, bf16x8& pa0, bf16x8& pa1, bf16x8& pa2, bf16x8& pa3) {
    for (int r = 0; r < 16; ++r) p1[r] = __builtin_amdgcn_exp2f(p1[r]);
    float ps = 0; for (int r = 0; r < 16; ++r) ps += p0[r]; for (int r = 0; r < 16; ++r) ps += p1[r];
    { auto rr = __builtin_amdgcn_permlane32_swap(__float_as_uint(ps), __float_as_uint(ps), false, false);
      ps = __uint_as_float(rr[0]) + __uint_as_float(rr[1]); }
    l_reg = l_reg * alpha + ps;
#define PK4(P, B_, OUT) do { unsigned a0 = cvtpk(P[B_+0], P[B_+1]), a1 = cvtpk(P[B_+2], P[B_+3]);                          \
        unsigned b0 = cvtpk(P[B_+4], P[B_+5]), b1 = cvtpk(P[B_+6], P[B_+7]);                                             \
        auto r0 = __builtin_amdgcn_permlane32_swap(a0, b0, false, false); auto r1 = __builtin_amdgcn_permlane32_swap(a1, b1, false, false); \
        u32x4 w = {r0[0], r1[0], r0[1], r1[1]}; OUT = *reinterpret_cast<bf16x8*>(&w); } while (0)
    PK4(p0, 0, pa0); PK4(p0, 8, pa1); PK4(p1, 0, pa2); PK4(p1, 8, pa3);
#undef PK4
}
template <int KB, int ROPE>
__device__ __forceinline__ void qkt(f32x16& p0, f32x16& p1, const char* lds, int r32_, int hi_, const bf16x8* qr, const char* qrl) {
    p0 = f32x16{}; p1 = f32x16{};
    int lane_ = r32_ | (hi_ << 5); asm volatile("" : "+v"(lane_)); const int r32 = lane_ & 31, hi = lane_ >> 5;
    const char* kb[4];
#pragma unroll
    for (int dd = 0; dd < 4; ++dd) kb[dd] = lds + OFF_K + KB * SHM_K + KSWZ(r32, (dd * 16 + hi * 8) * 2);
#pragma unroll
    for (int d0 = 0; d0 < 8; ++d0) { const char* a = kb[d0 & 3] + (d0 >> 2) * 128;
        bf16x8 b0 = *reinterpret_cast<const bf16x8*>(a);
        bf16x8 b1 = *reinterpret_cast<const bf16x8*>(a + 32 * 256);
        p0 = __builtin_amdgcn_mfma_f32_32x32x16_bf16(b0, qr[d0], p0, 0, 0, 0);
        p1 = __builtin_amdgcn_mfma_f32_32x32x16_bf16(b1, qr[d0], p1, 0, 0, 0); }
    if constexpr (ROPE > 0) {
#pragma unroll
        for (int d0 = 0; d0 < 4; ++d0) { const char* a = lds + OFF_R + KB * SHM_R + RSWZ(r32, d0 * 2 + hi);
            bf16x8 b0 = *reinterpret_cast<const bf16x8*>(a);
            bf16x8 b1 = *reinterpret_cast<const bf16x8*>(a + 32 * 128);
            const bf16x8 qf = *reinterpret_cast<const bf16x8*>(qrl + d0 * 1024);
            p0 = __builtin_amdgcn_mfma_f32_32x32x16_bf16(b0, qf, p0, 0, 0, 0);
            p1 = __builtin_amdgcn_mfma_f32_32x32x16_bf16(b1, qf, p1, 0, 0, 0); }
    }
}
template <int VB>
__device__ __forceinline__ void pv_tile(f32x16* o, int vb0, bf16x8 pa0, bf16x8 pa1, bf16x8 pa2, bf16x8 pa3) {
#define TRRD(dst, off) asm volatile("ds_read_b64_tr_b16 %0, %1 offset:%2" : "=&v"(dst) : "v"(vb0), "i"(off) : "memory")
#define PV_D0(d0) do { s16x4 l0, l1, l2, l3, h0, h1, h2, h3; constexpr int b_ = OFF_V + VB * SHM_V + v_rd_off(d0, 0, 0); \
        TRRD(l0, b_); TRRD(h0, b_ + 2048); TRRD(l1, b_ + 4096); TRRD(h1, b_ + 6144); TRRD(l2, b_ + 8192); TRRD(h2, b_ + 10240); TRRD(l3, b_ + 12288); TRRD(h3, b_ + 14336); \
        asm volatile("s_waitcnt lgkmcnt(0)" ::: "memory"); SBAR();   \
        o[d0] = __builtin_amdgcn_mfma_f32_32x32x16_bf16(pa0, (bf16x8){l0[0], l0[1], l0[2], l0[3], h0[0], h0[1], h0[2], h0[3]}, o[d0], 0, 0, 0);   \
        o[d0] = __builtin_amdgcn_mfma_f32_32x32x16_bf16(pa1, (bf16x8){l1[0], l1[1], l1[2], l1[3], h1[0], h1[1], h1[2], h1[3]}, o[d0], 0, 0, 0);   \
        o[d0] = __builtin_amdgcn_mfma_f32_32x32x16_bf16(pa2, (bf16x8){l2[0], l2[1], l2[2], l2[3], h2[0], h2[1], h2[2], h2[3]}, o[d0], 0, 0, 0);   \
        o[d0] = __builtin_amdgcn_mfma_f32_32x32x16_bf16(pa3, (bf16x8){l3[0], l3[1], l3[2], l3[3], h3[0], h3[1], h3[2], h3[3]}, o[d0], 0, 0, 0); } while (0)
    PV_D0(0); PV_D0(1); PV_D0(2); PV_D0(3);
#undef PV_D0
#undef TRRD
}

template <int LDQ, int LDK, int LDV, int LDO> struct Strides { static constexpr int ldq = LDQ, ldk = LDK, ldv = LDV, ldo = LDO; };
struct BlockRef { const bf16* Q; const bf16* K; const bf16* V; bf16* O; u64* ssq; int P0; int nk; };
template <int NQ> struct Seam { bf16x8 qr[8]; bf16x8 st_v0, st_v1, st_k0, st_k1, st_r; };

#define VMW() asm volatile("s_waitcnt vmcnt(0)" ::: "memory")
#define VMWN(n) asm volatile("s_waitcnt vmcnt(%0)" :: "i"(n) : "memory")
__device__ __forceinline__ int optid() { int t = threadIdx.x; asm volatile("" : "+v"(t)); return t; }
#define SLOAD_H(Kp, Vp, k0) do { const int t_ = optid(); const unsigned sr_ = t_ >> 4, sc_ = (t_ & 15) * 8, rr_ = t_ >> 3, rc_ = (t_ & 7) * 8;   \
                                 const bf16* kt_ = (Kp) + (size_t)(k0) * st.ldk; const bf16* vt_ = (Vp) + (size_t)(k0) * st.ldv;                    \
                                 S.st_v0 = load8(vt_ + (sr_ * st.ldv + sc_)); S.st_v1 = load8(vt_ + ((32 + sr_) * st.ldv + sc_));                   \
                                 S.st_k0 = load8(kt_ + (sr_ * st.ldk + sc_)); S.st_k1 = load8(kt_ + ((32 + sr_) * st.ldk + sc_));                   \
                                 if constexpr (ROPE > 0) S.st_r = load8(kt_ + (rr_ * st.ldk + 128 + rc_)); } while (0)
#define SWRITE_HK(bf) do { const int t_ = optid(); const int kws_ = KSWZ(t_ >> 4, (t_ & 15) * 16);                                                  \
                           *(bf16x8*)(lds + OFF_K + (bf) * SHM_K + kws_) = S.st_k0; *(bf16x8*)(lds + OFF_K + (bf) * SHM_K + kws_ + 32 * 256) = S.st_k1;   \
                           if constexpr (ROPE > 0) *(bf16x8*)(lds + OFF_R + (bf) * SHM_R + RSWZ(t_ >> 3, t_ & 7)) = S.st_r; } while (0)
#define SWRITE_HV(bf) do { const int t_ = optid(); const int sr_ = t_ >> 4, sc_ = (t_ & 15) * 8;                                                     \
                           *(bf16x8*)(lds + OFF_V + (bf) * SHM_V + v_st(sr_, sc_)) = S.st_v0; *(bf16x8*)(lds + OFF_V + (bf) * SHM_V + v_st(32 + sr_, sc_)) = S.st_v1; } while (0)
#define SWRITE_H(bf) do { SWRITE_HV(bf); SWRITE_HK(bf); } while (0)

template <int ROPE, class ST>
__device__ __forceinline__ void attn_prime(const BlockRef& cur, const ST& st, char* lds, Seam<8 + ROPE / 16>& S) {
    constexpr int NQ = 8 + ROPE / 16;
    int tid = threadIdx.x; asm volatile("" : "+v"(tid)); const int wid = __builtin_amdgcn_readfirstlane(tid >> 6), lane = tid & 63, r32 = lane & 31, hi = lane >> 5;
#pragma unroll
    for (int d0 = 0; d0 < 8; ++d0) S.qr[d0] = load8(cur.Q + (size_t)(wid * QBLK + r32) * st.ldq + d0 * 16 + hi * 8);
    if constexpr (ROPE > 0) {
#pragma unroll
        for (int d0 = 0; d0 < 4; ++d0) *(bf16x8*)(lds + OFF_QR + wid * 4096 + d0 * 1024 + lane * 16) = load8(cur.Q + (size_t)(wid * QBLK + r32) * st.ldq + 128 + d0 * 16 + hi * 8);
    }
    SLOAD_H(cur.K, cur.V, 0); VMW(); SWRITE_HK(0);
    __syncthreads();
}
template <int ROPE, bool CAUSAL, bool STAT, class ST>
__device__ __forceinline__ void attn_block(const BlockRef& cur, const BlockRef& nxt, const ST& st, const float SCALE, char* lds, Seam<8 + ROPE / 16>& S) {
    constexpr int NQ = 8 + ROPE / 16;
    int tid = threadIdx.x; asm volatile("" : "+v"(tid)); const int wid = __builtin_amdgcn_readfirstlane(tid >> 6), lane = tid & 63, r32 = lane & 31, hi = lane >> 5;
    const int NT = CAUSAL ? ((cur.P0 + QB - 1) / KVBLK + 1) : (cur.nk / KVBLK);
    const int qlo = cur.P0 + wid * QBLK, qm = qlo + r32 - 4 * hi;
    float* ws = (float*)(lds + OFF_WS) + wid * 64; float* li_l = ws, * al_l = ws + 32;
    float m_reg = -1e30f, l_reg = 0; f32x16 o[4] = {};
    const int vb0 = (int)(uintptr_t)lds + v_rd_base(lane);
    const bf16* Kh = cur.K; const bf16* Vh = cur.V;
    const char* qrl = lds + OFF_QR + wid * 4096 + lane * 16;
#define RESC(a) do { if (__any((a) < 1.f)) { if (hi == 0) al_l[r32] = (a); asm volatile("s_waitcnt lgkmcnt(0)" ::: "memory");              \
                     for (int d_ = 0; d_ < 4; ++d_) for (int r = 0; r < 16; ++r) o[d_][r] *= al_l[crow(r, hi)]; } } while (0)
#define KBASE(t) ((t) * KVBLK)
#define MASKT(P0_, P1_, t) do { if (CAUSAL) { const int kb_ = KBASE(t); if (kb_ + KVBLK - 1 > qlo) mask_tile(P0_, P1_, qm - kb_); } } while (0)
#define SEAM_K0() do { VMWN(8); SWRITE_HK(0); SBAR(); } while (0)
    f32x16 pA0, pA1, pB0, pB1; float mnA, mnB, alA, alB; bf16x8 pa0, pa1, pa2, pa3;
    SWRITE_HV(0); SBAR();
    if (NT > 1) { SLOAD_H(Kh, Vh, KBASE(1)); }
    SBAR(); qkt<0, ROPE>(pA0, pA1, lds, r32, hi, S.qr, qrl);
    MASKT(pA0, pA1, 0); partialSM(pA0, pA1, m_reg, mnA, alA, SCALE);
    if (NT > 1) { VMW(); SWRITE_H(1); }
    __syncthreads();
#define HALF_STEP(PX0, PX1, mnX, alX, PY0, PY1, alY, t, KB, VB, SB) do {                                                      \
        SBAR(); qkt<KB, ROPE>(PX0, PX1, lds, r32, hi, S.qr, qrl);                                                                  \
        finishSM(PY0, PY1, alY, l_reg, pa0, pa1, pa2, pa3); SBAR();                                                           \
        if ((t) + 1 < NT) { SLOAD_H(Kh, Vh, KBASE((t) + 1)); SBAR(); }                                                        \
        pv_tile<VB>(o, vb0, pa0, pa1, pa2, pa3); MASKT(PX0, PX1, (t)); partialSM(PX0, PX1, m_reg, mnX, alX, SCALE);           \
        __syncthreads();                                                                                                      \
        if ((t) + 1 < NT) { VMW(); SWRITE_H(SB); }                                                                            \
        RESC(alX); __syncthreads(); } while (0)
    for (int t = 1; t + 1 < NT; t += 2) {
        HALF_STEP(pB0, pB1, mnB, alB, pA0, pA1, alA, t, 1, 0, 0);
        HALF_STEP(pA0, pA1, mnA, alA, pB0, pB1, alB, t + 1, 0, 1, 1);
    }
    const bool even = (NT & 1) == 0;
    if (even) { SBAR(); qkt<1, ROPE>(pB0, pB1, lds, r32, hi, S.qr, qrl); SBAR(); }
    SLOAD_H(nxt.K, nxt.V, 0); SBAR();
#pragma unroll
    for (int d0 = 0; d0 < 8; ++d0) S.qr[d0] = load8(nxt.Q + (size_t)(wid * QBLK + r32) * st.ldq + d0 * 16 + hi * 8);
    SBAR();
    finishSM(pA0, pA1, alA, l_reg, pa0, pa1, pa2, pa3); SBAR();
    pv_tile<0>(o, vb0, pa0, pa1, pa2, pa3);
    if (even) { MASKT(pB0, pB1, NT - 1); partialSM(pB0, pB1, m_reg, mnB, alB, SCALE); __syncthreads(); RESC(alB);
        finishSM(pB0, pB1, alB, l_reg, pa0, pa1, pa2, pa3); SBAR(); pv_tile<1>(o, vb0, pa0, pa1, pa2, pa3); }
    SBAR(); SEAM_K0();
    if (hi == 0) li_l[r32] = l_reg; asm volatile("s_waitcnt lgkmcnt(0)" ::: "memory");
    float rli[16];
#pragma unroll
    for (int r = 0; r < 16; ++r) rli[r] = __builtin_amdgcn_rcpf(li_l[crow(r, hi)]);
    bf16* Ow = cur.O + (size_t)(wid * QBLK) * st.ldo;
#pragma unroll
    for (int r = 0; r < 16; ++r) { const int orow = crow(r, hi); float ss = 0.f;
#pragma unroll
        for (int d0 = 0; d0 < 4; ++d0) { const float v = o[d0][r] * rli[r]; ss += v * v;
            const float vn = __shfl_xor(v, 1);
            if ((r32 & 1) == 0) *(unsigned*)(Ow + (size_t)orow * st.ldo + d0 * 32 + r32) = cvtpk(v, vn); }
        if (STAT) { ss += __shfl_xor(ss, 1); ss += __shfl_xor(ss, 2); ss += __shfl_xor(ss, 4); ss += __shfl_xor(ss, 8); ss += __shfl_xor(ss, 16);
            if (r32 == 0) ssq_add(cur.ssq, wid * QBLK + orow, ss); } }
    if constexpr (ROPE > 0) {
#pragma unroll
        for (int d0 = 0; d0 < 4; ++d0) *(bf16x8*)(lds + OFF_QR + wid * 4096 + d0 * 1024 + lane * 16) = load8(nxt.Q + (size_t)(wid * QBLK + r32) * st.ldq + 128 + d0 * 16 + hi * 8);
    }
    __syncthreads();
#undef RESC
#undef KBASE
#undef MASKT
#undef SEAM_K0
#undef HALF_STEP
}
#undef VMW
#undef VMWN
#undef SLOAD_H
#undef SWRITE_HK
#undef SWRITE_HV
#undef SWRITE_H
}
constexpr size_t MiB = 1u << 20;
constexpr size_t WS_CTL = 0, WS_STAT = 1 * MiB, ZERO_BYTES = 3 * MiB;
constexpr size_t WS_TAB = 3 * MiB;
constexpr size_t WS_MEMB = 6 * MiB, WS_KVMEM = 8 * MiB, WS_KMEMN = 10 * MiB, WS_WMKV = 11 * MiB;
constexpr size_t WS_LOGIT = 20 * MiB, WS_MOE = 24 * MiB, WS_SCAN = 26 * MiB;
constexpr size_t WS_W = 28 * MiB;
constexpr size_t W_IN = 0, W_UQ = 12 * MiB, W_UKV = W_UQ + 3 * MiB / 2, W_G = W_UKV + MiB, W_OUT = W_G + MiB, W_MQ = W_OUT + 8 * MiB, W_MO = W_MQ + 2 * MiB, W_R = W_MO + 2 * MiB,
                 W_GU = W_R + MiB, W_D = W_GU + 128 * MiB, W_END = W_D + 64 * MiB;
constexpr size_t WS_XB = 250 * MiB, WS_R = 314 * MiB;
static_assert(WS_W + W_END <= WS_XB, "weights");
constexpr size_t R_Z = 0, R_Q = 96 * MiB, R_KVR = 144 * MiB, R_KK = 208 * MiB, R_XC = 256 * MiB, R_AA = 288 * MiB, R_UU = 352 * MiB, R_YMIX = 416 * MiB, R_END = 480 * MiB;
constexpr size_t R_QM = 0, R_QMN = 64 * MiB, R_OM = 80 * MiB;
constexpr size_t R_ACT = 0, R_Y = 40 * MiB;
constexpr size_t WS_END = WS_R + R_END;
constexpr int CW_BAR = 4096;
constexpr int CW_CNT = 16384;
enum { ST_X = 0, ST_CQ = 1, ST_CKV = 2, ST_YATT = 3, ST_YRNN = 4, ST_X1 = 5, ST_X2 = 6 };
constexpr int RING_BYTES = 131072, LDSCTL_OFF = RING_BYTES, LDS_BYTES = 147456;
constexpr int LC_BAR = 0, LC_NRT = 16, LC_RTAB = 64;

struct Params { const float* in[36]; float* out; unsigned char* ws; int ph_lo, ph_hi, probe, pad; };
static_assert(sizeof(Params) == 36 * 8 + 8 + 8 + 16, "Params layout");
typedef __attribute__((address_space(4))) const unsigned char kchar;
__device__ __forceinline__ kchar* karg_base() { kchar* ka = (kchar*)__builtin_amdgcn_kernarg_segment_ptr(); asm volatile("" : "+s"(ka)); return ka; }
__device__ __forceinline__ const float* in_ptr(const Params&, int i) { return (const float*)(*(GAS const float* const __attribute__((address_space(4)))*)(karg_base() + i * 8)); }
__device__ __forceinline__ float* out_ptr() { return (float*)(*(GAS float* const __attribute__((address_space(4)))*)(karg_base() + 288)); }
__device__ __forceinline__ unsigned char* ws_ptr() { return (unsigned char*)(*(GAS unsigned char* const __attribute__((address_space(4)))*)(karg_base() + 296)); }
__device__ __forceinline__ unsigned char* opaque_ptr(unsigned char*) { return ws_ptr(); }
enum { I_X = 0, I_MEM, I_MIXG, I_WIN, I_QLG, I_KVLG, I_WUQ, I_WUKV, I_AQG, I_AKG, I_CONVW, I_CONVB, I_WRG, I_BRG, I_WIG, I_BIG, I_LAM, I_AOG, I_ROG, I_WOUT, I_XNG, I_MNG, I_WMQ, I_WMK, I_WMV,
       I_MQG, I_MKG, I_WMO, I_MOEG, I_WRGRP, I_BRGRP, I_WREXP, I_BREXP, I_WEG, I_WEU, I_WED };

__device__ __forceinline__ int dmap(int map, int n) {
    if (map == 1) return n < 768 ? n : (n < 832 ? n + 2048 : n - 64);
    if (map == 2) return ((n >> 7) << 8) + (n & 127);
    if (map == 3) return ((n >> 7) << 8) + 128 + (n & 127);
    return n;
}
__device__ __forceinline__ void transpose_item(const float* W, int K, int Nsrc, bf16* WT, const float* gain, int map, LAS float* scr, int item, int lane) {
    const int nblk = Nsrc / 32, kb = item / nblk, nb = item % nblk, k0 = 64 * kb, n0 = 32 * nb;
    const GAS float* src = (const GAS float*)W + (size_t)(k0 + (lane >> 5)) * Nsrc + n0 + (lane & 31);
    float v[32];
#pragma unroll
    for (int i = 0; i < 32; ++i) v[i] = src[(size_t)(2 * i) * Nsrc];
    const int c = lane & 7; const int d0 = dmap(map, n0);
    f32x4 ga = (f32x4){1.f, 1.f, 1.f, 1.f}, gb = ga;
    if (gain) { ga = *(const GAS f32x4*)((const GAS float*)gain + k0 + 8 * c); gb = *(const GAS f32x4*)((const GAS float*)gain + k0 + 8 * c + 4); }
#pragma unroll
    for (int i = 0; i < 32; ++i) scr[(2 * i + (lane >> 5)) * 33 + (lane & 31)] = v[i];
    LDS_WAIT(); asm volatile("" ::: "memory");
#pragma unroll
    for (int j = 0; j < 4; ++j) { const int n = (lane >> 3) + 8 * j; const LAS float* s = scr + (8 * c) * 33 + n;
        u32x4 o; o.x = pk2(s[0 * 33] * ga[0], s[1 * 33] * ga[1]); o.y = pk2(s[2 * 33] * ga[2], s[3 * 33] * ga[3]); o.z = pk2(s[4 * 33] * gb[0], s[5 * 33] * gb[1]); o.w = pk2(s[6 * 33] * gb[2], s[7 * 33] * gb[3]);
        *(GAS u32x4*)((GAS bf16*)WT + (size_t)(d0 + n) * K + k0 + 8 * c) = o; }
    LDS_WAIT(); asm volatile("" ::: "memory");
}
__device__ __forceinline__ void convert_layer_weights(const Params& p, int l, LAS float* scr, int gw, int NGW, int lane, int gtid, int NGT) {
    unsigned char* wb = opaque_ptr(p.ws) + WS_W;
    constexpr int I0 = 32 * 90, I1 = 8 * 48, I2 = 4 * 64, I3 = 32 * 64, I4 = 32 * 16, I5 = 8 * 64, IE = 32 * 16, IEX = 32 * IE, ID = 8 * 64, IDX = 32 * ID;
    constexpr int NIT = I0 + I1 + I2 + I3 + I4 + I5 + 2 * IEX + IDX;
    for (int it = gw; it < NIT; it += NGW) {
        int r = it;
        if (r < I0) { transpose_item(in_ptr(p, I_WIN) + (size_t)l * D * 2880, D, 2880, (bf16*)(wb + W_IN), in_ptr(p, I_MIXG) + l * D, 1, scr, r, lane); continue; } r -= I0;
        if (r < I1) { transpose_item(in_ptr(p, I_WUQ) + (size_t)l * QL * NQU, QL, NQU, (bf16*)(wb + W_UQ), in_ptr(p, I_QLG) + l * QL, 0, scr, r, lane); continue; } r -= I1;
        if (r < I2) { transpose_item(in_ptr(p, I_WUKV) + (size_t)l * KVL * NKV, KVL, NKV, (bf16*)(wb + W_UKV), in_ptr(p, I_KVLG) + l * KVL, 0, scr, r, lane); continue; } r -= I2;
        if (r < I3) { const int k0 = 64 * (r / 64); const float* g = (k0 < 1024) ? (in_ptr(p, I_AOG) + l * 1024) : (in_ptr(p, I_ROG) + l * 1024 - 1024);
                      transpose_item(in_ptr(p, I_WOUT) + (size_t)l * D * D, D, D, (bf16*)(wb + W_OUT), g, 0, scr, r, lane); continue; } r -= I3;
        if (r < I4) { transpose_item(in_ptr(p, I_WMQ) + (size_t)l * D * DMA, D, DMA, (bf16*)(wb + W_MQ), in_ptr(p, I_XNG) + l * D, 0, scr, r, lane); continue; } r -= I4;
        if (r < I5) { transpose_item(in_ptr(p, I_WMO) + (size_t)l * DMA * D, DMA, D, (bf16*)(wb + W_MO), nullptr, 0, scr, r, lane); continue; } r -= I5;
        if (r < IEX) { const int e = r / IE; transpose_item(in_ptr(p, I_WEG) + ((size_t)l * NE + e) * D * DE, D, DE, (bf16*)(wb + W_GU) + (size_t)e * 1024 * D, in_ptr(p, I_MOEG) + l * D, 2, scr, r % IE, lane); continue; } r -= IEX;
        if (r < IEX) { const int e = r / IE; transpose_item(in_ptr(p, I_WEU) + ((size_t)l * NE + e) * D * DE, D, DE, (bf16*)(wb + W_GU) + (size_t)e * 1024 * D, in_ptr(p, I_MOEG) + l * D, 3, scr, r % IE, lane); continue; } r -= IEX;
        { const int e = r / ID; transpose_item(in_ptr(p, I_WED) + ((size_t)l * NE + e) * DE * D, DE, D, (bf16*)(wb + W_D) + (size_t)e * D * DE, nullptr, 0, scr, r % ID, lane); }
    }
    { u32x4* z = (u32x4*)((bf16*)(wb + W_IN) + (size_t)2880 * D); const int n16 = 192 * D * 2 / 16; for (int i = gtid; i < n16; i += NGT) z[i] = (u32x4){0u, 0u, 0u, 0u}; }
    { bf16* wr = (bf16*)(wb + W_R); const float* wg = in_ptr(p, I_WRGRP) + (size_t)l * D * 4; const float* we = in_ptr(p, I_WREXP) + (size_t)l * D * 32; const float* g = in_ptr(p, I_MOEG) + l * D;
      for (int i = gtid; i < 256 * D / 8; i += NGT) { const int n = i / (D / 8), k0 = (i % (D / 8)) * 8; float v[8];
#pragma unroll
          for (int j = 0; j < 8; ++j) { const int k = k0 + j; v[j] = n < 4 ? wg[k * 4 + n] * g[k] : (n < 36 ? we[k * 32 + (n - 4)] * g[k] : 0.f); }
          u32x4 o; o.x = pk2(v[0], v[1]); o.y = pk2(v[2], v[3]); o.z = pk2(v[4], v[5]); o.w = pk2(v[6], v[7]); *(u32x4*)(wr + (size_t)n * D + k0) = o; } }
    { bf16* wg = (bf16*)(wb + W_G); const float* wr = in_ptr(p, I_WRG) + (size_t)l * 8 * 128 * 128; const float* wi = in_ptr(p, I_WIG) + (size_t)l * 8 * 128 * 128;
      for (int i = gtid; i < 8 * 256 * 256 / 8; i += NGT) { const int n = i >> 13, j = (i >> 5) & 255, c0 = (i & 31) * 8; float v[8];
          const bool on = (c0 >> 7) == (n & 1); const float* src = (j < 128 ? wr : wi) + (size_t)n * 128 * 128 + (j & 127);
#pragma unroll
          for (int q = 0; q < 8; ++q) v[q] = on ? src[(size_t)((c0 & 127) + q) * 128] : 0.f;
          u32x4 o; o.x = pk2(v[0], v[1]); o.y = pk2(v[2], v[3]); o.z = pk2(v[4], v[5]); o.w = pk2(v[6], v[7]); *(u32x4*)(wg + (size_t)i * 8) = o; } }
}
__device__ __forceinline__ float row_to_bf16(const float* xrow, bf16* orow, int lane) {
    float ss = 0.f;
#pragma unroll
    for (int j = 0; j < 4; ++j) { const int c = lane * 8 + 512 * j; const f32x4 a = *(const f32x4*)(xrow + c), b = *(const f32x4*)(xrow + c + 4);
        ss += (a[0] * a[0] + a[1] * a[1]) + (a[2] * a[2] + a[3] * a[3]) + (b[0] * b[0] + b[1] * b[1]) + (b[2] * b[2] + b[3] * b[3]);
        u32x4 o; o.x = pk2(a[0], a[1]); o.y = pk2(a[2], a[3]); o.z = pk2(b[0], b[1]); o.w = pk2(b[2], b[3]); *(u32x4*)(orow + c) = o; }
    return wave_sum(ss);
}
__device__ __forceinline__ float gelu_tanh(float x) { const float y = 0.7978845608028654f * (x + 0.044715f * x * x * x); const float e = __expf(2.0f * y); const float th = 1.0f - 2.0f / (e + 1.0f); return 0.5f * x * (1.0f + th); }
__device__ __forceinline__ void unpack8(u32x4 w, float* v) { v[0] = bflo(w.x); v[1] = bfhi(w.x); v[2] = bflo(w.y); v[3] = bfhi(w.y); v[4] = bflo(w.z); v[5] = bfhi(w.z); v[6] = bflo(w.w); v[7] = bfhi(w.w); }
__device__ __forceinline__ u32x4 pack8f(const float* v) { u32x4 o; o.x = pk2(v[0], v[1]); o.y = pk2(v[2], v[3]); o.z = pk2(v[4], v[5]); o.w = pk2(v[6], v[7]); return o; }

__device__ __forceinline__ void conv_phase(const bf16* z, bf16* xc, const float* cw, const float* cb, int gtid, int NGT) {
    for (int it = gtid; it < (T / 16) * 128; it += NGT) {
        const int tb = it >> 7, cg = it & 127, row0 = tb * 16, s0 = row0 & (SEQ - 1), c0 = cg * 8;
        float w[4][8], b[8], p1[8], p2[8], p3[8];
#pragma unroll
        for (int j = 0; j < 4; ++j) { const f32x4 a = *(const f32x4*)(cw + j * DRNN + c0), bb = *(const f32x4*)(cw + j * DRNN + c0 + 4);
            w[j][0] = a[0]; w[j][1] = a[1]; w[j][2] = a[2]; w[j][3] = a[3]; w[j][4] = bb[0]; w[j][5] = bb[1]; w[j][6] = bb[2]; w[j][7] = bb[3]; }
        { const f32x4 a = *(const f32x4*)(cb + c0), bb = *(const f32x4*)(cb + c0 + 4); b[0] = a[0]; b[1] = a[1]; b[2] = a[2]; b[3] = a[3]; b[4] = bb[0]; b[5] = bb[1]; b[6] = bb[2]; b[7] = bb[3]; }
        const bf16* zp = z + (size_t)row0 * ZC + Z_XR + c0;
        if (s0 >= 1) unpack8(*(const u32x4*)(zp - (size_t)ZC), p1); else { for (int e = 0; e < 8; ++e) p1[e] = 0.f; }
        if (s0 >= 2) unpack8(*(const u32x4*)(zp - (size_t)2 * ZC), p2); else { for (int e = 0; e < 8; ++e) p2[e] = 0.f; }
        if (s0 >= 3) unpack8(*(const u32x4*)(zp - (size_t)3 * ZC), p3); else { for (int e = 0; e < 8; ++e) p3[e] = 0.f; }
#pragma unroll 4
        for (int r = 0; r < 16; ++r) { float cur[8], o[8]; unpack8(*(const u32x4*)(zp + (size_t)r * ZC), cur);
#pragma unroll
            for (int e = 0; e < 8; ++e) { o[e] = b[e] + w[3][e] * cur[e] + w[2][e] * p1[e] + w[1][e] * p2[e] + w[0][e] * p3[e]; p3[e] = p2[e]; p2[e] = p1[e]; p1[e] = cur[e]; }
            *(u32x4*)(xc + (size_t)(row0 + r) * DRNN + c0) = pack8f(o); }
    }
}
__device__ __forceinline__ void qk_post_phase(bf16* q, const bf16* kvr, const bf16* z, bf16* kk, const float* gq, const float* gk, const float* cosT, const float* sinT, int gw, int NGW, int lane) {
    const int h = lane >> 3, j = lane & 7;
    for (int row = gw; row < T; row += NGW) {
        const int s = row & (SEQ - 1);
        float cs[8], sn[8];
        { const int i0 = (j & 3) * 8; const f32x4 a = *(const f32x4*)(cosT + s * 32 + i0), b = *(const f32x4*)(cosT + s * 32 + i0 + 4), c = *(const f32x4*)(sinT + s * 32 + i0), d = *(const f32x4*)(sinT + s * 32 + i0 + 4);
          cs[0] = a[0]; cs[1] = a[1]; cs[2] = a[2]; cs[3] = a[3]; cs[4] = b[0]; cs[5] = b[1]; cs[6] = b[2]; cs[7] = b[3];
          sn[0] = c[0]; sn[1] = c[1]; sn[2] = c[2]; sn[3] = c[3]; sn[4] = d[0]; sn[5] = d[1]; sn[6] = d[2]; sn[7] = d[3]; }
#pragma unroll
        for (int which = 0; which < 2; ++which) {
            float v[3][8];
            if (which == 0) { bf16* qp = q + (size_t)row * NQU + h * QKH + j * 8;
#pragma unroll
                for (int i = 0; i < 3; ++i) unpack8(*(const u32x4*)(qp + 64 * i), v[i]); }
            else { const bf16* kp = kvr + (size_t)row * NKV + h * 256 + j * 8; unpack8(*(const u32x4*)kp, v[0]); unpack8(*(const u32x4*)(kp + 64), v[1]);
                   unpack8(*(const u32x4*)(z + (size_t)row * ZC + Z_KPE + j * 8), v[2]); }
            float ss = 0.f;
#pragma unroll
            for (int i = 0; i < 3; ++i)
#pragma unroll
                for (int e = 0; e < 8; ++e) ss += v[i][e] * v[i][e];
            ss += __shfl_xor(ss, 1); ss += __shfl_xor(ss, 2); ss += __shfl_xor(ss, 4);
            const float rstd = 1.0f / sqrtf(ss * (1.0f / 192.0f) + EPS);
            const float* g = which == 0 ? gq : gk;
#pragma unroll
            for (int i = 0; i < 3; ++i) { const f32x4 ga = *(const f32x4*)(g + 64 * i + j * 8), gb = *(const f32x4*)(g + 64 * i + j * 8 + 4);
                v[i][0] *= rstd * ga[0]; v[i][1] *= rstd * ga[1]; v[i][2] *= rstd * ga[2]; v[i][3] *= rstd * ga[3]; v[i][4] *= rstd * gb[0]; v[i][5] *= rstd * gb[1]; v[i][6] *= rstd * gb[2]; v[i][7] *= rstd * gb[3]; }
#pragma unroll
            for (int e = 0; e < 8; ++e) { const float mine = v[2][e], oth = __shfl_xor(mine, 4);
                v[2][e] = (j < 4) ? (mine * cs[e] - oth * sn[e]) : (oth * sn[e] + mine * cs[e]); }
            bf16* op = (which == 0 ? q + (size_t)row * NQU : kk + (size_t)row * NQU) + h * QKH + j * 8;
#pragma unroll
            for (int i = 0; i < 3; ++i) *(u32x4*)(op + 64 * i) = pack8f(v[i]);
        }
    }
}
template <bool F32IN>
__device__ __forceinline__ void head128_norm_rows(const void* in0, const float* in1, int ld_in, bf16* out, const float* g, int nrows, int gw, int NGW, int lane) {
    for (int row = gw; row < nrows; row += NGW) {
        float v[8];
        if (F32IN) { const float* a = (const float*)in0 + (size_t)row * ld_in + lane * 8; const float* b = in1 + (size_t)row * ld_in + lane * 8;
            const f32x4 a0 = *(const f32x4*)a, a1 = *(const f32x4*)(a + 4), b0 = *(const f32x4*)b, b1 = *(const f32x4*)(b + 4);
            v[0] = a0[0] + b0[0]; v[1] = a0[1] + b0[1]; v[2] = a0[2] + b0[2]; v[3] = a0[3] + b0[3]; v[4] = a1[0] + b1[0]; v[5] = a1[1] + b1[1]; v[6] = a1[2] + b1[2]; v[7] = a1[3] + b1[3]; }
        else unpack8(*(const u32x4*)((const bf16*)in0 + (size_t)row * ld_in + lane * 8), v);
        float ss = 0.f;
#pragma unroll
        for (int e = 0; e < 8; ++e) ss += v[e] * v[e];
        ss += __shfl_xor(ss, 1); ss += __shfl_xor(ss, 2); ss += __shfl_xor(ss, 4); ss += __shfl_xor(ss, 8);
        const float rstd = 1.0f / sqrtf(ss * (1.0f / 128.0f) + EPS);
        const int c = (lane * 8) & 127; const f32x4 ga = *(const f32x4*)(g + c), gb = *(const f32x4*)(g + c + 4);
        v[0] *= rstd * ga[0]; v[1] *= rstd * ga[1]; v[2] *= rstd * ga[2]; v[3] *= rstd * ga[3]; v[4] *= rstd * gb[0]; v[5] *= rstd * gb[1]; v[6] *= rstd * gb[2]; v[7] *= rstd * gb[3];
        *(u32x4*)(out + (size_t)row * DMA + lane * 8) = pack8f(v);
    }
}
__device__ __forceinline__ void scan_pass1(const float* aa, const float* uu, float* cA, float* cH, int unit, int tid) {
    const int half = unit & 1, chunk = (unit >> 1) & 63, b = unit >> 7, ch = half * 512 + tid;
    const size_t base = ((size_t)b * SEQ + (size_t)chunk * 128) * DRNN + ch;
    float A = 1.f, H = 0.f;
#pragma unroll 16
    for (int s = 0; s < 128; ++s) { const float a = aa[base + (size_t)s * DRNN], u = uu[base + (size_t)s * DRNN]; H = a * H + u; A *= a; }
    cA[(size_t)(b * 64 + chunk) * DRNN + ch] = A; cH[(size_t)(b * 64 + chunk) * DRNN + ch] = H;
}
__device__ __forceinline__ void scan_pass3(const float* aa, const float* uu, const float* cA, const float* cH, const bf16* z, bf16* ymix, u64* ssq, int unit, int tid, int lane) {
    const int half = unit & 1, chunk = (unit >> 1) & 63, b = unit >> 7, ch = half * 512 + tid;
    float h = 0.f;
    for (int j = 0; j < chunk; ++j) h = cA[(size_t)(b * 64 + j) * DRNN + ch] * h + cH[(size_t)(b * 64 + j) * DRNN + ch];
    const size_t row0 = (size_t)b * SEQ + (size_t)chunk * 128;
#pragma unroll 8
    for (int s = 0; s < 128; ++s) { const size_t row = row0 + s; const float a = aa[row * DRNN + ch], u = uu[row * DRNN + ch]; h = a * h + u;
        const float g = bf2f(z[row * ZC + Z_GATE + ch]); const float y = h * gelu_tanh(g);
        ymix[row * D + DATT + ch] = (bf16)f2bf(y);
        const float ss = wave_sum(y * y); if (lane == 0) ssq_add(ssq, (int)row, ss); }
}
__device__ __forceinline__ void route_phase(const float* logits, const u64* ssq_x2, const float* bg, const float* be, int* tok_e, float* tok_w, int* whist, unsigned* cnt, LAS int* hist, int wg, int tid) {
    if (tid < 32) hist[tid] = 0;
    __syncthreads();
    if (tid < 64) { const int t = wg * 64 + tid; const float rs = 1.0f / sqrtf(ssq_val(ssq_x2, t) * (1.0f / D) + EPS); const float* lp = logits + (size_t)t * 64;
        float lg[4]; int g = 0; float mx = -3.0e38f;
#pragma unroll
        for (int i = 0; i < 4; ++i) { lg[i] = lp[i] * rs + bg[i]; if (lg[i] > mx) { mx = lg[i]; g = i; } }
        float den = 0.f;
#pragma unroll
        for (int i = 0; i < 4; ++i) den += __expf(lg[i] - mx);
        const float gw = 1.0f / den;
        float l1 = -3.0e38f, l2 = -3.0e38f; int j1 = 0, j2 = 0;
        for (int i = 0; i < 8; ++i) { const float v = lp[4 + g * 8 + i] * rs + be[g * 8 + i];
            if (v > l1) { l2 = l1; j2 = j1; l1 = v; j1 = i; } else if (v > l2) { l2 = v; j2 = i; } }
        const float w1 = 1.0f / (1.0f + __expf(l2 - l1)), w2 = 1.0f - w1;
        const int e1 = g * 8 + j1, e2 = g * 8 + j2;
        tok_e[t * 2] = e1; tok_e[t * 2 + 1] = e2; tok_w[t * 2] = gw * w1; tok_w[t * 2 + 1] = gw * w2;
        __hip_atomic_fetch_add(hist + e1, 1, __ATOMIC_RELAXED, __HIP_MEMORY_SCOPE_WORKGROUP); __hip_atomic_fetch_add(hist + e2, 1, __ATOMIC_RELAXED, __HIP_MEMORY_SCOPE_WORKGROUP);
    }
    __syncthreads();
    if (tid < 32) { const int c = hist[tid]; whist[wg * 32 + tid] = c; if (c) atomicAdd(cnt + tid, (unsigned)c); }
}
__device__ __forceinline__ void dispatch_phase(const unsigned* cnt, const int* whist, const int* tok_e, const float* tok_w, const u64* ssq_x2, int* tok_slot, int* slot_tok, float* slot_w, float* slot_rs,
                                               LAS int* sc, int wg, int tid) {
    if (tid == 0) { int seg = 0; for (int e = 0; e < 32; ++e) { sc[e] = seg; seg += (((int)cnt[e] + 255) >> 8) << 8; } }
    { const int e = tid & 31, part = tid >> 5; int s = 0; for (int w = part; w < wg; w += 16) s += whist[w * 32 + e]; sc[64 + tid] = s; }
    if (tid < 128) sc[640 + tid] = tok_e[(wg * 64) * 2 + tid];
    __syncthreads();
    if (tid < 32) { int s = sc[tid]; for (int p = 0; p < 16; ++p) s += sc[64 + p * 32 + tid]; sc[32 + tid] = s; }
    __syncthreads();
    if (tid < 128) { const int e = sc[640 + tid]; int rank = 0; for (int j = 0; j < tid; ++j) rank += (sc[640 + j] == e) ? 1 : 0;
        const int slot = sc[32 + e] + rank; const int t = wg * 64 + (tid >> 1);
        slot_tok[slot] = t; slot_w[slot] = tok_w[(wg * 64) * 2 + tid]; slot_rs[slot] = 1.0f / sqrtf(ssq_val(ssq_x2, t) * (1.0f / D) + EPS); tok_slot[(wg * 64) * 2 + tid] = slot; }
    if (wg < 32) { const int c = (int)cnt[wg], lo = sc[wg] + c, hi = sc[wg] + (((c + 255) >> 8) << 8);
        for (int s = lo + tid; s < hi; s += NTHREADS) { slot_tok[s] = 0; slot_w[s] = 0.f; slot_rs[s] = 0.f; } }
    __syncthreads();
}
__device__ __forceinline__ int build_rtab(const unsigned* cnt, LAS int* lc, int tid) {
    if (tid == 0) { int seg = 0, k = 0; for (int e = 0; e < 32; ++e) { const int nt = ((int)cnt[e] + 255) >> 8; for (int r = 0; r < nt; ++r) { lc[LC_RTAB / 4 + 2 * k] = e; lc[LC_RTAB / 4 + 2 * k + 1] = seg + r * 256; ++k; } seg += nt * 256; } lc[LC_NRT / 4] = k; }
    __syncthreads();
    return lc[LC_NRT / 4];
}
__device__ __forceinline__ void combine_phase(float* out, const bf16* Y, const int* tok_slot, bf16* xb, u64* ssq_next, bool last, int gw, int NGW, int lane) {
    for (int row = gw; row < T; row += NGW) {
        const int s0 = tok_slot[row * 2], s1 = tok_slot[row * 2 + 1]; float ss = 0.f;
#pragma unroll
        for (int j = 0; j < 4; ++j) { const int c = lane * 8 + 512 * j; float x0[8], y0[8], y1[8], v[8];
            unpack8(*(const u32x4*)(xb + (size_t)row * D + c), x0); unpack8(*(const u32x4*)(Y + (size_t)s0 * D + c), y0); unpack8(*(const u32x4*)(Y + (size_t)s1 * D + c), y1);
#pragma unroll
            for (int e = 0; e < 8; ++e) { v[e] = x0[e] + y0[e] + y1[e]; ss += v[e] * v[e]; }
            if (last) { float* op = out + (size_t)row * D + c; *(f32x4*)op = (f32x4){v[0], v[1], v[2], v[3]}; *(f32x4*)(op + 4) = (f32x4){v[4], v[5], v[6], v[7]}; }
            else *(u32x4*)(xb + (size_t)row * D + c) = pack8f(v); }
        ss = wave_sum(ss); if (!last && lane == 0) ssq_set(ssq_next, row, ss);
    }
}
constexpr int NPL = 16, NPHASES = 1 + DEPTH * NPL;
__device__ __forceinline__ att::BlockRef mla_ref(int it, int pass, bf16* qbuf, bf16* kk, bf16* kvr, bf16* ymix, u64* ssq_ya) {
    const int bh = (it & 7) * 2 + ((it >> 3) >> 4), y = (it >> 3) & 15, b = bh >> 3, h = bh & 7; const int qb = pass ? 31 - y : y; const size_t r0 = (size_t)b * SEQ;
    att::BlockRef c; c.K = kk + r0 * NQU + h * QKH; c.V = kvr + r0 * NKV + h * 256 + 128; c.nk = SEQ;
    c.Q = qbuf + (r0 + (size_t)qb * 256) * NQU + h * QKH; c.O = ymix + (r0 + (size_t)qb * 256) * D + h * VH; c.ssq = ssq_ya + r0 + qb * 256; c.P0 = qb * 256; return c;
}
#ifndef PH_MASK
#define PH_MASK 0x1ffff
#endif
#define PH_ON(j) (((PH_MASK) >> (j)) & 1)
__global__ void __launch_bounds__(NTHREADS, 2) fwd_kernel(Params p) {
    extern __shared__ __attribute__((aligned(16))) unsigned char lds_raw[];
    LAS unsigned char* lds = (LAS unsigned char*)lds_raw;
    LAS int* lc = (LAS int*)(lds + LDSCTL_OFF);
    const int G = gridDim.x, bx = blockIdx.x;
    const int NGW = G * NWAVES, NGT = G * NTHREADS;
    if (threadIdx.x < 64) lc[threadIdx.x] = 0;
    __syncthreads();
    XcdBarrier bar = xcd_barrier_post((unsigned*)(ws_ptr() + WS_CTL) + CW_BAR, (volatile LAS unsigned*)(lds + LDSCTL_OFF + LC_BAR));
    const int lo = p.ph_lo, hi = p.ph_hi; const bool probe = p.probe != 0;
#define IN(k) (lo <= (k) && (k) < hi)
#define SEAM(k) do { if ((k) + 1 < hi) xcd_barrier(bar); } while (0)
#define WS_PTRS() unsigned char* ws = opaque_ptr(p.ws); unsigned char* wb = ws + WS_W; unsigned char* rg = ws + WS_R; (void)wb; (void)rg; \
    int tid = threadIdx.x; asm volatile("" : "+v"(tid)); const int lane = tid & 63, wave = __builtin_amdgcn_readfirstlane(tid >> 6); \
    const int gw = bx * NWAVES + wave, gtid = bx * NTHREADS + tid; (void)lane; (void)gw; (void)gtid
#define INP(i) in_ptr(p, (i))
#define STATP(l, k) ((u64*)(ws + WS_STAT) + (size_t)((l) * 7 + (k)) * 16384)

    if (PH_ON(0) && IN(0)) {
        WS_PTRS();
        float* cosT = (float*)(ws + WS_TAB); float* sinT = cosT + SEQ * 32; float* spT = (float*)(ws + WS_TAB + 2 * MiB); u64* ssq_mem = (u64*)(spT + 2 * 1024);
        bf16* memb = (bf16*)(ws + WS_MEMB); bf16* wmkv = (bf16*)(ws + WS_WMKV); bf16* xb = (bf16*)(ws + WS_XB);
        LAS float* scr = (LAS float*)(lds + wave * 16384);
        convert_layer_weights(p, 0, scr, gw, NGW, lane, gtid, NGT);
        for (int it = gw; it < 2 * 2 * 32 * 16; it += NGW) { const int l = it / (2 * 512), r = it % (2 * 512), kv = r / 512, item = r % 512;
            transpose_item(INP(kv ? I_WMV : I_WMK) + (size_t)l * D * DMA, D, DMA, wmkv + (size_t)l * 1024 * D + (size_t)kv * 512 * D, INP(I_MNG) + l * D, 0, scr, item, lane); }
        for (int i = gtid; i < SEQ * 32; i += NGT) { const int t = i >> 5, k = i & 31; const float inv = exp2f(-(float)k * (13.287712379549449f / 32.0f)); float s, c; sincosf((float)t * inv, &s, &c); cosT[i] = c; sinT[i] = s; }
        { const float* lam = INP(I_LAM); for (int i = gtid; i < 2 * 1024; i += NGT) spT[i] = log1pf(expf(-lam[i])); }
        u64* ssq_x0 = STATP(0, ST_X);
        { const float* x = INP(I_X); for (int row = gw; row < T; row += NGW) { const float ss = row_to_bf16(x + (size_t)row * D, xb + (size_t)row * D, lane); if (lane == 0) ssq_set(ssq_x0, row, ss); } }
        { const float* m = INP(I_MEM); for (int row = gw; row < TM; row += NGW) { const float ss = row_to_bf16(m + (size_t)row * D, memb + (size_t)row * D, lane); if (lane == 0) ssq_set(ssq_mem, row, ss); } }
        SEAM(0);
    }

    for (int l = 0; l < DEPTH; ++l) {
        const int pb = 1 + l * NPL;

        if (PH_ON(1) && IN(pb + 0)) {
            WS_PTRS();
            { pg8::DenseSched S{(const char*)(ws + WS_XB), (const char*)(wb + W_IN), D, D, T / 256, ZC / 256, 1, D, G, bx};
              pg8::EpiBf16<0, true> E{(bf16*)(rg + R_Z), ZC, STATP(l, ST_X), 1.0f / D, STATP(l, ST_CQ), STATP(l, ST_CKV), 2, 3};
              pg8::gemm_phase<pg8::EpiBf16<0, true>, pg8::DenseSched, true, false>(lds, D, D, D, S, E, 0); }
            if (l == 0) {
                pg8::DenseSched S{(const char*)(ws + WS_MEMB), (const char*)(ws + WS_WMKV), D, D, TM / 256, 2 * 1024 / 256, 1, D, G, bx};
                pg8::EpiBf16<0, false> E{(bf16*)(ws + WS_KVMEM), 2 * 1024, (const void*)((float*)(ws + WS_TAB + 2 * MiB) + 2 * 1024), 1.0f / D, nullptr, nullptr, 0, 0};
                pg8::gemm_phase<pg8::EpiBf16<0, false>, pg8::DenseSched, true, false>(lds, D, D, D, S, E, 0);
            }
            SEAM(pb + 0);
        }
        if (PH_ON(2) && IN(pb + 1)) {
            WS_PTRS();
            bf16* z = (bf16*)(rg + R_Z);
            { pg8::DenseSched S{(const char*)(z + Z_CQ), (const char*)(wb + W_UQ), ZC, QL, T / 256, NQU / 256, 1, QL, G, bx};
              pg8::EpiBf16<0, false> E{(bf16*)(rg + R_Q), NQU, STATP(l, ST_CQ), 1.0f / QL, nullptr, nullptr, 0, 0};
              pg8::gemm_phase<pg8::EpiBf16<0, false>, pg8::DenseSched, true, false>(lds, QL, ZC, QL, S, E, 0); }
            { pg8::DenseSched S{(const char*)(z + Z_CKV), (const char*)(wb + W_UKV), ZC, KVL, T / 256, NKV / 256, 1, KVL, G, bx};
              pg8::EpiBf16<0, false> E{(bf16*)(rg + R_KVR), NKV, STATP(l, ST_CKV), 1.0f / KVL, nullptr, nullptr, 0, 0};
              pg8::gemm_phase<pg8::EpiBf16<0, false>, pg8::DenseSched, true, false>(lds, KVL, ZC, KVL, S, E, 0); }
            conv_phase(z, (bf16*)(rg + R_XC), INP(I_CONVW) + (size_t)l * 4 * DRNN, INP(I_CONVB) + (size_t)l * DRNN, gtid, NGT);
            if (l == 0) { const float* mkg = INP(I_MKG); for (int ll = 0; ll < 2; ++ll) head128_norm_rows<false>((bf16*)(ws + WS_KVMEM) + (size_t)ll * 1024, nullptr, 2 * 1024, (bf16*)(ws + WS_KMEMN) + (size_t)ll * TM * DMA, mkg + ll * 128, TM, gw, NGW, lane); }
            SEAM(pb + 1);
        }
        if (PH_ON(3) && IN(pb + 2)) {
            WS_PTRS();
            float* cosT = (float*)(ws + WS_TAB);
            qk_post_phase((bf16*)(rg + R_Q), (const bf16*)(rg + R_KVR), (const bf16*)(rg + R_Z), (bf16*)(rg + R_KK), INP(I_AQG) + l * QKH, INP(I_AKG) + l * QKH, cosT, cosT + SEQ * 32, gw, NGW, lane);
            { pg8::GateSched S{(const char*)(rg + R_XC), (const char*)(wb + W_G), G, bx};
              pg8::EpiGates E{(const bf16*)(rg + R_XC), INP(I_BRG) + l * DRNN, INP(I_BIG) + l * DRNN, (float*)(ws + WS_TAB + 2 * MiB) + l * DRNN, (float*)(rg + R_AA), (float*)(rg + R_UU)};
              pg8::gemm_phase<pg8::EpiGates, pg8::GateSched, true, false>(lds, 256, DRNN, 256, S, E, 0); }
            SEAM(pb + 2);
        }
        if (PH_ON(4) && IN(pb + 3)) {
            WS_PTRS();
            float* chA = (float*)(ws + WS_SCAN);
            for (int u = bx; u < 256; u += G) scan_pass1((const float*)(rg + R_AA), (const float*)(rg + R_UU), chA, chA + 2 * 64 * DRNN, u, tid);
            SEAM(pb + 3);
        }
        if (PH_ON(5) && IN(pb + 4)) {
            WS_PTRS();
            bf16* ymix = (bf16*)(rg + R_YMIX);
            {
                bf16* qbuf = (bf16*)(rg + R_Q); bf16* kk = (bf16*)(rg + R_KK); bf16* kvr = (bf16*)(rg + R_KVR); u64* ssq_ya = STATP(l, ST_YATT);
                const att::Strides<NQU, NQU, NKV, D> sd;
                for (int it = bx; it < 256; it += G) {
                    att::BlockRef cur = mla_ref(it, 0, qbuf, kk, kvr, ymix, ssq_ya);
                    att::Seam<12> S;
                    att::attn_prime<64>(cur, sd, (char*)lds_raw, S);
                    for (int pass = 0; pass < 2; ++pass) {
                        const att::BlockRef nxt = (pass == 0) ? mla_ref(it, 1, qbuf, kk, kvr, ymix, ssq_ya) : cur;
                        att::attn_block<64, true, true>(cur, nxt, sd, 0.07216878364870322f, (char*)lds_raw, S);
                        cur = nxt;
                    }
                }
            }
            { float* chA = (float*)(ws + WS_SCAN);
              for (int u = bx; u < 256; u += G) scan_pass3((const float*)(rg + R_AA), (const float*)(rg + R_UU), chA, chA + 2 * 64 * DRNN, (const bf16*)(rg + R_Z), ymix, STATP(l, ST_YRNN), u, tid, lane); }
            SEAM(pb + 4);
        }
        if (PH_ON(6) && IN(pb + 5)) {
            WS_PTRS();
            pg8::DenseSched S{(const char*)(rg + R_YMIX), (const char*)(wb + W_OUT), D, D, T / 256, D / 256, 1, D, G, bx};
            pg8::EpiResid<true> E{(bf16*)(ws + WS_XB), STATP(l, ST_X1), STATP(l, ST_YATT), STATP(l, ST_YRNN)};
            pg8::gemm_phase<pg8::EpiResid<true>, pg8::DenseSched, true, true>(lds, D, D, D, S, E, 16);
            SEAM(pb + 5);
        }
        if (PH_ON(7) && IN(pb + 6)) {
            WS_PTRS();
            pg8::DenseSched S{(const char*)(ws + WS_XB), (const char*)(wb + W_MQ), D, D, T / 256, DMA / 256, 2, 1024, G, bx};
            pg8::EpiF32Slab E{(float*)(rg + R_QM), DMA, (size_t)T * DMA, STATP(l, ST_X1), 1.0f / D};
            pg8::gemm_phase<pg8::EpiF32Slab, pg8::DenseSched, true, false>(lds, 1024, D, D, S, E, 0);
            SEAM(pb + 6);
        }
        if (PH_ON(8) && IN(pb + 7)) {
            WS_PTRS();
            float* qm = (float*)(rg + R_QM);
            head128_norm_rows<true>(qm, qm + (size_t)T * DMA, DMA, (bf16*)(rg + R_QMN), INP(I_MQG) + l * 128, T, gw, NGW, lane);
            SEAM(pb + 7);
        }
        if (PH_ON(9) && IN(pb + 8)) {
            WS_PTRS();
            bf16* qmn = (bf16*)(rg + R_QMN); bf16* om = (bf16*)(rg + R_OM); bf16* kmemn = (bf16*)(ws + WS_KMEMN); bf16* kvmem = (bf16*)(ws + WS_KVMEM);
            const att::Strides<DMA, DMA, 2 * 1024, DMA> sd;
            for (int it = bx; it < 256; it += G) {
                const int h = it & 3, rb = it >> 2, b = rb >> 5;
                att::BlockRef c0;
                c0.Q = qmn + (size_t)rb * 256 * DMA + h * 128; c0.K = kmemn + ((size_t)l * TM + (size_t)b * NMEM) * DMA + h * 128;
                c0.V = kvmem + (size_t)l * 1024 + (size_t)b * NMEM * 2048 + 512 + h * 128; c0.O = om + (size_t)rb * 256 * DMA + h * 128; c0.ssq = nullptr; c0.P0 = 0; c0.nk = NMEM;
                att::Seam<8> S;
                att::attn_prime<0>(c0, sd, (char*)lds_raw, S);
                att::attn_block<0, false, false>(c0, c0, sd, 0.08838834764831845f, (char*)lds_raw, S);
            }
            SEAM(pb + 8);
        }
        if (PH_ON(10) && IN(pb + 9)) {
            WS_PTRS();
            pg8::DenseSched S{(const char*)(rg + R_OM), (const char*)(wb + W_MO), DMA, DMA, T / 256, D / 256, 1, DMA, G, bx};
            pg8::EpiResid<false> E{(bf16*)(ws + WS_XB), STATP(l, ST_X2), nullptr, nullptr};
            pg8::gemm_phase<pg8::EpiResid<false>, pg8::DenseSched, true, false>(lds, DMA, DMA, DMA, S, E, 0);
            SEAM(pb + 9);
        }
        if (PH_ON(11) && IN(pb + 10)) {
            WS_PTRS();
            pg8::DenseSched S{(const char*)(ws + WS_XB), (const char*)(wb + W_R), D, D, T / 256, 1, 1, D, G, bx};
            pg8::EpiRouter E{(float*)(ws + WS_LOGIT)};
            pg8::gemm_phase<pg8::EpiRouter, pg8::DenseSched, true, false>(lds, D, D, D, S, E, 0);
            SEAM(pb + 10);
        }
        if (PH_ON(12) && IN(pb + 11)) {
            WS_PTRS();
            unsigned* cnt = (unsigned*)(ws + WS_CTL) + CW_CNT + l * 64;
            for (int w = bx; w < 256; w += G) route_phase((const float*)(ws + WS_LOGIT), STATP(l, ST_X2), INP(I_BRGRP) + l * 4, INP(I_BREXP) + l * 32, (int*)(ws + WS_MOE), (float*)(ws + WS_MOE + 128 * 1024),
                                                          (int*)(ws + WS_MOE + 384 * 1024), cnt, (LAS int*)lds, w, tid);
            SEAM(pb + 11);
        }
        if (PH_ON(13) && IN(pb + 12)) {
            WS_PTRS();
            unsigned* cnt = (unsigned*)(ws + WS_CTL) + CW_CNT + l * 64;
            for (int w = bx; w < 256; w += G) dispatch_phase(cnt, (const int*)(ws + WS_MOE + 384 * 1024), (const int*)(ws + WS_MOE), (const float*)(ws + WS_MOE + 128 * 1024), STATP(l, ST_X2),
                                                             (int*)(ws + WS_MOE + 256 * 1024), (int*)(ws + WS_MOE + 512 * 1024), (float*)(ws + WS_MOE + 704 * 1024), (float*)(ws + WS_MOE + 896 * 1024), (LAS int*)lds, w, tid);
            SEAM(pb + 12);
        }
        if (PH_ON(14) && IN(pb + 13)) {
            WS_PTRS();
            const int nrt = build_rtab((unsigned*)(ws + WS_CTL) + CW_CNT + l * 64, lc, tid);
            pg8::MoeUpSched S{(const char*)(ws + WS_XB), (const char*)(wb + W_GU), (const int*)(ws + WS_MOE + 512 * 1024), (const LAS int*)(lc + LC_RTAB / 4), nrt, G, bx};
            pg8::EpiSwiglu E{(bf16*)(rg + R_ACT), (const float*)(ws + WS_MOE + 896 * 1024)};
            pg8::gemm_phase<pg8::EpiSwiglu, pg8::MoeUpSched, true, false>(lds, D, D, D, S, E, 0);
            SEAM(pb + 13);
        }
        if (PH_ON(15) && IN(pb + 14)) {
            WS_PTRS();
            const int nrt = build_rtab((unsigned*)(ws + WS_CTL) + CW_CNT + l * 64, lc, tid);
            pg8::MoeDownSched S{(const char*)(rg + R_ACT), (const char*)(wb + W_D), (const LAS int*)(lc + LC_RTAB / 4), nrt, G, bx};
            pg8::EpiBf16<1, false> E{(bf16*)(rg + R_Y), D, (const float*)(ws + WS_MOE + 704 * 1024), 0.f, nullptr, nullptr, 0, 0};
            pg8::gemm_phase<pg8::EpiBf16<1, false>, pg8::MoeDownSched, true, false>(lds, DE, DE, DE, S, E, 0);
            SEAM(pb + 14);
        }
        if (PH_ON(16) && IN(pb + 15)) {
            WS_PTRS();
            const bool more = (l + 1 < DEPTH);
            combine_phase(probe ? (float*)(rg + R_AA) : out_ptr(), (const bf16*)(rg + R_Y), (const int*)(ws + WS_MOE + 256 * 1024), (bf16*)(ws + WS_XB), STATP((l + 1) % DEPTH, ST_X), !more, gw, NGW, lane);
            if (more) { LAS float* scr = (LAS float*)(lds + wave * 16384); convert_layer_weights(p, l + 1, scr, gw, NGW, lane, gtid, NGT); }
            SEAM(pb + 15);
        }
    }
#undef IN
#undef SEAM
}

#ifndef MK_SPLIT
#define MK_SPLIT 0
#endif
extern "C" void kernel_launch(void* const* d_in, const int* in_sizes, int n_in, void* d_out, int out_size, void* d_ws, size_t ws_size, hipStream_t stream) {
    static int grid = 0;
    if (grid == 0) {
        if (n_in != 36 || in_sizes[0] != T * D || out_size != T * D || ws_size < WS_END) {
            fprintf(stderr, "kernel_launch: unexpected shapes (n_in %d, in0 %d, out %d, ws %zu < %zu)\n", n_in, n_in > 0 ? in_sizes[0] : -1, out_size, ws_size, (size_t)WS_END); grid = -1; return; }
        int dev = 0, cus = 0, per_cu = 0;
        if (hipGetDevice(&dev) != hipSuccess || hipDeviceGetAttribute(&cus, hipDeviceAttributeMultiprocessorCount, dev) != hipSuccess) { grid = -1; return; }
        if (hipFuncSetAttribute((const void*)fwd_kernel, hipFuncAttributeMaxDynamicSharedMemorySize, LDS_BYTES) != hipSuccess) { fprintf(stderr, "kernel_launch: hipFuncSetAttribute failed\n"); grid = -1; return; }
        if (hipOccupancyMaxActiveBlocksPerMultiprocessor(&per_cu, (const void*)fwd_kernel, NTHREADS, LDS_BYTES) != hipSuccess || per_cu < 1)
            fprintf(stderr, "kernel_launch: occupancy query reports %d workgroups per CU\n", per_cu);
        (void)hipGetLastError();
        grid = cus;
    }
    if (grid < 0) return;
    if (hipMemsetAsync((char*)d_ws, 0, ZERO_BYTES, stream) != hipSuccess) return;
    Params a{};
    for (int i = 0; i < 36; ++i) a.in[i] = (const float*)d_in[i];
    a.out = (float*)d_out; a.ws = (unsigned char*)d_ws;
#if MK_SPLIT
    for (int ph = 0; ph < NPHASES; ++ph) { a.ph_lo = ph; a.ph_hi = ph + 1; hipLaunchKernelGGL(fwd_kernel, dim3(grid), dim3(NTHREADS), LDS_BYTES, stream, a); }
#else
    a.ph_lo = 0; a.ph_hi = NPHASES;
    hipLaunchKernelGGL(fwd_kernel, dim3(grid), dim3(NTHREADS), LDS_BYTES, stream, a);
#endif
#if defined(PROBE_PHASE)
    a.ph_lo = PROBE_PHASE; a.ph_hi = PROBE_PHASE + 1; a.probe = 1;
    for (int r = 0; r < PROBE_REPS; ++r) hipLaunchKernelGGL(fwd_kernel, dim3(grid), dim3(NTHREADS), LDS_BYTES, stream, a);
#endif
}
```

```cpp
#include <hip/hip_runtime.h>
#include <cstdio>
#include <cstdint>

#define GAS __attribute__((address_space(1)))
#define LAS __attribute__((address_space(3)))
typedef unsigned short bf16;
typedef short bf16x8 __attribute__((ext_vector_type(8)));
typedef short s16x4 __attribute__((ext_vector_type(4)));
typedef float f32x4 __attribute__((ext_vector_type(4)));
typedef float f32x2 __attribute__((ext_vector_type(2)));
typedef float f32x16 __attribute__((ext_vector_type(16)));
typedef unsigned u32x4 __attribute__((ext_vector_type(4)));
typedef unsigned u32x2 __attribute__((ext_vector_type(2)));

constexpr int NBATCH = 2, SEQ = 8192, T = NBATCH * SEQ, D = 2048, DEPTH = 2;
constexpr int NMEM = 256, TM = NBATCH * NMEM;
constexpr int QL = 512, KVL = 256, DRNN = 1024, DATT = 1024;
constexpr int NH = 8, QKH = 192, VH = 128;
constexpr int ZC = 3072;
constexpr int Z_CQ = 0, Z_CKV = 512, Z_XR = 768, Z_GATE = 1792, Z_KPE = 2816;
constexpr int NE = 32, DE = 512, NSLOT = 40960;
constexpr int NQU = NH * QKH;
constexpr int NKV = NH * 256;
constexpr int DMA = 512;
constexpr float EPS = 1e-6f;
constexpr int NWAVES = 8, NTHREADS = 512;

__device__ __forceinline__ unsigned f2bf(float f) { unsigned u = __builtin_bit_cast(unsigned, f); return (u + 0x7fffu + ((u >> 16) & 1u)) >> 16; }
__device__ __forceinline__ unsigned pk2(float lo, float hi) { return f2bf(lo) | (f2bf(hi) << 16); }
__device__ __forceinline__ float bf2f(unsigned short h) { return __builtin_bit_cast(float, (unsigned)h << 16); }
__device__ __forceinline__ float bflo(unsigned w) { return __builtin_bit_cast(float, w << 16); }
__device__ __forceinline__ float bfhi(unsigned w) { return __builtin_bit_cast(float, w & 0xffff0000u); }
__device__ __forceinline__ unsigned cvt_pk_bf16(float lo, float hi) { unsigned r; asm volatile("v_cvt_pk_bf16_f32 %0, %1, %2" : "=v"(r) : "v"(lo), "v"(hi)); return r; }
__device__ __forceinline__ float wave_sum(float v) {
#pragma unroll
    for (int o = 1; o < 64; o <<= 1) v += __shfl_xor(v, o);
    return v;
}
typedef unsigned long long u64;
__device__ __forceinline__ float ssq_val(const u64* p, int row) { return (float)p[row] * (1.0f / 16777216.0f); }
__device__ __forceinline__ void ssq_add(u64* p, int row, float v) { atomicAdd(p + row, (u64)(v * 16777216.0f)); }
__device__ __forceinline__ void ssq_set(u64* p, int row, float v) { p[row] = (u64)(v * 16777216.0f); }
#define LDS_WAIT() asm volatile("s_waitcnt lgkmcnt(0)" ::: "memory")
#define VM_WAIT() asm volatile("s_waitcnt vmcnt(0)" ::: "memory")

#define XB_TMO      128
#define XB_XCNT(j)  (256  + 64 * (j))
#define XB_XSUB(j)  (1280 + 64 * (j))
#define XB_XGEN(j)  (2304 + 64 * (j))
#define XB_TOP      3328
#define XB_TOPGEN   3392
#define XCD_BAR_WORDS 3456
#define XB_SPIN_CAP (1u << 18)
__device__ __forceinline__ unsigned xb_ld(unsigned* p)              { return __hip_atomic_load(p, __ATOMIC_RELAXED, __HIP_MEMORY_SCOPE_AGENT); }
__device__ __forceinline__ unsigned xb_add(unsigned* p, unsigned v) { return __hip_atomic_fetch_add(p, v, __ATOMIC_RELAXED, __HIP_MEMORY_SCOPE_AGENT); }
__device__ __forceinline__ unsigned xb_xcc_id() { return (unsigned)__builtin_amdgcn_s_getreg((3 << 11) | 20) & 0xFu; }
#define XB_SPIN(cond, bar) do { unsigned _sp = 0; while (cond) { __builtin_amdgcn_s_sleep(1); \
    if ((++_sp & 255u) == 0u) { if (xb_ld(&(bar)[XB_TMO])) break; if (_sp > XB_SPIN_CAP) { atomicAdd(&(bar)[XB_TMO], 1u); break; } } } } while (0)
struct XcdBarrier { unsigned* bar; unsigned x; volatile LAS unsigned* st; };
__device__ __forceinline__ XcdBarrier xcd_barrier_post(unsigned* bar, volatile LAS unsigned* st) {
    XcdBarrier b; b.bar = bar; b.x = xb_xcc_id(); b.st = st;
    if (threadIdx.x == 0) (void)xb_add(&bar[XB_XCNT(b.x)], 1u);
    return b;
}
__device__ __forceinline__ void xcd_barrier_complete(unsigned* bar, unsigned x, unsigned& nloc, unsigned& nx) {
    const unsigned G = gridDim.x * gridDim.y * gridDim.z;
    unsigned sum, cnt, mine, sp = 0u;
    for (;;) {
        sum = 0u; cnt = 0u; mine = 0u;
#pragma unroll
        for (unsigned j = 0; j < 16; ++j) { const unsigned c = xb_ld(&bar[XB_XCNT(j)]); sum += c; cnt += (c > 0u) ? 1u : 0u; mine = (j == x) ? c : mine; }
        if (sum == G) break;
        __builtin_amdgcn_s_sleep(1);
        if ((++sp & 255u) == 0u) { if (xb_ld(&bar[XB_TMO])) break; if (sp > XB_SPIN_CAP) { atomicAdd(&bar[XB_TMO], 1u); break; } }
    }
    nloc = mine > 0u ? mine : 1u; nx = cnt > 0u ? cnt : 1u;
}
__device__ __forceinline__ void xcd_barrier(const XcdBarrier& b) {
    asm volatile("s_waitcnt vmcnt(0)" ::: "memory");
    __syncthreads();
    if (threadIdx.x == 0) {
        unsigned* bar = b.bar; unsigned bx_ = b.x; asm volatile("" : "+s"(bar), "+s"(bx_));
        __builtin_amdgcn_s_waitcnt(0);
        unsigned nloc = b.st[0], nx = b.st[1];
        if (nloc == 0u) { xcd_barrier_complete(bar, bx_, nloc, nx); b.st[0] = nloc; b.st[1] = nx; }
        const unsigned old = xb_add(&bar[XB_XSUB(bx_)], 1u);
        const unsigned gen = old / nloc;
        if (old + 1u == (gen + 1u) * nloc) {
            __builtin_amdgcn_fence(__ATOMIC_RELEASE, "agent");
            asm volatile("s_waitcnt vmcnt(0)" ::: "memory");
            const unsigned og = xb_add(&bar[XB_TOP], 1u);
            const unsigned tg = og / nx;
            if (og + 1u == (tg + 1u) * nx) xb_add(&bar[XB_TOPGEN], 1u);
            else XB_SPIN(xb_ld(&bar[XB_TOPGEN]) == tg, bar);
            __builtin_amdgcn_fence(__ATOMIC_ACQUIRE, "agent");
            xb_add(&bar[XB_XGEN(bx_)], 1u);
            asm volatile("s_waitcnt vmcnt(0)" ::: "memory");
        } else {
            XB_SPIN(xb_ld(&bar[XB_XGEN(bx_)]) == gen, bar);
            __builtin_amdgcn_fence(__ATOMIC_ACQUIRE, "agent");
            asm volatile("s_waitcnt vmcnt(0)" ::: "memory");
        }
    }
    __syncthreads();
}

namespace pg8 {
constexpr int BM = 256, BK = 64, HALF = 128, HTB = HALF * BK * 2, STAGE_BYTES = 8 * HTB, NXCD = 8, WGM = 8;
__host__ __device__ __forceinline__ int lds_byte(int r, int c) { const int st = (r >> 4) * 2 + (c >> 5), rr = r & 15, cc = c & 31, ob = rr * 64 + cc * 2; return st * 1024 + (ob ^ (((ob >> 9) & 1) << 5)); }
__host__ __device__ __forceinline__ void stage_rc(int b, int& R, int& C) { const int st = b / 1024, sb = b % 1024, swz = sb ^ (((sb >> 9) & 1) << 5); R = (st >> 1) * 16 + swz / 64; C = (st & 1) * 32 + (swz % 64) / 2; }
__host__ __device__ __forceinline__ int perm32(int rho) { const int n = rho >> 4, i = rho & 15; return 8 * (i >> 2) + 4 * n + (i & 3); }

struct Unit { const char* A; const char* B; int pm, pn, aux; };

__device__ __forceinline__ bool static_tile(int i, int G, int c, int nM, int nN, int& pm, int& pn) {
    const int nwg = nM * nN; const long L = (long)i * G + c; if (L >= nwg) return false;
    int wgid = (int)L; { const int q = nwg / NXCD, r = nwg % NXCD, xcd = wgid % NXCD, off = wgid / NXCD; wgid = (xcd < r ? xcd * (q + 1) : r * (q + 1) + (xcd - r) * q) + off; }
    const int nig = WGM * nN, gid = wgid / nig, fm = gid * WGM, gsz = (nM - fm) < WGM ? (nM - fm) : WGM;
    pm = fm + ((wgid % nig) % gsz); pn = (wgid % nig) / gsz; return true;
}

template <class Epi, class Sched, bool ALIGN_EPI, bool MID>
__device__ __forceinline__ void gemm_phase(LAS unsigned char* lds, const int K, const int lda, const int ldb, const Sched& S, const Epi& E, const int mid_t) {
    constexpr bool GATHER = Sched::GATHER;
    int tid = threadIdx.x; asm volatile("" : "+v"(tid)); const int wid = __builtin_amdgcn_readfirstlane(tid >> 6), lane = tid & 63, wr = wid >> 2, wc = wid & 3, fr = lane & 15, fq = lane >> 4;
    const int nt = K / BK;
    unsigned voffA[2], voffB[2];
#pragma unroll
    for (int i = 0; i < 2; ++i) { int R, C; stage_rc(tid * 16 + i * 8192, R, C); const int Rb = Epi::PERM ? ((R & ~31) + perm32(R & 31)) : R;
        voffA[i] = (unsigned)(R * lda + C) * 2u; voffB[i] = (unsigned)(Rb * ldb + C) * 2u; }
    const size_t kstep = (size_t)(BK * 2);
    const size_t hstepA = GATHER ? (size_t)0 : (size_t)HALF * lda * 2;
    const size_t hstepB = (size_t)HALF * ldb * 2;
    const unsigned ldsw = (unsigned)wid * 1024u;
    const int aoff = lds_byte(wr * 64 + fr, fq * 8), boff = lds_byte(wc * 32 + fr, fq * 8);
#define PG8_SA(b, h) (((b) * 2 + (h)) * HTB)
#define PG8_SB(b, h) ((4 + (b) * 2 + (h)) * HTB)
#define PG8_STAGE(bufoff, gbase, voff) do { _Pragma("unroll") for (int _i = 0; _i < 2; ++_i) \
        __builtin_amdgcn_global_load_lds((const unsigned*)((const char*)(gbase) + (voff)[_i]), (LAS unsigned*)(lds + (bufoff) + ldsw + _i * 8192), 16, 0, 0); } while (0)
#define PG8_LDA(dst, b, h) do { _Pragma("unroll") for (int m = 0; m < 4; ++m) _Pragma("unroll") for (int k = 0; k < 2; ++k) dst[m][k] = *(const LAS bf16x8*)(lds + PG8_SA(b, h) + aoff + m * 2048 + k * 1024); } while (0)
#define PG8_LDB(dst, b, h) do { _Pragma("unroll") for (int n = 0; n < 2; ++n) _Pragma("unroll") for (int k = 0; k < 2; ++k) dst[n][k] = *(const LAS bf16x8*)(lds + PG8_SB(b, h) + boff + n * 2048 + k * 1024); } while (0)
#define PG8_MMA(ai, bj, At, Bt) do { __builtin_amdgcn_s_setprio(1); _Pragma("unroll") for (int m = 0; m < 4; ++m) _Pragma("unroll") for (int n = 0; n < 2; ++n) _Pragma("unroll") for (int k = 0; k < 2; ++k) \
        acc[ai][bj][m][n] = __builtin_amdgcn_mfma_f32_16x16x32_bf16(Bt[n][k], At[m][k], acc[ai][bj][m][n], 0, 0, 0); __builtin_amdgcn_s_setprio(0); } while (0)
#define PG8_WAIT_V(n) asm volatile("s_waitcnt vmcnt(" #n ")" ::: "memory")
#define PG8_WAIT_L(n) asm volatile("s_waitcnt lgkmcnt(" #n ")" ::: "memory")
#define PG8_BAR __builtin_amdgcn_s_barrier()
#define PG8_SCHED __builtin_amdgcn_sched_barrier(0)
    Unit cur, nxt; int ui = 0;
    if (!S.next(0, cur)) return;
    f32x4 acc[2][2][4][2];
#pragma unroll
    for (int a = 0; a < 2; ++a)
#pragma unroll
        for (int b = 0; b < 2; ++b)
#pragma unroll
            for (int m = 0; m < 4; ++m)
#pragma unroll
                for (int n = 0; n < 2; ++n) acc[a][b][m][n] = (f32x4){0.f, 0.f, 0.f, 0.f};
    bf16x8 At[4][2], B0[2][2], B1[2][2];
    unsigned gA0[2], gA1[2], gN0[2], gN1[2];
    if constexpr (GATHER) {
#pragma unroll
        for (int i = 0; i < 2; ++i) { int R, C; stage_rc(tid * 16 + i * 8192, R, C); gA0[i] = S.arow(cur, R) + (unsigned)C * 2u; gA1[i] = S.arow(cur, HALF + R) + (unsigned)C * 2u; gN0[i] = gA0[i]; gN1[i] = gA1[i]; }
    }
#define PG8_STAGE_A(b, h, gbase, G0, G1) do { if constexpr (GATHER) { if ((h) == 0) PG8_STAGE(PG8_SA(b, h), gbase, G0); else PG8_STAGE(PG8_SA(b, h), gbase, G1); } \
        else PG8_STAGE(PG8_SA(b, h), (gbase) + (h) * hstepA, voffA); } while (0)
    const char* cA = cur.A; const char* cB = cur.B;
    PG8_STAGE(PG8_SB(0, 0), cB, voffB); PG8_STAGE(PG8_SB(0, 1), cB + hstepB, voffB); PG8_STAGE_A(0, 0, cA, gA0, gA1); PG8_STAGE_A(0, 1, cA, gA0, gA1);
    if (wr == 1) PG8_BAR;
    PG8_WAIT_V(2); PG8_BAR;
    PG8_STAGE(PG8_SB(1, 0), cB + kstep, voffB); PG8_STAGE_A(1, 0, cA + kstep, gA0, gA1); PG8_STAGE(PG8_SB(1, 1), cB + hstepB + kstep, voffB);
    PG8_WAIT_V(6); PG8_BAR;
    for (;;) {
        const bool has_next = S.next(ui + 1, nxt);
        const char* nA = has_next ? nxt.A : cA; const char* nB = has_next ? nxt.B : cB;
        if constexpr (GATHER) {
            if (has_next) {
#pragma unroll
                for (int i = 0; i < 2; ++i) { int R, C; stage_rc(tid * 16 + i * 8192, R, C); gN0[i] = S.arow(nxt, R) + (unsigned)C * 2u; gN1[i] = S.arow(nxt, HALF + R) + (unsigned)C * 2u; }
            }
        }
#pragma nounroll
        for (int t = 0; t < nt; t += 2) {
            const bool last = (t == nt - 2);
            if constexpr (MID) { if (t == mid_t) E.mid(acc, cur, wr, wc, fr, fq); }
            const char* a1 = cA + (size_t)(t + 1) * kstep;
            const char* a2 = last ? nA : cA + (size_t)(t + 2) * kstep; const char* b2 = last ? nB : cB + (size_t)(t + 2) * kstep;
            const char* a3 = a2 + kstep; const char* b3 = b2 + kstep;
            unsigned w0[2], w1[2];
            if constexpr (GATHER) {
#pragma unroll
                for (int i = 0; i < 2; ++i) { w0[i] = last ? gN0[i] : gA0[i]; w1[i] = last ? gN1[i] : gA1[i]; }
            }
            PG8_LDB(B0, 0, 0); PG8_LDB(B1, 0, 1); PG8_SCHED; PG8_LDA(At, 0, 0); PG8_STAGE_A(1, 1, a1, gA0, gA1);
            PG8_WAIT_V(8); PG8_WAIT_L(0); PG8_BAR; PG8_MMA(0, 0, At, B0); PG8_MMA(0, 1, At, B1); PG8_BAR; PG8_SCHED;
            PG8_LDA(At, 0, 1); PG8_STAGE(PG8_SB(0, 0), b2, voffB); PG8_STAGE(PG8_SB(0, 1), b2 + hstepB, voffB); PG8_STAGE_A(0, 0, a2, w0, w1);
            PG8_WAIT_V(8); PG8_WAIT_L(0); PG8_BAR; PG8_MMA(1, 0, At, B0); PG8_MMA(1, 1, At, B1); PG8_BAR; PG8_SCHED;
            PG8_LDB(B0, 1, 0); PG8_LDB(B1, 1, 1); PG8_SCHED; PG8_LDA(At, 1, 0); PG8_STAGE_A(0, 1, a2, w0, w1);
            PG8_WAIT_V(8); PG8_WAIT_L(0); PG8_BAR; PG8_MMA(0, 0, At, B0); PG8_MMA(0, 1, At, B1); PG8_BAR; PG8_SCHED;
            PG8_LDA(At, 1, 1); PG8_STAGE(PG8_SB(1, 0), b3, voffB); PG8_STAGE(PG8_SB(1, 1), b3 + hstepB, voffB); PG8_STAGE_A(1, 0, a3, w0, w1);
            PG8_WAIT_V(8); PG8_WAIT_L(0); PG8_BAR; PG8_MMA(1, 0, At, B0); PG8_MMA(1, 1, At, B1); PG8_BAR; PG8_SCHED;
        }
        if constexpr (ALIGN_EPI) { if (wr == 0) PG8_BAR; }
        E(acc, cur, wr, wc, fr, fq);
        if (!has_next) break;
#pragma unroll
        for (int a = 0; a < 2; ++a)
#pragma unroll
            for (int b = 0; b < 2; ++b)
#pragma unroll
                for (int m = 0; m < 4; ++m)
#pragma unroll
                    for (int n = 0; n < 2; ++n) acc[a][b][m][n] = (f32x4){0.f, 0.f, 0.f, 0.f};
        cur = nxt; cA = nA; cB = nB; ++ui;
        if constexpr (GATHER) {
#pragma unroll
            for (int i = 0; i < 2; ++i) { gA0[i] = gN0[i]; gA1[i] = gN1[i]; }
        }
        if constexpr (ALIGN_EPI) { if (wr == 1) PG8_BAR; }
    }
    PG8_WAIT_V(0);
    if constexpr (!ALIGN_EPI) { if (wr == 0) PG8_BAR; }
    PG8_BAR;
#undef PG8_SA
#undef PG8_SB
#undef PG8_STAGE
#undef PG8_STAGE_A
#undef PG8_LDA
#undef PG8_LDB
#undef PG8_MMA
#undef PG8_WAIT_V
#undef PG8_WAIT_L
#undef PG8_BAR
#undef PG8_SCHED
}
}
namespace pg8 {
struct DenseSched {
    static constexpr bool GATHER = false;
    const char* A; const char* B; int lda, ldb, nM, nN, nKS, Ksplit, G, c;
    __device__ __forceinline__ bool next(int i, Unit& u) const {
        int pm, pc; if (!static_tile(i, G, c, nM, nN * nKS, pm, pc)) return false;
        const int pn = pc / nKS, ks = pc - pn * nKS;
        u.pm = pm; u.pn = pn; u.aux = ks;
        u.A = A + ((size_t)pm * BM * lda + (size_t)ks * Ksplit) * 2;
        u.B = B + ((size_t)pn * BM * ldb + (size_t)ks * Ksplit) * 2;
        return true;
    }
    __device__ __forceinline__ unsigned arow(const Unit&, int r) const { return (unsigned)(r * lda) * 2u; }
};
struct GateSched {
    static constexpr bool GATHER = false;
    const char* A; const char* B; int G, c;
    __device__ __forceinline__ bool next(int i, Unit& u) const {
        int pm, pn; if (!static_tile(i, G, c, T / BM, 8, pm, pn)) return false;
        u.pm = pm; u.pn = pn; u.aux = 0;
        u.A = A + ((size_t)pm * BM * DRNN + (size_t)(pn >> 1) * 256) * 2;
        u.B = B + (size_t)pn * 256 * 256 * 2;
        return true;
    }
    __device__ __forceinline__ unsigned arow(const Unit&, int r) const { return (unsigned)(r * DRNN) * 2u; }
};
struct MoeUpSched {      static constexpr bool GATHER = true;
    const char* A; const char* B; const int* slot_tok; const LAS int* rtab; int nrt, G, c;
    __device__ __forceinline__ bool next(int i, Unit& u) const {
        const long L = (long)i * G + c; if (L >= (long)nrt * 4) return false;
        const int rt = (int)(L >> 2), pn = (int)(L & 3); const int e = rtab[2 * rt], row0 = rtab[2 * rt + 1];
        u.pm = row0 >> 8; u.pn = pn; u.aux = e; u.A = A;
        u.B = B + ((size_t)e * 1024 * D + (size_t)pn * BM * D) * 2;
        return true;
    }
    __device__ __forceinline__ unsigned arow(const Unit& u, int r) const { return (unsigned)slot_tok[u.pm * BM + r] * (unsigned)(D * 2); }
};
struct MoeDownSched {    static constexpr bool GATHER = false;
    const char* A; const char* B; const LAS int* rtab; int nrt, G, c;
    __device__ __forceinline__ bool next(int i, Unit& u) const {
        const long L = (long)i * G + c; if (L >= (long)nrt * 8) return false;
        const int rt = (int)(L >> 3), pn = (int)(L & 7); const int e = rtab[2 * rt], row0 = rtab[2 * rt + 1];
        u.pm = row0 >> 8; u.pn = pn; u.aux = e;
        u.A = A + (size_t)row0 * DE * 2;
        u.B = B + ((size_t)e * D * DE + (size_t)pn * BM * DE) * 2;
        return true;
    }
    __device__ __forceinline__ unsigned arow(const Unit&, int r) const { return (unsigned)(r * DE) * 2u; }
};

__device__ __forceinline__ void unpack8x(u32x4 w, float* v) { v[0] = bflo(w.x); v[1] = bfhi(w.x); v[2] = bflo(w.y); v[3] = bfhi(w.y); v[4] = bflo(w.z); v[5] = bfhi(w.z); v[6] = bflo(w.w); v[7] = bfhi(w.w); }
__device__ __forceinline__ void epi_ids(int& wr, int& wc, int& fr, int& fq) { int t = threadIdx.x; asm volatile("" : "+v"(t)); const int wid = t >> 6, lane = t & 63; wr = wid >> 2; wc = wid & 3; fr = lane & 15; fq = lane >> 4; }
template <int MODE, bool STAT> struct EpiBf16 {
    static constexpr bool PERM = true;
    bf16* O; int ldc; const void* rs; float inv_n; u64* stat_a; u64* stat_b; int stat_pn_a, stat_pn_b;
    __device__ __forceinline__ void operator()(const f32x4 (&acc)[2][2][4][2], const Unit& u, int, int, int, int) const {
        int wr, wc, fr, fq; epi_ids(wr, wc, fr, fq);
        int row0 = u.pm * BM + wr * 64 + fr; asm volatile("" : "+v"(row0)); const int col0 = u.pn * BM + wc * 32 + 8 * fq;
        u64* st = nullptr; if (STAT) st = (u.pn < stat_pn_a) ? stat_a : ((u.pn < stat_pn_b) ? stat_b : nullptr);
#pragma unroll
        for (int ai = 0; ai < 2; ++ai)
#pragma unroll
            for (int m = 0; m < 4; ++m) { const int row = row0 + ai * HALF + m * 16;
                float sc = 1.f;
                if (MODE == 0) sc = 1.0f / sqrtf(ssq_val((const u64*)rs, row) * inv_n + EPS); else if (MODE == 1) sc = ((const float*)rs)[row];
                bf16* rowp = O + (size_t)row * ldc + col0; float ss = 0.f;
#pragma unroll
                for (int bj = 0; bj < 2; ++bj) { const f32x4 v0 = acc[ai][bj][m][0] * sc, v1 = acc[ai][bj][m][1] * sc;
                    if (STAT) ss += (v0[0] * v0[0] + v0[1] * v0[1]) + (v0[2] * v0[2] + v0[3] * v0[3]) + (v1[0] * v1[0] + v1[1] * v1[1]) + (v1[2] * v1[2] + v1[3] * v1[3]);
                    u32x4 w; w.x = cvt_pk_bf16(v0[0], v0[1]); w.y = cvt_pk_bf16(v0[2], v0[3]); w.z = cvt_pk_bf16(v1[0], v1[1]); w.w = cvt_pk_bf16(v1[2], v1[3]);
                    *(u32x4*)(rowp + bj * HALF) = w; }
                if (STAT) { ss += __shfl_xor(ss, 16); ss += __shfl_xor(ss, 32); if (st != nullptr && fq == 0) ssq_add(st, row, ss); }
            }
    }
};
struct EpiF32Slab {
    static constexpr bool PERM = false;
    float* O; int ldc; size_t slab; const u64* rs; float inv_n;
    __device__ __forceinline__ void operator()(const f32x4 (&acc)[2][2][4][2], const Unit& u, int, int, int, int) const {
        int wr, wc, fr, fq; epi_ids(wr, wc, fr, fq);
        int row0 = u.pm * BM + wr * 64 + fr; asm volatile("" : "+v"(row0)); const int col0 = u.pn * BM + wc * 32 + 4 * fq; float* base = O + (size_t)u.aux * slab;
#pragma unroll
        for (int ai = 0; ai < 2; ++ai)
#pragma unroll
            for (int m = 0; m < 4; ++m) { const int row = row0 + ai * HALF + m * 16; const float sc = 1.0f / sqrtf(ssq_val(rs, row) * inv_n + EPS);
                float* rowp = base + (size_t)row * ldc + col0;
#pragma unroll
                for (int bj = 0; bj < 2; ++bj)
#pragma unroll
                    for (int n = 0; n < 2; ++n) *(f32x4*)(rowp + bj * HALF + n * 16) = acc[ai][bj][m][n] * sc; }
    }
};
template <bool SCALE> struct EpiResid {
    static constexpr bool PERM = true;
    bf16* xb; u64* stat; const u64* ssq_a; const u64* ssq_b;
    __device__ __forceinline__ void mid(f32x4 (&acc)[2][2][4][2], const Unit& u, int, int, int, int) const {
        int wr, wc, fr, fq; epi_ids(wr, wc, fr, fq);
        int row0 = u.pm * BM + wr * 64 + fr; asm volatile("" : "+v"(row0));
#pragma unroll
        for (int ai = 0; ai < 2; ++ai)
#pragma unroll
            for (int m = 0; m < 4; ++m) { const int row = row0 + ai * HALF + m * 16;
                const float ra = 1.0f / sqrtf(ssq_val(ssq_a, row) * (1.0f / 1024.0f) + EPS), rb = 1.0f / sqrtf(ssq_val(ssq_b, row) * (1.0f / 1024.0f) + EPS); const float f = ra / rb;
#pragma unroll
                for (int bj = 0; bj < 2; ++bj)
#pragma unroll
                    for (int n = 0; n < 2; ++n) acc[ai][bj][m][n] = acc[ai][bj][m][n] * f; }
    }
    __device__ __forceinline__ void operator()(const f32x4 (&acc)[2][2][4][2], const Unit& u, int, int, int, int) const {
        int wr, wc, fr, fq; epi_ids(wr, wc, fr, fq);
        int row0 = u.pm * BM + wr * 64 + fr; asm volatile("" : "+v"(row0)); const int col0 = u.pn * BM + wc * 32 + 8 * fq;
        GAS bf16* xg = (GAS bf16*)xb;
#pragma unroll
        for (int ai = 0; ai < 2; ++ai)
#pragma unroll
            for (int m = 0; m < 4; ++m) { const int row = row0 + ai * HALF + m * 16;
                float sc = 1.f; if (SCALE) sc = 1.0f / sqrtf(ssq_val(ssq_b, row) * (1.0f / 1024.0f) + EPS);
                const unsigned off = (unsigned)row * (unsigned)D + (unsigned)col0; float ss = 0.f;
#pragma unroll
                for (int bj = 0; bj < 2; ++bj) { float xv[8], v[8]; unpack8x(*(const GAS u32x4*)(xg + off + bj * HALF), xv);
#pragma unroll
                    for (int n = 0; n < 2; ++n)
#pragma unroll
                        for (int j = 0; j < 4; ++j) { v[n * 4 + j] = xv[n * 4 + j] + acc[ai][bj][m][n][j] * sc; ss += v[n * 4 + j] * v[n * 4 + j]; }
                    u32x4 w; w.x = cvt_pk_bf16(v[0], v[1]); w.y = cvt_pk_bf16(v[2], v[3]); w.z = cvt_pk_bf16(v[4], v[5]); w.w = cvt_pk_bf16(v[6], v[7]);
                    *(GAS u32x4*)(xg + off + bj * HALF) = w; }
                ss += __shfl_xor(ss, 16); ss += __shfl_xor(ss, 32); if (fq == 0) ssq_add(stat, row, ss);
                asm volatile("" ::: "memory"); __builtin_amdgcn_sched_barrier(0);
            }
    }
};
struct EpiGates {
    static constexpr bool PERM = false;
    const bf16* xc; const float* b_rg; const float* b_ig; const float* sp; float* a_out; float* u_out;
    __device__ __forceinline__ void operator()(const f32x4 (&acc)[2][2][4][2], const Unit& u, int, int, int, int) const {
        int wr, wc, fr, fq; epi_ids(wr, wc, fr, fq);
        const unsigned row0 = (unsigned)(u.pm * BM + wr * 64 + fr);
        const GAS bf16* xg = (const GAS bf16*)xc; GAS float* ag = (GAS float*)a_out; GAS float* ug = (GAS float*)u_out;
#pragma unroll
        for (int n = 0; n < 2; ++n) { const unsigned ch = (unsigned)(u.pn * 128 + wc * 32 + n * 16 + 4 * fq);
            const f32x4 br = *(const GAS f32x4*)((const GAS float*)b_rg + ch), bi = *(const GAS f32x4*)((const GAS float*)b_ig + ch), s4 = *(const GAS f32x4*)((const GAS float*)sp + ch);
#pragma unroll
            for (int ai = 0; ai < 2; ++ai)
#pragma unroll
                for (int m = 0; m < 4; ++m) { const unsigned off = (row0 + (unsigned)(ai * HALF + m * 16)) * (unsigned)DRNN + ch;
                    const u32x2 xw = *(const GAS u32x2*)(xg + off); const float xv[4] = {bflo(xw.x), bfhi(xw.x), bflo(xw.y), bfhi(xw.y)};
                    const f32x4 pr = acc[ai][0][m][n] + br, pi = acc[ai][1][m][n] + bi; f32x4 av, uv;
#pragma unroll
                    for (int j = 0; j < 4; ++j) { const float r = __builtin_amdgcn_rcpf(1.0f + __expf(-pr[j])), ig = __builtin_amdgcn_rcpf(1.0f + __expf(-pi[j]));
                        const float la = -8.0f * r * s4[j]; const float a = __expf(la); const float x2 = 2.0f * la;
                        const float om = (x2 > -0.03125f) ? -x2 * (1.0f + x2 * (0.5f + x2 * (0.16666667f + x2 * 0.041666668f))) : 1.0f - a * a;
                        av[j] = a; uv[j] = __builtin_amdgcn_sqrtf(om) * (ig * xv[j]); }
                    *(GAS f32x4*)(ag + off) = av; *(GAS f32x4*)(ug + off) = uv; asm volatile("" ::: "memory"); __builtin_amdgcn_sched_barrier(0); }
        }
    }
};
struct EpiSwiglu {
    static constexpr bool PERM = true;
    bf16* O; const float* rs;
    __device__ __forceinline__ void operator()(const f32x4 (&acc)[2][2][4][2], const Unit& u, int, int, int, int) const {
        int wr, wc, fr, fq; epi_ids(wr, wc, fr, fq);
        int row0 = u.pm * BM + wr * 64 + fr; asm volatile("" : "+v"(row0)); const int col0 = u.pn * 128 + wc * 32 + 8 * fq;
#pragma unroll
        for (int ai = 0; ai < 2; ++ai)
#pragma unroll
            for (int m = 0; m < 4; ++m) { const int row = row0 + ai * HALF + m * 16; const float sc = rs[row]; float h[8];
#pragma unroll
                for (int n = 0; n < 2; ++n)
#pragma unroll
                    for (int j = 0; j < 4; ++j) { const float g = acc[ai][0][m][n][j] * sc, up = acc[ai][1][m][n][j] * sc; h[n * 4 + j] = g / (1.0f + __expf(-g)) * up; }
                u32x4 w; w.x = cvt_pk_bf16(h[0], h[1]); w.y = cvt_pk_bf16(h[2], h[3]); w.z = cvt_pk_bf16(h[4], h[5]); w.w = cvt_pk_bf16(h[6], h[7]);
                *(u32x4*)(O + (size_t)row * DE + col0) = w; }
    }
};
struct EpiRouter {
    static constexpr bool PERM = false;
    float* O;
    __device__ __forceinline__ void operator()(const f32x4 (&acc)[2][2][4][2], const Unit& u, int, int, int, int) const {
        int wr, wc, fr, fq; epi_ids(wr, wc, fr, fq);
        if (wc >= 2) return;
        int row0 = u.pm * BM + wr * 64 + fr; asm volatile("" : "+v"(row0)); const int col0 = wc * 32 + 4 * fq;
#pragma unroll
        for (int ai = 0; ai < 2; ++ai)
#pragma unroll
            for (int m = 0; m < 4; ++m) { const int row = row0 + ai * HALF + m * 16;
#pragma unroll
                for (int n = 0; n < 2; ++n) *(f32x4*)(O + (size_t)row * 64 + col0 + n * 16) = acc[ai][0][m][n]; }
    }
};
}
namespace att {
constexpr int NW = 8, QBLK = 32, KVBLK = 64, QB = NW * QBLK;
constexpr int SHM_V = KVBLK * 128 * 2, SHM_K = KVBLK * 128 * 2, SHM_R = KVBLK * 64 * 2;
constexpr int OFF_V = 0, OFF_K = 2 * SHM_V, OFF_R = OFF_K + 2 * SHM_K, OFF_WS = OFF_R + 2 * SHM_R, OFF_QR = OFF_WS + NW * 64 * 4, LDS_BYTES = OFF_QR + NW * 4 * 1024;
constexpr float THR = 8.f;

#define KSWZ(row, colB) ((row) * 256 + ((colB) ^ (((row) & 7) << 4)))
#define RSWZ(row, ch) ((row) * 128 + ((((ch) ^ (((row) >> 1) & 7))) << 4))
#define SBAR() __builtin_amdgcn_sched_barrier(0)
__device__ __forceinline__ int v_st(int k, int c) { const int kk = (k & ~0xC) | ((k & 4) << 1) | ((k & 8) >> 1); return ((kk >> 3) * 4 + (c >> 5)) * 512 + ((kk & 7) * 32 + (c & 31)) * 2; }
__device__ __forceinline__ int v_rd_base(int lane) { return ((lane & 3) << 3) | (((lane >> 2) & 3) << 6) | (((lane >> 4) & 1) << 5) | (((lane >> 5) & 1) << 8); }
constexpr int v_rd_off(int d0, int ks, int half) { return d0 * 512 + ks * 4096 + half * 2048; }
__device__ __forceinline__ int crow(int r, int hi) { return (r & 3) + 8 * (r >> 2) + 4 * hi; }
__device__ __forceinline__ unsigned cvtpk(float lo, float hi) { unsigned r; asm volatile("v_cvt_pk_bf16_f32 %0, %1, %2" : "=v"(r) : "v"(lo), "v"(hi)); return r; }
__device__ __forceinline__ bf16x8 load8(const bf16* p) { return *reinterpret_cast<const bf16x8*>(p); }

__device__ __forceinline__ void mask_tile(f32x16& p0, f32x16& p1, int dq) {
    const float NEG = -__builtin_inff();
#pragma unroll
    for (int r = 0; r < 16; ++r) {
        const int c = (r & 3) + 8 * (r >> 2);
        if (dq - c < 0) p0[r] = NEG;
        if (dq - c - 32 < 0) p1[r] = NEG;
    }
}
__device__ __forceinline__ void partialSM(f32x16& p0, f32x16& p1, float& m_reg, float& mn, float& alpha, const float SCALE) {
    float pmax = p0[0]; for (int r = 1; r < 16; ++r) pmax = fmaxf(pmax, p0[r]); for (int r = 0; r < 16; ++r) pmax = fmaxf(pmax, p1[r]);
    { auto rr = __builtin_amdgcn_permlane32_swap(__float_as_uint(pmax), __float_as_uint(pmax), false, false);
      pmax = fmaxf(__uint_as_float(rr[0]), __uint_as_float(rr[1])); }
    const float C2 = 1.4426950408889634f * SCALE;
    if (__builtin_expect(__all((pmax - m_reg) * SCALE <= THR), 1)) { mn = m_reg; alpha = 1.f; }
    else { mn = fmaxf(m_reg, pmax); alpha = __builtin_amdgcn_exp2f((m_reg - mn) * C2); m_reg = mn; }
    const float mnL = -mn * C2;
    for (int r = 0; r < 16; ++r) p0[r] = fmaf(p0[r], C2, mnL); for (int r = 0; r < 16; ++r) p1[r] = fmaf(p1[r], C2, mnL);
    for (int r = 0; r < 16; ++r) p0[r] = __builtin_amdgcn_exp2f(p0[r]);
}
__device__ __forceinline__ void finishSM(f32x16& p0, f32x16& p1, float alpha, float& l_reg, bf16x8& pa0, bf16x8& pa1, bf16x8& pa2, bf16x8& pa3) {
    for (int r = 0; r < 16; ++r) p1[r] = __builtin_amdgcn_exp2f(p1[r]);
    float ps = 0; for (int r = 0; r < 16; ++r) ps += p0[r]; for (int r = 0; r < 16; ++r) ps += p1[r];
    { auto rr = __builtin_amdgcn_permlane32_swap(__float_as_uint(ps), __float_as_uint(ps), false, false);
      ps = __uint_as_float(rr[0]) + __uint_as_float(rr[1]); }
    l_reg = l_reg * alpha + ps;
#define PK4(P, B_, OUT) do { unsigned a0 = cvtpk(P[B_+0], P[B_+1]), a1 = cvtpk(P[B_+2], P[B_+3]);                          \
        unsigned b0 = cvtpk(P[B_+4], P[B_+5]), b1 = cvtpk(P[B_+6], P[B_+7]);                                             \
        auto r0 = __builtin_amdgcn_permlane32_swap(a0, b0, false, false); auto r1 = __builtin_amdgcn_permlane32_swap(a1, b1, false, false); \
        u32x4 w = {r0[0], r1[0], r0[1], r1[1]}; OUT = *reinterpret_cast<bf16x8*>(&w); } while (0)
    PK4(p0, 0, pa0); PK4(p0, 8, pa1); PK4(p1, 0, pa2); PK4(p1, 8, pa3);
#undef PK4
}
template <int KB, int ROPE>
__device__ __forceinline__ void qkt(f32x16& p0, f32x16& p1, const char* lds, int r32_, int hi_, const bf16x8* qr, const char* qrl) {
    p0 = f32x16{}; p1 = f32x16{};
    int lane_ = r32_ | (hi_ << 5); asm volatile("" : "+v"(lane_)); const int r32 = lane_ & 31, hi = lane_ >> 5;
    const char* kb[4];
#pragma unroll
    for (int dd = 0; dd < 4; ++dd) kb[dd] = lds + OFF_K + KB * SHM_K + KSWZ(r32, (dd * 16 + hi * 8) * 2);
#pragma unroll
    for (int d0 = 0; d0 < 8; ++d0) { const char* a = kb[d0 & 3] + (d0 >> 2) * 128;
        bf16x8 b0 = *reinterpret_cast<const bf16x8*>(a);
        bf16x8 b1 = *reinterpret_cast<const bf16x8*>(a + 32 * 256);
        p0 = __builtin_amdgcn_mfma_f32_32x32x16_bf16(b0, qr[d0], p0, 0, 0, 0);
        p1 = __builtin_amdgcn_mfma_f32_32x32x16_bf16(b1, qr[d0], p1, 0, 0, 0); }
    if constexpr (ROPE > 0) {
#pragma unroll
        for (int d0 = 0; d0 < 4; ++d0) { const char* a = lds + OFF_R + KB * SHM_R + RSWZ(r32, d0 * 2 + hi);
            bf16x8 b0 = *reinterpret_cast<const bf16x8*>(a);
            bf16x8 b1 = *reinterpret_cast<const bf16x8*>(a + 32 * 128);
            const bf16x8 qf = *reinterpret_cast<const bf16x8*>(qrl + d0 * 1024);
            p0 = __builtin_amdgcn_mfma_f32_32x32x16_bf16(b0, qf, p0, 0, 0, 0);
            p1 = __builtin_amdgcn_mfma_f32_32x32x16_bf16(b1, qf, p1, 0, 0, 0); }
    }
}
template <int VB>
__device__ __forceinline__ void pv_tile(f32x16* o, int vb0, bf16x8 pa0, bf16x8 pa1, bf16x8 pa2, bf16x8 pa3) {
#define TRRD(dst, off) asm volatile("ds_read_b64_tr_b16 %0, %1 offset:%2" : "=&v"(dst) : "v"(vb0), "i"(off) : "memory")
#define PV_D0(d0) do { s16x4 l0, l1, l2, l3, h0, h1, h2, h3; constexpr int b_ = OFF_V + VB * SHM_V + v_rd_off(d0, 0, 0); \
        TRRD(l0, b_); TRRD(h0, b_ + 2048); TRRD(l1, b_ + 4096); TRRD(h1, b_ + 6144); TRRD(l2, b_ + 8192); TRRD(h2, b_ + 10240); TRRD(l3, b_ + 12288); TRRD(h3, b_ + 14336); \
        asm volatile("s_waitcnt lgkmcnt(0)" ::: "memory"); SBAR();   \
        o[d0] = __builtin_amdgcn_mfma_f32_32x32x16_bf16(pa0, (bf16x8){l0[0], l0[1], l0[2], l0[3], h0[0], h0[1], h0[2], h0[3]}, o[d0], 0, 0, 0);   \
        o[d0] = __builtin_amdgcn_mfma_f32_32x32x16_bf16(pa1, (bf16x8){l1[0], l1[1], l1[2], l1[3], h1[0], h1[1], h1[2], h1[3]}, o[d0], 0, 0, 0);   \
        o[d0] = __builtin_amdgcn_mfma_f32_32x32x16_bf16(pa2, (bf16x8){l2[0], l2[1], l2[2], l2[3], h2[0], h2[1], h2[2], h2[3]}, o[d0], 0, 0, 0);   \
        o[d0] = __builtin_amdgcn_mfma_f32_32x32x16_bf16(pa3, (bf16x8){l3[0], l3[1], l3[2], l3[3], h3[0], h3[1], h3[2], h3[3]}, o[d0], 0, 0, 0); } while (0)
    PV_D0(0); PV_D0(1); PV_D0(2); PV_D0(3);
#undef PV_D0
#undef TRRD
}

template <int LDQ, int LDK, int LDV, int LDO> struct Strides { static constexpr int ldq = LDQ, ldk = LDK, ldv = LDV, ldo = LDO; };
struct BlockRef { const bf16* Q; const bf16* K; const bf16* V; bf16* O; u64* ssq; int P0; int nk; };
template <int NQ> struct Seam { bf16x8 qr[8]; bf16x8 st_v0, st_v1, st_k0, st_k1, st_r; };

#define VMW() asm volatile("s_waitcnt vmcnt(0)" ::: "memory")
#define VMWN(n) asm volatile("s_waitcnt vmcnt(%0)" :: "i"(n) : "memory")
__device__ __forceinline__ int optid() { int t = threadIdx.x; asm volatile("" : "+v"(t)); return t; }
#define SLOAD_H(Kp, Vp, k0) do { const int t_ = optid(); const unsigned sr_ = t_ >> 4, sc_ = (t_ & 15) * 8, rr_ = t_ >> 3, rc_ = (t_ & 7) * 8;   \
                                 const bf16* kt_ = (Kp) + (size_t)(k0) * st.ldk; const bf16* vt_ = (Vp) + (size_t)(k0) * st.ldv;                    \
                                 S.st_v0 = load8(vt_ + (sr_ * st.ldv + sc_)); S.st_v1 = load8(vt_ + ((32 + sr_) * st.ldv + sc_));                   \
                                 S.st_k0 = load8(kt_ + (sr_ * st.ldk + sc_)); S.st_k1 = load8(kt_ + ((32 + sr_) * st.ldk + sc_));                   \
                                 if constexpr (ROPE > 0) S.st_r = load8(kt_ + (rr_ * st.ldk + 128 + rc_)); } while (0)
#define SWRITE_HK(bf) do { const int t_ = optid(); const int kws_ = KSWZ(t_ >> 4, (t_ & 15) * 16);                                                  \
                           *(bf16x8*)(lds + OFF_K + (bf) * SHM_K + kws_) = S.st_k0; *(bf16x8*)(lds + OFF_K + (bf) * SHM_K + kws_ + 32 * 256) = S.st_k1;   \
                           if constexpr (ROPE > 0) *(bf16x8*)(lds + OFF_R + (bf) * SHM_R + RSWZ(t_ >> 3, t_ & 7)) = S.st_r; } while (0)
#define SWRITE_HV(bf) do { const int t_ = optid(); const int sr_ = t_ >> 4, sc_ = (t_ & 15) * 8;                                                     \
                           *(bf16x8*)(lds + OFF_V + (bf) * SHM_V + v_st(sr_, sc_)) = S.st_v0; *(bf16x8*)(lds + OFF_V + (bf) * SHM_V + v_st(32 + sr_, sc_)) = S.st_v1; } while (0)
#define SWRITE_H(bf) do { SWRITE_HV(bf); SWRITE_HK(bf); } while (0)

template <int ROPE, class ST>
__device__ __forceinline__ void attn_prime(const BlockRef& cur, const ST& st, char* lds, Seam<8 + ROPE / 16>& S) {
    constexpr int NQ = 8 + ROPE / 16;
    int tid = threadIdx.x; asm volatile("" : "+v"(tid)); const int wid = __builtin_amdgcn_readfirstlane(tid >> 6), lane = tid & 63, r32 = lane & 31, hi = lane >> 5;
#pragma unroll
    for (int d0 = 0; d0 < 8; ++d0) S.qr[d0] = load8(cur.Q + (size_t)(wid * QBLK + r32) * st.ldq + d0 * 16 + hi * 8);
    if constexpr (ROPE > 0) {
#pragma unroll
        for (int d0 = 0; d0 < 4; ++d0) *(bf16x8*)(lds + OFF_QR + wid * 4096 + d0 * 1024 + lane * 16) = load8(cur.Q + (size_t)(wid * QBLK + r32) * st.ldq + 128 + d0 * 16 + hi * 8);
    }
    SLOAD_H(cur.K, cur.V, 0); VMW(); SWRITE_HK(0);
    __syncthreads();
}
template <int ROPE, bool CAUSAL, bool STAT, class ST>
__device__ __forceinline__ void attn_block(const BlockRef& cur, const BlockRef& nxt, const ST& st, const float SCALE, char* lds, Seam<8 + ROPE / 16>& S) {
    constexpr int NQ = 8 + ROPE / 16;
    int tid = threadIdx.x; asm volatile("" : "+v"(tid)); const int wid = __builtin_amdgcn_readfirstlane(tid >> 6), lane = tid & 63, r32 = lane & 31, hi = lane >> 5;
    const int NT = CAUSAL ? ((cur.P0 + QB - 1) / KVBLK + 1) : (cur.nk / KVBLK);
    const int qlo = cur.P0 + wid * QBLK, qm = qlo + r32 - 4 * hi;
    float* ws = (float*)(lds + OFF_WS) + wid * 64; float* li_l = ws, * al_l = ws + 32;
    float m_reg = -1e30f, l_reg = 0; f32x16 o[4] = {};
    const int vb0 = (int)(uintptr_t)lds + v_rd_base(lane);
    const bf16* Kh = cur.K; const bf16* Vh = cur.V;
    const char* qrl = lds + OFF_QR + wid * 4096 + lane * 16;
#define RESC(a) do { if (__any((a) < 1.f)) { if (hi == 0) al_l[r32] = (a); asm volatile("s_waitcnt lgkmcnt(0)" ::: "memory");              \
                     for (int d_ = 0; d_ < 4; ++d_) for (int r = 0; r < 16; ++r) o[d_][r] *= al_l[crow(r, hi)]; } } while (0)
#define KBASE(t) ((t) * KVBLK)
#define MASKT(P0_, P1_, t) do { if (CAUSAL) { const int kb_ = KBASE(t); if (kb_ + KVBLK - 1 > qlo) mask_tile(P0_, P1_, qm - kb_); } } while (0)
#define SEAM_K0() do { VMWN(8); SWRITE_HK(0); SBAR(); } while (0)
    f32x16 pA0, pA1, pB0, pB1; float mnA, mnB, alA, alB; bf16x8 pa0, pa1, pa2, pa3;
    SWRITE_HV(0); SBAR();
    if (NT > 1) { SLOAD_H(Kh, Vh, KBASE(1)); }
    SBAR(); qkt<0, ROPE>(pA0, pA1, lds, r32, hi, S.qr, qrl);
    MASKT(pA0, pA1, 0); partialSM(pA0, pA1, m_reg, mnA, alA, SCALE);
    if (NT > 1) { VMW(); SWRITE_H(1); }
    __syncthreads();
#define HALF_STEP(PX0, PX1, mnX, alX, PY0, PY1, alY, t, KB, VB, SB) do {                                                      \
        SBAR(); qkt<KB, ROPE>(PX0, PX1, lds, r32, hi, S.qr, qrl);                                                                  \
        finishSM(PY0, PY1, alY, l_reg, pa0, pa1, pa2, pa3); SBAR();                                                           \
        if ((t) + 1 < NT) { SLOAD_H(Kh, Vh, KBASE((t) + 1)); SBAR(); }                                                        \
        pv_tile<VB>(o, vb0, pa0, pa1, pa2, pa3); MASKT(PX0, PX1, (t)); partialSM(PX0, PX1, m_reg, mnX, alX, SCALE);           \
        __syncthreads();                                                                                                      \
        if ((t) + 1 < NT) { VMW(); SWRITE_H(SB); }                                                                            \
        RESC(alX); __syncthreads(); } while (0)
    for (int t = 1; t + 1 < NT; t += 2) {
        HALF_STEP(pB0, pB1, mnB, alB, pA0, pA1, alA, t, 1, 0, 0);
        HALF_STEP(pA0, pA1, mnA, alA, pB0, pB1, alB, t + 1, 0, 1, 1);
    }
    const bool even = (NT & 1) == 0;
    if (even) { SBAR(); qkt<1, ROPE>(pB0, pB1, lds, r32, hi, S.qr, qrl); SBAR(); }
    SLOAD_H(nxt.K, nxt.V, 0); SBAR();
#pragma unroll
    for (int d0 = 0; d0 < 8; ++d0) S.qr[d0] = load8(nxt.Q + (size_t)(wid * QBLK + r32) * st.ldq + d0 * 16 + hi * 8);
    SBAR();
    finishSM(pA0, pA1, alA, l_reg, pa0, pa1, pa2, pa3); SBAR();
    pv_tile<0>(o, vb0, pa0, pa1, pa2, pa3);
    if (even) { MASKT(pB0, pB1, NT - 1); partialSM(pB0, pB1, m_reg, mnB, alB, SCALE); __syncthreads(); RESC(alB);
        finishSM(pB0, pB1, alB, l_reg, pa0, pa1, pa2, pa3); SBAR(); pv_tile<1>(o, vb0, pa0, pa1, pa2, pa3); }
    SBAR(); SEAM_K0();
    if (hi == 0) li_l[r32] = l_reg; asm volatile("s_waitcnt lgkmcnt(0)" ::: "memory");
    float rli[16];
#pragma unroll
    for (int r = 0; r < 16; ++r) rli[r] = __builtin_amdgcn_rcpf(li_l[crow(r, hi)]);
    bf16* Ow = cur.O + (size_t)(wid * QBLK) * st.ldo;
#pragma unroll
    for (int r = 0; r < 16; ++r) { const int orow = crow(r, hi); float ss = 0.f;
#pragma unroll
        for (int d0 = 0; d0 < 4; ++d0) { const float v = o[d0][r] * rli[r]; ss += v * v;
            const float vn = __shfl_xor(v, 1);
            if ((r32 & 1) == 0) *(unsigned*)(Ow + (size_t)orow * st.ldo + d0 * 32 + r32) = cvtpk(v, vn); }
        if (STAT) { ss += __shfl_xor(ss, 1); ss += __shfl_xor(ss, 2); ss += __shfl_xor(ss, 4); ss += __shfl_xor(ss, 8); ss += __shfl_xor(ss, 16);
            if (r32 == 0) ssq_add(cur.ssq, wid * QBLK + orow, ss); } }
    if constexpr (ROPE > 0) {
#pragma unroll
        for (int d0 = 0; d0 < 4; ++d0) *(bf16x8*)(lds + OFF_QR + wid * 4096 + d0 * 1024 + lane * 16) = load8(nxt.Q + (size_t)(wid * QBLK + r32) * st.ldq + 128 + d0 * 16 + hi * 8);
    }
    __syncthreads();
#undef RESC
#undef KBASE
#undef MASKT
#undef SEAM_K0
#undef HALF_STEP
}
#undef VMW
#undef VMWN
#undef SLOAD_H
#undef SWRITE_HK
#undef SWRITE_HV
#undef SWRITE_H
}
constexpr size_t MiB = 1u << 20;
constexpr size_t WS_CTL = 0, WS_STAT = 1 * MiB, ZERO_BYTES = 3 * MiB;
constexpr size_t WS_TAB = 3 * MiB;
constexpr size_t WS_MEMB = 6 * MiB, WS_KVMEM = 8 * MiB, WS_KMEMN = 10 * MiB, WS_WMKV = 11 * MiB;
constexpr size_t WS_LOGIT = 20 * MiB, WS_MOE = 24 * MiB, WS_SCAN = 26 * MiB;
constexpr size_t WS_W = 28 * MiB;
constexpr size_t W_IN = 0, W_UQ = 12 * MiB, W_UKV = W_UQ + 3 * MiB / 2, W_G = W_UKV + MiB, W_OUT = W_G + MiB, W_MQ = W_OUT + 8 * MiB, W_MO = W_MQ + 2 * MiB, W_R = W_MO + 2 * MiB,
                 W_GU = W_R + MiB, W_D = W_GU + 128 * MiB, W_END = W_D + 64 * MiB;
constexpr size_t WS_XB = 250 * MiB, WS_R = 314 * MiB;
static_assert(WS_W + W_END <= WS_XB, "weights");
constexpr size_t R_Z = 0, R_Q = 96 * MiB, R_KVR = 144 * MiB, R_KK = 208 * MiB, R_XC = 256 * MiB, R_AA = 288 * MiB, R_UU = 352 * MiB, R_YMIX = 416 * MiB, R_END = 480 * MiB;
constexpr size_t R_QM = 0, R_QMN = 64 * MiB, R_OM = 80 * MiB;
constexpr size_t R_ACT = 0, R_Y = 40 * MiB;
constexpr size_t WS_SCAN2 = WS_R + R_END;
constexpr size_t WS_END = WS_SCAN2 + 6 * MiB;
constexpr int CW_BAR = 4096;
constexpr int CW_CNT = 16384;
enum { ST_X = 0, ST_CQ = 1, ST_CKV = 2, ST_YATT = 3, ST_YRNN = 4, ST_X1 = 5, ST_X2 = 6 };
constexpr int RING_BYTES = 131072, LDSCTL_OFF = RING_BYTES, LDS_BYTES = 147456;
constexpr int LC_BAR = 0, LC_NRT = 16, LC_RTAB = 64;

struct Params { const float* in[36]; float* out; unsigned char* ws; int ph_lo, ph_hi, probe, pad; };
static_assert(sizeof(Params) == 36 * 8 + 8 + 8 + 16, "Params layout");
typedef __attribute__((address_space(4))) const unsigned char kchar;
__device__ __forceinline__ kchar* karg_base() { kchar* ka = (kchar*)__builtin_amdgcn_kernarg_segment_ptr(); asm volatile("" : "+s"(ka)); return ka; }
__device__ __forceinline__ const float* in_ptr(const Params&, int i) { return (const float*)(*(GAS const float* const __attribute__((address_space(4)))*)(karg_base() + i * 8)); }
__device__ __forceinline__ float* out_ptr() { return (float*)(*(GAS float* const __attribute__((address_space(4)))*)(karg_base() + 288)); }
__device__ __forceinline__ unsigned char* ws_ptr() { return (unsigned char*)(*(GAS unsigned char* const __attribute__((address_space(4)))*)(karg_base() + 296)); }
__device__ __forceinline__ unsigned char* opaque_ptr(unsigned char*) { return ws_ptr(); }
enum { I_X = 0, I_MEM, I_MIXG, I_WIN, I_QLG, I_KVLG, I_WUQ, I_WUKV, I_AQG, I_AKG, I_CONVW, I_CONVB, I_WRG, I_BRG, I_WIG, I_BIG, I_LAM, I_AOG, I_ROG, I_WOUT, I_XNG, I_MNG, I_WMQ, I_WMK, I_WMV,
       I_MQG, I_MKG, I_WMO, I_MOEG, I_WRGRP, I_BRGRP, I_WREXP, I_BREXP, I_WEG, I_WEU, I_WED };

__device__ __forceinline__ int dmap(int map, int n) {
    if (map == 1) return n < 768 ? n : (n < 832 ? n + 2048 : n - 64);
    if (map == 2) return ((n >> 7) << 8) + (n & 127);
    if (map == 3) return ((n >> 7) << 8) + 128 + (n & 127);
    return n;
}
__device__ __forceinline__ void transpose_item(const float* W, int K, int Nsrc, bf16* WT, const float* gain, int map, LAS float* scr, int item, int lane) {
    const int nblk = Nsrc / 32, kb = item / nblk, nb = item % nblk, k0 = 64 * kb, n0 = 32 * nb;
    const GAS float* src = (const GAS float*)W + (size_t)(k0 + (lane >> 5)) * Nsrc + n0 + (lane & 31);
    float v[32];
#pragma unroll
    for (int i = 0; i < 32; ++i) v[i] = src[(size_t)(2 * i) * Nsrc];
    const int c = lane & 7; const int d0 = dmap(map, n0);
    f32x4 ga = (f32x4){1.f, 1.f, 1.f, 1.f}, gb = ga;
    if (gain) { ga = *(const GAS f32x4*)((const GAS float*)gain + k0 + 8 * c); gb = *(const GAS f32x4*)((const GAS float*)gain + k0 + 8 * c + 4); }
#pragma unroll
    for (int i = 0; i < 32; ++i) scr[(2 * i + (lane >> 5)) * 33 + (lane & 31)] = v[i];
    LDS_WAIT(); asm volatile("" ::: "memory");
#pragma unroll
    for (int j = 0; j < 4; ++j) { const int n = (lane >> 3) + 8 * j; const LAS float* s = scr + (8 * c) * 33 + n;
        u32x4 o; o.x = pk2(s[0 * 33] * ga[0], s[1 * 33] * ga[1]); o.y = pk2(s[2 * 33] * ga[2], s[3 * 33] * ga[3]); o.z = pk2(s[4 * 33] * gb[0], s[5 * 33] * gb[1]); o.w = pk2(s[6 * 33] * gb[2], s[7 * 33] * gb[3]);
        *(GAS u32x4*)((GAS bf16*)WT + (size_t)(d0 + n) * K + k0 + 8 * c) = o; }
    LDS_WAIT(); asm volatile("" ::: "memory");
}
__device__ __forceinline__ void convert_layer_weights(const Params& p, int l, LAS float* scr, int gw, int NGW, int lane, int gtid, int NGT) {
    unsigned char* wb = opaque_ptr(p.ws) + WS_W;
    constexpr int I0 = 32 * 90, I1 = 8 * 48, I2 = 4 * 64, I3 = 32 * 64, I4 = 32 * 16, I5 = 8 * 64, IE = 32 * 16, IEX = 32 * IE, ID = 8 * 64, IDX = 32 * ID;
    constexpr int NIT = I0 + I1 + I2 + I3 + I4 + I5 + 2 * IEX + IDX;
    for (int it = gw; it < NIT; it += NGW) {
        int r = it;
        if (r < I0) { transpose_item(in_ptr(p, I_WIN) + (size_t)l * D * 2880, D, 2880, (bf16*)(wb + W_IN), in_ptr(p, I_MIXG) + l * D, 1, scr, r, lane); continue; } r -= I0;
        if (r < I1) { transpose_item(in_ptr(p, I_WUQ) + (size_t)l * QL * NQU, QL, NQU, (bf16*)(wb + W_UQ), in_ptr(p, I_QLG) + l * QL, 0, scr, r, lane); continue; } r -= I1;
        if (r < I2) { transpose_item(in_ptr(p, I_WUKV) + (size_t)l * KVL * NKV, KVL, NKV, (bf16*)(wb + W_UKV), in_ptr(p, I_KVLG) + l * KVL, 0, scr, r, lane); continue; } r -= I2;
        if (r < I3) { const int k0 = 64 * (r / 64); const float* g = (k0 < 1024) ? (in_ptr(p, I_AOG) + l * 1024) : (in_ptr(p, I_ROG) + l * 1024 - 1024);
                      transpose_item(in_ptr(p, I_WOUT) + (size_t)l * D * D, D, D, (bf16*)(wb + W_OUT), g, 0, scr, r, lane); continue; } r -= I3;
        if (r < I4) { transpose_item(in_ptr(p, I_WMQ) + (size_t)l * D * DMA, D, DMA, (bf16*)(wb + W_MQ), in_ptr(p, I_XNG) + l * D, 0, scr, r, lane); continue; } r -= I4;
        if (r < I5) { transpose_item(in_ptr(p, I_WMO) + (size_t)l * DMA * D, DMA, D, (bf16*)(wb + W_MO), nullptr, 0, scr, r, lane); continue; } r -= I5;
        if (r < IEX) { const int e = r / IE; transpose_item(in_ptr(p, I_WEG) + ((size_t)l * NE + e) * D * DE, D, DE, (bf16*)(wb + W_GU) + (size_t)e * 1024 * D, in_ptr(p, I_MOEG) + l * D, 2, scr, r % IE, lane); continue; } r -= IEX;
        if (r < IEX) { const int e = r / IE; transpose_item(in_ptr(p, I_WEU) + ((size_t)l * NE + e) * D * DE, D, DE, (bf16*)(wb + W_GU) + (size_t)e * 1024 * D, in_ptr(p, I_MOEG) + l * D, 3, scr, r % IE, lane); continue; } r -= IEX;
        { const int e = r / ID; transpose_item(in_ptr(p, I_WED) + ((size_t)l * NE + e) * DE * D, DE, D, (bf16*)(wb + W_D) + (size_t)e * D * DE, nullptr, 0, scr, r % ID, lane); }
    }
    { u32x4* z = (u32x4*)((bf16*)(wb + W_IN) + (size_t)2880 * D); const int n16 = 192 * D * 2 / 16; for (int i = gtid; i < n16; i += NGT) z[i] = (u32x4){0u, 0u, 0u, 0u}; }
    { bf16* wr = (bf16*)(wb + W_R); const float* wg = in_ptr(p, I_WRGRP) + (size_t)l * D * 4; const float* we = in_ptr(p, I_WREXP) + (size_t)l * D * 32; const float* g = in_ptr(p, I_MOEG) + l * D;
      for (int i = gtid; i < 256 * D / 8; i += NGT) { const int n = i / (D / 8), k0 = (i % (D / 8)) * 8; float v[8];
#pragma unroll
          for (int j = 0; j < 8; ++j) { const int k = k0 + j; v[j] = n < 4 ? wg[k * 4 + n] * g[k] : (n < 36 ? we[k * 32 + (n - 4)] * g[k] : 0.f); }
          u32x4 o; o.x = pk2(v[0], v[1]); o.y = pk2(v[2], v[3]); o.z = pk2(v[4], v[5]); o.w = pk2(v[6], v[7]); *(u32x4*)(wr + (size_t)n * D + k0) = o; } }
    { bf16* wg = (bf16*)(wb + W_G); const float* wr = in_ptr(p, I_WRG) + (size_t)l * 8 * 128 * 128; const float* wi = in_ptr(p, I_WIG) + (size_t)l * 8 * 128 * 128;
      for (int i = gtid; i < 8 * 256 * 256 / 8; i += NGT) { const int n = i >> 13, j = (i >> 5) & 255, c0 = (i & 31) * 8; float v[8];
          const bool on = (c0 >> 7) == (n & 1); const float* src = (j < 128 ? wr : wi) + (size_t)n * 128 * 128 + (j & 127);
#pragma unroll
          for (int q = 0; q < 8; ++q) v[q] = on ? src[(size_t)((c0 & 127) + q) * 128] : 0.f;
          u32x4 o; o.x = pk2(v[0], v[1]); o.y = pk2(v[2], v[3]); o.z = pk2(v[4], v[5]); o.w = pk2(v[6], v[7]); *(u32x4*)(wg + (size_t)i * 8) = o; } }
}
__device__ __forceinline__ float row_to_bf16(const float* xrow, bf16* orow, int lane) {
    float ss = 0.f;
#pragma unroll
    for (int j = 0; j < 4; ++j) { const int c = lane * 8 + 512 * j; const f32x4 a = *(const f32x4*)(xrow + c), b = *(const f32x4*)(xrow + c + 4);
        ss += (a[0] * a[0] + a[1] * a[1]) + (a[2] * a[2] + a[3] * a[3]) + (b[0] * b[0] + b[1] * b[1]) + (b[2] * b[2] + b[3] * b[3]);
        u32x4 o; o.x = pk2(a[0], a[1]); o.y = pk2(a[2], a[3]); o.z = pk2(b[0], b[1]); o.w = pk2(b[2], b[3]); *(u32x4*)(orow + c) = o; }
    return wave_sum(ss);
}
__device__ __forceinline__ float gelu_tanh(float x) { const float y = 0.7978845608028654f * (x + 0.044715f * x * x * x); const float e = __expf(2.0f * y); const float th = 1.0f - 2.0f / (e + 1.0f); return 0.5f * x * (1.0f + th); }
__device__ __forceinline__ void unpack8(u32x4 w, float* v) { v[0] = bflo(w.x); v[1] = bfhi(w.x); v[2] = bflo(w.y); v[3] = bfhi(w.y); v[4] = bflo(w.z); v[5] = bfhi(w.z); v[6] = bflo(w.w); v[7] = bfhi(w.w); }
__device__ __forceinline__ u32x4 pack8f(const float* v) { u32x4 o; o.x = pk2(v[0], v[1]); o.y = pk2(v[2], v[3]); o.z = pk2(v[4], v[5]); o.w = pk2(v[6], v[7]); return o; }

__device__ __forceinline__ void conv_phase(const bf16* z, bf16* xc, const float* cw, const float* cb, int gtid, int NGT) {
    for (int it = gtid; it < (T / 16) * 128; it += NGT) {
        const int tb = it >> 7, cg = it & 127, row0 = tb * 16, s0 = row0 & (SEQ - 1), c0 = cg * 8;
        float w[4][8], b[8], p1[8], p2[8], p3[8];
#pragma unroll
        for (int j = 0; j < 4; ++j) { const f32x4 a = *(const f32x4*)(cw + j * DRNN + c0), bb = *(const f32x4*)(cw + j * DRNN + c0 + 4);
            w[j][0] = a[0]; w[j][1] = a[1]; w[j][2] = a[2]; w[j][3] = a[3]; w[j][4] = bb[0]; w[j][5] = bb[1]; w[j][6] = bb[2]; w[j][7] = bb[3]; }
        { const f32x4 a = *(const f32x4*)(cb + c0), bb = *(const f32x4*)(cb + c0 + 4); b[0] = a[0]; b[1] = a[1]; b[2] = a[2]; b[3] = a[3]; b[4] = bb[0]; b[5] = bb[1]; b[6] = bb[2]; b[7] = bb[3]; }
        const bf16* zp = z + (size_t)row0 * ZC + Z_XR + c0;
        if (s0 >= 1) unpack8(*(const u32x4*)(zp - (size_t)ZC), p1); else { for (int e = 0; e < 8; ++e) p1[e] = 0.f; }
        if (s0 >= 2) unpack8(*(const u32x4*)(zp - (size_t)2 * ZC), p2); else { for (int e = 0; e < 8; ++e) p2[e] = 0.f; }
        if (s0 >= 3) unpack8(*(const u32x4*)(zp - (size_t)3 * ZC), p3); else { for (int e = 0; e < 8; ++e) p3[e] = 0.f; }
#pragma unroll 4
        for (int r = 0; r < 16; ++r) { float cur[8], o[8]; unpack8(*(const u32x4*)(zp + (size_t)r * ZC), cur);
#pragma unroll
            for (int e = 0; e < 8; ++e) { o[e] = b[e] + w[3][e] * cur[e] + w[2][e] * p1[e] + w[1][e] * p2[e] + w[0][e] * p3[e]; p3[e] = p2[e]; p2[e] = p1[e]; p1[e] = cur[e]; }
            *(u32x4*)(xc + (size_t)(row0 + r) * DRNN + c0) = pack8f(o); }
    }
}
__device__ __forceinline__ void qk_post_phase(bf16* q, const bf16* kvr, const bf16* z, bf16* kk, const float* gq, const float* gk, const float* cosT, const float* sinT, int gw, int NGW, int lane) {
    const int h = lane >> 3, j = lane & 7;
    for (int row = gw; row < T; row += NGW) {
        const int s = row & (SEQ - 1);
        float cs[8], sn[8];
        { const int i0 = (j & 3) * 8; const f32x4 a = *(const f32x4*)(cosT + s * 32 + i0), b = *(const f32x4*)(cosT + s * 32 + i0 + 4), c = *(const f32x4*)(sinT + s * 32 + i0), d = *(const f32x4*)(sinT + s * 32 + i0 + 4);
          cs[0] = a[0]; cs[1] = a[1]; cs[2] = a[2]; cs[3] = a[3]; cs[4] = b[0]; cs[5] = b[1]; cs[6] = b[2]; cs[7] = b[3];
          sn[0] = c[0]; sn[1] = c[1]; sn[2] = c[2]; sn[3] = c[3]; sn[4] = d[0]; sn[5] = d[1]; sn[6] = d[2]; sn[7] = d[3]; }
#pragma unroll
        for (int which = 0; which < 2; ++which) {
            float v[3][8];
            if (which == 0) { bf16* qp = q + (size_t)row * NQU + h * QKH + j * 8;
#pragma unroll
                for (int i = 0; i < 3; ++i) unpack8(*(const u32x4*)(qp + 64 * i), v[i]); }
            else { const bf16* kp = kvr + (size_t)row * NKV + h * 256 + j * 8; unpack8(*(const u32x4*)kp, v[0]); unpack8(*(const u32x4*)(kp + 64), v[1]);
                   unpack8(*(const u32x4*)(z + (size_t)row * ZC + Z_KPE + j * 8), v[2]); }
            float ss = 0.f;
#pragma unroll
            for (int i = 0; i < 3; ++i)
#pragma unroll
                for (int e = 0; e < 8; ++e) ss += v[i][e] * v[i][e];
            ss += __shfl_xor(ss, 1); ss += __shfl_xor(ss, 2); ss += __shfl_xor(ss, 4);
            const float rstd = 1.0f / sqrtf(ss * (1.0f / 192.0f) + EPS);
            const float* g = which == 0 ? gq : gk;
#pragma unroll
            for (int i = 0; i < 3; ++i) { const f32x4 ga = *(const f32x4*)(g + 64 * i + j * 8), gb = *(const f32x4*)(g + 64 * i + j * 8 + 4);
                v[i][0] *= rstd * ga[0]; v[i][1] *= rstd * ga[1]; v[i][2] *= rstd * ga[2]; v[i][3] *= rstd * ga[3]; v[i][4] *= rstd * gb[0]; v[i][5] *= rstd * gb[1]; v[i][6] *= rstd * gb[2]; v[i][7] *= rstd * gb[3]; }
#pragma unroll
            for (int e = 0; e < 8; ++e) { const float mine = v[2][e], oth = __shfl_xor(mine, 4);
                v[2][e] = (j < 4) ? (mine * cs[e] - oth * sn[e]) : (oth * sn[e] + mine * cs[e]); }
            bf16* op = (which == 0 ? q + (size_t)row * NQU : kk + (size_t)row * NQU) + h * QKH + j * 8;
#pragma unroll
            for (int i = 0; i < 3; ++i) *(u32x4*)(op + 64 * i) = pack8f(v[i]);
        }
    }
}
template <bool F32IN>
__device__ __forceinline__ void head128_norm_rows(const void* in0, const float* in1, int ld_in, bf16* out, const float* g, int nrows, int gw, int NGW, int lane) {
    for (int row = gw; row < nrows; row += NGW) {
        float v[8];
        if (F32IN) { const float* a = (const float*)in0 + (size_t)row * ld_in + lane * 8; const float* b = in1 + (size_t)row * ld_in + lane * 8;
            const f32x4 a0 = *(const f32x4*)a, a1 = *(const f32x4*)(a + 4), b0 = *(const f32x4*)b, b1 = *(const f32x4*)(b + 4);
            v[0] = a0[0] + b0[0]; v[1] = a0[1] + b0[1]; v[2] = a0[2] + b0[2]; v[3] = a0[3] + b0[3]; v[4] = a1[0] + b1[0]; v[5] = a1[1] + b1[1]; v[6] = a1[2] + b1[2]; v[7] = a1[3] + b1[3]; }
        else unpack8(*(const u32x4*)((const bf16*)in0 + (size_t)row * ld_in + lane * 8), v);
        float ss = 0.f;
#pragma unroll
        for (int e = 0; e < 8; ++e) ss += v[e] * v[e];
        ss += __shfl_xor(ss, 1); ss += __shfl_xor(ss, 2); ss += __shfl_xor(ss, 4); ss += __shfl_xor(ss, 8);
        const float rstd = 1.0f / sqrtf(ss * (1.0f / 128.0f) + EPS);
        const int c = (lane * 8) & 127; const f32x4 ga = *(const f32x4*)(g + c), gb = *(const f32x4*)(g + c + 4);
        v[0] *= rstd * ga[0]; v[1] *= rstd * ga[1]; v[2] *= rstd * ga[2]; v[3] *= rstd * ga[3]; v[4] *= rstd * gb[0]; v[5] *= rstd * gb[1]; v[6] *= rstd * gb[2]; v[7] *= rstd * gb[3];
        *(u32x4*)(out + (size_t)row * DMA + lane * 8) = pack8f(v);
    }
}
__device__ __forceinline__ void scan_pass1(const float* aa, const float* uu, float* sA, float* sH, float* cA, float* cH, LAS f32x4* xch, int unit, int wave, int lane) {
    const int q = unit & 3, c = (unit >> 2) & 31, b = unit >> 7; const unsigned ch = (unsigned)(q * 256 + lane * 4);
    const GAS float* ap = (const GAS float*)aa + ((size_t)b * SEQ + (size_t)c * 256 + (size_t)wave * 32) * DRNN + ch;
    const GAS float* up = (const GAS float*)uu + ((size_t)b * SEQ + (size_t)c * 256 + (size_t)wave * 32) * DRNN + ch;
    f32x4 A = (f32x4){1.f, 1.f, 1.f, 1.f}, H = (f32x4){0.f, 0.f, 0.f, 0.f};
#pragma unroll
    for (int hb = 0; hb < 2; ++hb) { f32x4 av[16], uv[16];
#pragma unroll
        for (int s = 0; s < 16; ++s) { av[s] = *(const GAS f32x4*)(ap + (size_t)(hb * 16 + s) * DRNN); uv[s] = *(const GAS f32x4*)(up + (size_t)(hb * 16 + s) * DRNN); }
#pragma unroll
        for (int s = 0; s < 16; ++s) { H = av[s] * H + uv[s]; A = A * av[s]; } }
    const size_t so = ((size_t)(b * 32 + c) * 8 + wave) * DRNN + ch;
    *(GAS f32x4*)((GAS float*)sA + so) = A; *(GAS f32x4*)((GAS float*)sH + so) = H;
    xch[(wave * 64 + lane) * 2] = A; xch[(wave * 64 + lane) * 2 + 1] = H;
    __syncthreads();
    if (wave == 0) { f32x4 Ac = (f32x4){1.f, 1.f, 1.f, 1.f}, Hc = (f32x4){0.f, 0.f, 0.f, 0.f};
#pragma unroll
        for (int w = 0; w < 8; ++w) { const f32x4 a = xch[(w * 64 + lane) * 2], h = xch[(w * 64 + lane) * 2 + 1]; Hc = a * Hc + h; Ac = Ac * a; }
        const size_t co = (size_t)(b * 32 + c) * DRNN + ch; *(GAS f32x4*)((GAS float*)cA + co) = Ac; *(GAS f32x4*)((GAS float*)cH + co) = Hc; }
    __syncthreads();
}
__device__ __forceinline__ void scan_pass3(const float* aa, const float* uu, const float* sA, const float* sH, const float* cA, const float* cH, const bf16* z, bf16* ymix, u64* ssq, int unit, int wave, int lane) {
    const int q = unit & 3, c = (unit >> 2) & 31, b = unit >> 7; const unsigned ch = (unsigned)(q * 256 + lane * 4);
    f32x4 h = (f32x4){0.f, 0.f, 0.f, 0.f};
    { const GAS float* ca = (const GAS float*)cA + (size_t)(b * 32) * DRNN + ch; const GAS float* chh = (const GAS float*)cH + (size_t)(b * 32) * DRNN + ch;
#pragma unroll 8
      for (int j = 0; j < c; ++j) { const f32x4 a = *(const GAS f32x4*)(ca + (size_t)j * DRNN), hh = *(const GAS f32x4*)(chh + (size_t)j * DRNN); h = a * h + hh; }
      const GAS float* sa = (const GAS float*)sA + (size_t)(b * 32 + c) * 8 * DRNN + ch; const GAS float* sh = (const GAS float*)sH + (size_t)(b * 32 + c) * 8 * DRNN + ch;
      for (int j = 0; j < wave; ++j) { const f32x4 a = *(const GAS f32x4*)(sa + (size_t)j * DRNN), hh = *(const GAS f32x4*)(sh + (size_t)j * DRNN); h = a * h + hh; } }
    const size_t row0 = (size_t)b * SEQ + (size_t)c * 256 + (size_t)wave * 32;
    const GAS float* ap = (const GAS float*)aa + row0 * DRNN + ch; const GAS float* up = (const GAS float*)uu + row0 * DRNN + ch;
    const GAS bf16* gp = (const GAS bf16*)z + row0 * ZC + Z_GATE + ch; GAS bf16* yp = (GAS bf16*)ymix + row0 * D + DATT + ch;
#pragma unroll
    for (int hb = 0; hb < 2; ++hb) { f32x4 av[16], uv[16]; u32x2 gv[16];
#pragma unroll
        for (int s = 0; s < 16; ++s) { av[s] = *(const GAS f32x4*)(ap + (size_t)(hb * 16 + s) * DRNN); uv[s] = *(const GAS f32x4*)(up + (size_t)(hb * 16 + s) * DRNN); gv[s] = *(const GAS u32x2*)(gp + (size_t)(hb * 16 + s) * ZC); }
#pragma unroll
        for (int s = 0; s < 16; ++s) { h = av[s] * h + uv[s];
            const float y0 = h[0] * gelu_tanh(bflo(gv[s].x)), y1 = h[1] * gelu_tanh(bfhi(gv[s].x)), y2 = h[2] * gelu_tanh(bflo(gv[s].y)), y3 = h[3] * gelu_tanh(bfhi(gv[s].y));
            u32x2 o; o.x = pk2(y0, y1); o.y = pk2(y2, y3); *(GAS u32x2*)(yp + (size_t)(hb * 16 + s) * D) = o;
            const float ss = wave_sum((y0 * y0 + y1 * y1) + (y2 * y2 + y3 * y3)); if (lane == 0) ssq_add(ssq, (int)(row0 + hb * 16 + s), ss); } }
}
__device__ __forceinline__ void route_phase(const float* logits, const u64* ssq_x2, const float* bg, const float* be, int* tok_e, float* tok_w, int* whist, unsigned* cnt, LAS int* hist, int wg, int tid) {
    if (tid < 32) hist[tid] = 0;
    __syncthreads();
    if (tid < 64) { const int t = wg * 64 + tid; const float rs = 1.0f / sqrtf(ssq_val(ssq_x2, t) * (1.0f / D) + EPS); const float* lp = logits + (size_t)t * 64;
        float lg[4]; int g = 0; float mx = -3.0e38f;
#pragma unroll
        for (int i = 0; i < 4; ++i) { lg[i] = lp[i] * rs + bg[i]; if (lg[i] > mx) { mx = lg[i]; g = i; } }
        float den = 0.f;
#pragma unroll
        for (int i = 0; i < 4; ++i) den += __expf(lg[i] - mx);
        const float gw = 1.0f / den;
        float l1 = -3.0e38f, l2 = -3.0e38f; int j1 = 0, j2 = 0;
        for (int i = 0; i < 8; ++i) { const float v = lp[4 + g * 8 + i] * rs + be[g * 8 + i];
            if (v > l1) { l2 = l1; j2 = j1; l1 = v; j1 = i; } else if (v > l2) { l2 = v; j2 = i; } }
        const float w1 = 1.0f / (1.0f + __expf(l2 - l1)), w2 = 1.0f - w1;
        const int e1 = g * 8 + j1, e2 = g * 8 + j2;
        tok_e[t * 2] = e1; tok_e[t * 2 + 1] = e2; tok_w[t * 2] = gw * w1; tok_w[t * 2 + 1] = gw * w2;
        __hip_atomic_fetch_add(hist + e1, 1, __ATOMIC_RELAXED, __HIP_MEMORY_SCOPE_WORKGROUP); __hip_atomic_fetch_add(hist + e2, 1, __ATOMIC_RELAXED, __HIP_MEMORY_SCOPE_WORKGROUP);
    }
    __syncthreads();
    if (tid < 32) { const int c = hist[tid]; whist[wg * 32 + tid] = c; if (c) atomicAdd(cnt + tid, (unsigned)c); }
}
__device__ __forceinline__ void dispatch_phase(const unsigned* cnt, const int* whist, const int* tok_e, const float* tok_w, const u64* ssq_x2, int* tok_slot, int* slot_tok, float* slot_w, float* slot_rs,
                                               LAS int* sc, int wg, int tid) {
    if (tid == 0) { int seg = 0; for (int e = 0; e < 32; ++e) { sc[e] = seg; seg += (((int)cnt[e] + 255) >> 8) << 8; } }
    { const int e = tid & 31, part = tid >> 5; int s = 0; for (int w = part; w < wg; w += 16) s += whist[w * 32 + e]; sc[64 + tid] = s; }
    if (tid < 128) sc[640 + tid] = tok_e[(wg * 64) * 2 + tid];
    __syncthreads();
    if (tid < 32) { int s = sc[tid]; for (int p = 0; p < 16; ++p) s += sc[64 + p * 32 + tid]; sc[32 + tid] = s; }
    __syncthreads();
    if (tid < 128) { const int e = sc[640 + tid]; int rank = 0; for (int j = 0; j < tid; ++j) rank += (sc[640 + j] == e) ? 1 : 0;
        const int slot = sc[32 + e] + rank; const int t = wg * 64 + (tid >> 1);
        slot_tok[slot] = t; slot_w[slot] = tok_w[(wg * 64) * 2 + tid]; slot_rs[slot] = 1.0f / sqrtf(ssq_val(ssq_x2, t) * (1.0f / D) + EPS); tok_slot[(wg * 64) * 2 + tid] = slot; }
    if (wg < 32) { const int c = (int)cnt[wg], lo = sc[wg] + c, hi = sc[wg] + (((c + 255) >> 8) << 8);
        for (int s = lo + tid; s < hi; s += NTHREADS) { slot_tok[s] = 0; slot_w[s] = 0.f; slot_rs[s] = 0.f; } }
    __syncthreads();
}
__device__ __forceinline__ int build_rtab(const unsigned* cnt, LAS int* lc, int tid) {
    if (tid == 0) { int seg = 0, k = 0; for (int e = 0; e < 32; ++e) { const int nt = ((int)cnt[e] + 255) >> 8; for (int r = 0; r < nt; ++r) { lc[LC_RTAB / 4 + 2 * k] = e; lc[LC_RTAB / 4 + 2 * k + 1] = seg + r * 256; ++k; } seg += nt * 256; } lc[LC_NRT / 4] = k; }
    __syncthreads();
    return lc[LC_NRT / 4];
}
__device__ __forceinline__ void combine_phase(float* out, const bf16* Y, const int* tok_slot, bf16* xb, u64* ssq_next, bool last, int gw, int NGW, int lane) {
    for (int row = gw; row < T; row += NGW) {
        const int s0 = tok_slot[row * 2], s1 = tok_slot[row * 2 + 1]; float ss = 0.f;
#pragma unroll
        for (int j = 0; j < 4; ++j) { const int c = lane * 8 + 512 * j; float x0[8], y0[8], y1[8], v[8];
            unpack8(*(const u32x4*)(xb + (size_t)row * D + c), x0); unpack8(*(const u32x4*)(Y + (size_t)s0 * D + c), y0); unpack8(*(const u32x4*)(Y + (size_t)s1 * D + c), y1);
#pragma unroll
            for (int e = 0; e < 8; ++e) { v[e] = x0[e] + y0[e] + y1[e]; ss += v[e] * v[e]; }
            if (last) { float* op = out + (size_t)row * D + c; *(f32x4*)op = (f32x4){v[0], v[1], v[2], v[3]}; *(f32x4*)(op + 4) = (f32x4){v[4], v[5], v[6], v[7]}; }
            else *(u32x4*)(xb + (size_t)row * D + c) = pack8f(v); }
        ss = wave_sum(ss); if (!last && lane == 0) ssq_set(ssq_next, row, ss);
    }
}
constexpr int NPL = 16, NPHASES = 1 + DEPTH * NPL;
__device__ __forceinline__ att::BlockRef mla_ref(int it, int pass, bf16* qbuf, bf16* kk, bf16* kvr, bf16* ymix, u64* ssq_ya) {
    const int bh = (it & 7) * 2 + ((it >> 3) >> 4), y = (it >> 3) & 15, b = bh >> 3, h = bh & 7; const int qb = pass ? 31 - y : y; const size_t r0 = (size_t)b * SEQ;
    att::BlockRef c; c.K = kk + r0 * NQU + h * QKH; c.V = kvr + r0 * NKV + h * 256 + 128; c.nk = SEQ;
    c.Q = qbuf + (r0 + (size_t)qb * 256) * NQU + h * QKH; c.O = ymix + (r0 + (size_t)qb * 256) * D + h * VH; c.ssq = ssq_ya + r0 + qb * 256; c.P0 = qb * 256; return c;
}
#ifndef PH_MASK
#define PH_MASK 0x1ffff
#endif
#define PH_ON(j) (((PH_MASK) >> (j)) & 1)
__global__ void __launch_bounds__(NTHREADS, 2) fwd_kernel(Params p) {
    extern __shared__ __attribute__((aligned(16))) unsigned char lds_raw[];
    LAS unsigned char* lds = (LAS unsigned char*)lds_raw;
    LAS int* lc = (LAS int*)(lds + LDSCTL_OFF);
    const int G = gridDim.x, bx = blockIdx.x;
    const int NGW = G * NWAVES, NGT = G * NTHREADS;
    if (threadIdx.x < 64) lc[threadIdx.x] = 0;
    __syncthreads();
    XcdBarrier bar = xcd_barrier_post((unsigned*)(ws_ptr() + WS_CTL) + CW_BAR, (volatile LAS unsigned*)(lds + LDSCTL_OFF + LC_BAR));
    const int lo = p.ph_lo, hi = p.ph_hi; const bool probe = p.probe != 0;
#define IN(k) (lo <= (k) && (k) < hi)
#define SEAM(k) do { if ((k) + 1 < hi) xcd_barrier(bar); } while (0)
#define WS_PTRS() unsigned char* ws = opaque_ptr(p.ws); unsigned char* wb = ws + WS_W; unsigned char* rg = ws + WS_R; (void)wb; (void)rg; \
    int tid = threadIdx.x; asm volatile("" : "+v"(tid)); const int lane = tid & 63, wave = __builtin_amdgcn_readfirstlane(tid >> 6); \
    const int gw = bx * NWAVES + wave, gtid = bx * NTHREADS + tid; (void)lane; (void)gw; (void)gtid
#define INP(i) in_ptr(p, (i))
#define STATP(l, k) ((u64*)(ws + WS_STAT) + (size_t)((l) * 7 + (k)) * 16384)

    if (PH_ON(0) && IN(0)) {
        WS_PTRS();
        float* cosT = (float*)(ws + WS_TAB); float* sinT = cosT + SEQ * 32; float* spT = (float*)(ws + WS_TAB + 2 * MiB); u64* ssq_mem = (u64*)(spT + 2 * 1024);
        bf16* memb = (bf16*)(ws + WS_MEMB); bf16* wmkv = (bf16*)(ws + WS_WMKV); bf16* xb = (bf16*)(ws + WS_XB);
        LAS float* scr = (LAS float*)(lds + wave * 16384);
        convert_layer_weights(p, 0, scr, gw, NGW, lane, gtid, NGT);
        for (int it = gw; it < 2 * 2 * 32 * 16; it += NGW) { const int l = it / (2 * 512), r = it % (2 * 512), kv = r / 512, item = r % 512;
            transpose_item(INP(kv ? I_WMV : I_WMK) + (size_t)l * D * DMA, D, DMA, wmkv + (size_t)l * 1024 * D + (size_t)kv * 512 * D, INP(I_MNG) + l * D, 0, scr, item, lane); }
        for (int i = gtid; i < SEQ * 32; i += NGT) { const int t = i >> 5, k = i & 31; const float inv = exp2f(-(float)k * (13.287712379549449f / 32.0f)); float s, c; sincosf((float)t * inv, &s, &c); cosT[i] = c; sinT[i] = s; }
        { const float* lam = INP(I_LAM); for (int i = gtid; i < 2 * 1024; i += NGT) spT[i] = log1pf(expf(-lam[i])); }
        u64* ssq_x0 = STATP(0, ST_X);
        { const float* x = INP(I_X); for (int row = gw; row < T; row += NGW) { const float ss = row_to_bf16(x + (size_t)row * D, xb + (size_t)row * D, lane); if (lane == 0) ssq_set(ssq_x0, row, ss); } }
        { const float* m = INP(I_MEM); for (int row = gw; row < TM; row += NGW) { const float ss = row_to_bf16(m + (size_t)row * D, memb + (size_t)row * D, lane); if (lane == 0) ssq_set(ssq_mem, row, ss); } }
        SEAM(0);
    }

    for (int l = 0; l < DEPTH; ++l) {
        const int pb = 1 + l * NPL;

        if (PH_ON(1) && IN(pb + 0)) {
            WS_PTRS();
            { pg8::DenseSched S{(const char*)(ws + WS_XB), (const char*)(wb + W_IN), D, D, T / 256, ZC / 256, 1, D, G, bx};
              pg8::EpiBf16<0, true> E{(bf16*)(rg + R_Z), ZC, STATP(l, ST_X), 1.0f / D, STATP(l, ST_CQ), STATP(l, ST_CKV), 2, 3};
              pg8::gemm_phase<pg8::EpiBf16<0, true>, pg8::DenseSched, true, false>(lds, D, D, D, S, E, 0); }
            if (l == 0) {
                pg8::DenseSched S{(const char*)(ws + WS_MEMB), (const char*)(ws + WS_WMKV), D, D, TM / 256, 2 * 1024 / 256, 1, D, G, bx};
                pg8::EpiBf16<0, false> E{(bf16*)(ws + WS_KVMEM), 2 * 1024, (const void*)((float*)(ws + WS_TAB + 2 * MiB) + 2 * 1024), 1.0f / D, nullptr, nullptr, 0, 0};
                pg8::gemm_phase<pg8::EpiBf16<0, false>, pg8::DenseSched, true, false>(lds, D, D, D, S, E, 0);
            }
            SEAM(pb + 0);
        }
        if (PH_ON(2) && IN(pb + 1)) {
            WS_PTRS();
            bf16* z = (bf16*)(rg + R_Z);
            { pg8::DenseSched S{(const char*)(z + Z_CQ), (const char*)(wb + W_UQ), ZC, QL, T / 256, NQU / 256, 1, QL, G, bx};
              pg8::EpiBf16<0, false> E{(bf16*)(rg + R_Q), NQU, STATP(l, ST_CQ), 1.0f / QL, nullptr, nullptr, 0, 0};
              pg8::gemm_phase<pg8::EpiBf16<0, false>, pg8::DenseSched, true, false>(lds, QL, ZC, QL, S, E, 0); }
            { pg8::DenseSched S{(const char*)(z + Z_CKV), (const char*)(wb + W_UKV), ZC, KVL, T / 256, NKV / 256, 1, KVL, G, bx};
              pg8::EpiBf16<0, false> E{(bf16*)(rg + R_KVR), NKV, STATP(l, ST_CKV), 1.0f / KVL, nullptr, nullptr, 0, 0};
              pg8::gemm_phase<pg8::EpiBf16<0, false>, pg8::DenseSched, true, false>(lds, KVL, ZC, KVL, S, E, 0); }
            conv_phase(z, (bf16*)(rg + R_XC), INP(I_CONVW) + (size_t)l * 4 * DRNN, INP(I_CONVB) + (size_t)l * DRNN, gtid, NGT);
            if (l == 0) { const float* mkg = INP(I_MKG); for (int ll = 0; ll < 2; ++ll) head128_norm_rows<false>((bf16*)(ws + WS_KVMEM) + (size_t)ll * 1024, nullptr, 2 * 1024, (bf16*)(ws + WS_KMEMN) + (size_t)ll * TM * DMA, mkg + ll * 128, TM, gw, NGW, lane); }
            SEAM(pb + 1);
        }
        if (PH_ON(3) && IN(pb + 2)) {
            WS_PTRS();
            float* cosT = (float*)(ws + WS_TAB);
            qk_post_phase((bf16*)(rg + R_Q), (const bf16*)(rg + R_KVR), (const bf16*)(rg + R_Z), (bf16*)(rg + R_KK), INP(I_AQG) + l * QKH, INP(I_AKG) + l * QKH, cosT, cosT + SEQ * 32, gw, NGW, lane);
            { pg8::GateSched S{(const char*)(rg + R_XC), (const char*)(wb + W_G), G, bx};
              pg8::EpiGates E{(const bf16*)(rg + R_XC), INP(I_BRG) + l * DRNN, INP(I_BIG) + l * DRNN, (float*)(ws + WS_TAB + 2 * MiB) + l * DRNN, (float*)(rg + R_AA), (float*)(rg + R_UU)};
              pg8::gemm_phase<pg8::EpiGates, pg8::GateSched, true, false>(lds, 256, DRNN, 256, S, E, 0); }
            SEAM(pb + 2);
        }
        if (PH_ON(4) && IN(pb + 3)) {
            WS_PTRS();
            float* sA = (float*)(ws + WS_SCAN2);
            for (int u = bx; u < 256; u += G) scan_pass1((const float*)(rg + R_AA), (const float*)(rg + R_UU), sA, sA + 512 * 1024, sA + 1024 * 1024, sA + 1024 * 1024 + 64 * 1024, (LAS f32x4*)lds, u, wave, lane);
            SEAM(pb + 3);
        }
        if (PH_ON(5) && IN(pb + 4)) {
            WS_PTRS();
            bf16* ymix = (bf16*)(rg + R_YMIX);
            {
                bf16* qbuf = (bf16*)(rg + R_Q); bf16* kk = (bf16*)(rg + R_KK); bf16* kvr = (bf16*)(rg + R_KVR); u64* ssq_ya = STATP(l, ST_YATT);
                const att::Strides<NQU, NQU, NKV, D> sd;
                for (int it = bx; it < 256; it += G) {
                    att::BlockRef cur = mla_ref(it, 0, qbuf, kk, kvr, ymix, ssq_ya);
                    att::Seam<12> S;
                    att::attn_prime<64>(cur, sd, (char*)lds_raw, S);
                    for (int pass = 0; pass < 2; ++pass) {
                        const att::BlockRef nxt = (pass == 0) ? mla_ref(it, 1, qbuf, kk, kvr, ymix, ssq_ya) : cur;
                        att::attn_block<64, true, true>(cur, nxt, sd, 0.07216878364870322f, (char*)lds_raw, S);
                        cur = nxt;
                    }
                }
            }
            { float* sA = (float*)(ws + WS_SCAN2);
              for (int u = bx; u < 256; u += G) scan_pass3((const float*)(rg + R_AA), (const float*)(rg + R_UU), sA, sA + 512 * 1024, sA + 1024 * 1024, sA + 1024 * 1024 + 64 * 1024, (const bf16*)(rg + R_Z), ymix, STATP(l, ST_YRNN), u, wave, lane); }
            SEAM(pb + 4);
        }
        if (PH_ON(6) && IN(pb + 5)) {
            WS_PTRS();
            pg8::DenseSched S{(const char*)(rg + R_YMIX), (const char*)(wb + W_OUT), D, D, T / 256, D / 256, 1, D, G, bx};
            pg8::EpiResid<true> E{(bf16*)(ws + WS_XB), STATP(l, ST_X1), STATP(l, ST_YATT), STATP(l, ST_YRNN)};
            pg8::gemm_phase<pg8::EpiResid<true>, pg8::DenseSched, true, true>(lds, D, D, D, S, E, 16);
            SEAM(pb + 5);
        }
        if (PH_ON(7) && IN(pb + 6)) {
            WS_PTRS();
            pg8::DenseSched S{(const char*)(ws + WS_XB), (const char*)(wb + W_MQ), D, D, T / 256, DMA / 256, 2, 1024, G, bx};
            pg8::EpiF32Slab E{(float*)(rg + R_QM), DMA, (size_t)T * DMA, STATP(l, ST_X1), 1.0f / D};
            pg8::gemm_phase<pg8::EpiF32Slab, pg8::DenseSched, true, false>(lds, 1024, D, D, S, E, 0);
            SEAM(pb + 6);
        }
        if (PH_ON(8) && IN(pb + 7)) {
            WS_PTRS();
            float* qm = (float*)(rg + R_QM);
            head128_norm_rows<true>(qm, qm + (size_t)T * DMA, DMA, (bf16*)(rg + R_QMN), INP(I_MQG) + l * 128, T, gw, NGW, lane);
            SEAM(pb + 7);
        }
        if (PH_ON(9) && IN(pb + 8)) {
            WS_PTRS();
            bf16* qmn = (bf16*)(rg + R_QMN); bf16* om = (bf16*)(rg + R_OM); bf16* kmemn = (bf16*)(ws + WS_KMEMN); bf16* kvmem = (bf16*)(ws + WS_KVMEM);
            const att::Strides<DMA, DMA, 2 * 1024, DMA> sd;
            for (int it = bx; it < 256; it += G) {
                const int h = it & 3, rb = it >> 2, b = rb >> 5;
                att::BlockRef c0;
                c0.Q = qmn + (size_t)rb * 256 * DMA + h * 128; c0.K = kmemn + ((size_t)l * TM + (size_t)b * NMEM) * DMA + h * 128;
                c0.V = kvmem + (size_t)l * 1024 + (size_t)b * NMEM * 2048 + 512 + h * 128; c0.O = om + (size_t)rb * 256 * DMA + h * 128; c0.ssq = nullptr; c0.P0 = 0; c0.nk = NMEM;
                att::Seam<8> S;
                att::attn_prime<0>(c0, sd, (char*)lds_raw, S);
                att::attn_block<0, false, false>(c0, c0, sd, 0.08838834764831845f, (char*)lds_raw, S);
            }
            SEAM(pb + 8);
        }
        if (PH_ON(10) && IN(pb + 9)) {
            WS_PTRS();
            pg8::DenseSched S{(const char*)(rg + R_OM), (const char*)(wb + W_MO), DMA, DMA, T / 256, D / 256, 1, DMA, G, bx};
            pg8::EpiResid<false> E{(bf16*)(ws + WS_XB), STATP(l, ST_X2), nullptr, nullptr};
            pg8::gemm_phase<pg8::EpiResid<false>, pg8::DenseSched, true, false>(lds, DMA, DMA, DMA, S, E, 0);
            SEAM(pb + 9);
        }
        if (PH_ON(11) && IN(pb + 10)) {
            WS_PTRS();
            pg8::DenseSched S{(const char*)(ws + WS_XB), (const char*)(wb + W_R), D, D, T / 256, 1, 1, D, G, bx};
            pg8::EpiRouter E{(float*)(ws + WS_LOGIT)};
            pg8::gemm_phase<pg8::EpiRouter, pg8::DenseSched, true, false>(lds, D, D, D, S, E, 0);
            SEAM(pb + 10);
        }
        if (PH_ON(12) && IN(pb + 11)) {
            WS_PTRS();
            unsigned* cnt = (unsigned*)(ws + WS_CTL) + CW_CNT + l * 64;
            for (int w = bx; w < 256; w += G) route_phase((const float*)(ws + WS_LOGIT), STATP(l, ST_X2), INP(I_BRGRP) + l * 4, INP(I_BREXP) + l * 32, (int*)(ws + WS_MOE), (float*)(ws + WS_MOE + 128 * 1024),
                                                          (int*)(ws + WS_MOE + 384 * 1024), cnt, (LAS int*)lds, w, tid);
            SEAM(pb + 11);
        }
        if (PH_ON(13) && IN(pb + 12)) {
            WS_PTRS();
            unsigned* cnt = (unsigned*)(ws + WS_CTL) + CW_CNT + l * 64;
            for (int w = bx; w < 256; w += G) dispatch_phase(cnt, (const int*)(ws + WS_MOE + 384 * 1024), (const int*)(ws + WS_MOE), (const float*)(ws + WS_MOE + 128 * 1024), STATP(l, ST_X2),
                                                             (int*)(ws + WS_MOE + 256 * 1024), (int*)(ws + WS_MOE + 512 * 1024), (float*)(ws + WS_MOE + 704 * 1024), (float*)(ws + WS_MOE + 896 * 1024), (LAS int*)lds, w, tid);
            SEAM(pb + 12);
        }
        if (PH_ON(14) && IN(pb + 13)) {
            WS_PTRS();
            const int nrt = build_rtab((unsigned*)(ws + WS_CTL) + CW_CNT + l * 64, lc, tid);
            pg8::MoeUpSched S{(const char*)(ws + WS_XB), (const char*)(wb + W_GU), (const int*)(ws + WS_MOE + 512 * 1024), (const LAS int*)(lc + LC_RTAB / 4), nrt, G, bx};
            pg8::EpiSwiglu E{(bf16*)(rg + R_ACT), (const float*)(ws + WS_MOE + 896 * 1024)};
            pg8::gemm_phase<pg8::EpiSwiglu, pg8::MoeUpSched, true, false>(lds, D, D, D, S, E, 0);
            SEAM(pb + 13);
        }
        if (PH_ON(15) && IN(pb + 14)) {
            WS_PTRS();
            const int nrt = build_rtab((unsigned*)(ws + WS_CTL) + CW_CNT + l * 64, lc, tid);
            pg8::MoeDownSched S{(const char*)(rg + R_ACT), (const char*)(wb + W_D), (const LAS int*)(lc + LC_RTAB / 4), nrt, G, bx};
            pg8::EpiBf16<1, false> E{(bf16*)(rg + R_Y), D, (const float*)(ws + WS_MOE + 704 * 1024), 0.f, nullptr, nullptr, 0, 0};
            pg8::gemm_phase<pg8::EpiBf16<1, false>, pg8::MoeDownSched, true, false>(lds, DE, DE, DE, S, E, 0);
            SEAM(pb + 14);
        }
        if (PH_ON(16) && IN(pb + 15)) {
            WS_PTRS();
            const bool more = (l + 1 < DEPTH);
            combine_phase(probe ? (float*)(rg + R_AA) : out_ptr(), (const bf16*)(rg + R_Y), (const int*)(ws + WS_MOE + 256 * 1024), (bf16*)(ws + WS_XB), STATP((l + 1) % DEPTH, ST_X), !more, gw, NGW, lane);
            if (more) { LAS float* scr = (LAS float*)(lds + wave * 16384); convert_layer_weights(p, l + 1, scr, gw, NGW, lane, gtid, NGT); }
            SEAM(pb + 15);
        }
    }
#undef IN
#undef SEAM
}

#ifndef MK_SPLIT
#define MK_SPLIT 0
#endif
extern "C" void kernel_launch(void* const* d_in, const int* in_sizes, int n_in, void* d_out, int out_size, void* d_ws, size_t ws_size, hipStream_t stream) {
    static int grid = 0;
    if (grid == 0) {
        if (n_in != 36 || in_sizes[0] != T * D || out_size != T * D || ws_size < WS_END) {
            fprintf(stderr, "kernel_launch: unexpected shapes (n_in %d, in0 %d, out %d, ws %zu < %zu)\n", n_in, n_in > 0 ? in_sizes[0] : -1, out_size, ws_size, (size_t)WS_END); grid = -1; return; }
        int dev = 0, cus = 0, per_cu = 0;
        if (hipGetDevice(&dev) != hipSuccess || hipDeviceGetAttribute(&cus, hipDeviceAttributeMultiprocessorCount, dev) != hipSuccess) { grid = -1; return; }
        if (hipFuncSetAttribute((const void*)fwd_kernel, hipFuncAttributeMaxDynamicSharedMemorySize, LDS_BYTES) != hipSuccess) { fprintf(stderr, "kernel_launch: hipFuncSetAttribute failed\n"); grid = -1; return; }
        if (hipOccupancyMaxActiveBlocksPerMultiprocessor(&per_cu, (const void*)fwd_kernel, NTHREADS, LDS_BYTES) != hipSuccess || per_cu < 1)
            fprintf(stderr, "kernel_launch: occupancy query reports %d workgroups per CU\n", per_cu);
        (void)hipGetLastError();
        grid = cus;
    }
    if (grid < 0) return;
    if (hipMemsetAsync((char*)d_ws, 0, ZERO_BYTES, stream) != hipSuccess) return;
    Params a{};
    for (int i = 0; i < 36; ++i) a.in[i] = (const float*)d_in[i];
    a.out = (float*)d_out; a.ws = (unsigned char*)d_ws;
#if MK_SPLIT
    for (int ph = 0; ph < NPHASES; ++ph) { a.ph_lo = ph; a.ph_hi = ph + 1; hipLaunchKernelGGL(fwd_kernel, dim3(grid), dim3(NTHREADS), LDS_BYTES, stream, a); }
#else
    a.ph_lo = 0; a.ph_hi = NPHASES;
    hipLaunchKernelGGL(fwd_kernel, dim3(grid), dim3(NTHREADS), LDS_BYTES, stream, a);
#endif
#if defined(PROBE_PHASE)
    a.ph_lo = PROBE_PHASE; a.ph_hi = PROBE_PHASE + 1; a.probe = 1;
    for (int r = 0; r < PROBE_REPS; ++r) hipLaunchKernelGGL(fwd_kernel, dim3(grid), dim3(NTHREADS), LDS_BYTES, stream, a);
#endif
}
```

```cpp
#include <hip/hip_runtime.h>
#include <cstdio>
#include <cstdint>

#define GAS __attribute__((address_space(1)))
#define LAS __attribute__((address_space(3)))
typedef unsigned short bf16;
typedef short bf16x8 __attribute__((ext_vector_type(8)));
typedef short s16x4 __attribute__((ext_vector_type(4)));
typedef float f32x4 __attribute__((ext_vector_type(4)));
typedef float f32x2 __attribute__((ext_vector_type(2)));
typedef float f32x16 __attribute__((ext_vector_type(16)));
typedef unsigned u32x4 __attribute__((ext_vector_type(4)));
typedef unsigned u32x2 __attribute__((ext_vector_type(2)));

constexpr int NBATCH = 2, SEQ = 8192, T = NBATCH * SEQ, D = 2048, DEPTH = 2;
constexpr int NMEM = 256, TM = NBATCH * NMEM;
constexpr int QL = 512, KVL = 256, DRNN = 1024, DATT = 1024;
constexpr int NH = 8, QKH = 192, VH = 128;
constexpr int ZC = 3072;
constexpr int Z_CQ = 0, Z_CKV = 512, Z_XR = 768, Z_GATE = 1792, Z_KPE = 2816;
constexpr int NE = 32, DE = 512, NSLOT = 40960;
constexpr int NQU = NH * QKH;
constexpr int NKV = NH * 256;
constexpr int DMA = 512;
constexpr float EPS = 1e-6f;
constexpr int NWAVES = 8, NTHREADS = 512;

__device__ __forceinline__ unsigned f2bf(float f) { unsigned u = __builtin_bit_cast(unsigned, f); return (u + 0x7fffu + ((u >> 16) & 1u)) >> 16; }
__device__ __forceinline__ unsigned pk2(float lo, float hi) { return f2bf(lo) | (f2bf(hi) << 16); }
__device__ __forceinline__ float bf2f(unsigned short h) { return __builtin_bit_cast(float, (unsigned)h << 16); }
__device__ __forceinline__ float bflo(unsigned w) { return __builtin_bit_cast(float, w << 16); }
__device__ __forceinline__ float bfhi(unsigned w) { return __builtin_bit_cast(float, w & 0xffff0000u); }
__device__ __forceinline__ unsigned cvt_pk_bf16(float lo, float hi) { unsigned r; asm volatile("v_cvt_pk_bf16_f32 %0, %1, %2" : "=v"(r) : "v"(lo), "v"(hi)); return r; }
__device__ __forceinline__ float wave_sum(float v) {
#pragma unroll
    for (int o = 1; o < 64; o <<= 1) v += __shfl_xor(v, o);
    return v;
}
typedef unsigned long long u64;
__device__ __forceinline__ float ssq_val(const u64* p, int row) { return (float)p[row] * (1.0f / 16777216.0f); }
__device__ __forceinline__ void ssq_add(u64* p, int row, float v) { atomicAdd(p + row, (u64)(v * 16777216.0f)); }
__device__ __forceinline__ void ssq_set(u64* p, int row, float v) { p[row] = (u64)(v * 16777216.0f); }
#define LDS_WAIT() asm volatile("s_waitcnt lgkmcnt(0)" ::: "memory")
#define VM_WAIT() asm volatile("s_waitcnt vmcnt(0)" ::: "memory")

#define XB_TMO      128
#define XB_XCNT(j)  (256  + 64 * (j))
#define XB_XSUB(j)  (1280 + 64 * (j))
#define XB_XGEN(j)  (2304 + 64 * (j))
#define XB_TOP      3328
#define XB_TOPGEN   3392
#define XCD_BAR_WORDS 3456
#define XB_SPIN_CAP (1u << 18)
__device__ __forceinline__ unsigned xb_ld(unsigned* p)              { return __hip_atomic_load(p, __ATOMIC_RELAXED, __HIP_MEMORY_SCOPE_AGENT); }
__device__ __forceinline__ unsigned xb_add(unsigned* p, unsigned v) { return __hip_atomic_fetch_add(p, v, __ATOMIC_RELAXED, __HIP_MEMORY_SCOPE_AGENT); }
__device__ __forceinline__ unsigned xb_xcc_id() { return (unsigned)__builtin_amdgcn_s_getreg((3 << 11) | 20) & 0xFu; }
#define XB_SPIN(cond, bar) do { unsigned _sp = 0; while (cond) { __builtin_amdgcn_s_sleep(1); \
    if ((++_sp & 255u) == 0u) { if (xb_ld(&(bar)[XB_TMO])) break; if (_sp > XB_SPIN_CAP) { atomicAdd(&(bar)[XB_TMO], 1u); break; } } } } while (0)
struct XcdBarrier { unsigned* bar; unsigned x; volatile LAS unsigned* st; };
__device__ __forceinline__ XcdBarrier xcd_barrier_post(unsigned* bar, volatile LAS unsigned* st) {
    XcdBarrier b; b.bar = bar; b.x = xb_xcc_id(); b.st = st;
    if (threadIdx.x == 0) (void)xb_add(&bar[XB_XCNT(b.x)], 1u);
    return b;
}
__device__ __forceinline__ void xcd_barrier_complete(unsigned* bar, unsigned x, unsigned& nloc, unsigned& nx) {
    const unsigned G = gridDim.x * gridDim.y * gridDim.z;
    unsigned sum, cnt, mine, sp = 0u;
    for (;;) {
        sum = 0u; cnt = 0u; mine = 0u;
#pragma unroll
        for (unsigned j = 0; j < 16; ++j) { const unsigned c = xb_ld(&bar[XB_XCNT(j)]); sum += c; cnt += (c > 0u) ? 1u : 0u; mine = (j == x) ? c : mine; }
        if (sum == G) break;
        __builtin_amdgcn_s_sleep(1);
        if ((++sp & 255u) == 0u) { if (xb_ld(&bar[XB_TMO])) break; if (sp > XB_SPIN_CAP) { atomicAdd(&bar[XB_TMO], 1u); break; } }
    }
    nloc = mine > 0u ? mine : 1u; nx = cnt > 0u ? cnt : 1u;
}
__device__ __forceinline__ void xcd_barrier(const XcdBarrier& b) {
    asm volatile("s_waitcnt vmcnt(0)" ::: "memory");
    __syncthreads();
    if (threadIdx.x == 0) {
        unsigned* bar = b.bar; unsigned bx_ = b.x; asm volatile("" : "+s"(bar), "+s"(bx_));
        __builtin_amdgcn_s_waitcnt(0);
        unsigned nloc = b.st[0], nx = b.st[1];
        if (nloc == 0u) { xcd_barrier_complete(bar, bx_, nloc, nx); b.st[0] = nloc; b.st[1] = nx; }
        const unsigned old = xb_add(&bar[XB_XSUB(bx_)], 1u);
        const unsigned gen = old / nloc;
        if (old + 1u == (gen + 1u) * nloc) {
            __builtin_amdgcn_fence(__ATOMIC_RELEASE, "agent");
            asm volatile("s_waitcnt vmcnt(0)" ::: "memory");
            const unsigned og = xb_add(&bar[XB_TOP], 1u);
            const unsigned tg = og / nx;
            if (og + 1u == (tg + 1u) * nx) xb_add(&bar[XB_TOPGEN], 1u);
            else XB_SPIN(xb_ld(&bar[XB_TOPGEN]) == tg, bar);
            __builtin_amdgcn_fence(__ATOMIC_ACQUIRE, "agent");
            xb_add(&bar[XB_XGEN(bx_)], 1u);
            asm volatile("s_waitcnt vmcnt(0)" ::: "memory");
        } else {
            XB_SPIN(xb_ld(&bar[XB_XGEN(bx_)]) == gen, bar);
            __builtin_amdgcn_fence(__ATOMIC_ACQUIRE, "agent");
            asm volatile("s_waitcnt vmcnt(0)" ::: "memory");
        }
    }
    __syncthreads();
}

namespace pg8 {
constexpr int BM = 256, BK = 64, HALF = 128, HTB = HALF * BK * 2, STAGE_BYTES = 8 * HTB, NXCD = 8, WGM = 8;
__host__ __device__ __forceinline__ int lds_byte(int r, int c) { const int st = (r >> 4) * 2 + (c >> 5), rr = r & 15, cc = c & 31, ob = rr * 64 + cc * 2; return st * 1024 + (ob ^ (((ob >> 9) & 1) << 5)); }
__host__ __device__ __forceinline__ void stage_rc(int b, int& R, int& C) { const int st = b / 1024, sb = b % 1024, swz = sb ^ (((sb >> 9) & 1) << 5); R = (st >> 1) * 16 + swz / 64; C = (st & 1) * 32 + (swz % 64) / 2; }
__host__ __device__ __forceinline__ int perm32(int rho) { const int n = rho >> 4, i = rho & 15; return 8 * (i >> 2) + 4 * n + (i & 3); }

struct Unit { const char* A; const char* B; int pm, pn, aux; };

__device__ __forceinline__ bool static_tile(int i, int G, int c, int nM, int nN, int& pm, int& pn) {
    const int nwg = nM * nN; const long L = (long)i * G + c; if (L >= nwg) return false;
    int wgid = (int)L; { const int q = nwg / NXCD, r = nwg % NXCD, xcd = wgid % NXCD, off = wgid / NXCD; wgid = (xcd < r ? xcd * (q + 1) : r * (q + 1) + (xcd - r) * q) + off; }
    const int nig = WGM * nN, gid = wgid / nig, fm = gid * WGM, gsz = (nM - fm) < WGM ? (nM - fm) : WGM;
    pm = fm + ((wgid % nig) % gsz); pn = (wgid % nig) / gsz; return true;
}

template <class Epi, class Sched, bool ALIGN_EPI, bool MID>
__device__ __forceinline__ void gemm_phase(LAS unsigned char* lds, const int K, const int lda, const int ldb, const Sched& S, const Epi& E, const int mid_t) {
    constexpr bool GATHER = Sched::GATHER;
    int tid = threadIdx.x; asm volatile("" : "+v"(tid)); const int wid = __builtin_amdgcn_readfirstlane(tid >> 6), lane = tid & 63, wr = wid >> 2, wc = wid & 3, fr = lane & 15, fq = lane >> 4;
    const int nt = K / BK;
    unsigned voffA[2], voffB[2];
#pragma unroll
    for (int i = 0; i < 2; ++i) { int R, C; stage_rc(tid * 16 + i * 8192, R, C); const int Rb = Epi::PERM ? ((R & ~31) + perm32(R & 31)) : R;
        voffA[i] = (unsigned)(R * lda + C) * 2u; voffB[i] = (unsigned)(Rb * ldb + C) * 2u; }
    const size_t kstep = (size_t)(BK * 2);
    const size_t hstepA = GATHER ? (size_t)0 : (size_t)HALF * lda * 2;
    const size_t hstepB = (size_t)HALF * ldb * 2;
    const unsigned ldsw = (unsigned)wid * 1024u;
    const int aoff = lds_byte(wr * 64 + fr, fq * 8), boff = lds_byte(wc * 32 + fr, fq * 8);
#define PG8_SA(b, h) (((b) * 2 + (h)) * HTB)
#define PG8_SB(b, h) ((4 + (b) * 2 + (h)) * HTB)
#define PG8_STAGE(bufoff, gbase, voff) do { _Pragma("unroll") for (int _i = 0; _i < 2; ++_i) \
        __builtin_amdgcn_global_load_lds((const unsigned*)((const char*)(gbase) + (voff)[_i]), (LAS unsigned*)(lds + (bufoff) + ldsw + _i * 8192), 16, 0, 0); } while (0)
#define PG8_LDA(dst, b, h) do { _Pragma("unroll") for (int m = 0; m < 4; ++m) _Pragma("unroll") for (int k = 0; k < 2; ++k) dst[m][k] = *(const LAS bf16x8*)(lds + PG8_SA(b, h) + aoff + m * 2048 + k * 1024); } while (0)
#define PG8_LDB(dst, b, h) do { _Pragma("unroll") for (int n = 0; n < 2; ++n) _Pragma("unroll") for (int k = 0; k < 2; ++k) dst[n][k] = *(const LAS bf16x8*)(lds + PG8_SB(b, h) + boff + n * 2048 + k * 1024); } while (0)
#define PG8_MMA(ai, bj, At, Bt) do { __builtin_amdgcn_s_setprio(1); _Pragma("unroll") for (int m = 0; m < 4; ++m) _Pragma("unroll") for (int n = 0; n < 2; ++n) _Pragma("unroll") for (int k = 0; k < 2; ++k) \
        acc[ai][bj][m][n] = __builtin_amdgcn_mfma_f32_16x16x32_bf16(Bt[n][k], At[m][k], acc[ai][bj][m][n], 0, 0, 0); __builtin_amdgcn_s_setprio(0); } while (0)
#define PG8_WAIT_V(n) asm volatile("s_waitcnt vmcnt(" #n ")" ::: "memory")
#define PG8_WAIT_L(n) asm volatile("s_waitcnt lgkmcnt(" #n ")" ::: "memory")
#define PG8_BAR __builtin_amdgcn_s_barrier()
#define PG8_SCHED __builtin_amdgcn_sched_barrier(0)
    Unit cur, nxt; int ui = 0;
    if (!S.next(0, cur)) return;
    f32x4 acc[2][2][4][2];
#pragma unroll
    for (int a = 0; a < 2; ++a)
#pragma unroll
        for (int b = 0; b < 2; ++b)
#pragma unroll
            for (int m = 0; m < 4; ++m)
#pragma unroll
                for (int n = 0; n < 2; ++n) acc[a][b][m][n] = (f32x4){0.f, 0.f, 0.f, 0.f};
    bf16x8 At[4][2], B0[2][2], B1[2][2];
    unsigned gA0[2], gA1[2], gN0[2], gN1[2];
    if constexpr (GATHER) {
#pragma unroll
        for (int i = 0; i < 2; ++i) { int R, C; stage_rc(tid * 16 + i * 8192, R, C); gA0[i] = S.arow(cur, R) + (unsigned)C * 2u; gA1[i] = S.arow(cur, HALF + R) + (unsigned)C * 2u; gN0[i] = gA0[i]; gN1[i] = gA1[i]; }
    }
#define PG8_STAGE_A(b, h, gbase, G0, G1) do { if constexpr (GATHER) { if ((h) == 0) PG8_STAGE(PG8_SA(b, h), gbase, G0); else PG8_STAGE(PG8_SA(b, h), gbase, G1); } \
        else PG8_STAGE(PG8_SA(b, h), (gbase) + (h) * hstepA, voffA); } while (0)
    const char* cA = cur.A; const char* cB = cur.B;
    PG8_STAGE(PG8_SB(0, 0), cB, voffB); PG8_STAGE(PG8_SB(0, 1), cB + hstepB, voffB); PG8_STAGE_A(0, 0, cA, gA0, gA1); PG8_STAGE_A(0, 1, cA, gA0, gA1);
    if (wr == 1) PG8_BAR;
    PG8_WAIT_V(2); PG8_BAR;
    PG8_STAGE(PG8_SB(1, 0), cB + kstep, voffB); PG8_STAGE_A(1, 0, cA + kstep, gA0, gA1); PG8_STAGE(PG8_SB(1, 1), cB + hstepB + kstep, voffB);
    PG8_WAIT_V(6); PG8_BAR;
    for (;;) {
        const bool has_next = S.next(ui + 1, nxt);
        const char* nA = has_next ? nxt.A : cA; const char* nB = has_next ? nxt.B : cB;
        if constexpr (GATHER) {
            if (has_next) {
#pragma unroll
                for (int i = 0; i < 2; ++i) { int R, C; stage_rc(tid * 16 + i * 8192, R, C); gN0[i] = S.arow(nxt, R) + (unsigned)C * 2u; gN1[i] = S.arow(nxt, HALF + R) + (unsigned)C * 2u; }
            }
        }
#pragma nounroll
        for (int t = 0; t < nt; t += 2) {
            const bool last = (t == nt - 2);
            if constexpr (MID) { if (t == mid_t) E.mid(acc, cur, wr, wc, fr, fq); }
            const char* a1 = cA + (size_t)(t + 1) * kstep;
            const char* a2 = last ? nA : cA + (size_t)(t + 2) * kstep; const char* b2 = last ? nB : cB + (size_t)(t + 2) * kstep;
            const char* a3 = a2 + kstep; const char* b3 = b2 + kstep;
            unsigned w0[2], w1[2];
            if constexpr (GATHER) {
#pragma unroll
                for (int i = 0; i < 2; ++i) { w0[i] = last ? gN0[i] : gA0[i]; w1[i] = last ? gN1[i] : gA1[i]; }
            }
            PG8_LDB(B0, 0, 0); PG8_LDB(B1, 0, 1); PG8_SCHED; PG8_LDA(At, 0, 0); PG8_STAGE_A(1, 1, a1, gA0, gA1);
            PG8_WAIT_V(8); PG8_WAIT_L(0); PG8_BAR; PG8_MMA(0, 0, At, B0); PG8_MMA(0, 1, At, B1); PG8_BAR; PG8_SCHED;
            PG8_LDA(At, 0, 1); PG8_STAGE(PG8_SB(0, 0), b2, voffB); PG8_STAGE(PG8_SB(0, 1), b2 + hstepB, voffB); PG8_STAGE_A(0, 0, a2, w0, w1);
            PG8_WAIT_V(8); PG8_WAIT_L(0); PG8_BAR; PG8_MMA(1, 0, At, B0); PG8_MMA(1, 1, At, B1); PG8_BAR; PG8_SCHED;
            PG8_LDB(B0, 1, 0); PG8_LDB(B1, 1, 1); PG8_SCHED; PG8_LDA(At, 1, 0); PG8_STAGE_A(0, 1, a2, w0, w1);
            PG8_WAIT_V(8); PG8_WAIT_L(0); PG8_BAR; PG8_MMA(0, 0, At, B0); PG8_MMA(0, 1, At, B1); PG8_BAR; PG8_SCHED;
            PG8_LDA(At, 1, 1); PG8_STAGE(PG8_SB(1, 0), b3, voffB); PG8_STAGE(PG8_SB(1, 1), b3 + hstepB, voffB); PG8_STAGE_A(1, 0, a3, w0, w1);
            PG8_WAIT_V(8); PG8_WAIT_L(0); PG8_BAR; PG8_MMA(1, 0, At, B0); PG8_MMA(1, 1, At, B1); PG8_BAR; PG8_SCHED;
        }
        if constexpr (ALIGN_EPI) { if (wr == 0) PG8_BAR; }
        E(acc, cur, wr, wc, fr, fq);
        if (!has_next) break;
#pragma unroll
        for (int a = 0; a < 2; ++a)
#pragma unroll
            for (int b = 0; b < 2; ++b)
#pragma unroll
                for (int m = 0; m < 4; ++m)
#pragma unroll
                    for (int n = 0; n < 2; ++n) acc[a][b][m][n] = (f32x4){0.f, 0.f, 0.f, 0.f};
        cur = nxt; cA = nA; cB = nB; ++ui;
        if constexpr (GATHER) {
#pragma unroll
            for (int i = 0; i < 2; ++i) { gA0[i] = gN0[i]; gA1[i] = gN1[i]; }
        }
        if constexpr (ALIGN_EPI) { if (wr == 1) PG8_BAR; }
    }
    PG8_WAIT_V(0);
    if constexpr (!ALIGN_EPI) { if (wr == 0) PG8_BAR; }
    PG8_BAR;
#undef PG8_SA
#undef PG8_SB
#undef PG8_STAGE
#undef PG8_STAGE_A
#undef PG8_LDA
#undef PG8_LDB
#undef PG8_MMA
#undef PG8_WAIT_V
#undef PG8_WAIT_L
#undef PG8_BAR
#undef PG8_SCHED
}
}
namespace pg8 {
struct DenseSched {
    static constexpr bool GATHER = false;
    const char* A; const char* B; int lda, ldb, nM, nN, nKS, Ksplit, G, c;
    __device__ __forceinline__ bool next(int i, Unit& u) const {
        int pm, pc; if (!static_tile(i, G, c, nM, nN * nKS, pm, pc)) return false;
        const int pn = pc / nKS, ks = pc - pn * nKS;
        u.pm = pm; u.pn = pn; u.aux = ks;
        u.A = A + ((size_t)pm * BM * lda + (size_t)ks * Ksplit) * 2;
        u.B = B + ((size_t)pn * BM * ldb + (size_t)ks * Ksplit) * 2;
        return true;
    }
    __device__ __forceinline__ unsigned arow(const Unit&, int r) const { return (unsigned)(r * lda) * 2u; }
};
struct GateSched {
    static constexpr bool GATHER = false;
    const char* A; const char* B; int G, c;
    __device__ __forceinline__ bool next(int i, Unit& u) const {
        int pm, pn; if (!static_tile(i, G, c, T / BM, 8, pm, pn)) return false;
        u.pm = pm; u.pn = pn; u.aux = 0;
        u.A = A + ((size_t)pm * BM * DRNN + (size_t)(pn >> 1) * 256) * 2;
        u.B = B + (size_t)pn * 256 * 256 * 2;
        return true;
    }
    __device__ __forceinline__ unsigned arow(const Unit&, int r) const { return (unsigned)(r * DRNN) * 2u; }
};
struct MoeUpSched {      static constexpr bool GATHER = true;
    const char* A; const char* B; const LAS int* ltok; const LAS int* rtab; int nrt, G, c;
    __device__ __forceinline__ bool next(int i, Unit& u) const {
        const long L = (long)i * G + c; if (L >= (long)nrt * 4) return false;
        const int rt = (int)(L >> 2), pn = (int)(L & 3); const int e = rtab[2 * rt], row0 = rtab[2 * rt + 1];
        u.pm = row0 >> 8; u.pn = pn; u.aux = i; u.A = A;
        u.B = B + ((size_t)e * 1024 * D + (size_t)pn * BM * D) * 2;
        return true;
    }
    __device__ __forceinline__ unsigned arow(const Unit& u, int r) const { return (unsigned)ltok[u.aux * BM + r] * (unsigned)(D * 2); }
};
struct MoeDownSched {    static constexpr bool GATHER = false;
    const char* A; const char* B; const LAS int* rtab; int nrt, G, c;
    __device__ __forceinline__ bool next(int i, Unit& u) const {
        const long L = (long)i * G + c; if (L >= (long)nrt * 8) return false;
        const int rt = (int)(L >> 3), pn = (int)(L & 7); const int e = rtab[2 * rt], row0 = rtab[2 * rt + 1];
        u.pm = row0 >> 8; u.pn = pn; u.aux = e;
        u.A = A + (size_t)row0 * DE * 2;
        u.B = B + ((size_t)e * D * DE + (size_t)pn * BM * DE) * 2;
        return true;
    }
    __device__ __forceinline__ unsigned arow(const Unit&, int r) const { return (unsigned)(r * DE) * 2u; }
};

__device__ __forceinline__ void unpack8x(u32x4 w, float* v) { v[0] = bflo(w.x); v[1] = bfhi(w.x); v[2] = bflo(w.y); v[3] = bfhi(w.y); v[4] = bflo(w.z); v[5] = bfhi(w.z); v[6] = bflo(w.w); v[7] = bfhi(w.w); }
__device__ __forceinline__ void epi_ids(int& wr, int& wc, int& fr, int& fq) { int t = threadIdx.x; asm volatile("" : "+v"(t)); const int wid = t >> 6, lane = t & 63; wr = wid >> 2; wc = wid & 3; fr = lane & 15; fq = lane >> 4; }
template <int MODE, bool STAT> struct EpiBf16 {
    static constexpr bool PERM = true;
    bf16* O; int ldc; const void* rs; float inv_n; u64* stat_a; u64* stat_b; int stat_pn_a, stat_pn_b;
    __device__ __forceinline__ void operator()(const f32x4 (&acc)[2][2][4][2], const Unit& u, int, int, int, int) const {
        int wr, wc, fr, fq; epi_ids(wr, wc, fr, fq);
        int row0 = u.pm * BM + wr * 64 + fr; asm volatile("" : "+v"(row0)); const int col0 = u.pn * BM + wc * 32 + 8 * fq;
        u64* st = nullptr; if (STAT) st = (u.pn < stat_pn_a) ? stat_a : ((u.pn < stat_pn_b) ? stat_b : nullptr);
#pragma unroll
        for (int ai = 0; ai < 2; ++ai)
#pragma unroll
            for (int m = 0; m < 4; ++m) { const int row = row0 + ai * HALF + m * 16;
                float sc = 1.f;
                if (MODE == 0) sc = 1.0f / sqrtf(ssq_val((const u64*)rs, row) * inv_n + EPS); else if (MODE == 1) sc = ((const float*)rs)[row];
                bf16* rowp = O + (size_t)row * ldc + col0; float ss = 0.f;
#pragma unroll
                for (int bj = 0; bj < 2; ++bj) { const f32x4 v0 = acc[ai][bj][m][0] * sc, v1 = acc[ai][bj][m][1] * sc;
                    if (STAT) ss += (v0[0] * v0[0] + v0[1] * v0[1]) + (v0[2] * v0[2] + v0[3] * v0[3]) + (v1[0] * v1[0] + v1[1] * v1[1]) + (v1[2] * v1[2] + v1[3] * v1[3]);
                    u32x4 w; w.x = cvt_pk_bf16(v0[0], v0[1]); w.y = cvt_pk_bf16(v0[2], v0[3]); w.z = cvt_pk_bf16(v1[0], v1[1]); w.w = cvt_pk_bf16(v1[2], v1[3]);
                    *(u32x4*)(rowp + bj * HALF) = w; }
                if (STAT) { ss += __shfl_xor(ss, 16); ss += __shfl_xor(ss, 32); if (st != nullptr && fq == 0) ssq_add(st, row, ss); }
            }
    }
};
struct EpiF32Slab {
    static constexpr bool PERM = false;
    float* O; int ldc; size_t slab; const u64* rs; float inv_n;
    __device__ __forceinline__ void operator()(const f32x4 (&acc)[2][2][4][2], const Unit& u, int, int, int, int) const {
        int wr, wc, fr, fq; epi_ids(wr, wc, fr, fq);
        int row0 = u.pm * BM + wr * 64 + fr; asm volatile("" : "+v"(row0)); const int col0 = u.pn * BM + wc * 32 + 4 * fq; float* base = O + (size_t)u.aux * slab;
#pragma unroll
        for (int ai = 0; ai < 2; ++ai)
#pragma unroll
            for (int m = 0; m < 4; ++m) { const int row = row0 + ai * HALF + m * 16; const float sc = 1.0f / sqrtf(ssq_val(rs, row) * inv_n + EPS);
                float* rowp = base + (size_t)row * ldc + col0;
#pragma unroll
                for (int bj = 0; bj < 2; ++bj)
#pragma unroll
                    for (int n = 0; n < 2; ++n) *(f32x4*)(rowp + bj * HALF + n * 16) = acc[ai][bj][m][n] * sc; }
    }
};
template <bool SCALE> struct EpiResid {
    static constexpr bool PERM = true;
    bf16* xb; u64* stat; const u64* ssq_a; const u64* ssq_b;
    __device__ __forceinline__ void mid(f32x4 (&acc)[2][2][4][2], const Unit& u, int, int, int, int) const {
        int wr, wc, fr, fq; epi_ids(wr, wc, fr, fq);
        int row0 = u.pm * BM + wr * 64 + fr; asm volatile("" : "+v"(row0));
#pragma unroll
        for (int ai = 0; ai < 2; ++ai)
#pragma unroll
            for (int m = 0; m < 4; ++m) { const int row = row0 + ai * HALF + m * 16;
                const float ra = 1.0f / sqrtf(ssq_val(ssq_a, row) * (1.0f / 1024.0f) + EPS), rb = 1.0f / sqrtf(ssq_val(ssq_b, row) * (1.0f / 1024.0f) + EPS); const float f = ra / rb;
#pragma unroll
                for (int bj = 0; bj < 2; ++bj)
#pragma unroll
                    for (int n = 0; n < 2; ++n) acc[ai][bj][m][n] = acc[ai][bj][m][n] * f; }
    }
    __device__ __forceinline__ void operator()(const f32x4 (&acc)[2][2][4][2], const Unit& u, int, int, int, int) const {
        int wr, wc, fr, fq; epi_ids(wr, wc, fr, fq);
        int row0 = u.pm * BM + wr * 64 + fr; asm volatile("" : "+v"(row0)); const int col0 = u.pn * BM + wc * 32 + 8 * fq;
        GAS bf16* xg = (GAS bf16*)xb;
#pragma unroll
        for (int ai = 0; ai < 2; ++ai) {
            u32x4 xr[4][2];
#pragma unroll
            for (int m = 0; m < 4; ++m)
#pragma unroll
                for (int bj = 0; bj < 2; ++bj) xr[m][bj] = *(const GAS u32x4*)(xg + (unsigned)(row0 + ai * HALF + m * 16) * (unsigned)D + (unsigned)(col0 + bj * HALF));
#pragma unroll
            for (int m = 0; m < 4; ++m) { const int row = row0 + ai * HALF + m * 16;
                float sc = 1.f; if (SCALE) sc = 1.0f / sqrtf(ssq_val(ssq_b, row) * (1.0f / 1024.0f) + EPS);
                const unsigned off = (unsigned)row * (unsigned)D + (unsigned)col0; float ss = 0.f;
#pragma unroll
                for (int bj = 0; bj < 2; ++bj) { float xv[8], v[8]; unpack8x(xr[m][bj], xv);
#pragma unroll
                    for (int n = 0; n < 2; ++n)
#pragma unroll
                        for (int j = 0; j < 4; ++j) { v[n * 4 + j] = xv[n * 4 + j] + acc[ai][bj][m][n][j] * sc; ss += v[n * 4 + j] * v[n * 4 + j]; }
                    u32x4 w; w.x = cvt_pk_bf16(v[0], v[1]); w.y = cvt_pk_bf16(v[2], v[3]); w.z = cvt_pk_bf16(v[4], v[5]); w.w = cvt_pk_bf16(v[6], v[7]);
                    *(GAS u32x4*)(xg + off + bj * HALF) = w; }
                ss += __shfl_xor(ss, 16); ss += __shfl_xor(ss, 32); if (fq == 0) ssq_add(stat, row, ss);
            }
            asm volatile("" ::: "memory"); __builtin_amdgcn_sched_barrier(0);
        }
    }
};
struct EpiGates {
    static constexpr bool PERM = false;
    const bf16* xc; const float* b_rg; const float* b_ig; const float* sp; float* a_out; float* u_out;
    __device__ __forceinline__ void operator()(const f32x4 (&acc)[2][2][4][2], const Unit& u, int, int, int, int) const {
        int wr, wc, fr, fq; epi_ids(wr, wc, fr, fq);
        const unsigned row0 = (unsigned)(u.pm * BM + wr * 64 + fr);
        const GAS bf16* xg = (const GAS bf16*)xc; GAS float* ag = (GAS float*)a_out; GAS float* ug = (GAS float*)u_out;
#pragma unroll
        for (int n = 0; n < 2; ++n) { const unsigned ch = (unsigned)(u.pn * 128 + wc * 32 + n * 16 + 4 * fq);
            const f32x4 br = *(const GAS f32x4*)((const GAS float*)b_rg + ch), bi = *(const GAS f32x4*)((const GAS float*)b_ig + ch), s4 = *(const GAS f32x4*)((const GAS float*)sp + ch);
            u32x2 xws[2][4];
#pragma unroll
            for (int ai = 0; ai < 2; ++ai)
#pragma unroll
                for (int m = 0; m < 4; ++m) xws[ai][m] = *(const GAS u32x2*)(xg + (row0 + (unsigned)(ai * HALF + m * 16)) * (unsigned)DRNN + ch);
#pragma unroll
            for (int ai = 0; ai < 2; ++ai)
#pragma unroll
                for (int m = 0; m < 4; ++m) { const unsigned off = (row0 + (unsigned)(ai * HALF + m * 16)) * (unsigned)DRNN + ch;
                    const u32x2 xw = xws[ai][m]; const float xv[4] = {bflo(xw.x), bfhi(xw.x), bflo(xw.y), bfhi(xw.y)};
                    const f32x4 pr = acc[ai][0][m][n] + br, pi = acc[ai][1][m][n] + bi; f32x4 av, uv;
#pragma unroll
                    for (int j = 0; j < 4; ++j) { const float r = __builtin_amdgcn_rcpf(1.0f + __expf(-pr[j])), ig = __builtin_amdgcn_rcpf(1.0f + __expf(-pi[j]));
                        const float la = -8.0f * r * s4[j]; const float a = __expf(la); const float x2 = 2.0f * la;
                        const float om = (x2 > -0.03125f) ? -x2 * (1.0f + x2 * (0.5f + x2 * (0.16666667f + x2 * 0.041666668f))) : 1.0f - a * a;
                        av[j] = a; uv[j] = __builtin_amdgcn_sqrtf(om) * (ig * xv[j]); }
                    *(GAS f32x4*)(ag + off) = av; *(GAS f32x4*)(ug + off) = uv; }
        }
    }
};
struct EpiSwiglu {
    static constexpr bool PERM = true;
    bf16* O; const float* rs;
    __device__ __forceinline__ void operator()(const f32x4 (&acc)[2][2][4][2], const Unit& u, int, int, int, int) const {
        int wr, wc, fr, fq; epi_ids(wr, wc, fr, fq);
        int row0 = u.pm * BM + wr * 64 + fr; asm volatile("" : "+v"(row0)); const int col0 = u.pn * 128 + wc * 32 + 8 * fq;
#pragma unroll
        for (int ai = 0; ai < 2; ++ai)
#pragma unroll
            for (int m = 0; m < 4; ++m) { const int row = row0 + ai * HALF + m * 16; const float sc = rs[row]; float h[8];
#pragma unroll
                for (int n = 0; n < 2; ++n)
#pragma unroll
                    for (int j = 0; j < 4; ++j) { const float g = acc[ai][0][m][n][j] * sc, up = acc[ai][1][m][n][j] * sc; h[n * 4 + j] = g / (1.0f + __expf(-g)) * up; }
                u32x4 w; w.x = cvt_pk_bf16(h[0], h[1]); w.y = cvt_pk_bf16(h[2], h[3]); w.z = cvt_pk_bf16(h[4], h[5]); w.w = cvt_pk_bf16(h[6], h[7]);
                *(u32x4*)(O + (size_t)row * DE + col0) = w; }
    }
};
struct EpiRouter {
    static constexpr bool PERM = false;
    float* O;
    __device__ __forceinline__ void operator()(const f32x4 (&acc)[2][2][4][2], const Unit& u, int, int, int, int) const {
        int wr, wc, fr, fq; epi_ids(wr, wc, fr, fq);
        if (wc >= 2) return;
        float* Os = O + (size_t)u.aux * ((size_t)T * 64);
        int row0 = u.pm * BM + wr * 64 + fr; asm volatile("" : "+v"(row0)); const int col0 = wc * 32 + 4 * fq;
#pragma unroll
        for (int ai = 0; ai < 2; ++ai)
#pragma unroll
            for (int m = 0; m < 4; ++m) { const int row = row0 + ai * HALF + m * 16;
#pragma unroll
                for (int n = 0; n < 2; ++n) *(f32x4*)(Os + (size_t)row * 64 + col0 + n * 16) = acc[ai][0][m][n]; }
    }
};
}
namespace att {
constexpr int NW = 8, QBLK = 32, KVBLK = 64, QB = NW * QBLK;
constexpr int SHM_V = KVBLK * 128 * 2, SHM_K = KVBLK * 128 * 2, SHM_R = KVBLK * 64 * 2;
constexpr int OFF_V = 0, OFF_K = 2 * SHM_V, OFF_R = OFF_K + 2 * SHM_K, OFF_WS = OFF_R + 2 * SHM_R, OFF_QR = OFF_WS + NW * 64 * 4, LDS_BYTES = OFF_QR + NW * 4 * 1024;
constexpr float THR = 8.f;

#define KSWZ(row, colB) ((row) * 256 + ((colB) ^ (((row) & 7) << 4)))
#define RSWZ(row, ch) ((row) * 128 + ((((ch) ^ (((row) >> 1) & 7))) << 4))
#define SBAR() __builtin_amdgcn_sched_barrier(0)
__device__ __forceinline__ int v_st(int k, int c) { const int kk = (k & ~0xC) | ((k & 4) << 1) | ((k & 8) >> 1); return ((kk >> 3) * 4 + (c >> 5)) * 512 + ((kk & 7) * 32 + (c & 31)) * 2; }
__device__ __forceinline__ int v_rd_base(int lane) { return ((lane & 3) << 3) | (((lane >> 2) & 3) << 6) | (((lane >> 4) & 1) << 5) | (((lane >> 5) & 1) << 8); }
constexpr int v_rd_off(int d0, int ks, int half) { return d0 * 512 + ks * 4096 + half * 2048; }
__device__ __forceinline__ int crow(int r, int hi) { return (r & 3) + 8 * (r >> 2) + 4 * hi; }
__device__ __forceinline__ unsigned cvtpk(float lo, float hi) { unsigned r; asm volatile("v_cvt_pk_bf16_f32 %0, %1, %2" : "=v"(r) : "v"(lo), "v"(hi)); return r; }
__device__ __forceinline__ bf16x8 load8(const bf16* p) { return *reinterpret_cast<const bf16x8*>(p); }

__device__ __forceinline__ void mask_tile(f32x16& p0, f32x16& p1, int dq) {
    const float NEG = -__builtin_inff();
#pragma unroll
    for (int r = 0; r < 16; ++r) {
        const int c = (r & 3) + 8 * (r >> 2);
        if (dq - c < 0) p0[r] = NEG;
        if (dq - c - 32 < 0) p1[r] = NEG;
    }
}
__device__ __forceinline__ void partialSM(f32x16& p0, f32x16& p1, float& m_reg, float& mn, float& alpha, const float SCALE) {
    float pmax = p0[0]; for (int r = 1; r < 16; ++r) pmax = fmaxf(pmax, p0[r]); for (int r = 0; r < 16; ++r) pmax = fmaxf(pmax, p1[r]);
    { auto rr = __builtin_amdgcn_permlane32_swap(__float_as_uint(pmax), __float_as_uint(pmax), false, false);
      pmax = fmaxf(__uint_as_float(rr[0]), __uint_as_float(rr[1])); }
    const float C2 = 1.4426950408889634f * SCALE;
    if (__builtin_expect(__all((pmax - m_reg) * SCALE <= THR), 1)) { mn = m_reg; alpha = 1.f; }
    else { mn = fmaxf(m_reg, pmax); alpha = __builtin_amdgcn_exp2f((m_reg - mn) * C2); m_reg = mn; }
    const float mnL = -mn * C2;
    for (int r = 0; r < 16; ++r) p0[r] = fmaf(p0[r], C2, mnL); for (int r = 0; r < 16; ++r) p1[r] = fmaf(p1[r], C2, mnL);
    for (int r = 0; r < 16; ++r) p0[r] = __builtin_amdgcn_exp2f(p0[r]);
}
__device__ __forceinline__ void finishSM(f32x16& p0, f32x16& p1, float alpha, float& l_reg, bf16x8& pa0, bf16x8& pa1, bf16x8& pa2, bf16x8& pa3) {
    for (int r = 0; r < 16; ++r) p1[r] = __builtin_amdgcn_exp2f(p1[r]);
    float ps = 0; for (int r = 0; r < 16; ++r) ps += p0[r]; for (int r = 0; r < 16; ++r) ps += p1[r];
    { auto rr = __builtin_amdgcn_permlane32_swap(__float_as_uint(ps), __float_as_uint(ps), false, false);
      ps = __uint_as_float(rr[0]) + __uint_as_float(rr[1]); }
    l_reg = l_reg * alpha + ps;
#define PK4(P, B_, OUT) do { unsigned a0 = cvtpk(P[B_+0], P[B_+1]), a1 = cvtpk(P[B_+2], P[B_+3]);                          \
        unsigned b0 = cvtpk(P[B_+4], P[B_+5]), b1 = cvtpk(P[B_+6], P[B_+7]);                                             \
        auto r0 = __builtin_amdgcn_permlane32_swap(a0, b0, false, false); auto r1 = __builtin_amdgcn_permlane32_swap(a1, b1, false, false); \
        u32x4 w = {r0[0], r1[0], r0[1], r1[1]}; OUT = *reinterpret_cast<bf16x8*>(&w); } while (0)
    PK4(p0, 0, pa0); PK4(p0, 8, pa1); PK4(p1, 0, pa2); PK4(p1, 8, pa3);
#undef PK4
}
template <int KB, int ROPE>
__device__ __forceinline__ void qkt(f32x16& p0, f32x16& p1, const char* lds, int r32_, int hi_, const bf16x8* qr, const char* qrl) {
    p0 = f32x16{}; p1 = f32x16{};
    int lane_ = r32_ | (hi_ << 5); asm volatile("" : "+v"(lane_)); const int r32 = lane_ & 31, hi = lane_ >> 5;
    const char* kb[4];
#pragma unroll
    for (int dd = 0; dd < 4; ++dd) kb[dd] = lds + OFF_K + KB * SHM_K + KSWZ(r32, (dd * 16 + hi * 8) * 2);
#pragma unroll
    for (int d0 = 0; d0 < 8; ++d0) { const char* a = kb[d0 & 3] + (d0 >> 2) * 128;
        bf16x8 b0 = *reinterpret_cast<const bf16x8*>(a);
        bf16x8 b1 = *reinterpret_cast<const bf16x8*>(a + 32 * 256);
        p0 = __builtin_amdgcn_mfma_f32_32x32x16_bf16(b0, qr[d0], p0, 0, 0, 0);
        p1 = __builtin_amdgcn_mfma_f32_32x32x16_bf16(b1, qr[d0], p1, 0, 0, 0); }
    if constexpr (ROPE > 0) {
#pragma unroll
        for (int d0 = 0; d0 < 4; ++d0) { const char* a = lds + OFF_R + KB * SHM_R + RSWZ(r32, d0 * 2 + hi);
            bf16x8 b0 = *reinterpret_cast<const bf16x8*>(a);
            bf16x8 b1 = *reinterpret_cast<const bf16x8*>(a + 32 * 128);
            const bf16x8 qf = *reinterpret_cast<const bf16x8*>(qrl + d0 * 1024);
            p0 = __builtin_amdgcn_mfma_f32_32x32x16_bf16(b0, qf, p0, 0, 0, 0);
            p1 = __builtin_amdgcn_mfma_f32_32x32x16_bf16(b1, qf, p1, 0, 0, 0); }
    }
}
template <int VB>
__device__ __forceinline__ void pv_tile(f32x16* o, int vb0, bf16x8 pa0, bf16x8 pa1, bf16x8 pa2, bf16x8 pa3) {
#define TRRD(dst, off) asm volatile("ds_read_b64_tr_b16 %0, %1 offset:%2" : "=&v"(dst) : "v"(vb0), "i"(off) : "memory")
#define PV_D0(d0) do { s16x4 l0, l1, l2, l3, h0, h1, h2, h3; constexpr int b_ = OFF_V + VB * SHM_V + v_rd_off(d0, 0, 0); \
        TRRD(l0, b_); TRRD(h0, b_ + 2048); TRRD(l1, b_ + 4096); TRRD(h1, b_ + 6144); TRRD(l2, b_ + 8192); TRRD(h2, b_ + 10240); TRRD(l3, b_ + 12288); TRRD(h3, b_ + 14336); \
        asm volatile("s_waitcnt lgkmcnt(0)" ::: "memory"); SBAR();   \
        o[d0] = __builtin_amdgcn_mfma_f32_32x32x16_bf16(pa0, (bf16x8){l0[0], l0[1], l0[2], l0[3], h0[0], h0[1], h0[2], h0[3]}, o[d0], 0, 0, 0);   \
        o[d0] = __builtin_amdgcn_mfma_f32_32x32x16_bf16(pa1, (bf16x8){l1[0], l1[1], l1[2], l1[3], h1[0], h1[1], h1[2], h1[3]}, o[d0], 0, 0, 0);   \
        o[d0] = __builtin_amdgcn_mfma_f32_32x32x16_bf16(pa2, (bf16x8){l2[0], l2[1], l2[2], l2[3], h2[0], h2[1], h2[2], h2[3]}, o[d0], 0, 0, 0);   \
        o[d0] = __builtin_amdgcn_mfma_f32_32x32x16_bf16(pa3, (bf16x8){l3[0], l3[1], l3[2], l3[3], h3[0], h3[1], h3[2], h3[3]}, o[d0], 0, 0, 0); } while (0)
    PV_D0(0); PV_D0(1); PV_D0(2); PV_D0(3);
#undef PV_D0
#undef TRRD
}

template <int LDQ, int LDK, int LDV, int LDO> struct Strides { static constexpr int ldq = LDQ, ldk = LDK, ldv = LDV, ldo = LDO; };
struct BlockRef { const bf16* Q; const bf16* K; const bf16* V; bf16* O; u64* ssq; int P0; int nk; };
template <int NQ> struct Seam { bf16x8 qr[8]; bf16x8 st_v0, st_v1, st_k0, st_k1, st_r; };

#define VMW() asm volatile("s_waitcnt vmcnt(0)" ::: "memory")
#define VMWN(n) asm volatile("s_waitcnt vmcnt(%0)" :: "i"(n) : "memory")
__device__ __forceinline__ int optid() { int t = threadIdx.x; asm volatile("" : "+v"(t)); return t; }
#define SLOAD_H(Kp, Vp, k0) do { const int t_ = optid(); const unsigned sr_ = t_ >> 4, sc_ = (t_ & 15) * 8, rr_ = t_ >> 3, rc_ = (t_ & 7) * 8;   \
                                 const bf16* kt_ = (Kp) + (size_t)(k0) * st.ldk; const bf16* vt_ = (Vp) + (size_t)(k0) * st.ldv;                    \
                                 S.st_v0 = load8(vt_ + (sr_ * st.ldv + sc_)); S.st_v1 = load8(vt_ + ((32 + sr_) * st.ldv + sc_));                   \
                                 S.st_k0 = load8(kt_ + (sr_ * st.ldk + sc_)); S.st_k1 = load8(kt_ + ((32 + sr_) * st.ldk + sc_));                   \
                                 if constexpr (ROPE > 0) S.st_r = load8(kt_ + (rr_ * st.ldk + 128 + rc_)); } while (0)
#define SWRITE_HK(bf) do { const int t_ = optid(); const int kws_ = KSWZ(t_ >> 4, (t_ & 15) * 16);                                                  \
                           *(bf16x8*)(lds + OFF_K + (bf) * SHM_K + kws_) = S.st_k0; *(bf16x8*)(lds + OFF_K + (bf) * SHM_K + kws_ + 32 * 256) = S.st_k1;   \
                           if constexpr (ROPE > 0) *(bf16x8*)(lds + OFF_R + (bf) * SHM_R + RSWZ(t_ >> 3, t_ & 7)) = S.st_r; } while (0)
#define SWRITE_HV(bf) do { const int t_ = optid(); const int sr_ = t_ >> 4, sc_ = (t_ & 15) * 8;                                                     \
                           *(bf16x8*)(lds + OFF_V + (bf) * SHM_V + v_st(sr_, sc_)) = S.st_v0; *(bf16x8*)(lds + OFF_V + (bf) * SHM_V + v_st(32 + sr_, sc_)) = S.st_v1; } while (0)
#define SWRITE_H(bf) do { SWRITE_HV(bf); SWRITE_HK(bf); } while (0)

template <int ROPE, class ST>
__device__ __forceinline__ void attn_prime(const BlockRef& cur, const ST& st, char* lds, Seam<8 + ROPE / 16>& S) {
    constexpr int NQ = 8 + ROPE / 16;
    int tid = threadIdx.x; asm volatile("" : "+v"(tid)); const int wid = __builtin_amdgcn_readfirstlane(tid >> 6), lane = tid & 63, r32 = lane & 31, hi = lane >> 5;
#pragma unroll
    for (int d0 = 0; d0 < 8; ++d0) S.qr[d0] = load8(cur.Q + (size_t)(wid * QBLK + r32) * st.ldq + d0 * 16 + hi * 8);
    if constexpr (ROPE > 0) {
#pragma unroll
        for (int d0 = 0; d0 < 4; ++d0) *(bf16x8*)(lds + OFF_QR + wid * 4096 + d0 * 1024 + lane * 16) = load8(cur.Q + (size_t)(wid * QBLK + r32) * st.ldq + 128 + d0 * 16 + hi * 8);
    }
    SLOAD_H(cur.K, cur.V, 0); VMW(); SWRITE_HK(0);
    __syncthreads();
}
template <int ROPE, bool CAUSAL, bool STAT, class ST>
__device__ __forceinline__ void attn_block(const BlockRef& cur, const BlockRef& nxt, const ST& st, const float SCALE, char* lds, Seam<8 + ROPE / 16>& S) {
    constexpr int NQ = 8 + ROPE / 16;
    int tid = threadIdx.x; asm volatile("" : "+v"(tid)); const int wid = __builtin_amdgcn_readfirstlane(tid >> 6), lane = tid & 63, r32 = lane & 31, hi = lane >> 5;
    const int NT = CAUSAL ? ((cur.P0 + QB - 1) / KVBLK + 1) : (cur.nk / KVBLK);
    const int qlo = cur.P0 + wid * QBLK, qm = qlo + r32 - 4 * hi;
    float* ws = (float*)(lds + OFF_WS) + wid * 64; float* li_l = ws, * al_l = ws + 32;
    float m_reg = -1e30f, l_reg = 0; f32x16 o[4] = {};
    const int vb0 = (int)(uintptr_t)lds + v_rd_base(lane);
    const bf16* Kh = cur.K; const bf16* Vh = cur.V;
    const char* qrl = lds + OFF_QR + wid * 4096 + lane * 16;
#define RESC(a) do { if (__any((a) < 1.f)) { if (hi == 0) al_l[r32] = (a); asm volatile("s_waitcnt lgkmcnt(0)" ::: "memory");              \
                     for (int d_ = 0; d_ < 4; ++d_) for (int r = 0; r < 16; ++r) o[d_][r] *= al_l[crow(r, hi)]; } } while (0)
#define KBASE(t) ((t) * KVBLK)
#define MASKT(P0_, P1_, t) do { if (CAUSAL) { const int kb_ = KBASE(t); if (kb_ + KVBLK - 1 > qlo) mask_tile(P0_, P1_, qm - kb_); } } while (0)
#define SEAM_K0() do { VMWN(8); SWRITE_HK(0); SBAR(); } while (0)
    f32x16 pA0, pA1, pB0, pB1; float mnA, mnB, alA, alB; bf16x8 pa0, pa1, pa2, pa3;
    SWRITE_HV(0); SBAR();
    if (NT > 1) { SLOAD_H(Kh, Vh, KBASE(1)); }
    SBAR(); qkt<0, ROPE>(pA0, pA1, lds, r32, hi, S.qr, qrl);
    MASKT(pA0, pA1, 0); partialSM(pA0, pA1, m_reg, mnA, alA, SCALE);
    if (NT > 1) { VMW(); SWRITE_H(1); }
    __syncthreads();
#define HALF_STEP(PX0, PX1, mnX, alX, PY0, PY1, alY, t, KB, VB, SB) do {                                                      \
        SBAR(); qkt<KB, ROPE>(PX0, PX1, lds, r32, hi, S.qr, qrl);                                                                  \
        finishSM(PY0, PY1, alY, l_reg, pa0, pa1, pa2, pa3); SBAR();                                                           \
        if ((t) + 1 < NT) { SLOAD_H(Kh, Vh, KBASE((t) + 1)); SBAR(); }                                                        \
        pv_tile<VB>(o, vb0, pa0, pa1, pa2, pa3); MASKT(PX0, PX1, (t)); partialSM(PX0, PX1, m_reg, mnX, alX, SCALE);           \
        __syncthreads();                                                                                                      \
        if ((t) + 1 < NT) { VMW(); SWRITE_H(SB); }                                                                            \
        RESC(alX); __syncthreads(); } while (0)
    for (int t = 1; t + 1 < NT; t += 2) {
        HALF_STEP(pB0, pB1, mnB, alB, pA0, pA1, alA, t, 1, 0, 0);
        HALF_STEP(pA0, pA1, mnA, alA, pB0, pB1, alB, t + 1, 0, 1, 1);
    }
    const bool even = (NT & 1) == 0;
    if (even) { SBAR(); qkt<1, ROPE>(pB0, pB1, lds, r32, hi, S.qr, qrl); SBAR(); }
    SLOAD_H(nxt.K, nxt.V, 0); SBAR();
#pragma unroll
    for (int d0 = 0; d0 < 8; ++d0) S.qr[d0] = load8(nxt.Q + (size_t)(wid * QBLK + r32) * st.ldq + d0 * 16 + hi * 8);
    SBAR();
    finishSM(pA0, pA1, alA, l_reg, pa0, pa1, pa2, pa3); SBAR();
    pv_tile<0>(o, vb0, pa0, pa1, pa2, pa3);
    if (even) { MASKT(pB0, pB1, NT - 1); partialSM(pB0, pB1, m_reg, mnB, alB, SCALE); __syncthreads(); RESC(alB);
        finishSM(pB0, pB1, alB, l_reg, pa0, pa1, pa2, pa3); SBAR(); pv_tile<1>(o, vb0, pa0, pa1, pa2, pa3); }
    SBAR(); SEAM_K0();
    if (hi == 0) li_l[r32] = l_reg; asm volatile("s_waitcnt lgkmcnt(0)" ::: "memory");
    float rli[16];
#pragma unroll
    for (int r = 0; r < 16; ++r) rli[r] = __builtin_amdgcn_rcpf(li_l[crow(r, hi)]);
    bf16* Ow = cur.O + (size_t)(wid * QBLK) * st.ldo;
#pragma unroll
    for (int r = 0; r < 16; ++r) { const int orow = crow(r, hi); float ss = 0.f;
#pragma unroll
        for (int d0 = 0; d0 < 4; ++d0) { const float v = o[d0][r] * rli[r]; ss += v * v;
            const float vn = __shfl_xor(v, 1);
            if ((r32 & 1) == 0) *(unsigned*)(Ow + (size_t)orow * st.ldo + d0 * 32 + r32) = cvtpk(v, vn); }
        if (STAT) { ss += __shfl_xor(ss, 1); ss += __shfl_xor(ss, 2); ss += __shfl_xor(ss, 4); ss += __shfl_xor(ss, 8); ss += __shfl_xor(ss, 16);
            if (r32 == 0) ssq_add(cur.ssq, wid * QBLK + orow, ss); } }
    if constexpr (ROPE > 0) {
#pragma unroll
        for (int d0 = 0; d0 < 4; ++d0) *(bf16x8*)(lds + OFF_QR + wid * 4096 + d0 * 1024 + lane * 16) = load8(nxt.Q + (size_t)(wid * QBLK + r32) * st.ldq + 128 + d0 * 16 + hi * 8);
    }
    __syncthreads();
#undef RESC
#undef KBASE
#undef MASKT
#undef SEAM_K0
#undef HALF_STEP
}
#undef VMW
#undef VMWN
#undef SLOAD_H
#undef SWRITE_HK
#undef SWRITE_HV
#undef SWRITE_H
}
constexpr size_t MiB = 1u << 20;
constexpr size_t WS_CTL = 0, WS_STAT = 1 * MiB, ZERO_BYTES = 3 * MiB;
constexpr size_t WS_TAB = 3 * MiB;
constexpr size_t WS_MEMB = 6 * MiB, WS_KVMEM = 8 * MiB, WS_KMEMN = 10 * MiB, WS_WMKV = 11 * MiB;
constexpr size_t WS_LOGIT = 20 * MiB, WS_MOE = 24 * MiB, WS_SCAN = 26 * MiB;
constexpr size_t WS_W = 28 * MiB;
constexpr size_t W_IN = 0, W_UQ = 12 * MiB, W_UKV = W_UQ + 3 * MiB / 2, W_G = W_UKV + MiB, W_OUT = W_G + MiB, W_MQ = W_OUT + 8 * MiB, W_MO = W_MQ + 2 * MiB, W_R = W_MO + 2 * MiB,
                 W_GU = W_R + MiB, W_D = W_GU + 128 * MiB, W_END = W_D + 64 * MiB;
constexpr size_t WS_XB = 250 * MiB, WS_R = 314 * MiB;
static_assert(WS_W + W_END <= WS_XB, "weights");
constexpr size_t R_Z = 0, R_Q = 96 * MiB, R_KVR = 144 * MiB, R_KK = 208 * MiB, R_XC = 256 * MiB, R_AA = 288 * MiB, R_UU = 352 * MiB, R_YMIX = 416 * MiB, R_END = 480 * MiB;
constexpr size_t R_QM = 0, R_QMN = 64 * MiB, R_OM = 80 * MiB;
constexpr size_t R_ACT = 0, R_Y = 40 * MiB;
constexpr size_t WS_SCAN2 = WS_R + R_END;
constexpr size_t WS_END = WS_SCAN2 + 6 * MiB;
constexpr int CW_BAR = 4096;
constexpr int CW_CNT = 16384;
enum { ST_X = 0, ST_CQ = 1, ST_CKV = 2, ST_YATT = 3, ST_YRNN = 4, ST_X1 = 5, ST_X2 = 6 };
constexpr int RING_BYTES = 131072, LDSCTL_OFF = RING_BYTES, LDS_BYTES = 147456;
constexpr int LC_BAR = 0, LC_NRT = 16, LC_RTAB = 64, LC_LTOK = 2048;

struct Params { const float* in[36]; float* out; unsigned char* ws; int ph_lo, ph_hi, probe, pad; };
static_assert(sizeof(Params) == 36 * 8 + 8 + 8 + 16, "Params layout");
typedef __attribute__((address_space(4))) const unsigned char kchar;
__device__ __forceinline__ kchar* karg_base() { kchar* ka = (kchar*)__builtin_amdgcn_kernarg_segment_ptr(); asm volatile("" : "+s"(ka)); return ka; }
__device__ __forceinline__ const float* in_ptr(const Params&, int i) { return (const float*)(*(GAS const float* const __attribute__((address_space(4)))*)(karg_base() + i * 8)); }
__device__ __forceinline__ float* out_ptr() { return (float*)(*(GAS float* const __attribute__((address_space(4)))*)(karg_base() + 288)); }
__device__ __forceinline__ unsigned char* ws_ptr() { return (unsigned char*)(*(GAS unsigned char* const __attribute__((address_space(4)))*)(karg_base() + 296)); }
__device__ __forceinline__ unsigned char* opaque_ptr(unsigned char*) { return ws_ptr(); }
enum { I_X = 0, I_MEM, I_MIXG, I_WIN, I_QLG, I_KVLG, I_WUQ, I_WUKV, I_AQG, I_AKG, I_CONVW, I_CONVB, I_WRG, I_BRG, I_WIG, I_BIG, I_LAM, I_AOG, I_ROG, I_WOUT, I_XNG, I_MNG, I_WMQ, I_WMK, I_WMV,
       I_MQG, I_MKG, I_WMO, I_MOEG, I_WRGRP, I_BRGRP, I_WREXP, I_BREXP, I_WEG, I_WEU, I_WED };

__device__ __forceinline__ int dmap(int map, int n) {
    if (map == 1) return n < 768 ? n : (n < 832 ? n + 2048 : n - 64);
    if (map == 2) return ((n >> 7) << 8) + (n & 127);
    if (map == 3) return ((n >> 7) << 8) + 128 + (n & 127);
    return n;
}
__device__ __forceinline__ void transpose_item(const float* W, int K, int Nsrc, bf16* WT, const float* gain, int map, LAS float* scr, int item, int lane) {
    const int nblk = Nsrc / 32, kb = item / nblk, nb = item % nblk, k0 = 64 * kb, n0 = 32 * nb;
    const GAS float* src = (const GAS float*)W + (size_t)(k0 + (lane >> 5)) * Nsrc + n0 + (lane & 31);
    float v[32];
#pragma unroll
    for (int i = 0; i < 32; ++i) v[i] = src[(size_t)(2 * i) * Nsrc];
    const int c = lane & 7; const int d0 = dmap(map, n0);
    f32x4 ga = (f32x4){1.f, 1.f, 1.f, 1.f}, gb = ga;
    if (gain) { ga = *(const GAS f32x4*)((const GAS float*)gain + k0 + 8 * c); gb = *(const GAS f32x4*)((const GAS float*)gain + k0 + 8 * c + 4); }
#pragma unroll
    for (int i = 0; i < 32; ++i) scr[(2 * i + (lane >> 5)) * 33 + (lane & 31)] = v[i];
    LDS_WAIT(); asm volatile("" ::: "memory");
#pragma unroll
    for (int j = 0; j < 4; ++j) { const int n = (lane >> 3) + 8 * j; const LAS float* s = scr + (8 * c) * 33 + n;
        u32x4 o; o.x = pk2(s[0 * 33] * ga[0], s[1 * 33] * ga[1]); o.y = pk2(s[2 * 33] * ga[2], s[3 * 33] * ga[3]); o.z = pk2(s[4 * 33] * gb[0], s[5 * 33] * gb[1]); o.w = pk2(s[6 * 33] * gb[2], s[7 * 33] * gb[3]);
        *(GAS u32x4*)((GAS bf16*)WT + (size_t)(d0 + n) * K + k0 + 8 * c) = o; }
    LDS_WAIT(); asm volatile("" ::: "memory");
}
__device__ __forceinline__ void convert_layer_weights(const Params& p, int l, LAS float* scr, int gw, int NGW, int lane, int gtid, int NGT) {
    unsigned char* wb = opaque_ptr(p.ws) + WS_W;
    constexpr int I0 = 32 * 90, I1 = 8 * 48, I2 = 4 * 64, I3 = 32 * 64, I4 = 32 * 16, I5 = 8 * 64, IE = 32 * 16, IEX = 32 * IE, ID = 8 * 64, IDX = 32 * ID;
    constexpr int NIT = I0 + I1 + I2 + I3 + I4 + I5 + 2 * IEX + IDX;
    for (int it = gw; it < NIT; it += NGW) {
        int r = it;
        if (r < I0) { transpose_item(in_ptr(p, I_WIN) + (size_t)l * D * 2880, D, 2880, (bf16*)(wb + W_IN), in_ptr(p, I_MIXG) + l * D, 1, scr, r, lane); continue; } r -= I0;
        if (r < I1) { transpose_item(in_ptr(p, I_WUQ) + (size_t)l * QL * NQU, QL, NQU, (bf16*)(wb + W_UQ), in_ptr(p, I_QLG) + l * QL, 0, scr, r, lane); continue; } r -= I1;
        if (r < I2) { transpose_item(in_ptr(p, I_WUKV) + (size_t)l * KVL * NKV, KVL, NKV, (bf16*)(wb + W_UKV), in_ptr(p, I_KVLG) + l * KVL, 0, scr, r, lane); continue; } r -= I2;
        if (r < I3) { const int k0 = 64 * (r / 64); const float* g = (k0 < 1024) ? (in_ptr(p, I_AOG) + l * 1024) : (in_ptr(p, I_ROG) + l * 1024 - 1024);
                      transpose_item(in_ptr(p, I_WOUT) + (size_t)l * D * D, D, D, (bf16*)(wb + W_OUT), g, 0, scr, r, lane); continue; } r -= I3;
        if (r < I4) { transpose_item(in_ptr(p, I_WMQ) + (size_t)l * D * DMA, D, DMA, (bf16*)(wb + W_MQ), in_ptr(p, I_XNG) + l * D, 0, scr, r, lane); continue; } r -= I4;
        if (r < I5) { transpose_item(in_ptr(p, I_WMO) + (size_t)l * DMA * D, DMA, D, (bf16*)(wb + W_MO), nullptr, 0, scr, r, lane); continue; } r -= I5;
        if (r < IEX) { const int e = r / IE; transpose_item(in_ptr(p, I_WEG) + ((size_t)l * NE + e) * D * DE, D, DE, (bf16*)(wb + W_GU) + (size_t)e * 1024 * D, in_ptr(p, I_MOEG) + l * D, 2, scr, r % IE, lane); continue; } r -= IEX;
        if (r < IEX) { const int e = r / IE; transpose_item(in_ptr(p, I_WEU) + ((size_t)l * NE + e) * D * DE, D, DE, (bf16*)(wb + W_GU) + (size_t)e * 1024 * D, in_ptr(p, I_MOEG) + l * D, 3, scr, r % IE, lane); continue; } r -= IEX;
        { const int e = r / ID; transpose_item(in_ptr(p, I_WED) + ((size_t)l * NE + e) * DE * D, DE, D, (bf16*)(wb + W_D) + (size_t)e * D * DE, nullptr, 0, scr, r % ID, lane); }
    }
    { u32x4* z = (u32x4*)((bf16*)(wb + W_IN) + (size_t)2880 * D); const int n16 = 192 * D * 2 / 16; for (int i = gtid; i < n16; i += NGT) z[i] = (u32x4){0u, 0u, 0u, 0u}; }
    { bf16* wr = (bf16*)(wb + W_R); const float* wg = in_ptr(p, I_WRGRP) + (size_t)l * D * 4; const float* we = in_ptr(p, I_WREXP) + (size_t)l * D * 32; const float* g = in_ptr(p, I_MOEG) + l * D;
      for (int i = gtid; i < 256 * D / 8; i += NGT) { const int n = i / (D / 8), k0 = (i % (D / 8)) * 8; float v[8];
#pragma unroll
          for (int j = 0; j < 8; ++j) { const int k = k0 + j; v[j] = n < 4 ? wg[k * 4 + n] * g[k] : (n < 36 ? we[k * 32 + (n - 4)] * g[k] : 0.f); }
          u32x4 o; o.x = pk2(v[0], v[1]); o.y = pk2(v[2], v[3]); o.z = pk2(v[4], v[5]); o.w = pk2(v[6], v[7]); *(u32x4*)(wr + (size_t)n * D + k0) = o; } }
    { bf16* wg = (bf16*)(wb + W_G); const float* wr = in_ptr(p, I_WRG) + (size_t)l * 8 * 128 * 128; const float* wi = in_ptr(p, I_WIG) + (size_t)l * 8 * 128 * 128;
      for (int i = gtid; i < 8 * 256 * 256 / 8; i += NGT) { const int n = i >> 13, j = (i >> 5) & 255, c0 = (i & 31) * 8; float v[8];
          const bool on = (c0 >> 7) == (n & 1); const float* src = (j < 128 ? wr : wi) + (size_t)n * 128 * 128 + (j & 127);
#pragma unroll
          for (int q = 0; q < 8; ++q) v[q] = on ? src[(size_t)((c0 & 127) + q) * 128] : 0.f;
          u32x4 o; o.x = pk2(v[0], v[1]); o.y = pk2(v[2], v[3]); o.z = pk2(v[4], v[5]); o.w = pk2(v[6], v[7]); *(u32x4*)(wg + (size_t)i * 8) = o; } }
}
__device__ __forceinline__ float row_to_bf16(const float* xrow, bf16* orow, int lane) {
    float ss = 0.f;
#pragma unroll
    for (int j = 0; j < 4; ++j) { const int c = lane * 8 + 512 * j; const f32x4 a = *(const f32x4*)(xrow + c), b = *(const f32x4*)(xrow + c + 4);
        ss += (a[0] * a[0] + a[1] * a[1]) + (a[2] * a[2] + a[3] * a[3]) + (b[0] * b[0] + b[1] * b[1]) + (b[2] * b[2] + b[3] * b[3]);
        u32x4 o; o.x = pk2(a[0], a[1]); o.y = pk2(a[2], a[3]); o.z = pk2(b[0], b[1]); o.w = pk2(b[2], b[3]); *(u32x4*)(orow + c) = o; }
    return wave_sum(ss);
}
__device__ __forceinline__ float gelu_tanh(float x) { const float y = 0.7978845608028654f * (x + 0.044715f * x * x * x); const float e = __expf(2.0f * y); const float th = 1.0f - 2.0f / (e + 1.0f); return 0.5f * x * (1.0f + th); }
__device__ __forceinline__ void unpack8(u32x4 w, float* v) { v[0] = bflo(w.x); v[1] = bfhi(w.x); v[2] = bflo(w.y); v[3] = bfhi(w.y); v[4] = bflo(w.z); v[5] = bfhi(w.z); v[6] = bflo(w.w); v[7] = bfhi(w.w); }
__device__ __forceinline__ u32x4 pack8f(const float* v) { u32x4 o; o.x = pk2(v[0], v[1]); o.y = pk2(v[2], v[3]); o.z = pk2(v[4], v[5]); o.w = pk2(v[6], v[7]); return o; }

__device__ __forceinline__ void conv_phase(const bf16* z, bf16* xc, const float* cw, const float* cb, int gtid, int NGT) {
    for (int it = gtid; it < (T / 16) * 128; it += NGT) {
        const int tb = it >> 7, cg = it & 127, row0 = tb * 16, s0 = row0 & (SEQ - 1), c0 = cg * 8;
        float w[4][8], b[8], p1[8], p2[8], p3[8];
#pragma unroll
        for (int j = 0; j < 4; ++j) { const f32x4 a = *(const f32x4*)(cw + j * DRNN + c0), bb = *(const f32x4*)(cw + j * DRNN + c0 + 4);
            w[j][0] = a[0]; w[j][1] = a[1]; w[j][2] = a[2]; w[j][3] = a[3]; w[j][4] = bb[0]; w[j][5] = bb[1]; w[j][6] = bb[2]; w[j][7] = bb[3]; }
        { const f32x4 a = *(const f32x4*)(cb + c0), bb = *(const f32x4*)(cb + c0 + 4); b[0] = a[0]; b[1] = a[1]; b[2] = a[2]; b[3] = a[3]; b[4] = bb[0]; b[5] = bb[1]; b[6] = bb[2]; b[7] = bb[3]; }
        const bf16* zp = z + (size_t)row0 * ZC + Z_XR + c0;
        if (s0 >= 1) unpack8(*(const u32x4*)(zp - (size_t)ZC), p1); else { for (int e = 0; e < 8; ++e) p1[e] = 0.f; }
        if (s0 >= 2) unpack8(*(const u32x4*)(zp - (size_t)2 * ZC), p2); else { for (int e = 0; e < 8; ++e) p2[e] = 0.f; }
        if (s0 >= 3) unpack8(*(const u32x4*)(zp - (size_t)3 * ZC), p3); else { for (int e = 0; e < 8; ++e) p3[e] = 0.f; }
#pragma unroll 4
        for (int r = 0; r < 16; ++r) { float cur[8], o[8]; unpack8(*(const u32x4*)(zp + (size_t)r * ZC), cur);
#pragma unroll
            for (int e = 0; e < 8; ++e) { o[e] = b[e] + w[3][e] * cur[e] + w[2][e] * p1[e] + w[1][e] * p2[e] + w[0][e] * p3[e]; p3[e] = p2[e]; p2[e] = p1[e]; p1[e] = cur[e]; }
            *(u32x4*)(xc + (size_t)(row0 + r) * DRNN + c0) = pack8f(o); }
    }
}
__device__ __forceinline__ void qk_post_phase(bf16* q, const bf16* kvr, const bf16* z, bf16* kk, const float* gq, const float* gk, const float* cosT, const float* sinT, int gw, int NGW, int lane) {
    const int h = lane >> 3, j = lane & 7;
    for (int row = gw; row < T; row += NGW) {
        const int s = row & (SEQ - 1);
        float cs[8], sn[8];
        { const int i0 = (j & 3) * 8; const f32x4 a = *(const f32x4*)(cosT + s * 32 + i0), b = *(const f32x4*)(cosT + s * 32 + i0 + 4), c = *(const f32x4*)(sinT + s * 32 + i0), d = *(const f32x4*)(sinT + s * 32 + i0 + 4);
          cs[0] = a[0]; cs[1] = a[1]; cs[2] = a[2]; cs[3] = a[3]; cs[4] = b[0]; cs[5] = b[1]; cs[6] = b[2]; cs[7] = b[3];
          sn[0] = c[0]; sn[1] = c[1]; sn[2] = c[2]; sn[3] = c[3]; sn[4] = d[0]; sn[5] = d[1]; sn[6] = d[2]; sn[7] = d[3]; }
#pragma unroll
        for (int which = 0; which < 2; ++which) {
            float v[3][8];
            if (which == 0) { bf16* qp = q + (size_t)row * NQU + h * QKH + j * 8;
#pragma unroll
                for (int i = 0; i < 3; ++i) unpack8(*(const u32x4*)(qp + 64 * i), v[i]); }
            else { const bf16* kp = kvr + (size_t)row * NKV + h * 256 + j * 8; unpack8(*(const u32x4*)kp, v[0]); unpack8(*(const u32x4*)(kp + 64), v[1]);
                   unpack8(*(const u32x4*)(z + (size_t)row * ZC + Z_KPE + j * 8), v[2]); }
            float ss = 0.f;
#pragma unroll
            for (int i = 0; i < 3; ++i)
#pragma unroll
                for (int e = 0; e < 8; ++e) ss += v[i][e] * v[i][e];
            ss += __shfl_xor(ss, 1); ss += __shfl_xor(ss, 2); ss += __shfl_xor(ss, 4);
            const float rstd = 1.0f / sqrtf(ss * (1.0f / 192.0f) + EPS);
            const float* g = which == 0 ? gq : gk;
#pragma unroll
            for (int i = 0; i < 3; ++i) { const f32x4 ga = *(const f32x4*)(g + 64 * i + j * 8), gb = *(const f32x4*)(g + 64 * i + j * 8 + 4);
                v[i][0] *= rstd * ga[0]; v[i][1] *= rstd * ga[1]; v[i][2] *= rstd * ga[2]; v[i][3] *= rstd * ga[3]; v[i][4] *= rstd * gb[0]; v[i][5] *= rstd * gb[1]; v[i][6] *= rstd * gb[2]; v[i][7] *= rstd * gb[3]; }
#pragma unroll
            for (int e = 0; e < 8; ++e) { const float mine = v[2][e], oth = __shfl_xor(mine, 4);
                v[2][e] = (j < 4) ? (mine * cs[e] - oth * sn[e]) : (oth * sn[e] + mine * cs[e]); }
            bf16* op = (which == 0 ? q + (size_t)row * NQU : kk + (size_t)row * NQU) + h * QKH + j * 8;
#pragma unroll
            for (int i = 0; i < 3; ++i) *(u32x4*)(op + 64 * i) = pack8f(v[i]);
        }
    }
}
template <bool F32IN>
__device__ __forceinline__ void head128_norm_rows(const void* in0, const float* in1, int ld_in, bf16* out, const float* g, int nrows, int gw, int NGW, int lane) {
    for (int row = gw; row < nrows; row += NGW) {
        float v[8];
        if (F32IN) { const float* a = (const float*)in0 + (size_t)row * ld_in + lane * 8; const float* b = in1 + (size_t)row * ld_in + lane * 8;
            const f32x4 a0 = *(const f32x4*)a, a1 = *(const f32x4*)(a + 4), b0 = *(const f32x4*)b, b1 = *(const f32x4*)(b + 4);
            v[0] = a0[0] + b0[0]; v[1] = a0[1] + b0[1]; v[2] = a0[2] + b0[2]; v[3] = a0[3] + b0[3]; v[4] = a1[0] + b1[0]; v[5] = a1[1] + b1[1]; v[6] = a1[2] + b1[2]; v[7] = a1[3] + b1[3]; }
        else unpack8(*(const u32x4*)((const bf16*)in0 + (size_t)row * ld_in + lane * 8), v);
        float ss = 0.f;
#pragma unroll
        for (int e = 0; e < 8; ++e) ss += v[e] * v[e];
        ss += __shfl_xor(ss, 1); ss += __shfl_xor(ss, 2); ss += __shfl_xor(ss, 4); ss += __shfl_xor(ss, 8);
        const float rstd = 1.0f / sqrtf(ss * (1.0f / 128.0f) + EPS);
        const int c = (lane * 8) & 127; const f32x4 ga = *(const f32x4*)(g + c), gb = *(const f32x4*)(g + c + 4);
        v[0] *= rstd * ga[0]; v[1] *= rstd * ga[1]; v[2] *= rstd * ga[2]; v[3] *= rstd * ga[3]; v[4] *= rstd * gb[0]; v[5] *= rstd * gb[1]; v[6] *= rstd * gb[2]; v[7] *= rstd * gb[3];
        *(u32x4*)(out + (size_t)row * DMA + lane * 8) = pack8f(v);
    }
}
__device__ __forceinline__ void scan_pass1(const float* aa, const float* uu, float* sA, float* sH, float* cA, float* cH, LAS f32x4* xch, int unit, int wave, int lane) {
    const int q = unit & 3, c = (unit >> 2) & 31, b = unit >> 7; const unsigned ch = (unsigned)(q * 256 + lane * 4);
    const GAS float* ap = (const GAS float*)aa + ((size_t)b * SEQ + (size_t)c * 256 + (size_t)wave * 32) * DRNN + ch;
    const GAS float* up = (const GAS float*)uu + ((size_t)b * SEQ + (size_t)c * 256 + (size_t)wave * 32) * DRNN + ch;
    f32x4 A = (f32x4){1.f, 1.f, 1.f, 1.f}, H = (f32x4){0.f, 0.f, 0.f, 0.f};
#pragma unroll
    for (int hb = 0; hb < 2; ++hb) { f32x4 av[16], uv[16];
#pragma unroll
        for (int s = 0; s < 16; ++s) { av[s] = *(const GAS f32x4*)(ap + (size_t)(hb * 16 + s) * DRNN); uv[s] = *(const GAS f32x4*)(up + (size_t)(hb * 16 + s) * DRNN); }
#pragma unroll
        for (int s = 0; s < 16; ++s) { H = av[s] * H + uv[s]; A = A * av[s]; } }
    const size_t so = ((size_t)(b * 32 + c) * 8 + wave) * DRNN + ch;
    *(GAS f32x4*)((GAS float*)sA + so) = A; *(GAS f32x4*)((GAS float*)sH + so) = H;
    xch[(wave * 64 + lane) * 2] = A; xch[(wave * 64 + lane) * 2 + 1] = H;
    __syncthreads();
    if (wave == 0) { f32x4 Ac = (f32x4){1.f, 1.f, 1.f, 1.f}, Hc = (f32x4){0.f, 0.f, 0.f, 0.f};
#pragma unroll
        for (int w = 0; w < 8; ++w) { const f32x4 a = xch[(w * 64 + lane) * 2], h = xch[(w * 64 + lane) * 2 + 1]; Hc = a * Hc + h; Ac = Ac * a; }
        const size_t co = (size_t)(b * 32 + c) * DRNN + ch; *(GAS f32x4*)((GAS float*)cA + co) = Ac; *(GAS f32x4*)((GAS float*)cH + co) = Hc; }
    __syncthreads();
}
__device__ __forceinline__ void scan_pass3(const float* aa, const float* uu, const float* sA, const float* sH, const float* cA, const float* cH, const bf16* z, bf16* ymix, u64* ssq, int unit, int wave, int lane) {
    const int q = unit & 3, c = (unit >> 2) & 31, b = unit >> 7; const unsigned ch = (unsigned)(q * 256 + lane * 4);
    f32x4 h = (f32x4){0.f, 0.f, 0.f, 0.f};
    { const GAS float* ca = (const GAS float*)cA + (size_t)(b * 32) * DRNN + ch; const GAS float* chh = (const GAS float*)cH + (size_t)(b * 32) * DRNN + ch;
#pragma unroll 8
      for (int j = 0; j < c; ++j) { const f32x4 a = *(const GAS f32x4*)(ca + (size_t)j * DRNN), hh = *(const GAS f32x4*)(chh + (size_t)j * DRNN); h = a * h + hh; }
      const GAS float* sa = (const GAS float*)sA + (size_t)(b * 32 + c) * 8 * DRNN + ch; const GAS float* sh = (const GAS float*)sH + (size_t)(b * 32 + c) * 8 * DRNN + ch;
      for (int j = 0; j < wave; ++j) { const f32x4 a = *(const GAS f32x4*)(sa + (size_t)j * DRNN), hh = *(const GAS f32x4*)(sh + (size_t)j * DRNN); h = a * h + hh; } }
    const size_t row0 = (size_t)b * SEQ + (size_t)c * 256 + (size_t)wave * 32;
    const GAS float* ap = (const GAS float*)aa + row0 * DRNN + ch; const GAS float* up = (const GAS float*)uu + row0 * DRNN + ch;
    const GAS bf16* gp = (const GAS bf16*)z + row0 * ZC + Z_GATE + ch; GAS bf16* yp = (GAS bf16*)ymix + row0 * D + DATT + ch;
    const int rowsel = lane & 15;
#pragma unroll
    for (int hb = 0; hb < 2; ++hb) { f32x4 av[16], uv[16]; u32x2 gv[16]; float sq[16];
#pragma unroll
        for (int s = 0; s < 16; ++s) { av[s] = *(const GAS f32x4*)(ap + (size_t)(hb * 16 + s) * DRNN); uv[s] = *(const GAS f32x4*)(up + (size_t)(hb * 16 + s) * DRNN); gv[s] = *(const GAS u32x2*)(gp + (size_t)(hb * 16 + s) * ZC); }
#pragma unroll
        for (int s = 0; s < 16; ++s) { h = av[s] * h + uv[s];
            const float y0 = h[0] * gelu_tanh(bflo(gv[s].x)), y1 = h[1] * gelu_tanh(bfhi(gv[s].x)), y2 = h[2] * gelu_tanh(bflo(gv[s].y)), y3 = h[3] * gelu_tanh(bfhi(gv[s].y));
            u32x2 o; o.x = pk2(y0, y1); o.y = pk2(y2, y3); *(GAS u32x2*)(yp + (size_t)(hb * 16 + s) * D) = o;
            sq[s] = (y0 * y0 + y1 * y1) + (y2 * y2 + y3 * y3); }
#pragma unroll
        for (int st = 0; st < 4; ++st) { const int n = 8 >> st; const bool up = (lane >> st) & 1;
#pragma unroll
            for (int i = 0; i < 8; ++i) if (i < n) { const float keep = up ? sq[2 * i + 1] : sq[2 * i], give = up ? sq[2 * i] : sq[2 * i + 1]; sq[i] = keep + __shfl_xor(give, 1 << st); } }
        float tot = sq[0]; tot += __shfl_xor(tot, 16); tot += __shfl_xor(tot, 32);
        if (lane < 16) ssq_add(ssq, (int)(row0 + hb * 16 + rowsel), tot); }
}
__device__ __forceinline__ void route_phase(const float* logits, const u64* ssq_x2, const float* bg, const float* be, int* tok_e, float* tok_w, int* whist, unsigned* cnt, LAS int* hist, int wg, int tid) {
    if (tid < 32) hist[tid] = 0;
    __syncthreads();
    if (tid < 64) { const int t = wg * 64 + tid; const float rs = 1.0f / sqrtf(ssq_val(ssq_x2, t) * (1.0f / D) + EPS); const float* lq = logits + (size_t)t * 64;
#define LSUM(i) ((lq[(i)] + lq[(size_t)T * 64 + (i)]) + (lq[(size_t)2 * T * 64 + (i)] + lq[(size_t)3 * T * 64 + (i)]))
        float lg[4]; int g = 0; float mx = -3.0e38f;
#pragma unroll
        for (int i = 0; i < 4; ++i) { lg[i] = LSUM(i) * rs + bg[i]; if (lg[i] > mx) { mx = lg[i]; g = i; } }
        float den = 0.f;
#pragma unroll
        for (int i = 0; i < 4; ++i) den += __expf(lg[i] - mx);
        const float gw = 1.0f / den;
        float l1 = -3.0e38f, l2 = -3.0e38f; int j1 = 0, j2 = 0;
        for (int i = 0; i < 8; ++i) { const float v = LSUM(4 + g * 8 + i) * rs + be[g * 8 + i];
            if (v > l1) { l2 = l1; j2 = j1; l1 = v; j1 = i; } else if (v > l2) { l2 = v; j2 = i; } }
        const float w1 = 1.0f / (1.0f + __expf(l2 - l1)), w2 = 1.0f - w1;
        const int e1 = g * 8 + j1, e2 = g * 8 + j2;
        tok_e[t * 2] = e1; tok_e[t * 2 + 1] = e2; tok_w[t * 2] = gw * w1; tok_w[t * 2 + 1] = gw * w2;
        __hip_atomic_fetch_add(hist + e1, 1, __ATOMIC_RELAXED, __HIP_MEMORY_SCOPE_WORKGROUP); __hip_atomic_fetch_add(hist + e2, 1, __ATOMIC_RELAXED, __HIP_MEMORY_SCOPE_WORKGROUP);
    }
#undef LSUM
    __syncthreads();
    if (tid < 32) { const int c = hist[tid]; whist[wg * 32 + tid] = c; if (c) atomicAdd(cnt + tid, (unsigned)c); }
}
__device__ __forceinline__ void dispatch_phase(const unsigned* cnt, const int* whist, const int* tok_e, const float* tok_w, const u64* ssq_x2, int* tok_slot, int* slot_tok, float* slot_w, float* slot_rs,
                                               LAS int* sc, int wg, int tid) {
    if (tid == 0) { int seg = 0; for (int e = 0; e < 32; ++e) { sc[e] = seg; seg += (((int)cnt[e] + 255) >> 8) << 8; } }
    { const int e = tid & 31, part = tid >> 5; int s = 0; for (int w = part; w < wg; w += 16) s += whist[w * 32 + e]; sc[64 + tid] = s; }
    if (tid < 128) sc[640 + tid] = tok_e[(wg * 64) * 2 + tid];
    __syncthreads();
    if (tid < 32) { int s = sc[tid]; for (int p = 0; p < 16; ++p) s += sc[64 + p * 32 + tid]; sc[32 + tid] = s; }
    __syncthreads();
    if (tid < 128) { const int e = sc[640 + tid]; int rank = 0; for (int j = 0; j < tid; ++j) rank += (sc[640 + j] == e) ? 1 : 0;
        const int slot = sc[32 + e] + rank; const int t = wg * 64 + (tid >> 1);
        slot_tok[slot] = t; slot_w[slot] = tok_w[(wg * 64) * 2 + tid]; slot_rs[slot] = 1.0f / sqrtf(ssq_val(ssq_x2, t) * (1.0f / D) + EPS); tok_slot[(wg * 64) * 2 + tid] = slot; }
    if (wg < 32) { const int c = (int)cnt[wg], lo = sc[wg] + c, hi = sc[wg] + (((c + 255) >> 8) << 8);
        for (int s = lo + tid; s < hi; s += NTHREADS) { slot_tok[s] = 0; slot_w[s] = 0.f; slot_rs[s] = 0.f; } }
    __syncthreads();
}
__device__ __forceinline__ int build_rtab(const unsigned* cnt, LAS int* lc, int tid) {
    if (tid == 0) { int seg = 0, k = 0; for (int e = 0; e < 32; ++e) { const int nt = ((int)cnt[e] + 255) >> 8; for (int r = 0; r < nt; ++r) { lc[LC_RTAB / 4 + 2 * k] = e; lc[LC_RTAB / 4 + 2 * k + 1] = seg + r * 256; ++k; } seg += nt * 256; } lc[LC_NRT / 4] = k; }
    __syncthreads();
    return lc[LC_NRT / 4];
}
__device__ __forceinline__ void combine_phase(float* out, const bf16* Y, const int* tok_slot, bf16* xb, u64* ssq_next, bool last, int gw, int NGW, int lane) {
    for (int row = gw; row < T; row += NGW) {
        const int s0 = tok_slot[row * 2], s1 = tok_slot[row * 2 + 1]; float ss = 0.f;
#pragma unroll
        for (int j = 0; j < 4; ++j) { const int c = lane * 8 + 512 * j; float x0[8], y0[8], y1[8], v[8];
            unpack8(*(const u32x4*)(xb + (size_t)row * D + c), x0); unpack8(*(const u32x4*)(Y + (size_t)s0 * D + c), y0); unpack8(*(const u32x4*)(Y + (size_t)s1 * D + c), y1);
#pragma unroll
            for (int e = 0; e < 8; ++e) { v[e] = x0[e] + y0[e] + y1[e]; ss += v[e] * v[e]; }
            if (last) { float* op = out + (size_t)row * D + c; *(f32x4*)op = (f32x4){v[0], v[1], v[2], v[3]}; *(f32x4*)(op + 4) = (f32x4){v[4], v[5], v[6], v[7]}; }
            else *(u32x4*)(xb + (size_t)row * D + c) = pack8f(v); }
        ss = wave_sum(ss); if (!last && lane == 0) ssq_set(ssq_next, row, ss);
    }
}
constexpr int NPL = 16, NPHASES = 1 + DEPTH * NPL;
__device__ __forceinline__ att::BlockRef mla_ref(int it, int pass, bf16* qbuf, bf16* kk, bf16* kvr, bf16* ymix, u64* ssq_ya) {
    const int bh = (it & 7) * 2 + ((it >> 3) >> 4), y = (it >> 3) & 15, b = bh >> 3, h = bh & 7; const int qb = pass ? 31 - y : y; const size_t r0 = (size_t)b * SEQ;
    att::BlockRef c; c.K = kk + r0 * NQU + h * QKH; c.V = kvr + r0 * NKV + h * 256 + 128; c.nk = SEQ;
    c.Q = qbuf + (r0 + (size_t)qb * 256) * NQU + h * QKH; c.O = ymix + (r0 + (size_t)qb * 256) * D + h * VH; c.ssq = ssq_ya + r0 + qb * 256; c.P0 = qb * 256; return c;
}
#ifndef PH_MASK
#define PH_MASK 0x1ffff
#endif
#define PH_ON(j) (((PH_MASK) >> (j)) & 1)
__global__ void __launch_bounds__(NTHREADS, 2) fwd_kernel(Params p) {
    extern __shared__ __attribute__((aligned(16))) unsigned char lds_raw[];
    LAS unsigned char* lds = (LAS unsigned char*)lds_raw;
    LAS int* lc = (LAS int*)(lds + LDSCTL_OFF);
    const int G = gridDim.x, bx = blockIdx.x;
    const int NGW = G * NWAVES, NGT = G * NTHREADS;
    if (threadIdx.x < 64) lc[threadIdx.x] = 0;
    __syncthreads();
    XcdBarrier bar = xcd_barrier_post((unsigned*)(ws_ptr() + WS_CTL) + CW_BAR, (volatile LAS unsigned*)(lds + LDSCTL_OFF + LC_BAR));
    const int lo = p.ph_lo, hi = p.ph_hi; const bool probe = p.probe != 0;
#define IN(k) (lo <= (k) && (k) < hi)
#define SEAM(k) do { if ((k) + 1 < hi) xcd_barrier(bar); } while (0)
#define WS_PTRS() unsigned char* ws = opaque_ptr(p.ws); unsigned char* wb = ws + WS_W; unsigned char* rg = ws + WS_R; (void)wb; (void)rg; \
    int tid = threadIdx.x; asm volatile("" : "+v"(tid)); const int lane = tid & 63, wave = __builtin_amdgcn_readfirstlane(tid >> 6); \
    const int gw = bx * NWAVES + wave, gtid = bx * NTHREADS + tid; (void)lane; (void)gw; (void)gtid
#define INP(i) in_ptr(p, (i))
#define STATP(l, k) ((u64*)(ws + WS_STAT) + (size_t)((l) * 7 + (k)) * 16384)

    if (PH_ON(0) && IN(0)) {
        WS_PTRS();
        float* cosT = (float*)(ws + WS_TAB); float* sinT = cosT + SEQ * 32; float* spT = (float*)(ws + WS_TAB + 2 * MiB); u64* ssq_mem = (u64*)(spT + 2 * 1024);
        bf16* memb = (bf16*)(ws + WS_MEMB); bf16* wmkv = (bf16*)(ws + WS_WMKV); bf16* xb = (bf16*)(ws + WS_XB);
        LAS float* scr = (LAS float*)(lds + wave * 16384);
        convert_layer_weights(p, 0, scr, gw, NGW, lane, gtid, NGT);
        for (int it = gw; it < 2 * 2 * 32 * 16; it += NGW) { const int l = it / (2 * 512), r = it % (2 * 512), kv = r / 512, item = r % 512;
            transpose_item(INP(kv ? I_WMV : I_WMK) + (size_t)l * D * DMA, D, DMA, wmkv + (size_t)l * 1024 * D + (size_t)kv * 512 * D, INP(I_MNG) + l * D, 0, scr, item, lane); }
        for (int i = gtid; i < SEQ * 32; i += NGT) { const int t = i >> 5, k = i & 31; const float inv = exp2f(-(float)k * (13.287712379549449f / 32.0f)); float s, c; sincosf((float)t * inv, &s, &c); cosT[i] = c; sinT[i] = s; }
        { const float* lam = INP(I_LAM); for (int i = gtid; i < 2 * 1024; i += NGT) spT[i] = log1pf(expf(-lam[i])); }
        u64* ssq_x0 = STATP(0, ST_X);
        { const float* x = INP(I_X); for (int row = gw; row < T; row += NGW) { const float ss = row_to_bf16(x + (size_t)row * D, xb + (size_t)row * D, lane); if (lane == 0) ssq_set(ssq_x0, row, ss); } }
        { const float* m = INP(I_MEM); for (int row = gw; row < TM; row += NGW) { const float ss = row_to_bf16(m + (size_t)row * D, memb + (size_t)row * D, lane); if (lane == 0) ssq_set(ssq_mem, row, ss); } }
        SEAM(0);
    }

    for (int l = 0; l < DEPTH; ++l) {
        const int pb = 1 + l * NPL;

        if (PH_ON(1) && IN(pb + 0)) {
            WS_PTRS();
            { pg8::DenseSched S{(const char*)(ws + WS_XB), (const char*)(wb + W_IN), D, D, T / 256, ZC / 256, 1, D, G, bx};
              pg8::EpiBf16<0, true> E{(bf16*)(rg + R_Z), ZC, STATP(l, ST_X), 1.0f / D, STATP(l, ST_CQ), STATP(l, ST_CKV), 2, 3};
              pg8::gemm_phase<pg8::EpiBf16<0, true>, pg8::DenseSched, true, false>(lds, D, D, D, S, E, 0); }
            if (l == 0) {
                pg8::DenseSched S{(const char*)(ws + WS_MEMB), (const char*)(ws + WS_WMKV), D, D, TM / 256, 2 * 1024 / 256, 1, D, G, bx};
                pg8::EpiBf16<0, false> E{(bf16*)(ws + WS_KVMEM), 2 * 1024, (const void*)((float*)(ws + WS_TAB + 2 * MiB) + 2 * 1024), 1.0f / D, nullptr, nullptr, 0, 0};
                pg8::gemm_phase<pg8::EpiBf16<0, false>, pg8::DenseSched, true, false>(lds, D, D, D, S, E, 0);
            }
            SEAM(pb + 0);
        }
        if (PH_ON(2) && IN(pb + 1)) {
            WS_PTRS();
            bf16* z = (bf16*)(rg + R_Z);
            { pg8::DenseSched S{(const char*)(z + Z_CQ), (const char*)(wb + W_UQ), ZC, QL, T / 256, NQU / 256, 1, QL, G, bx};
              pg8::EpiBf16<0, false> E{(bf16*)(rg + R_Q), NQU, STATP(l, ST_CQ), 1.0f / QL, nullptr, nullptr, 0, 0};
              pg8::gemm_phase<pg8::EpiBf16<0, false>, pg8::DenseSched, true, false>(lds, QL, ZC, QL, S, E, 0); }
            { pg8::DenseSched S{(const char*)(z + Z_CKV), (const char*)(wb + W_UKV), ZC, KVL, T / 256, NKV / 256, 1, KVL, G, bx};
              pg8::EpiBf16<0, false> E{(bf16*)(rg + R_KVR), NKV, STATP(l, ST_CKV), 1.0f / KVL, nullptr, nullptr, 0, 0};
              pg8::gemm_phase<pg8::EpiBf16<0, false>, pg8::DenseSched, true, false>(lds, KVL, ZC, KVL, S, E, 0); }
            conv_phase(z, (bf16*)(rg + R_XC), INP(I_CONVW) + (size_t)l * 4 * DRNN, INP(I_CONVB) + (size_t)l * DRNN, gtid, NGT);
            if (l == 0) { const float* mkg = INP(I_MKG); for (int ll = 0; ll < 2; ++ll) head128_norm_rows<false>((bf16*)(ws + WS_KVMEM) + (size_t)ll * 1024, nullptr, 2 * 1024, (bf16*)(ws + WS_KMEMN) + (size_t)ll * TM * DMA, mkg + ll * 128, TM, gw, NGW, lane); }
            SEAM(pb + 1);
        }
        if (PH_ON(3) && IN(pb + 2)) {
            WS_PTRS();
            float* cosT = (float*)(ws + WS_TAB);
            qk_post_phase((bf16*)(rg + R_Q), (const bf16*)(rg + R_KVR), (const bf16*)(rg + R_Z), (bf16*)(rg + R_KK), INP(I_AQG) + l * QKH, INP(I_AKG) + l * QKH, cosT, cosT + SEQ * 32, gw, NGW, lane);
            { pg8::GateSched S{(const char*)(rg + R_XC), (const char*)(wb + W_G), G, bx};
              pg8::EpiGates E{(const bf16*)(rg + R_XC), INP(I_BRG) + l * DRNN, INP(I_BIG) + l * DRNN, (float*)(ws + WS_TAB + 2 * MiB) + l * DRNN, (float*)(rg + R_AA), (float*)(rg + R_UU)};
              pg8::gemm_phase<pg8::EpiGates, pg8::GateSched, true, false>(lds, 256, DRNN, 256, S, E, 0); }
            SEAM(pb + 2);
        }
        if (PH_ON(4) && IN(pb + 3)) {
            WS_PTRS();
            float* sA = (float*)(ws + WS_SCAN2);
            for (int u = bx; u < 256; u += G) scan_pass1((const float*)(rg + R_AA), (const float*)(rg + R_UU), sA, sA + 512 * 1024, sA + 1024 * 1024, sA + 1024 * 1024 + 64 * 1024, (LAS f32x4*)lds, u, wave, lane);
            SEAM(pb + 3);
        }
        if (PH_ON(5) && IN(pb + 4)) {
            WS_PTRS();
            bf16* ymix = (bf16*)(rg + R_YMIX);
            {
                bf16* qbuf = (bf16*)(rg + R_Q); bf16* kk = (bf16*)(rg + R_KK); bf16* kvr = (bf16*)(rg + R_KVR); u64* ssq_ya = STATP(l, ST_YATT);
                const att::Strides<NQU, NQU, NKV, D> sd;
                for (int it = bx; it < 256; it += G) {
                    att::BlockRef cur = mla_ref(it, 0, qbuf, kk, kvr, ymix, ssq_ya);
                    att::Seam<12> S;
                    att::attn_prime<64>(cur, sd, (char*)lds_raw, S);
                    for (int pass = 0; pass < 2; ++pass) {
                        const att::BlockRef nxt = (pass == 0) ? mla_ref(it, 1, qbuf, kk, kvr, ymix, ssq_ya) : cur;
                        att::attn_block<64, true, true>(cur, nxt, sd, 0.07216878364870322f, (char*)lds_raw, S);
                        cur = nxt;
                    }
                }
            }
            { float* sA = (float*)(ws + WS_SCAN2);
              for (int u = bx; u < 256; u += G) scan_pass3((const float*)(rg + R_AA), (const float*)(rg + R_UU), sA, sA + 512 * 1024, sA + 1024 * 1024, sA + 1024 * 1024 + 64 * 1024, (const bf16*)(rg + R_Z), ymix, STATP(l, ST_YRNN), u, wave, lane); }
            SEAM(pb + 4);
        }
        if (PH_ON(6) && IN(pb + 5)) {
            WS_PTRS();
            pg8::DenseSched S{(const char*)(rg + R_YMIX), (const char*)(wb + W_OUT), D, D, T / 256, D / 256, 1, D, G, bx};
            pg8::EpiResid<true> E{(bf16*)(ws + WS_XB), STATP(l, ST_X1), STATP(l, ST_YATT), STATP(l, ST_YRNN)};
            pg8::gemm_phase<pg8::EpiResid<true>, pg8::DenseSched, true, true>(lds, D, D, D, S, E, 16);
            SEAM(pb + 5);
        }
        if (PH_ON(7) && IN(pb + 6)) {
            WS_PTRS();
            pg8::DenseSched S{(const char*)(ws + WS_XB), (const char*)(wb + W_MQ), D, D, T / 256, DMA / 256, 2, 1024, G, bx};
            pg8::EpiF32Slab E{(float*)(rg + R_QM), DMA, (size_t)T * DMA, STATP(l, ST_X1), 1.0f / D};
            pg8::gemm_phase<pg8::EpiF32Slab, pg8::DenseSched, true, false>(lds, 1024, D, D, S, E, 0);
            SEAM(pb + 6);
        }
        if (PH_ON(8) && IN(pb + 7)) {
            WS_PTRS();
            float* qm = (float*)(rg + R_QM);
            head128_norm_rows<true>(qm, qm + (size_t)T * DMA, DMA, (bf16*)(rg + R_QMN), INP(I_MQG) + l * 128, T, gw, NGW, lane);
            SEAM(pb + 7);
        }
        if (PH_ON(9) && IN(pb + 8)) {
            WS_PTRS();
            bf16* qmn = (bf16*)(rg + R_QMN); bf16* om = (bf16*)(rg + R_OM); bf16* kmemn = (bf16*)(ws + WS_KMEMN); bf16* kvmem = (bf16*)(ws + WS_KVMEM);
            const att::Strides<DMA, DMA, 2 * 1024, DMA> sd;
            for (int it = bx; it < 256; it += G) {
                const int h = it & 3, rb = it >> 2, b = rb >> 5;
                att::BlockRef c0;
                c0.Q = qmn + (size_t)rb * 256 * DMA + h * 128; c0.K = kmemn + ((size_t)l * TM + (size_t)b * NMEM) * DMA + h * 128;
                c0.V = kvmem + (size_t)l * 1024 + (size_t)b * NMEM * 2048 + 512 + h * 128; c0.O = om + (size_t)rb * 256 * DMA + h * 128; c0.ssq = nullptr; c0.P0 = 0; c0.nk = NMEM;
                att::Seam<8> S;
                att::attn_prime<0>(c0, sd, (char*)lds_raw, S);
                att::attn_block<0, false, false>(c0, c0, sd, 0.08838834764831845f, (char*)lds_raw, S);
            }
            SEAM(pb + 8);
        }
        if (PH_ON(10) && IN(pb + 9)) {
            WS_PTRS();
            pg8::DenseSched S{(const char*)(rg + R_OM), (const char*)(wb + W_MO), DMA, DMA, T / 256, D / 256, 1, DMA, G, bx};
            pg8::EpiResid<false> E{(bf16*)(ws + WS_XB), STATP(l, ST_X2), nullptr, nullptr};
            pg8::gemm_phase<pg8::EpiResid<false>, pg8::DenseSched, true, false>(lds, DMA, DMA, DMA, S, E, 0);
            SEAM(pb + 9);
        }
        if (PH_ON(11) && IN(pb + 10)) {
            WS_PTRS();
            pg8::DenseSched S{(const char*)(ws + WS_XB), (const char*)(wb + W_R), D, D, T / 256, 1, 4, 512, G, bx};
            pg8::EpiRouter E{(float*)(rg + R_AA)};
            pg8::gemm_phase<pg8::EpiRouter, pg8::DenseSched, true, false>(lds, 512, D, D, S, E, 0);
            SEAM(pb + 10);
        }
        if (PH_ON(12) && IN(pb + 11)) {
            WS_PTRS();
            unsigned* cnt = (unsigned*)(ws + WS_CTL) + CW_CNT + l * 64;
            for (int w = bx; w < 256; w += G) route_phase((const float*)(rg + R_AA), STATP(l, ST_X2), INP(I_BRGRP) + l * 4, INP(I_BREXP) + l * 32, (int*)(ws + WS_MOE), (float*)(ws + WS_MOE + 128 * 1024),
                                                          (int*)(ws + WS_MOE + 384 * 1024), cnt, (LAS int*)lds, w, tid);
            SEAM(pb + 11);
        }
        if (PH_ON(13) && IN(pb + 12)) {
            WS_PTRS();
            unsigned* cnt = (unsigned*)(ws + WS_CTL) + CW_CNT + l * 64;
            for (int w = bx; w < 256; w += G) dispatch_phase(cnt, (const int*)(ws + WS_MOE + 384 * 1024), (const int*)(ws + WS_MOE), (const float*)(ws + WS_MOE + 128 * 1024), STATP(l, ST_X2),
                                                             (int*)(ws + WS_MOE + 256 * 1024), (int*)(ws + WS_MOE + 512 * 1024), (float*)(ws + WS_MOE + 704 * 1024), (float*)(ws + WS_MOE + 896 * 1024), (LAS int*)lds, w, tid);
            SEAM(pb + 12);
        }
        if (PH_ON(14) && IN(pb + 13)) {
            WS_PTRS();
            const int nrt = build_rtab((unsigned*)(ws + WS_CTL) + CW_CNT + l * 64, lc, tid);
            { const int* slot_tok = (const int*)(ws + WS_MOE + 512 * 1024);
              for (int i = 0; i < 4; ++i) { const long L = (long)i * G + bx; if (L < (long)nrt * 4 && tid < 256) lc[LC_LTOK / 4 + i * 256 + tid] = slot_tok[lc[LC_RTAB / 4 + 2 * (int)(L >> 2) + 1] + tid]; }
              __syncthreads(); }
            pg8::MoeUpSched S{(const char*)(ws + WS_XB), (const char*)(wb + W_GU), (const LAS int*)(lc + LC_LTOK / 4), (const LAS int*)(lc + LC_RTAB / 4), nrt, G, bx};
            pg8::EpiSwiglu E{(bf16*)(rg + R_ACT), (const float*)(ws + WS_MOE + 896 * 1024)};
            pg8::gemm_phase<pg8::EpiSwiglu, pg8::MoeUpSched, true, false>(lds, D, D, D, S, E, 0);
            SEAM(pb + 13);
        }
        if (PH_ON(15) && IN(pb + 14)) {
            WS_PTRS();
            const int nrt = build_rtab((unsigned*)(ws + WS_CTL) + CW_CNT + l * 64, lc, tid);
            pg8::MoeDownSched S{(const char*)(rg + R_ACT), (const char*)(wb + W_D), (const LAS int*)(lc + LC_RTAB / 4), nrt, G, bx};
            pg8::EpiBf16<1, false> E{(bf16*)(rg + R_Y), D, (const float*)(ws + WS_MOE + 704 * 1024), 0.f, nullptr, nullptr, 0, 0};
            pg8::gemm_phase<pg8::EpiBf16<1, false>, pg8::MoeDownSched, true, false>(lds, DE, DE, DE, S, E, 0);
            SEAM(pb + 14);
        }
        if (PH_ON(16) && IN(pb + 15)) {
            WS_PTRS();
            const bool more = (l + 1 < DEPTH);
            combine_phase(probe ? (float*)(rg + R_AA) : out_ptr(), (const bf16*)(rg + R_Y), (const int*)(ws + WS_MOE + 256 * 1024), (bf16*)(ws + WS_XB), STATP((l + 1) % DEPTH, ST_X), !more, gw, NGW, lane);
            if (more) { LAS float* scr = (LAS float*)(lds + wave * 16384); convert_layer_weights(p, l + 1, scr, gw, NGW, lane, gtid, NGT); }
            SEAM(pb + 15);
        }
    }
#undef IN
#undef SEAM
}

#ifndef MK_SPLIT
#define MK_SPLIT 0
#endif
extern "C" void kernel_launch(void* const* d_in, const int* in_sizes, int n_in, void* d_out, int out_size, void* d_ws, size_t ws_size, hipStream_t stream) {
    static int grid = 0;
    if (grid == 0) {
        if (n_in != 36 || in_sizes[0] != T * D || out_size != T * D || ws_size < WS_END) {
            fprintf(stderr, "kernel_launch: unexpected shapes (n_in %d, in0 %d, out %d, ws %zu < %zu)\n", n_in, n_in > 0 ? in_sizes[0] : -1, out_size, ws_size, (size_t)WS_END); grid = -1; return; }
        int dev = 0, cus = 0, per_cu = 0;
        if (hipGetDevice(&dev) != hipSuccess || hipDeviceGetAttribute(&cus, hipDeviceAttributeMultiprocessorCount, dev) != hipSuccess) { grid = -1; return; }
        if (hipFuncSetAttribute((const void*)fwd_kernel, hipFuncAttributeMaxDynamicSharedMemorySize, LDS_BYTES) != hipSuccess) { fprintf(stderr, "kernel_launch: hipFuncSetAttribute failed\n"); grid = -1; return; }
        if (hipOccupancyMaxActiveBlocksPerMultiprocessor(&per_cu, (const void*)fwd_kernel, NTHREADS, LDS_BYTES) != hipSuccess || per_cu < 1)
            fprintf(stderr, "kernel_launch: occupancy query reports %d workgroups per CU\n", per_cu);
        (void)hipGetLastError();
        grid = cus;
    }
    if (grid < 0) return;
    if (hipMemsetAsync((char*)d_ws, 0, ZERO_BYTES, stream) != hipSuccess) return;
    Params a{};
    for (int i = 0; i < 36; ++i) a.in[i] = (const float*)d_in[i];
    a.out = (float*)d_out; a.ws = (unsigned char*)d_ws;
#if MK_SPLIT
    for (int ph = 0; ph < NPHASES; ++ph) { a.ph_lo = ph; a.ph_hi = ph + 1; hipLaunchKernelGGL(fwd_kernel, dim3(grid), dim3(NTHREADS), LDS_BYTES, stream, a); }
#else
    a.ph_lo = 0; a.ph_hi = NPHASES;
    hipLaunchKernelGGL(fwd_kernel, dim3(grid), dim3(NTHREADS), LDS_BYTES, stream, a);
#endif
#if defined(PROBE_PHASE)
    a.ph_lo = PROBE_PHASE; a.ph_hi = PROBE_PHASE + 1; a.probe = 1;
    for (int r = 0; r < PROBE_REPS; ++r) hipLaunchKernelGGL(fwd_kernel, dim3(grid), dim3(NTHREADS), LDS_BYTES, stream, a);
#endif
}
```

```cpp
#include <hip/hip_runtime.h>
#include <cstdio>
#include <cstdint>

#define GAS __attribute__((address_space(1)))
#define LAS __attribute__((address_space(3)))
typedef unsigned short bf16;
typedef short bf16x8 __attribute__((ext_vector_type(8)));
typedef short s16x4 __attribute__((ext_vector_type(4)));
typedef float f32x4 __attribute__((ext_vector_type(4)));
typedef float f32x2 __attribute__((ext_vector_type(2)));
typedef float f32x16 __attribute__((ext_vector_type(16)));
typedef unsigned u32x4 __attribute__((ext_vector_type(4)));
typedef unsigned u32x2 __attribute__((ext_vector_type(2)));

constexpr int NBATCH = 2, SEQ = 8192, T = NBATCH * SEQ, D = 2048, DEPTH = 2;
constexpr int NMEM = 256, TM = NBATCH * NMEM;
constexpr int QL = 512, KVL = 256, DRNN = 1024, DATT = 1024;
constexpr int NH = 8, QKH = 192, VH = 128;
constexpr int ZC = 3072;
constexpr int Z_CQ = 0, Z_CKV = 512, Z_XR = 768, Z_GATE = 1792, Z_KPE = 2816;
constexpr int NE = 32, DE = 512, NSLOT = 40960;
constexpr int NQU = NH * QKH;
constexpr int NKV = NH * 256;
constexpr int DMA = 512;
constexpr float EPS = 1e-6f;
constexpr int NWAVES = 8, NTHREADS = 512;

__device__ __forceinline__ unsigned f2bf(float f) { unsigned u = __builtin_bit_cast(unsigned, f); return (u + 0x7fffu + ((u >> 16) & 1u)) >> 16; }
__device__ __forceinline__ unsigned pk2(float lo, float hi) { return f2bf(lo) | (f2bf(hi) << 16); }
__device__ __forceinline__ float bf2f(unsigned short h) { return __builtin_bit_cast(float, (unsigned)h << 16); }
__device__ __forceinline__ float bflo(unsigned w) { return __builtin_bit_cast(float, w << 16); }
__device__ __forceinline__ float bfhi(unsigned w) { return __builtin_bit_cast(float, w & 0xffff0000u); }
__device__ __forceinline__ unsigned cvt_pk_bf16(float lo, float hi) { unsigned r; asm volatile("v_cvt_pk_bf16_f32 %0, %1, %2" : "=v"(r) : "v"(lo), "v"(hi)); return r; }
__device__ __forceinline__ float wave_sum(float v) {
#pragma unroll
    for (int o = 1; o < 64; o <<= 1) v += __shfl_xor(v, o);
    return v;
}
typedef unsigned long long u64;
__device__ __forceinline__ float ssq_val(const u64* p, int row) { return (float)p[row] * (1.0f / 16777216.0f); }
__device__ __forceinline__ void ssq_add(u64* p, int row, float v) { atomicAdd(p + row, (u64)(v * 16777216.0f)); }
__device__ __forceinline__ void ssq_set(u64* p, int row, float v) { p[row] = (u64)(v * 16777216.0f); }
#define LDS_WAIT() asm volatile("s_waitcnt lgkmcnt(0)" ::: "memory")
#define VM_WAIT() asm volatile("s_waitcnt vmcnt(0)" ::: "memory")

#define XB_TMO      128
#define XB_XCNT(j)  (256  + 64 * (j))
#define XB_XSUB(j)  (1280 + 64 * (j))
#define XB_XGEN(j)  (2304 + 64 * (j))
#define XB_TOP      3328
#define XB_TOPGEN   3392
#define XCD_BAR_WORDS 3456
#define XB_SPIN_CAP (1u << 18)
__device__ __forceinline__ unsigned xb_ld(unsigned* p)              { return __hip_atomic_load(p, __ATOMIC_RELAXED, __HIP_MEMORY_SCOPE_AGENT); }
__device__ __forceinline__ unsigned xb_add(unsigned* p, unsigned v) { return __hip_atomic_fetch_add(p, v, __ATOMIC_RELAXED, __HIP_MEMORY_SCOPE_AGENT); }
__device__ __forceinline__ unsigned xb_xcc_id() { return (unsigned)__builtin_amdgcn_s_getreg((3 << 11) | 20) & 0xFu; }
#define XB_SPIN(cond, bar) do { unsigned _sp = 0; while (cond) { __builtin_amdgcn_s_sleep(1); \
    if ((++_sp & 255u) == 0u) { if (xb_ld(&(bar)[XB_TMO])) break; if (_sp > XB_SPIN_CAP) { atomicAdd(&(bar)[XB_TMO], 1u); break; } } } } while (0)
struct XcdBarrier { unsigned* bar; unsigned x; volatile LAS unsigned* st; };
__device__ __forceinline__ XcdBarrier xcd_barrier_post(unsigned* bar, volatile LAS unsigned* st) {
    XcdBarrier b; b.bar = bar; b.x = xb_xcc_id(); b.st = st;
    if (threadIdx.x == 0) (void)xb_add(&bar[XB_XCNT(b.x)], 1u);
    return b;
}
__device__ __forceinline__ void xcd_barrier_complete(unsigned* bar, unsigned x, unsigned& nloc, unsigned& nx) {
    const unsigned G = gridDim.x * gridDim.y * gridDim.z;
    unsigned sum, cnt, mine, sp = 0u;
    for (;;) {
        sum = 0u; cnt = 0u; mine = 0u;
#pragma unroll
        for (unsigned j = 0; j < 16; ++j) { const unsigned c = xb_ld(&bar[XB_XCNT(j)]); sum += c; cnt += (c > 0u) ? 1u : 0u; mine = (j == x) ? c : mine; }
        if (sum == G) break;
        __builtin_amdgcn_s_sleep(1);
        if ((++sp & 255u) == 0u) { if (xb_ld(&bar[XB_TMO])) break; if (sp > XB_SPIN_CAP) { atomicAdd(&bar[XB_TMO], 1u); break; } }
    }
    nloc = mine > 0u ? mine : 1u; nx = cnt > 0u ? cnt : 1u;
}
__device__ __forceinline__ void xcd_barrier(const XcdBarrier& b) {
    asm volatile("s_waitcnt vmcnt(0)" ::: "memory");
    __syncthreads();
    if (threadIdx.x == 0) {
        unsigned* bar = b.bar; unsigned bx_ = b.x; asm volatile("" : "+s"(bar), "+s"(bx_));
        __builtin_amdgcn_s_waitcnt(0);
        unsigned nloc = b.st[0], nx = b.st[1];
        if (nloc == 0u) { xcd_barrier_complete(bar, bx_, nloc, nx); b.st[0] = nloc; b.st[1] = nx; }
        const unsigned old = xb_add(&bar[XB_XSUB(bx_)], 1u);
        const unsigned gen = old / nloc;
        if (old + 1u == (gen + 1u) * nloc) {
            __builtin_amdgcn_fence(__ATOMIC_RELEASE, "agent");
            asm volatile("s_waitcnt vmcnt(0)" ::: "memory");
            const unsigned og = xb_add(&bar[XB_TOP], 1u);
            const unsigned tg = og / nx;
            if (og + 1u == (tg + 1u) * nx) xb_add(&bar[XB_TOPGEN], 1u);
            else XB_SPIN(xb_ld(&bar[XB_TOPGEN]) == tg, bar);
            __builtin_amdgcn_fence(__ATOMIC_ACQUIRE, "agent");
            xb_add(&bar[XB_XGEN(bx_)], 1u);
            asm volatile("s_waitcnt vmcnt(0)" ::: "memory");
        } else {
            XB_SPIN(xb_ld(&bar[XB_XGEN(bx_)]) == gen, bar);
            __builtin_amdgcn_fence(__ATOMIC_ACQUIRE, "agent");
            asm volatile("s_waitcnt vmcnt(0)" ::: "memory");
        }
    }
    __syncthreads();
}

namespace pg8 {
constexpr int BM = 256, BK = 64, HALF = 128, HTB = HALF * BK * 2, STAGE_BYTES = 8 * HTB, NXCD = 8, WGM = 8;
__host__ __device__ __forceinline__ int lds_byte(int r, int c) { const int st = (r >> 4) * 2 + (c >> 5), rr = r & 15, cc = c & 31, ob = rr * 64 + cc * 2; return st * 1024 + (ob ^ (((ob >> 9) & 1) << 5)); }
__host__ __device__ __forceinline__ void stage_rc(int b, int& R, int& C) { const int st = b / 1024, sb = b % 1024, swz = sb ^ (((sb >> 9) & 1) << 5); R = (st >> 1) * 16 + swz / 64; C = (st & 1) * 32 + (swz % 64) / 2; }
__host__ __device__ __forceinline__ int perm32(int rho) { const int n = rho >> 4, i = rho & 15; return 8 * (i >> 2) + 4 * n + (i & 3); }

struct Unit { const char* A; const char* B; int pm, pn, aux; };

__device__ __forceinline__ bool static_tile(int i, int G, int c, int nM, int nN, int& pm, int& pn) {
    const int nwg = nM * nN; const long L = (long)i * G + c; if (L >= nwg) return false;
    int wgid = (int)L; { const int q = nwg / NXCD, r = nwg % NXCD, xcd = wgid % NXCD, off = wgid / NXCD; wgid = (xcd < r ? xcd * (q + 1) : r * (q + 1) + (xcd - r) * q) + off; }
    const int nig = WGM * nN, gid = wgid / nig, fm = gid * WGM, gsz = (nM - fm) < WGM ? (nM - fm) : WGM;
    pm = fm + ((wgid % nig) % gsz); pn = (wgid % nig) / gsz; return true;
}

template <class Epi, class Sched, bool ALIGN_EPI, bool MID>
__device__ __forceinline__ void gemm_phase(LAS unsigned char* lds, const int K, const int lda, const int ldb, const Sched& S, const Epi& E, const int mid_t) {
    constexpr bool GATHER = Sched::GATHER;
    int tid = threadIdx.x; asm volatile("" : "+v"(tid)); const int wid = __builtin_amdgcn_readfirstlane(tid >> 6), lane = tid & 63, wr = wid >> 2, wc = wid & 3, fr = lane & 15, fq = lane >> 4;
    const int nt = K / BK;
    unsigned voffA[2], voffB[2];
#pragma unroll
    for (int i = 0; i < 2; ++i) { int R, C; stage_rc(tid * 16 + i * 8192, R, C); const int Rb = Epi::PERM ? ((R & ~31) + perm32(R & 31)) : R;
        voffA[i] = (unsigned)(R * lda + C) * 2u; voffB[i] = (unsigned)(Rb * ldb + C) * 2u; }
    const size_t kstep = (size_t)(BK * 2);
    const size_t hstepA = GATHER ? (size_t)0 : (size_t)HALF * lda * 2;
    const size_t hstepB = (size_t)HALF * ldb * 2;
    const unsigned ldsw = (unsigned)wid * 1024u;
    const int aoff = lds_byte(wr * 64 + fr, fq * 8), boff = lds_byte(wc * 32 + fr, fq * 8);
#define PG8_SA(b, h) (((b) * 2 + (h)) * HTB)
#define PG8_SB(b, h) ((4 + (b) * 2 + (h)) * HTB)
#define PG8_STAGE(bufoff, gbase, voff) do { _Pragma("unroll") for (int _i = 0; _i < 2; ++_i) \
        __builtin_amdgcn_global_load_lds((const unsigned*)((const char*)(gbase) + (voff)[_i]), (LAS unsigned*)(lds + (bufoff) + ldsw + _i * 8192), 16, 0, 0); } while (0)
#define PG8_LDA(dst, b, h) do { _Pragma("unroll") for (int m = 0; m < 4; ++m) _Pragma("unroll") for (int k = 0; k < 2; ++k) dst[m][k] = *(const LAS bf16x8*)(lds + PG8_SA(b, h) + aoff + m * 2048 + k * 1024); } while (0)
#define PG8_LDB(dst, b, h) do { _Pragma("unroll") for (int n = 0; n < 2; ++n) _Pragma("unroll") for (int k = 0; k < 2; ++k) dst[n][k] = *(const LAS bf16x8*)(lds + PG8_SB(b, h) + boff + n * 2048 + k * 1024); } while (0)
#define PG8_MMA(ai, bj, At, Bt) do { __builtin_amdgcn_s_setprio(1); _Pragma("unroll") for (int m = 0; m < 4; ++m) _Pragma("unroll") for (int n = 0; n < 2; ++n) _Pragma("unroll") for (int k = 0; k < 2; ++k) \
        acc[ai][bj][m][n] = __builtin_amdgcn_mfma_f32_16x16x32_bf16(Bt[n][k], At[m][k], acc[ai][bj][m][n], 0, 0, 0); __builtin_amdgcn_s_setprio(0); } while (0)
#define PG8_WAIT_V(n) asm volatile("s_waitcnt vmcnt(" #n ")" ::: "memory")
#define PG8_WAIT_L(n) asm volatile("s_waitcnt lgkmcnt(" #n ")" ::: "memory")
#define PG8_BAR __builtin_amdgcn_s_barrier()
#define PG8_SCHED __builtin_amdgcn_sched_barrier(0)
    Unit cur, nxt; int ui = 0;
    if (!S.next(0, cur)) return;
    f32x4 acc[2][2][4][2];
#pragma unroll
    for (int a = 0; a < 2; ++a)
#pragma unroll
        for (int b = 0; b < 2; ++b)
#pragma unroll
            for (int m = 0; m < 4; ++m)
#pragma unroll
                for (int n = 0; n < 2; ++n) acc[a][b][m][n] = (f32x4){0.f, 0.f, 0.f, 0.f};
    bf16x8 At[4][2], B0[2][2], B1[2][2];
    unsigned gA0[2], gA1[2], gN0[2], gN1[2];
    if constexpr (GATHER) {
#pragma unroll
        for (int i = 0; i < 2; ++i) { int R, C; stage_rc(tid * 16 + i * 8192, R, C); gA0[i] = S.arow(cur, R) + (unsigned)C * 2u; gA1[i] = S.arow(cur, HALF + R) + (unsigned)C * 2u; gN0[i] = gA0[i]; gN1[i] = gA1[i]; }
    }
#define PG8_STAGE_A(b, h, gbase, G0, G1) do { if constexpr (GATHER) { if ((h) == 0) PG8_STAGE(PG8_SA(b, h), gbase, G0); else PG8_STAGE(PG8_SA(b, h), gbase, G1); } \
        else PG8_STAGE(PG8_SA(b, h), (gbase) + (h) * hstepA, voffA); } while (0)
    const char* cA = cur.A; const char* cB = cur.B;
    PG8_STAGE(PG8_SB(0, 0), cB, voffB); PG8_STAGE(PG8_SB(0, 1), cB + hstepB, voffB); PG8_STAGE_A(0, 0, cA, gA0, gA1); PG8_STAGE_A(0, 1, cA, gA0, gA1);
    if (wr == 1) PG8_BAR;
    PG8_WAIT_V(2); PG8_BAR;
    PG8_STAGE(PG8_SB(1, 0), cB + kstep, voffB); PG8_STAGE_A(1, 0, cA + kstep, gA0, gA1); PG8_STAGE(PG8_SB(1, 1), cB + hstepB + kstep, voffB);
    PG8_WAIT_V(6); PG8_BAR;
    for (;;) {
        const bool has_next = S.next(ui + 1, nxt);
        const char* nA = has_next ? nxt.A : cA; const char* nB = has_next ? nxt.B : cB;
        if constexpr (GATHER) {
            if (has_next) {
#pragma unroll
                for (int i = 0; i < 2; ++i) { int R, C; stage_rc(tid * 16 + i * 8192, R, C); gN0[i] = S.arow(nxt, R) + (unsigned)C * 2u; gN1[i] = S.arow(nxt, HALF + R) + (unsigned)C * 2u; }
            }
        }
#pragma nounroll
        for (int t = 0; t < nt; t += 2) {
            const bool last = (t == nt - 2);
            if constexpr (MID) { if (t == mid_t) E.mid(acc, cur, wr, wc, fr, fq); }
            const char* a1 = cA + (size_t)(t + 1) * kstep;
            const char* a2 = last ? nA : cA + (size_t)(t + 2) * kstep; const char* b2 = last ? nB : cB + (size_t)(t + 2) * kstep;
            const char* a3 = a2 + kstep; const char* b3 = b2 + kstep;
            unsigned w0[2], w1[2];
            if constexpr (GATHER) {
#pragma unroll
                for (int i = 0; i < 2; ++i) { w0[i] = last ? gN0[i] : gA0[i]; w1[i] = last ? gN1[i] : gA1[i]; }
            }
            PG8_LDB(B0, 0, 0); PG8_LDB(B1, 0, 1); PG8_SCHED; PG8_LDA(At, 0, 0); PG8_STAGE_A(1, 1, a1, gA0, gA1);
            PG8_WAIT_V(8); PG8_WAIT_L(0); PG8_BAR; PG8_MMA(0, 0, At, B0); PG8_MMA(0, 1, At, B1); PG8_BAR; PG8_SCHED;
            PG8_LDA(At, 0, 1); PG8_STAGE(PG8_SB(0, 0), b2, voffB); PG8_STAGE(PG8_SB(0, 1), b2 + hstepB, voffB); PG8_STAGE_A(0, 0, a2, w0, w1);
            PG8_WAIT_V(8); PG8_WAIT_L(0); PG8_BAR; PG8_MMA(1, 0, At, B0); PG8_MMA(1, 1, At, B1); PG8_BAR; PG8_SCHED;
            PG8_LDB(B0, 1, 0); PG8_LDB(B1, 1, 1); PG8_SCHED; PG8_LDA(At, 1, 0); PG8_STAGE_A(0, 1, a2, w0, w1);
            PG8_WAIT_V(8); PG8_WAIT_L(0); PG8_BAR; PG8_MMA(0, 0, At, B0); PG8_MMA(0, 1, At, B1); PG8_BAR; PG8_SCHED;
            PG8_LDA(At, 1, 1); PG8_STAGE(PG8_SB(1, 0), b3, voffB); PG8_STAGE(PG8_SB(1, 1), b3 + hstepB, voffB); PG8_STAGE_A(1, 0, a3, w0, w1);
            PG8_WAIT_V(8); PG8_WAIT_L(0); PG8_BAR; PG8_MMA(1, 0, At, B0); PG8_MMA(1, 1, At, B1); PG8_BAR; PG8_SCHED;
        }
        if constexpr (ALIGN_EPI) { if (wr == 0) PG8_BAR; }
        E(acc, cur, wr, wc, fr, fq);
        if (!has_next) break;
#pragma unroll
        for (int a = 0; a < 2; ++a)
#pragma unroll
            for (int b = 0; b < 2; ++b)
#pragma unroll
                for (int m = 0; m < 4; ++m)
#pragma unroll
                    for (int n = 0; n < 2; ++n) acc[a][b][m][n] = (f32x4){0.f, 0.f, 0.f, 0.f};
        cur = nxt; cA = nA; cB = nB; ++ui;
        if constexpr (GATHER) {
#pragma unroll
            for (int i = 0; i < 2; ++i) { gA0[i] = gN0[i]; gA1[i] = gN1[i]; }
        }
        if constexpr (ALIGN_EPI) { if (wr == 1) PG8_BAR; }
    }
    PG8_WAIT_V(0);
    if constexpr (!ALIGN_EPI) { if (wr == 0) PG8_BAR; }
    PG8_BAR;
#undef PG8_SA
#undef PG8_SB
#undef PG8_STAGE
#undef PG8_STAGE_A
#undef PG8_LDA
#undef PG8_LDB
#undef PG8_MMA
#undef PG8_WAIT_V
#undef PG8_WAIT_L
#undef PG8_BAR
#undef PG8_SCHED
}
}
namespace pg8 {
struct DenseSched {
    static constexpr bool GATHER = false;
    const char* A; const char* B; int lda, ldb, nM, nN, nKS, Ksplit, G, c;
    __device__ __forceinline__ bool next(int i, Unit& u) const {
        int pm, pc; if (!static_tile(i, G, c, nM, nN * nKS, pm, pc)) return false;
        const int pn = pc / nKS, ks = pc - pn * nKS;
        u.pm = pm; u.pn = pn; u.aux = ks;
        u.A = A + ((size_t)pm * BM * lda + (size_t)ks * Ksplit) * 2;
        u.B = B + ((size_t)pn * BM * ldb + (size_t)ks * Ksplit) * 2;
        return true;
    }
    __device__ __forceinline__ unsigned arow(const Unit&, int r) const { return (unsigned)(r * lda) * 2u; }
};
struct GateSched {
    static constexpr bool GATHER = false;
    const char* A; const char* B; int G, c;
    __device__ __forceinline__ bool next(int i, Unit& u) const {
        int pm, pn; if (!static_tile(i, G, c, T / BM, 8, pm, pn)) return false;
        u.pm = pm; u.pn = pn; u.aux = 0;
        u.A = A + ((size_t)pm * BM * DRNN + (size_t)(pn >> 1) * 256) * 2;
        u.B = B + (size_t)pn * 256 * 256 * 2;
        return true;
    }
    __device__ __forceinline__ unsigned arow(const Unit&, int r) const { return (unsigned)(r * DRNN) * 2u; }
};
struct MoeUpSched {      static constexpr bool GATHER = true;
    const char* A; const char* B; const LAS int* ltok; const LAS int* rtab; int nrt, G, c;
    __device__ __forceinline__ bool next(int i, Unit& u) const {
        const long L = (long)i * G + c; if (L >= (long)nrt * 4) return false;
        const int rt = (int)(L >> 2), pn = (int)(L & 3); const int e = rtab[2 * rt], row0 = rtab[2 * rt + 1];
        u.pm = row0 >> 8; u.pn = pn; u.aux = i; u.A = A;
        u.B = B + ((size_t)e * 1024 * D + (size_t)pn * BM * D) * 2;
        return true;
    }
    __device__ __forceinline__ unsigned arow(const Unit& u, int r) const { return (unsigned)ltok[u.aux * BM + r] * (unsigned)(D * 2); }
};
struct MoeDownSched {    static constexpr bool GATHER = false;
    const char* A; const char* B; const LAS int* rtab; int nrt, G, c;
    __device__ __forceinline__ bool next(int i, Unit& u) const {
        const long L = (long)i * G + c; if (L >= (long)nrt * 8) return false;
        const int rt = (int)(L >> 3), pn = (int)(L & 7); const int e = rtab[2 * rt], row0 = rtab[2 * rt + 1];
        u.pm = row0 >> 8; u.pn = pn; u.aux = e;
        u.A = A + (size_t)row0 * DE * 2;
        u.B = B + ((size_t)e * D * DE + (size_t)pn * BM * DE) * 2;
        return true;
    }
    __device__ __forceinline__ unsigned arow(const Unit&, int r) const { return (unsigned)(r * DE) * 2u; }
};

__device__ __forceinline__ void unpack8x(u32x4 w, float* v) { v[0] = bflo(w.x); v[1] = bfhi(w.x); v[2] = bflo(w.y); v[3] = bfhi(w.y); v[4] = bflo(w.z); v[5] = bfhi(w.z); v[6] = bflo(w.w); v[7] = bfhi(w.w); }
__device__ __forceinline__ void epi_ids(int& wr, int& wc, int& fr, int& fq) { int t = threadIdx.x; asm volatile("" : "+v"(t)); const int wid = t >> 6, lane = t & 63; wr = wid >> 2; wc = wid & 3; fr = lane & 15; fq = lane >> 4; }
template <int MODE, bool STAT> struct EpiBf16 {
    static constexpr bool PERM = true;
    bf16* O; int ldc; const void* rs; float inv_n; u64* stat_a; u64* stat_b; int stat_pn_a, stat_pn_b;
    __device__ __forceinline__ void operator()(const f32x4 (&acc)[2][2][4][2], const Unit& u, int, int, int, int) const {
        int wr, wc, fr, fq; epi_ids(wr, wc, fr, fq);
        int row0 = u.pm * BM + wr * 64 + fr; asm volatile("" : "+v"(row0)); const int col0 = u.pn * BM + wc * 32 + 8 * fq;
        u64* st = nullptr; if (STAT) st = (u.pn < stat_pn_a) ? stat_a : ((u.pn < stat_pn_b) ? stat_b : nullptr);
        float scv[8];
#pragma unroll
        for (int i = 0; i < 8; ++i) { const int row = row0 + (i >> 2) * HALF + (i & 3) * 16; scv[i] = (MODE == 0) ? ssq_val((const u64*)rs, row) : ((MODE == 1) ? ((const float*)rs)[row] : 1.f); }
#pragma unroll
        for (int ai = 0; ai < 2; ++ai)
#pragma unroll
            for (int m = 0; m < 4; ++m) { const int row = row0 + ai * HALF + m * 16;
                float sc = scv[ai * 4 + m];
                if (MODE == 0) sc = 1.0f / sqrtf(sc * inv_n + EPS);
                bf16* rowp = O + (size_t)row * ldc + col0; float ss = 0.f;
#pragma unroll
                for (int bj = 0; bj < 2; ++bj) { const f32x4 v0 = acc[ai][bj][m][0] * sc, v1 = acc[ai][bj][m][1] * sc;
                    if (STAT) ss += (v0[0] * v0[0] + v0[1] * v0[1]) + (v0[2] * v0[2] + v0[3] * v0[3]) + (v1[0] * v1[0] + v1[1] * v1[1]) + (v1[2] * v1[2] + v1[3] * v1[3]);
                    u32x4 w; w.x = cvt_pk_bf16(v0[0], v0[1]); w.y = cvt_pk_bf16(v0[2], v0[3]); w.z = cvt_pk_bf16(v1[0], v1[1]); w.w = cvt_pk_bf16(v1[2], v1[3]);
                    *(u32x4*)(rowp + bj * HALF) = w; }
                if (STAT) { ss += __shfl_xor(ss, 16); ss += __shfl_xor(ss, 32); if (st != nullptr && fq == 0) ssq_add(st, row, ss); }
            }
    }
};
struct EpiF32Slab {
    static constexpr bool PERM = false;
    float* O; int ldc; size_t slab; const u64* rs; float inv_n;
    __device__ __forceinline__ void operator()(const f32x4 (&acc)[2][2][4][2], const Unit& u, int, int, int, int) const {
        int wr, wc, fr, fq; epi_ids(wr, wc, fr, fq);
        int row0 = u.pm * BM + wr * 64 + fr; asm volatile("" : "+v"(row0)); const int col0 = u.pn * BM + wc * 32 + 4 * fq; float* base = O + (size_t)u.aux * slab;
        float scv[8];
#pragma unroll
        for (int i = 0; i < 8; ++i) scv[i] = ssq_val(rs, row0 + (i >> 2) * HALF + (i & 3) * 16);
#pragma unroll
        for (int ai = 0; ai < 2; ++ai)
#pragma unroll
            for (int m = 0; m < 4; ++m) { const int row = row0 + ai * HALF + m * 16; const float sc = 1.0f / sqrtf(scv[ai * 4 + m] * inv_n + EPS);
                float* rowp = base + (size_t)row * ldc + col0;
#pragma unroll
                for (int bj = 0; bj < 2; ++bj)
#pragma unroll
                    for (int n = 0; n < 2; ++n) *(f32x4*)(rowp + bj * HALF + n * 16) = acc[ai][bj][m][n] * sc; }
    }
};
template <bool SCALE> struct EpiResid {
    static constexpr bool PERM = true;
    bf16* xb; u64* stat; const u64* ssq_a; const u64* ssq_b;
    __device__ __forceinline__ void mid(f32x4 (&acc)[2][2][4][2], const Unit& u, int, int, int, int) const {
        int wr, wc, fr, fq; epi_ids(wr, wc, fr, fq);
        int row0 = u.pm * BM + wr * 64 + fr; asm volatile("" : "+v"(row0));
        float sa[8], sb[8];
#pragma unroll
        for (int i = 0; i < 8; ++i) { const int row = row0 + (i >> 2) * HALF + (i & 3) * 16; sa[i] = ssq_val(ssq_a, row); sb[i] = ssq_val(ssq_b, row); }
#pragma unroll
        for (int ai = 0; ai < 2; ++ai)
#pragma unroll
            for (int m = 0; m < 4; ++m) {
                const float ra = 1.0f / sqrtf(sa[ai * 4 + m] * (1.0f / 1024.0f) + EPS), rb = 1.0f / sqrtf(sb[ai * 4 + m] * (1.0f / 1024.0f) + EPS); const float f = ra / rb;
#pragma unroll
                for (int bj = 0; bj < 2; ++bj)
#pragma unroll
                    for (int n = 0; n < 2; ++n) acc[ai][bj][m][n] = acc[ai][bj][m][n] * f; }
    }
    __device__ __forceinline__ void operator()(const f32x4 (&acc)[2][2][4][2], const Unit& u, int, int, int, int) const {
        int wr, wc, fr, fq; epi_ids(wr, wc, fr, fq);
        int row0 = u.pm * BM + wr * 64 + fr; asm volatile("" : "+v"(row0)); const int col0 = u.pn * BM + wc * 32 + 8 * fq;
        GAS bf16* xg = (GAS bf16*)xb;
        float sbv[8];
#pragma unroll
        for (int i = 0; i < 8; ++i) sbv[i] = SCALE ? ssq_val(ssq_b, row0 + (i >> 2) * HALF + (i & 3) * 16) : 0.f;
#pragma unroll
        for (int ai = 0; ai < 2; ++ai) {
            u32x4 xr[4][2];
#pragma unroll
            for (int m = 0; m < 4; ++m)
#pragma unroll
                for (int bj = 0; bj < 2; ++bj) xr[m][bj] = *(const GAS u32x4*)(xg + (unsigned)(row0 + ai * HALF + m * 16) * (unsigned)D + (unsigned)(col0 + bj * HALF));
#pragma unroll
            for (int m = 0; m < 4; ++m) { const int row = row0 + ai * HALF + m * 16;
                float sc = 1.f; if (SCALE) sc = 1.0f / sqrtf(sbv[ai * 4 + m] * (1.0f / 1024.0f) + EPS);
                const unsigned off = (unsigned)row * (unsigned)D + (unsigned)col0; float ss = 0.f;
#pragma unroll
                for (int bj = 0; bj < 2; ++bj) { float xv[8], v[8]; unpack8x(xr[m][bj], xv);
#pragma unroll
                    for (int n = 0; n < 2; ++n)
#pragma unroll
                        for (int j = 0; j < 4; ++j) { v[n * 4 + j] = xv[n * 4 + j] + acc[ai][bj][m][n][j] * sc; ss += v[n * 4 + j] * v[n * 4 + j]; }
                    u32x4 w; w.x = cvt_pk_bf16(v[0], v[1]); w.y = cvt_pk_bf16(v[2], v[3]); w.z = cvt_pk_bf16(v[4], v[5]); w.w = cvt_pk_bf16(v[6], v[7]);
                    *(GAS u32x4*)(xg + off + bj * HALF) = w; }
                ss += __shfl_xor(ss, 16); ss += __shfl_xor(ss, 32); if (fq == 0) ssq_add(stat, row, ss);
            }
            asm volatile("" ::: "memory"); __builtin_amdgcn_sched_barrier(0);
        }
    }
};
struct EpiGates {
    static constexpr bool PERM = false;
    const bf16* xc; const float* b_rg; const float* b_ig; const float* sp; float* a_out; float* u_out;
    __device__ __forceinline__ void operator()(const f32x4 (&acc)[2][2][4][2], const Unit& u, int, int, int, int) const {
        int wr, wc, fr, fq; epi_ids(wr, wc, fr, fq);
        const unsigned row0 = (unsigned)(u.pm * BM + wr * 64 + fr);
        const GAS bf16* xg = (const GAS bf16*)xc; GAS float* ag = (GAS float*)a_out; GAS float* ug = (GAS float*)u_out;
#pragma unroll
        for (int n = 0; n < 2; ++n) { const unsigned ch = (unsigned)(u.pn * 128 + wc * 32 + n * 16 + 4 * fq);
            const f32x4 br = *(const GAS f32x4*)((const GAS float*)b_rg + ch), bi = *(const GAS f32x4*)((const GAS float*)b_ig + ch), s4 = *(const GAS f32x4*)((const GAS float*)sp + ch);
            u32x2 xws[2][4];
#pragma unroll
            for (int ai = 0; ai < 2; ++ai)
#pragma unroll
                for (int m = 0; m < 4; ++m) xws[ai][m] = *(const GAS u32x2*)(xg + (row0 + (unsigned)(ai * HALF + m * 16)) * (unsigned)DRNN + ch);
#pragma unroll
            for (int ai = 0; ai < 2; ++ai)
#pragma unroll
                for (int m = 0; m < 4; ++m) { const unsigned off = (row0 + (unsigned)(ai * HALF + m * 16)) * (unsigned)DRNN + ch;
                    const u32x2 xw = xws[ai][m]; const float xv[4] = {bflo(xw.x), bfhi(xw.x), bflo(xw.y), bfhi(xw.y)};
                    const f32x4 pr = acc[ai][0][m][n] + br, pi = acc[ai][1][m][n] + bi; f32x4 av, uv;
#pragma unroll
                    for (int j = 0; j < 4; ++j) { const float r = __builtin_amdgcn_rcpf(1.0f + __expf(-pr[j])), ig = __builtin_amdgcn_rcpf(1.0f + __expf(-pi[j]));
                        const float la = -8.0f * r * s4[j]; const float a = __expf(la); const float x2 = 2.0f * la;
                        const float om = (x2 > -0.03125f) ? -x2 * (1.0f + x2 * (0.5f + x2 * (0.16666667f + x2 * 0.041666668f))) : 1.0f - a * a;
                        av[j] = a; uv[j] = __builtin_amdgcn_sqrtf(om) * (ig * xv[j]); }
                    *(GAS f32x4*)(ag + off) = av; *(GAS f32x4*)(ug + off) = uv; }
        }
    }
};
struct EpiSwiglu {
    static constexpr bool PERM = true;
    bf16* O; const float* rs;
    __device__ __forceinline__ void operator()(const f32x4 (&acc)[2][2][4][2], const Unit& u, int, int, int, int) const {
        int wr, wc, fr, fq; epi_ids(wr, wc, fr, fq);
        int row0 = u.pm * BM + wr * 64 + fr; asm volatile("" : "+v"(row0)); const int col0 = u.pn * 128 + wc * 32 + 8 * fq;
        float scv[8];
#pragma unroll
        for (int i = 0; i < 8; ++i) scv[i] = rs[row0 + (i >> 2) * HALF + (i & 3) * 16];
#pragma unroll
        for (int ai = 0; ai < 2; ++ai)
#pragma unroll
            for (int m = 0; m < 4; ++m) { const int row = row0 + ai * HALF + m * 16; const float sc = scv[ai * 4 + m]; float h[8];
#pragma unroll
                for (int n = 0; n < 2; ++n)
#pragma unroll
                    for (int j = 0; j < 4; ++j) { const float g = acc[ai][0][m][n][j] * sc, up = acc[ai][1][m][n][j] * sc; h[n * 4 + j] = g / (1.0f + __expf(-g)) * up; }
                u32x4 w; w.x = cvt_pk_bf16(h[0], h[1]); w.y = cvt_pk_bf16(h[2], h[3]); w.z = cvt_pk_bf16(h[4], h[5]); w.w = cvt_pk_bf16(h[6], h[7]);
                *(u32x4*)(O + (size_t)row * DE + col0) = w; }
    }
};
struct EpiRouter {
    static constexpr bool PERM = false;
    float* O;
    __device__ __forceinline__ void operator()(const f32x4 (&acc)[2][2][4][2], const Unit& u, int, int, int, int) const {
        int wr, wc, fr, fq; epi_ids(wr, wc, fr, fq);
        if (wc >= 2) return;
        float* Os = O + (size_t)u.aux * ((size_t)T * 64);
        int row0 = u.pm * BM + wr * 64 + fr; asm volatile("" : "+v"(row0)); const int col0 = wc * 32 + 4 * fq;
#pragma unroll
        for (int ai = 0; ai < 2; ++ai)
#pragma unroll
            for (int m = 0; m < 4; ++m) { const int row = row0 + ai * HALF + m * 16;
#pragma unroll
                for (int n = 0; n < 2; ++n) *(f32x4*)(Os + (size_t)row * 64 + col0 + n * 16) = acc[ai][0][m][n]; }
    }
};
}
namespace att {
constexpr int NW = 8, QBLK = 32, KVBLK = 64, QB = NW * QBLK;
constexpr int SHM_V = KVBLK * 128 * 2, SHM_K = KVBLK * 128 * 2, SHM_R = KVBLK * 64 * 2;
constexpr int OFF_V = 0, OFF_K = 2 * SHM_V, OFF_R = OFF_K + 2 * SHM_K, OFF_WS = OFF_R + 2 * SHM_R, OFF_QR = OFF_WS + NW * 64 * 4, LDS_BYTES = OFF_QR + NW * 4 * 1024;
constexpr float THR = 8.f;

#define KSWZ(row, colB) ((row) * 256 + ((colB) ^ (((row) & 7) << 4)))
#define RSWZ(row, ch) ((row) * 128 + ((((ch) ^ (((row) >> 1) & 7))) << 4))
#define SBAR() __builtin_amdgcn_sched_barrier(0)
__device__ __forceinline__ int v_st(int k, int c) { const int kk = (k & ~0xC) | ((k & 4) << 1) | ((k & 8) >> 1); return ((kk >> 3) * 4 + (c >> 5)) * 512 + ((kk & 7) * 32 + (c & 31)) * 2; }
__device__ __forceinline__ int v_rd_base(int lane) { return ((lane & 3) << 3) | (((lane >> 2) & 3) << 6) | (((lane >> 4) & 1) << 5) | (((lane >> 5) & 1) << 8); }
constexpr int v_rd_off(int d0, int ks, int half) { return d0 * 512 + ks * 4096 + half * 2048; }
__device__ __forceinline__ int crow(int r, int hi) { return (r & 3) + 8 * (r >> 2) + 4 * hi; }
__device__ __forceinline__ unsigned cvtpk(float lo, float hi) { unsigned r; asm volatile("v_cvt_pk_bf16_f32 %0, %1, %2" : "=v"(r) : "v"(lo), "v"(hi)); return r; }
__device__ __forceinline__ bf16x8 load8(const bf16* p) { return *reinterpret_cast<const bf16x8*>(p); }

__device__ __forceinline__ void mask_tile(f32x16& p0, f32x16& p1, int dq) {
    const float NEG = -__builtin_inff();
#pragma unroll
    for (int r = 0; r < 16; ++r) {
        const int c = (r & 3) + 8 * (r >> 2);
        if (dq - c < 0) p0[r] = NEG;
        if (dq - c - 32 < 0) p1[r] = NEG;
    }
}
__device__ __forceinline__ void partialSM(f32x16& p0, f32x16& p1, float& m_reg, float& mn, float& alpha, const float SCALE) {
    float pmax = p0[0]; for (int r = 1; r < 16; ++r) pmax = fmaxf(pmax, p0[r]); for (int r = 0; r < 16; ++r) pmax = fmaxf(pmax, p1[r]);
    { auto rr = __builtin_amdgcn_permlane32_swap(__float_as_uint(pmax), __float_as_uint(pmax), false, false);
      pmax = fmaxf(__uint_as_float(rr[0]), __uint_as_float(rr[1])); }
    const float C2 = 1.4426950408889634f * SCALE;
    if (__builtin_expect(__all((pmax - m_reg) * SCALE <= THR), 1)) { mn = m_reg; alpha = 1.f; }
    else { mn = fmaxf(m_reg, pmax); alpha = __builtin_amdgcn_exp2f((m_reg - mn) * C2); m_reg = mn; }
    const float mnL = -mn * C2;
    for (int r = 0; r < 16; ++r) p0[r] = fmaf(p0[r], C2, mnL); for (int r = 0; r < 16; ++r) p1[r] = fmaf(p1[r], C2, mnL);
    for (int r = 0; r < 16; ++r) p0[r] = __builtin_amdgcn_exp2f(p0[r]);
}
__device__ __forceinline__ void finishSM(f32x16& p0, f32x16& p1, float alpha, float& l_reg, bf16x8& pa0, bf16x8& pa1, bf16x8& pa2, bf16x8& pa3) {
    for (int r = 0; r < 16; ++r) p1[r] = __builtin_amdgcn_exp2f(p1[r]);
    float ps = 0; for (int r = 0; r < 16; ++r) ps += p0[r]; for (int r = 0; r < 16; ++r) ps += p1[r];
    { auto rr = __builtin_amdgcn_permlane32_swap(__float_as_uint(ps), __float_as_uint(ps), false, false);
      ps = __uint_as_float(rr[0]) + __uint_as_float(rr[1]); }
    l_reg = l_reg * alpha + ps;
#define PK4(P, B_, OUT) do { unsigned a0 = cvtpk(P[B_+0], P[B_+1]), a1 = cvtpk(P[B_+2], P[B_+3]);                          \
        unsigned b0 = cvtpk(P[B_+4], P[B_+5]), b1 = cvtpk(P[B_+6], P[B_+7]);                                             \
        auto r0 = __builtin_amdgcn_permlane32_swap(a0, b0, false, false); auto r1 = __builtin_amdgcn_permlane32_swap(a1, b1, false, false); \
        u32x4 w = {r0[0], r1[0], r0[1], r1[1]}; OUT = *reinterpret_cast<bf16x8*>(&w); } while (0)
    PK4(p0, 0, pa0); PK4(p0, 8, pa1); PK4(p1, 0, pa2); PK4(p1, 8, pa3);
#undef PK4
}
template <int KB, int ROPE>
__device__ __forceinline__ void qkt(f32x16& p0, f32x16& p1, const char* lds, int r32_, int hi_, const bf16x8* qr, const char* qrl) {
    p0 = f32x16{}; p1 = f32x16{};
    int lane_ = r32_ | (hi_ << 5); asm volatile("" : "+v"(lane_)); const int r32 = lane_ & 31, hi = lane_ >> 5;
    const char* kb[4];
#pragma unroll
    for (int dd = 0; dd < 4; ++dd) kb[dd] = lds + OFF_K + KB * SHM_K + KSWZ(r32, (dd * 16 + hi * 8) * 2);
#pragma unroll
    for (int d0 = 0; d0 < 8; ++d0) { const char* a = kb[d0 & 3] + (d0 >> 2) * 128;
        bf16x8 b0 = *reinterpret_cast<const bf16x8*>(a);
        bf16x8 b1 = *reinterpret_cast<const bf16x8*>(a + 32 * 256);
        p0 = __builtin_amdgcn_mfma_f32_32x32x16_bf16(b0, qr[d0], p0, 0, 0, 0);
        p1 = __builtin_amdgcn_mfma_f32_32x32x16_bf16(b1, qr[d0], p1, 0, 0, 0); }
    if constexpr (ROPE > 0) {
#pragma unroll
        for (int d0 = 0; d0 < 4; ++d0) { const char* a = lds + OFF_R + KB * SHM_R + RSWZ(r32, d0 * 2 + hi);
            bf16x8 b0 = *reinterpret_cast<const bf16x8*>(a);
            bf16x8 b1 = *reinterpret_cast<const bf16x8*>(a + 32 * 128);
            const bf16x8 qf = *reinterpret_cast<const bf16x8*>(qrl + d0 * 1024);
            p0 = __builtin_amdgcn_mfma_f32_32x32x16_bf16(b0, qf, p0, 0, 0, 0);
            p1 = __builtin_amdgcn_mfma_f32_32x32x16_bf16(b1, qf, p1, 0, 0, 0); }
    }
}
template <int VB>
__device__ __forceinline__ void pv_tile(f32x16* o, int vb0, bf16x8 pa0, bf16x8 pa1, bf16x8 pa2, bf16x8 pa3) {
#define TRRD(dst, off) asm volatile("ds_read_b64_tr_b16 %0, %1 offset:%2" : "=&v"(dst) : "v"(vb0), "i"(off) : "memory")
#define PV_D0(d0) do { s16x4 l0, l1, l2, l3, h0, h1, h2, h3; constexpr int b_ = OFF_V + VB * SHM_V + v_rd_off(d0, 0, 0); \
        TRRD(l0, b_); TRRD(h0, b_ + 2048); TRRD(l1, b_ + 4096); TRRD(h1, b_ + 6144); TRRD(l2, b_ + 8192); TRRD(h2, b_ + 10240); TRRD(l3, b_ + 12288); TRRD(h3, b_ + 14336); \
        asm volatile("s_waitcnt lgkmcnt(0)" ::: "memory"); SBAR();   \
        o[d0] = __builtin_amdgcn_mfma_f32_32x32x16_bf16(pa0, (bf16x8){l0[0], l0[1], l0[2], l0[3], h0[0], h0[1], h0[2], h0[3]}, o[d0], 0, 0, 0);   \
        o[d0] = __builtin_amdgcn_mfma_f32_32x32x16_bf16(pa1, (bf16x8){l1[0], l1[1], l1[2], l1[3], h1[0], h1[1], h1[2], h1[3]}, o[d0], 0, 0, 0);   \
        o[d0] = __builtin_amdgcn_mfma_f32_32x32x16_bf16(pa2, (bf16x8){l2[0], l2[1], l2[2], l2[3], h2[0], h2[1], h2[2], h2[3]}, o[d0], 0, 0, 0);   \
        o[d0] = __builtin_amdgcn_mfma_f32_32x32x16_bf16(pa3, (bf16x8){l3[0], l3[1], l3[2], l3[3], h3[0], h3[1], h3[2], h3[3]}, o[d0], 0, 0, 0); } while (0)
    PV_D0(0); PV_D0(1); PV_D0(2); PV_D0(3);
#undef PV_D0
#undef TRRD
}

template <int LDQ, int LDK, int LDV, int LDO> struct Strides { static constexpr int ldq = LDQ, ldk = LDK, ldv = LDV, ldo = LDO; };
struct BlockRef { const bf16* Q; const bf16* K; const bf16* V; bf16* O; u64* ssq; int P0; int nk; };
template <int NQ> struct Seam { bf16x8 qr[8]; bf16x8 st_v0, st_v1, st_k0, st_k1, st_r; };

#define VMW() asm volatile("s_waitcnt vmcnt(0)" ::: "memory")
#define VMWN(n) asm volatile("s_waitcnt vmcnt(%0)" :: "i"(n) : "memory")
__device__ __forceinline__ int optid() { int t = threadIdx.x; asm volatile("" : "+v"(t)); return t; }
#define SLOAD_H(Kp, Vp, k0) do { const int t_ = optid(); const unsigned sr_ = t_ >> 4, sc_ = (t_ & 15) * 8, rr_ = t_ >> 3, rc_ = (t_ & 7) * 8;   \
                                 const bf16* kt_ = (Kp) + (size_t)(k0) * st.ldk; const bf16* vt_ = (Vp) + (size_t)(k0) * st.ldv;                    \
                                 S.st_v0 = load8(vt_ + (sr_ * st.ldv + sc_)); S.st_v1 = load8(vt_ + ((32 + sr_) * st.ldv + sc_));                   \
                                 S.st_k0 = load8(kt_ + (sr_ * st.ldk + sc_)); S.st_k1 = load8(kt_ + ((32 + sr_) * st.ldk + sc_));                   \
                                 if constexpr (ROPE > 0) S.st_r = load8(kt_ + (rr_ * st.ldk + 128 + rc_)); } while (0)
#define SWRITE_HK(bf) do { const int t_ = optid(); const int kws_ = KSWZ(t_ >> 4, (t_ & 15) * 16);                                                  \
                           *(bf16x8*)(lds + OFF_K + (bf) * SHM_K + kws_) = S.st_k0; *(bf16x8*)(lds + OFF_K + (bf) * SHM_K + kws_ + 32 * 256) = S.st_k1;   \
                           if constexpr (ROPE > 0) *(bf16x8*)(lds + OFF_R + (bf) * SHM_R + RSWZ(t_ >> 3, t_ & 7)) = S.st_r; } while (0)
#define SWRITE_HV(bf) do { const int t_ = optid(); const int sr_ = t_ >> 4, sc_ = (t_ & 15) * 8;                                                     \
                           *(bf16x8*)(lds + OFF_V + (bf) * SHM_V + v_st(sr_, sc_)) = S.st_v0; *(bf16x8*)(lds + OFF_V + (bf) * SHM_V + v_st(32 + sr_, sc_)) = S.st_v1; } while (0)
#define SWRITE_H(bf) do { SWRITE_HV(bf); SWRITE_HK(bf); } while (0)

template <int ROPE, class ST>
__device__ __forceinline__ void attn_prime(const BlockRef& cur, const ST& st, char* lds, Seam<8 + ROPE / 16>& S) {
    constexpr int NQ = 8 + ROPE / 16;
    int tid = threadIdx.x; asm volatile("" : "+v"(tid)); const int wid = __builtin_amdgcn_readfirstlane(tid >> 6), lane = tid & 63, r32 = lane & 31, hi = lane >> 5;
#pragma unroll
    for (int d0 = 0; d0 < 8; ++d0) S.qr[d0] = load8(cur.Q + (size_t)(wid * QBLK + r32) * st.ldq + d0 * 16 + hi * 8);
    if constexpr (ROPE > 0) {
#pragma unroll
        for (int d0 = 0; d0 < 4; ++d0) *(bf16x8*)(lds + OFF_QR + wid * 4096 + d0 * 1024 + lane * 16) = load8(cur.Q + (size_t)(wid * QBLK + r32) * st.ldq + 128 + d0 * 16 + hi * 8);
    }
    SLOAD_H(cur.K, cur.V, 0); VMW(); SWRITE_HK(0);
    __syncthreads();
}
template <int ROPE, bool CAUSAL, bool STAT, class ST>
__device__ __forceinline__ void attn_block(const BlockRef& cur, const BlockRef& nxt, const ST& st, const float SCALE, char* lds, Seam<8 + ROPE / 16>& S) {
    constexpr int NQ = 8 + ROPE / 16;
    int tid = threadIdx.x; asm volatile("" : "+v"(tid)); const int wid = __builtin_amdgcn_readfirstlane(tid >> 6), lane = tid & 63, r32 = lane & 31, hi = lane >> 5;
    const int NT = CAUSAL ? ((cur.P0 + QB - 1) / KVBLK + 1) : (cur.nk / KVBLK);
    const int qlo = cur.P0 + wid * QBLK, qm = qlo + r32 - 4 * hi;
    float* ws = (float*)(lds + OFF_WS) + wid * 64; float* li_l = ws, * al_l = ws + 32;
    float m_reg = -1e30f, l_reg = 0; f32x16 o[4] = {};
    const int vb0 = (int)(uintptr_t)lds + v_rd_base(lane);
    const bf16* Kh = cur.K; const bf16* Vh = cur.V;
    const char* qrl = lds + OFF_QR + wid * 4096 + lane * 16;
#define RESC(a) do { if (__any((a) < 1.f)) { if (hi == 0) al_l[r32] = (a); asm volatile("s_waitcnt lgkmcnt(0)" ::: "memory");              \
                     for (int d_ = 0; d_ < 4; ++d_) for (int r = 0; r < 16; ++r) o[d_][r] *= al_l[crow(r, hi)]; } } while (0)
#define KBASE(t) ((t) * KVBLK)
#define MASKT(P0_, P1_, t) do { if (CAUSAL) { const int kb_ = KBASE(t); if (kb_ + KVBLK - 1 > qlo) mask_tile(P0_, P1_, qm - kb_); } } while (0)
#define SEAM_K0() do { VMWN(8); SWRITE_HK(0); SBAR(); } while (0)
    f32x16 pA0, pA1, pB0, pB1; float mnA, mnB, alA, alB; bf16x8 pa0, pa1, pa2, pa3;
    SWRITE_HV(0); SBAR();
    if (NT > 1) { SLOAD_H(Kh, Vh, KBASE(1)); }
    SBAR(); qkt<0, ROPE>(pA0, pA1, lds, r32, hi, S.qr, qrl);
    MASKT(pA0, pA1, 0); partialSM(pA0, pA1, m_reg, mnA, alA, SCALE);
    if (NT > 1) { VMW(); SWRITE_H(1); }
    __syncthreads();
#define HALF_STEP(PX0, PX1, mnX, alX, PY0, PY1, alY, t, KB, VB, SB) do {                                                      \
        SBAR(); qkt<KB, ROPE>(PX0, PX1, lds, r32, hi, S.qr, qrl);                                                                  \
        finishSM(PY0, PY1, alY, l_reg, pa0, pa1, pa2, pa3); SBAR();                                                           \
        if ((t) + 1 < NT) { SLOAD_H(Kh, Vh, KBASE((t) + 1)); SBAR(); }                                                        \
        pv_tile<VB>(o, vb0, pa0, pa1, pa2, pa3); MASKT(PX0, PX1, (t)); partialSM(PX0, PX1, m_reg, mnX, alX, SCALE);           \
        __syncthreads();                                                                                                      \
        if ((t) + 1 < NT) { VMW(); SWRITE_H(SB); }                                                                            \
        RESC(alX); __syncthreads(); } while (0)
    for (int t = 1; t + 1 < NT; t += 2) {
        HALF_STEP(pB0, pB1, mnB, alB, pA0, pA1, alA, t, 1, 0, 0);
        HALF_STEP(pA0, pA1, mnA, alA, pB0, pB1, alB, t + 1, 0, 1, 1);
    }
    const bool even = (NT & 1) == 0;
    if (even) { SBAR(); qkt<1, ROPE>(pB0, pB1, lds, r32, hi, S.qr, qrl); SBAR(); }
    SLOAD_H(nxt.K, nxt.V, 0); SBAR();
#pragma unroll
    for (int d0 = 0; d0 < 8; ++d0) S.qr[d0] = load8(nxt.Q + (size_t)(wid * QBLK + r32) * st.ldq + d0 * 16 + hi * 8);
    SBAR();
    finishSM(pA0, pA1, alA, l_reg, pa0, pa1, pa2, pa3); SBAR();
    pv_tile<0>(o, vb0, pa0, pa1, pa2, pa3);
    if (even) { MASKT(pB0, pB1, NT - 1); partialSM(pB0, pB1, m_reg, mnB, alB, SCALE); __syncthreads(); RESC(alB);
        finishSM(pB0, pB1, alB, l_reg, pa0, pa1, pa2, pa3); SBAR(); pv_tile<1>(o, vb0, pa0, pa1, pa2, pa3); }
    SBAR(); SEAM_K0();
    if (hi == 0) li_l[r32] = l_reg; asm volatile("s_waitcnt lgkmcnt(0)" ::: "memory");
    float rli[16];
#pragma unroll
    for (int r = 0; r < 16; ++r) rli[r] = __builtin_amdgcn_rcpf(li_l[crow(r, hi)]);
    bf16* Ow = cur.O + (size_t)(wid * QBLK) * st.ldo;
#pragma unroll
    for (int r = 0; r < 16; ++r) { const int orow = crow(r, hi); float ss = 0.f;
#pragma unroll
        for (int d0 = 0; d0 < 4; ++d0) { const float v = o[d0][r] * rli[r]; ss += v * v;
            const float vn = __shfl_xor(v, 1);
            if ((r32 & 1) == 0) *(unsigned*)(Ow + (size_t)orow * st.ldo + d0 * 32 + r32) = cvtpk(v, vn); }
        if (STAT) { ss += __shfl_xor(ss, 1); ss += __shfl_xor(ss, 2); ss += __shfl_xor(ss, 4); ss += __shfl_xor(ss, 8); ss += __shfl_xor(ss, 16);
            if (r32 == 0) ssq_add(cur.ssq, wid * QBLK + orow, ss); } }
    if constexpr (ROPE > 0) {
#pragma unroll
        for (int d0 = 0; d0 < 4; ++d0) *(bf16x8*)(lds + OFF_QR + wid * 4096 + d0 * 1024 + lane * 16) = load8(nxt.Q + (size_t)(wid * QBLK + r32) * st.ldq + 128 + d0 * 16 + hi * 8);
    }
    __syncthreads();
#undef RESC
#undef KBASE
#undef MASKT
#undef SEAM_K0
#undef HALF_STEP
}
#undef VMW
#undef VMWN
#undef SLOAD_H
#undef SWRITE_HK
#undef SWRITE_HV
#undef SWRITE_H
}
constexpr size_t MiB = 1u << 20;
constexpr size_t WS_CTL = 0, WS_STAT = 1 * MiB, ZERO_BYTES = 3 * MiB;
constexpr size_t WS_TAB = 3 * MiB;
constexpr size_t WS_MEMB = 6 * MiB, WS_KVMEM = 8 * MiB, WS_KMEMN = 10 * MiB, WS_WMKV = 11 * MiB;
constexpr size_t WS_LOGIT = 20 * MiB, WS_MOE = 24 * MiB, WS_SCAN = 26 * MiB;
constexpr size_t WS_W = 28 * MiB;
constexpr size_t W_IN = 0, W_UQ = 12 * MiB, W_UKV = W_UQ + 3 * MiB / 2, W_G = W_UKV + MiB, W_OUT = W_G + MiB, W_MQ = W_OUT + 8 * MiB, W_MO = W_MQ + 2 * MiB, W_R = W_MO + 2 * MiB,
                 W_GU = W_R + MiB, W_D = W_GU + 128 * MiB, W_END = W_D + 64 * MiB;
constexpr size_t WS_XB = 250 * MiB, WS_R = 314 * MiB;
static_assert(WS_W + W_END <= WS_XB, "weights");
constexpr size_t R_Z = 0, R_Q = 96 * MiB, R_KVR = 144 * MiB, R_KK = 208 * MiB, R_XC = 256 * MiB, R_AA = 288 * MiB, R_UU = 352 * MiB, R_YMIX = 416 * MiB, R_END = 480 * MiB;
constexpr size_t R_QM = 0, R_QMN = 64 * MiB, R_OM = 80 * MiB;
constexpr size_t R_ACT = 0, R_Y = 40 * MiB;
constexpr size_t WS_SCAN2 = WS_R + R_END;
constexpr size_t WS_END = WS_SCAN2 + 6 * MiB;
constexpr int CW_BAR = 4096;
constexpr int CW_CNT = 16384;
enum { ST_X = 0, ST_CQ = 1, ST_CKV = 2, ST_YATT = 3, ST_YRNN = 4, ST_X1 = 5, ST_X2 = 6 };
constexpr int RING_BYTES = 131072, LDSCTL_OFF = RING_BYTES, LDS_BYTES = 147456;
constexpr int LC_BAR = 0, LC_NRT = 16, LC_RTAB = 64, LC_LTOK = 2048;

struct Params { const float* in[36]; float* out; unsigned char* ws; int ph_lo, ph_hi, probe, pad; };
static_assert(sizeof(Params) == 36 * 8 + 8 + 8 + 16, "Params layout");
typedef __attribute__((address_space(4))) const unsigned char kchar;
__device__ __forceinline__ kchar* karg_base() { kchar* ka = (kchar*)__builtin_amdgcn_kernarg_segment_ptr(); asm volatile("" : "+s"(ka)); return ka; }
__device__ __forceinline__ const float* in_ptr(const Params&, int i) { return (const float*)(*(GAS const float* const __attribute__((address_space(4)))*)(karg_base() + i * 8)); }
__device__ __forceinline__ float* out_ptr() { return (float*)(*(GAS float* const __attribute__((address_space(4)))*)(karg_base() + 288)); }
__device__ __forceinline__ unsigned char* ws_ptr() { return (unsigned char*)(*(GAS unsigned char* const __attribute__((address_space(4)))*)(karg_base() + 296)); }
__device__ __forceinline__ unsigned char* opaque_ptr(unsigned char*) { return ws_ptr(); }
enum { I_X = 0, I_MEM, I_MIXG, I_WIN, I_QLG, I_KVLG, I_WUQ, I_WUKV, I_AQG, I_AKG, I_CONVW, I_CONVB, I_WRG, I_BRG, I_WIG, I_BIG, I_LAM, I_AOG, I_ROG, I_WOUT, I_XNG, I_MNG, I_WMQ, I_WMK, I_WMV,
       I_MQG, I_MKG, I_WMO, I_MOEG, I_WRGRP, I_BRGRP, I_WREXP, I_BREXP, I_WEG, I_WEU, I_WED };

__device__ __forceinline__ int dmap(int map, int n) {
    if (map == 1) return n < 768 ? n : (n < 832 ? n + 2048 : n - 64);
    if (map == 2) return ((n >> 7) << 8) + (n & 127);
    if (map == 3) return ((n >> 7) << 8) + 128 + (n & 127);
    return n;
}
__device__ __forceinline__ void transpose_item(const float* W, int K, int Nsrc, bf16* WT, const float* gain, int map, LAS float* scr, int item, int lane) {
    const int nblk = Nsrc / 32, kb = item / nblk, nb = item % nblk, k0 = 64 * kb, n0 = 32 * nb;
    const GAS float* src = (const GAS float*)W + (size_t)(k0 + (lane >> 5)) * Nsrc + n0 + (lane & 31);
    float v[32];
#pragma unroll
    for (int i = 0; i < 32; ++i) v[i] = src[(size_t)(2 * i) * Nsrc];
    const int c = lane & 7; const int d0 = dmap(map, n0);
    f32x4 ga = (f32x4){1.f, 1.f, 1.f, 1.f}, gb = ga;
    if (gain) { ga = *(const GAS f32x4*)((const GAS float*)gain + k0 + 8 * c); gb = *(const GAS f32x4*)((const GAS float*)gain + k0 + 8 * c + 4); }
#pragma unroll
    for (int i = 0; i < 32; ++i) scr[(2 * i + (lane >> 5)) * 33 + (lane & 31)] = v[i];
    LDS_WAIT(); asm volatile("" ::: "memory");
#pragma unroll
    for (int j = 0; j < 4; ++j) { const int n = (lane >> 3) + 8 * j; const LAS float* s = scr + (8 * c) * 33 + n;
        u32x4 o; o.x = pk2(s[0 * 33] * ga[0], s[1 * 33] * ga[1]); o.y = pk2(s[2 * 33] * ga[2], s[3 * 33] * ga[3]); o.z = pk2(s[4 * 33] * gb[0], s[5 * 33] * gb[1]); o.w = pk2(s[6 * 33] * gb[2], s[7 * 33] * gb[3]);
        *(GAS u32x4*)((GAS bf16*)WT + (size_t)(d0 + n) * K + k0 + 8 * c) = o; }
    LDS_WAIT(); asm volatile("" ::: "memory");
}
__device__ __forceinline__ void convert_layer_weights(const Params& p, int l, LAS float* scr, int gw, int NGW, int lane, int gtid, int NGT) {
    unsigned char* wb = opaque_ptr(p.ws) + WS_W;
    constexpr int I0 = 32 * 90, I1 = 8 * 48, I2 = 4 * 64, I3 = 32 * 64, I4 = 32 * 16, I5 = 8 * 64, IE = 32 * 16, IEX = 32 * IE, ID = 8 * 64, IDX = 32 * ID;
    constexpr int NIT = I0 + I1 + I2 + I3 + I4 + I5 + 2 * IEX + IDX;
    for (int it = gw; it < NIT; it += NGW) {
        int r = it;
        if (r < I0) { transpose_item(in_ptr(p, I_WIN) + (size_t)l * D * 2880, D, 2880, (bf16*)(wb + W_IN), in_ptr(p, I_MIXG) + l * D, 1, scr, r, lane); continue; } r -= I0;
        if (r < I1) { transpose_item(in_ptr(p, I_WUQ) + (size_t)l * QL * NQU, QL, NQU, (bf16*)(wb + W_UQ), in_ptr(p, I_QLG) + l * QL, 0, scr, r, lane); continue; } r -= I1;
        if (r < I2) { transpose_item(in_ptr(p, I_WUKV) + (size_t)l * KVL * NKV, KVL, NKV, (bf16*)(wb + W_UKV), in_ptr(p, I_KVLG) + l * KVL, 0, scr, r, lane); continue; } r -= I2;
        if (r < I3) { const int k0 = 64 * (r / 64); const float* g = (k0 < 1024) ? (in_ptr(p, I_AOG) + l * 1024) : (in_ptr(p, I_ROG) + l * 1024 - 1024);
                      transpose_item(in_ptr(p, I_WOUT) + (size_t)l * D * D, D, D, (bf16*)(wb + W_OUT), g, 0, scr, r, lane); continue; } r -= I3;
        if (r < I4) { transpose_item(in_ptr(p, I_WMQ) + (size_t)l * D * DMA, D, DMA, (bf16*)(wb + W_MQ), in_ptr(p, I_XNG) + l * D, 0, scr, r, lane); continue; } r -= I4;
        if (r < I5) { transpose_item(in_ptr(p, I_WMO) + (size_t)l * DMA * D, DMA, D, (bf16*)(wb + W_MO), nullptr, 0, scr, r, lane); continue; } r -= I5;
        if (r < IEX) { const int e = r / IE; transpose_item(in_ptr(p, I_WEG) + ((size_t)l * NE + e) * D * DE, D, DE, (bf16*)(wb + W_GU) + (size_t)e * 1024 * D, in_ptr(p, I_MOEG) + l * D, 2, scr, r % IE, lane); continue; } r -= IEX;
        if (r < IEX) { const int e = r / IE; transpose_item(in_ptr(p, I_WEU) + ((size_t)l * NE + e) * D * DE, D, DE, (bf16*)(wb + W_GU) + (size_t)e * 1024 * D, in_ptr(p, I_MOEG) + l * D, 3, scr, r % IE, lane); continue; } r -= IEX;
        { const int e = r / ID; transpose_item(in_ptr(p, I_WED) + ((size_t)l * NE + e) * DE * D, DE, D, (bf16*)(wb + W_D) + (size_t)e * D * DE, nullptr, 0, scr, r % ID, lane); }
    }
    { u32x4* z = (u32x4*)((bf16*)(wb + W_IN) + (size_t)2880 * D); const int n16 = 192 * D * 2 / 16; for (int i = gtid; i < n16; i += NGT) z[i] = (u32x4){0u, 0u, 0u, 0u}; }
    { bf16* wr = (bf16*)(wb + W_R); const float* wg = in_ptr(p, I_WRGRP) + (size_t)l * D * 4; const float* we = in_ptr(p, I_WREXP) + (size_t)l * D * 32; const float* g = in_ptr(p, I_MOEG) + l * D;
      for (int i = gtid; i < 256 * D / 8; i += NGT) { const int n = i / (D / 8), k0 = (i % (D / 8)) * 8; float v[8];
#pragma unroll
          for (int j = 0; j < 8; ++j) { const int k = k0 + j; v[j] = n < 4 ? wg[k * 4 + n] * g[k] : (n < 36 ? we[k * 32 + (n - 4)] * g[k] : 0.f); }
          u32x4 o; o.x = pk2(v[0], v[1]); o.y = pk2(v[2], v[3]); o.z = pk2(v[4], v[5]); o.w = pk2(v[6], v[7]); *(u32x4*)(wr + (size_t)n * D + k0) = o; } }
    { bf16* wg = (bf16*)(wb + W_G); const float* wr = in_ptr(p, I_WRG) + (size_t)l * 8 * 128 * 128; const float* wi = in_ptr(p, I_WIG) + (size_t)l * 8 * 128 * 128;
      for (int i = gtid; i < 8 * 256 * 256 / 8; i += NGT) { const int n = i >> 13, j = (i >> 5) & 255, c0 = (i & 31) * 8; float v[8];
          const bool on = (c0 >> 7) == (n & 1); const float* src = (j < 128 ? wr : wi) + (size_t)n * 128 * 128 + (j & 127);
#pragma unroll
          for (int q = 0; q < 8; ++q) v[q] = on ? src[(size_t)((c0 & 127) + q) * 128] : 0.f;
          u32x4 o; o.x = pk2(v[0], v[1]); o.y = pk2(v[2], v[3]); o.z = pk2(v[4], v[5]); o.w = pk2(v[6], v[7]); *(u32x4*)(wg + (size_t)i * 8) = o; } }
}
__device__ __forceinline__ float row_to_bf16(const float* xrow, bf16* orow, int lane) {
    float ss = 0.f;
#pragma unroll
    for (int j = 0; j < 4; ++j) { const int c = lane * 8 + 512 * j; const f32x4 a = *(const f32x4*)(xrow + c), b = *(const f32x4*)(xrow + c + 4);
        ss += (a[0] * a[0] + a[1] * a[1]) + (a[2] * a[2] + a[3] * a[3]) + (b[0] * b[0] + b[1] * b[1]) + (b[2] * b[2] + b[3] * b[3]);
        u32x4 o; o.x = pk2(a[0], a[1]); o.y = pk2(a[2], a[3]); o.z = pk2(b[0], b[1]); o.w = pk2(b[2], b[3]); *(u32x4*)(orow + c) = o; }
    return wave_sum(ss);
}
__device__ __forceinline__ float gelu_tanh(float x) { const float y = 0.7978845608028654f * (x + 0.044715f * x * x * x); const float e = __expf(2.0f * y); const float th = 1.0f - 2.0f / (e + 1.0f); return 0.5f * x * (1.0f + th); }
__device__ __forceinline__ void unpack8(u32x4 w, float* v) { v[0] = bflo(w.x); v[1] = bfhi(w.x); v[2] = bflo(w.y); v[3] = bfhi(w.y); v[4] = bflo(w.z); v[5] = bfhi(w.z); v[6] = bflo(w.w); v[7] = bfhi(w.w); }
__device__ __forceinline__ u32x4 pack8f(const float* v) { u32x4 o; o.x = pk2(v[0], v[1]); o.y = pk2(v[2], v[3]); o.z = pk2(v[4], v[5]); o.w = pk2(v[6], v[7]); return o; }

__device__ __forceinline__ void conv_phase(const bf16* z, bf16* xc, const float* cw, const float* cb, int gtid, int NGT) {
    for (int it = gtid; it < (T / 16) * 128; it += NGT) {
        const int tb = it >> 7, cg = it & 127, row0 = tb * 16, s0 = row0 & (SEQ - 1), c0 = cg * 8;
        float w[4][8], b[8], p1[8], p2[8], p3[8];
#pragma unroll
        for (int j = 0; j < 4; ++j) { const f32x4 a = *(const f32x4*)(cw + j * DRNN + c0), bb = *(const f32x4*)(cw + j * DRNN + c0 + 4);
            w[j][0] = a[0]; w[j][1] = a[1]; w[j][2] = a[2]; w[j][3] = a[3]; w[j][4] = bb[0]; w[j][5] = bb[1]; w[j][6] = bb[2]; w[j][7] = bb[3]; }
        { const f32x4 a = *(const f32x4*)(cb + c0), bb = *(const f32x4*)(cb + c0 + 4); b[0] = a[0]; b[1] = a[1]; b[2] = a[2]; b[3] = a[3]; b[4] = bb[0]; b[5] = bb[1]; b[6] = bb[2]; b[7] = bb[3]; }
        const bf16* zp = z + (size_t)row0 * ZC + Z_XR + c0;
        if (s0 >= 1) unpack8(*(const u32x4*)(zp - (size_t)ZC), p1); else { for (int e = 0; e < 8; ++e) p1[e] = 0.f; }
        if (s0 >= 2) unpack8(*(const u32x4*)(zp - (size_t)2 * ZC), p2); else { for (int e = 0; e < 8; ++e) p2[e] = 0.f; }
        if (s0 >= 3) unpack8(*(const u32x4*)(zp - (size_t)3 * ZC), p3); else { for (int e = 0; e < 8; ++e) p3[e] = 0.f; }
#pragma unroll 4
        for (int r = 0; r < 16; ++r) { float cur[8], o[8]; unpack8(*(const u32x4*)(zp + (size_t)r * ZC), cur);
#pragma unroll
            for (int e = 0; e < 8; ++e) { o[e] = b[e] + w[3][e] * cur[e] + w[2][e] * p1[e] + w[1][e] * p2[e] + w[0][e] * p3[e]; p3[e] = p2[e]; p2[e] = p1[e]; p1[e] = cur[e]; }
            *(u32x4*)(xc + (size_t)(row0 + r) * DRNN + c0) = pack8f(o); }
    }
}
__device__ __forceinline__ void qk_post_phase(bf16* q, const bf16* kvr, const bf16* z, bf16* kk, const float* gq, const float* gk, const float* cosT, const float* sinT, int gw, int NGW, int lane) {
    const int h = lane >> 3, j = lane & 7;
    for (int row = gw; row < T; row += NGW) {
        const int s = row & (SEQ - 1);
        float cs[8], sn[8];
        { const int i0 = (j & 3) * 8; const f32x4 a = *(const f32x4*)(cosT + s * 32 + i0), b = *(const f32x4*)(cosT + s * 32 + i0 + 4), c = *(const f32x4*)(sinT + s * 32 + i0), d = *(const f32x4*)(sinT + s * 32 + i0 + 4);
          cs[0] = a[0]; cs[1] = a[1]; cs[2] = a[2]; cs[3] = a[3]; cs[4] = b[0]; cs[5] = b[1]; cs[6] = b[2]; cs[7] = b[3];
          sn[0] = c[0]; sn[1] = c[1]; sn[2] = c[2]; sn[3] = c[3]; sn[4] = d[0]; sn[5] = d[1]; sn[6] = d[2]; sn[7] = d[3]; }
#pragma unroll
        for (int which = 0; which < 2; ++which) {
            float v[3][8];
            if (which == 0) { bf16* qp = q + (size_t)row * NQU + h * QKH + j * 8;
#pragma unroll
                for (int i = 0; i < 3; ++i) unpack8(*(const u32x4*)(qp + 64 * i), v[i]); }
            else { const bf16* kp = kvr + (size_t)row * NKV + h * 256 + j * 8; unpack8(*(const u32x4*)kp, v[0]); unpack8(*(const u32x4*)(kp + 64), v[1]);
                   unpack8(*(const u32x4*)(z + (size_t)row * ZC + Z_KPE + j * 8), v[2]); }
            float ss = 0.f;
#pragma unroll
            for (int i = 0; i < 3; ++i)
#pragma unroll
                for (int e = 0; e < 8; ++e) ss += v[i][e] * v[i][e];
            ss += __shfl_xor(ss, 1); ss += __shfl_xor(ss, 2); ss += __shfl_xor(ss, 4);
            const float rstd = 1.0f / sqrtf(ss * (1.0f / 192.0f) + EPS);
            const float* g = which == 0 ? gq : gk;
#pragma unroll
            for (int i = 0; i < 3; ++i) { const f32x4 ga = *(const f32x4*)(g + 64 * i + j * 8), gb = *(const f32x4*)(g + 64 * i + j * 8 + 4);
                v[i][0] *= rstd * ga[0]; v[i][1] *= rstd * ga[1]; v[i][2] *= rstd * ga[2]; v[i][3] *= rstd * ga[3]; v[i][4] *= rstd * gb[0]; v[i][5] *= rstd * gb[1]; v[i][6] *= rstd * gb[2]; v[i][7] *= rstd * gb[3]; }
#pragma unroll
            for (int e = 0; e < 8; ++e) { const float mine = v[2][e], oth = __shfl_xor(mine, 4);
                v[2][e] = (j < 4) ? (mine * cs[e] - oth * sn[e]) : (oth * sn[e] + mine * cs[e]); }
            bf16* op = (which == 0 ? q + (size_t)row * NQU : kk + (size_t)row * NQU) + h * QKH + j * 8;
#pragma unroll
            for (int i = 0; i < 3; ++i) *(u32x4*)(op + 64 * i) = pack8f(v[i]);
        }
    }
}
template <bool F32IN>
__device__ __forceinline__ void head128_norm_rows(const void* in0, const float* in1, int ld_in, bf16* out, const float* g, int nrows, int gw, int NGW, int lane) {
    for (int row = gw; row < nrows; row += NGW) {
        float v[8];
        if (F32IN) { const float* a = (const float*)in0 + (size_t)row * ld_in + lane * 8; const float* b = in1 + (size_t)row * ld_in + lane * 8;
            const f32x4 a0 = *(const f32x4*)a, a1 = *(const f32x4*)(a + 4), b0 = *(const f32x4*)b, b1 = *(const f32x4*)(b + 4);
            v[0] = a0[0] + b0[0]; v[1] = a0[1] + b0[1]; v[2] = a0[2] + b0[2]; v[3] = a0[3] + b0[3]; v[4] = a1[0] + b1[0]; v[5] = a1[1] + b1[1]; v[6] = a1[2] + b1[2]; v[7] = a1[3] + b1[3]; }
        else unpack8(*(const u32x4*)((const bf16*)in0 + (size_t)row * ld_in + lane * 8), v);
        float ss = 0.f;
#pragma unroll
        for (int e = 0; e < 8; ++e) ss += v[e] * v[e];
        ss += __shfl_xor(ss, 1); ss += __shfl_xor(ss, 2); ss += __shfl_xor(ss, 4); ss += __shfl_xor(ss, 8);
        const float rstd = 1.0f / sqrtf(ss * (1.0f / 128.0f) + EPS);
        const int c = (lane * 8) & 127; const f32x4 ga = *(const f32x4*)(g + c), gb = *(const f32x4*)(g + c + 4);
        v[0] *= rstd * ga[0]; v[1] *= rstd * ga[1]; v[2] *= rstd * ga[2]; v[3] *= rstd * ga[3]; v[4] *= rstd * gb[0]; v[5] *= rstd * gb[1]; v[6] *= rstd * gb[2]; v[7] *= rstd * gb[3];
        *(u32x4*)(out + (size_t)row * DMA + lane * 8) = pack8f(v);
    }
}
__device__ __forceinline__ void scan_pass1(const float* aa, const float* uu, float* sA, float* sH, float* cA, float* cH, LAS f32x4* xch, int unit, int wave, int lane) {
    const int q = unit & 3, c = (unit >> 2) & 31, b = unit >> 7; const unsigned ch = (unsigned)(q * 256 + lane * 4);
    const GAS float* ap = (const GAS float*)aa + ((size_t)b * SEQ + (size_t)c * 256 + (size_t)wave * 32) * DRNN + ch;
    const GAS float* up = (const GAS float*)uu + ((size_t)b * SEQ + (size_t)c * 256 + (size_t)wave * 32) * DRNN + ch;
    f32x4 A = (f32x4){1.f, 1.f, 1.f, 1.f}, H = (f32x4){0.f, 0.f, 0.f, 0.f};
#pragma unroll
    for (int hb = 0; hb < 2; ++hb) { f32x4 av[16], uv[16];
#pragma unroll
        for (int s = 0; s < 16; ++s) { av[s] = *(const GAS f32x4*)(ap + (size_t)(hb * 16 + s) * DRNN); uv[s] = *(const GAS f32x4*)(up + (size_t)(hb * 16 + s) * DRNN); }
#pragma unroll
        for (int s = 0; s < 16; ++s) { H = av[s] * H + uv[s]; A = A * av[s]; } }
    const size_t so = ((size_t)(b * 32 + c) * 8 + wave) * DRNN + ch;
    *(GAS f32x4*)((GAS float*)sA + so) = A; *(GAS f32x4*)((GAS float*)sH + so) = H;
    xch[(wave * 64 + lane) * 2] = A; xch[(wave * 64 + lane) * 2 + 1] = H;
    __syncthreads();
    if (wave == 0) { f32x4 Ac = (f32x4){1.f, 1.f, 1.f, 1.f}, Hc = (f32x4){0.f, 0.f, 0.f, 0.f};
#pragma unroll
        for (int w = 0; w < 8; ++w) { const f32x4 a = xch[(w * 64 + lane) * 2], h = xch[(w * 64 + lane) * 2 + 1]; Hc = a * Hc + h; Ac = Ac * a; }
        const size_t co = (size_t)(b * 32 + c) * DRNN + ch; *(GAS f32x4*)((GAS float*)cA + co) = Ac; *(GAS f32x4*)((GAS float*)cH + co) = Hc; }
    __syncthreads();
}
__device__ __forceinline__ void scan_pass3(const float* aa, const float* uu, const float* sA, const float* sH, const float* cA, const float* cH, const bf16* z, bf16* ymix, u64* ssq, int unit, int wave, int lane) {
    const int q = unit & 3, c = (unit >> 2) & 31, b = unit >> 7; const unsigned ch = (unsigned)(q * 256 + lane * 4);
    f32x4 h = (f32x4){0.f, 0.f, 0.f, 0.f};
    { const GAS float* ca = (const GAS float*)cA + (size_t)(b * 32) * DRNN + ch; const GAS float* chh = (const GAS float*)cH + (size_t)(b * 32) * DRNN + ch;
#pragma unroll 8
      for (int j = 0; j < c; ++j) { const f32x4 a = *(const GAS f32x4*)(ca + (size_t)j * DRNN), hh = *(const GAS f32x4*)(chh + (size_t)j * DRNN); h = a * h + hh; }
      const GAS float* sa = (const GAS float*)sA + (size_t)(b * 32 + c) * 8 * DRNN + ch; const GAS float* sh = (const GAS float*)sH + (size_t)(b * 32 + c) * 8 * DRNN + ch;
      for (int j = 0; j < wave; ++j) { const f32x4 a = *(const GAS f32x4*)(sa + (size_t)j * DRNN), hh = *(const GAS f32x4*)(sh + (size_t)j * DRNN); h = a * h + hh; } }
    const size_t row0 = (size_t)b * SEQ + (size_t)c * 256 + (size_t)wave * 32;
    const GAS float* ap = (const GAS float*)aa + row0 * DRNN + ch; const GAS float* up = (const GAS float*)uu + row0 * DRNN + ch;
    const GAS bf16* gp = (const GAS bf16*)z + row0 * ZC + Z_GATE + ch; GAS bf16* yp = (GAS bf16*)ymix + row0 * D + DATT + ch;
    const int rowsel = lane & 15;
#pragma unroll
    for (int hb = 0; hb < 2; ++hb) { f32x4 av[16], uv[16]; u32x2 gv[16]; float sq[16];
#pragma unroll
        for (int s = 0; s < 16; ++s) { av[s] = *(const GAS f32x4*)(ap + (size_t)(hb * 16 + s) * DRNN); uv[s] = *(const GAS f32x4*)(up + (size_t)(hb * 16 + s) * DRNN); gv[s] = *(const GAS u32x2*)(gp + (size_t)(hb * 16 + s) * ZC); }
#pragma unroll
        for (int s = 0; s < 16; ++s) { h = av[s] * h + uv[s];
            const float y0 = h[0] * gelu_tanh(bflo(gv[s].x)), y1 = h[1] * gelu_tanh(bfhi(gv[s].x)), y2 = h[2] * gelu_tanh(bflo(gv[s].y)), y3 = h[3] * gelu_tanh(bfhi(gv[s].y));
            u32x2 o; o.x = pk2(y0, y1); o.y = pk2(y2, y3); *(GAS u32x2*)(yp + (size_t)(hb * 16 + s) * D) = o;
            sq[s] = (y0 * y0 + y1 * y1) + (y2 * y2 + y3 * y3); }
#pragma unroll
        for (int st = 0; st < 4; ++st) { const int n = 8 >> st; const bool up = (lane >> st) & 1;
#pragma unroll
            for (int i = 0; i < 8; ++i) if (i < n) { const float keep = up ? sq[2 * i + 1] : sq[2 * i], give = up ? sq[2 * i] : sq[2 * i + 1]; sq[i] = keep + __shfl_xor(give, 1 << st); } }
        float tot = sq[0]; tot += __shfl_xor(tot, 16); tot += __shfl_xor(tot, 32);
        if (lane < 16) ssq_add(ssq, (int)(row0 + hb * 16 + rowsel), tot); }
}
__device__ __forceinline__ void route_phase(const float* logits, const u64* ssq_x2, const float* bg, const float* be, int* tok_e, float* tok_w, int* whist, unsigned* cnt, LAS int* hist, int wg, int tid) {
    if (tid < 32) hist[tid] = 0;
    __syncthreads();
    if (tid < 64) { const int t = wg * 64 + tid; const float rs = 1.0f / sqrtf(ssq_val(ssq_x2, t) * (1.0f / D) + EPS); const float* lq = logits + (size_t)t * 64;
#define LSUM(i) ((lq[(i)] + lq[(size_t)T * 64 + (i)]) + (lq[(size_t)2 * T * 64 + (i)] + lq[(size_t)3 * T * 64 + (i)]))
        float lg[4]; int g = 0; float mx = -3.0e38f;
#pragma unroll
        for (int i = 0; i < 4; ++i) { lg[i] = LSUM(i) * rs + bg[i]; if (lg[i] > mx) { mx = lg[i]; g = i; } }
        float den = 0.f;
#pragma unroll
        for (int i = 0; i < 4; ++i) den += __expf(lg[i] - mx);
        const float gw = 1.0f / den;
        float l1 = -3.0e38f, l2 = -3.0e38f; int j1 = 0, j2 = 0;
        for (int i = 0; i < 8; ++i) { const float v = LSUM(4 + g * 8 + i) * rs + be[g * 8 + i];
            if (v > l1) { l2 = l1; j2 = j1; l1 = v; j1 = i; } else if (v > l2) { l2 = v; j2 = i; } }
        const float w1 = 1.0f / (1.0f + __expf(l2 - l1)), w2 = 1.0f - w1;
        const int e1 = g * 8 + j1, e2 = g * 8 + j2;
        tok_e[t * 2] = e1; tok_e[t * 2 + 1] = e2; tok_w[t * 2] = gw * w1; tok_w[t * 2 + 1] = gw * w2;
        __hip_atomic_fetch_add(hist + e1, 1, __ATOMIC_RELAXED, __HIP_MEMORY_SCOPE_WORKGROUP); __hip_atomic_fetch_add(hist + e2, 1, __ATOMIC_RELAXED, __HIP_MEMORY_SCOPE_WORKGROUP);
    }
#undef LSUM
    __syncthreads();
    if (tid < 32) { const int c = hist[tid]; whist[wg * 32 + tid] = c; if (c) atomicAdd(cnt + tid, (unsigned)c); }
}
__device__ __forceinline__ void dispatch_phase(const unsigned* cnt, const int* whist, const int* tok_e, const float* tok_w, const u64* ssq_x2, int* tok_slot, int* slot_tok, float* slot_w, float* slot_rs,
                                               LAS int* sc, int wg, int tid) {
    if (tid == 0) { int seg = 0; for (int e = 0; e < 32; ++e) { sc[e] = seg; seg += (((int)cnt[e] + 255) >> 8) << 8; } }
    { const int e = tid & 31, part = tid >> 5; int s = 0; for (int w = part; w < wg; w += 16) s += whist[w * 32 + e]; sc[64 + tid] = s; }
    if (tid < 128) sc[640 + tid] = tok_e[(wg * 64) * 2 + tid];
    __syncthreads();
    if (tid < 32) { int s = sc[tid]; for (int p = 0; p < 16; ++p) s += sc[64 + p * 32 + tid]; sc[32 + tid] = s; }
    __syncthreads();
    if (tid < 128) { const int e = sc[640 + tid]; int rank = 0; for (int j = 0; j < tid; ++j) rank += (sc[640 + j] == e) ? 1 : 0;
        const int slot = sc[32 + e] + rank; const int t = wg * 64 + (tid >> 1);
        slot_tok[slot] = t; slot_w[slot] = tok_w[(wg * 64) * 2 + tid]; slot_rs[slot] = 1.0f / sqrtf(ssq_val(ssq_x2, t) * (1.0f / D) + EPS); tok_slot[(wg * 64) * 2 + tid] = slot; }
    if (wg < 32) { const int c = (int)cnt[wg], lo = sc[wg] + c, hi = sc[wg] + (((c + 255) >> 8) << 8);
        for (int s = lo + tid; s < hi; s += NTHREADS) { slot_tok[s] = 0; slot_w[s] = 0.f; slot_rs[s] = 0.f; } }
    __syncthreads();
}
__device__ __forceinline__ int build_rtab(const unsigned* cnt, LAS int* lc, int tid) {
    if (tid == 0) { int seg = 0, k = 0; for (int e = 0; e < 32; ++e) { const int nt = ((int)cnt[e] + 255) >> 8; for (int r = 0; r < nt; ++r) { lc[LC_RTAB / 4 + 2 * k] = e; lc[LC_RTAB / 4 + 2 * k + 1] = seg + r * 256; ++k; } seg += nt * 256; } lc[LC_NRT / 4] = k; }
    __syncthreads();
    return lc[LC_NRT / 4];
}
__device__ __forceinline__ void combine_phase(float* out, const bf16* Y, const int* tok_slot, bf16* xb, u64* ssq_next, bool last, int gw, int NGW, int lane) {
    for (int row = gw; row < T; row += NGW) {
        const int s0 = tok_slot[row * 2], s1 = tok_slot[row * 2 + 1]; float ss = 0.f;
#pragma unroll
        for (int j = 0; j < 4; ++j) { const int c = lane * 8 + 512 * j; float x0[8], y0[8], y1[8], v[8];
            unpack8(*(const u32x4*)(xb + (size_t)row * D + c), x0); unpack8(*(const u32x4*)(Y + (size_t)s0 * D + c), y0); unpack8(*(const u32x4*)(Y + (size_t)s1 * D + c), y1);
#pragma unroll
            for (int e = 0; e < 8; ++e) { v[e] = x0[e] + y0[e] + y1[e]; ss += v[e] * v[e]; }
            if (last) { float* op = out + (size_t)row * D + c; *(f32x4*)op = (f32x4){v[0], v[1], v[2], v[3]}; *(f32x4*)(op + 4) = (f32x4){v[4], v[5], v[6], v[7]}; }
            else *(u32x4*)(xb + (size_t)row * D + c) = pack8f(v); }
        ss = wave_sum(ss); if (!last && lane == 0) ssq_set(ssq_next, row, ss);
    }
}
constexpr int NPL = 16, NPHASES = 1 + DEPTH * NPL;
__device__ __forceinline__ att::BlockRef mla_ref(int it, int pass, bf16* qbuf, bf16* kk, bf16* kvr, bf16* ymix, u64* ssq_ya) {
    const int bh = (it & 7) * 2 + ((it >> 3) >> 4), y = (it >> 3) & 15, b = bh >> 3, h = bh & 7; const int qb = pass ? 31 - y : y; const size_t r0 = (size_t)b * SEQ;
    att::BlockRef c; c.K = kk + r0 * NQU + h * QKH; c.V = kvr + r0 * NKV + h * 256 + 128; c.nk = SEQ;
    c.Q = qbuf + (r0 + (size_t)qb * 256) * NQU + h * QKH; c.O = ymix + (r0 + (size_t)qb * 256) * D + h * VH; c.ssq = ssq_ya + r0 + qb * 256; c.P0 = qb * 256; return c;
}
#ifndef PH_MASK
#define PH_MASK 0x1ffff
#endif
#define PH_ON(j) (((PH_MASK) >> (j)) & 1)
__global__ void __launch_bounds__(NTHREADS, 2) fwd_kernel(Params p) {
    extern __shared__ __attribute__((aligned(16))) unsigned char lds_raw[];
    LAS unsigned char* lds = (LAS unsigned char*)lds_raw;
    LAS int* lc = (LAS int*)(lds + LDSCTL_OFF);
    const int G = gridDim.x, bx = blockIdx.x;
    const int NGW = G * NWAVES, NGT = G * NTHREADS;
    if (threadIdx.x < 64) lc[threadIdx.x] = 0;
    __syncthreads();
    XcdBarrier bar = xcd_barrier_post((unsigned*)(ws_ptr() + WS_CTL) + CW_BAR, (volatile LAS unsigned*)(lds + LDSCTL_OFF + LC_BAR));
    const int lo = p.ph_lo, hi = p.ph_hi; const bool probe = p.probe != 0;
#define IN(k) (lo <= (k) && (k) < hi)
#define SEAM(k) do { if ((k) + 1 < hi) xcd_barrier(bar); } while (0)
#define WS_PTRS() unsigned char* ws = opaque_ptr(p.ws); unsigned char* wb = ws + WS_W; unsigned char* rg = ws + WS_R; (void)wb; (void)rg; \
    int tid = threadIdx.x; asm volatile("" : "+v"(tid)); const int lane = tid & 63, wave = __builtin_amdgcn_readfirstlane(tid >> 6); \
    const int gw = bx * NWAVES + wave, gtid = bx * NTHREADS + tid; (void)lane; (void)gw; (void)gtid
#define INP(i) in_ptr(p, (i))
#define STATP(l, k) ((u64*)(ws + WS_STAT) + (size_t)((l) * 7 + (k)) * 16384)

    if (PH_ON(0) && IN(0)) {
        WS_PTRS();
        float* cosT = (float*)(ws + WS_TAB); float* sinT = cosT + SEQ * 32; float* spT = (float*)(ws + WS_TAB + 2 * MiB); u64* ssq_mem = (u64*)(spT + 2 * 1024);
        bf16* memb = (bf16*)(ws + WS_MEMB); bf16* wmkv = (bf16*)(ws + WS_WMKV); bf16* xb = (bf16*)(ws + WS_XB);
        LAS float* scr = (LAS float*)(lds + wave * 16384);
        convert_layer_weights(p, 0, scr, gw, NGW, lane, gtid, NGT);
        for (int it = gw; it < 2 * 2 * 32 * 16; it += NGW) { const int l = it / (2 * 512), r = it % (2 * 512), kv = r / 512, item = r % 512;
            transpose_item(INP(kv ? I_WMV : I_WMK) + (size_t)l * D * DMA, D, DMA, wmkv + (size_t)l * 1024 * D + (size_t)kv * 512 * D, INP(I_MNG) + l * D, 0, scr, item, lane); }
        for (int i = gtid; i < SEQ * 32; i += NGT) { const int t = i >> 5, k = i & 31; const float inv = exp2f(-(float)k * (13.287712379549449f / 32.0f)); float s, c; sincosf((float)t * inv, &s, &c); cosT[i] = c; sinT[i] = s; }
        { const float* lam = INP(I_LAM); for (int i = gtid; i < 2 * 1024; i += NGT) spT[i] = log1pf(expf(-lam[i])); }
        u64* ssq_x0 = STATP(0, ST_X);
        { const float* x = INP(I_X); for (int row = gw; row < T; row += NGW) { const float ss = row_to_bf16(x + (size_t)row * D, xb + (size_t)row * D, lane); if (lane == 0) ssq_set(ssq_x0, row, ss); } }
        { const float* m = INP(I_MEM); for (int row = gw; row < TM; row += NGW) { const float ss = row_to_bf16(m + (size_t)row * D, memb + (size_t)row * D, lane); if (lane == 0) ssq_set(ssq_mem, row, ss); } }
        SEAM(0);
    }

    for (int l = 0; l < DEPTH; ++l) {
        const int pb = 1 + l * NPL;

        if (PH_ON(1) && IN(pb + 0)) {
            WS_PTRS();
            { pg8::DenseSched S{(const char*)(ws + WS_XB), (const char*)(wb + W_IN), D, D, T / 256, ZC / 256, 1, D, G, bx};
              pg8::EpiBf16<0, true> E{(bf16*)(rg + R_Z), ZC, STATP(l, ST_X), 1.0f / D, STATP(l, ST_CQ), STATP(l, ST_CKV), 2, 3};
              pg8::gemm_phase<pg8::EpiBf16<0, true>, pg8::DenseSched, true, false>(lds, D, D, D, S, E, 0); }
            if (l == 0) {
                pg8::DenseSched S{(const char*)(ws + WS_MEMB), (const char*)(ws + WS_WMKV), D, D, TM / 256, 2 * 1024 / 256, 1, D, G, bx};
                pg8::EpiBf16<0, false> E{(bf16*)(ws + WS_KVMEM), 2 * 1024, (const void*)((float*)(ws + WS_TAB + 2 * MiB) + 2 * 1024), 1.0f / D, nullptr, nullptr, 0, 0};
                pg8::gemm_phase<pg8::EpiBf16<0, false>, pg8::DenseSched, true, false>(lds, D, D, D, S, E, 0);
            }
            SEAM(pb + 0);
        }
        if (PH_ON(2) && IN(pb + 1)) {
            WS_PTRS();
            bf16* z = (bf16*)(rg + R_Z);
            { pg8::DenseSched S{(const char*)(z + Z_CQ), (const char*)(wb + W_UQ), ZC, QL, T / 256, NQU / 256, 1, QL, G, bx};
              pg8::EpiBf16<0, false> E{(bf16*)(rg + R_Q), NQU, STATP(l, ST_CQ), 1.0f / QL, nullptr, nullptr, 0, 0};
              pg8::gemm_phase<pg8::EpiBf16<0, false>, pg8::DenseSched, true, false>(lds, QL, ZC, QL, S, E, 0); }
            { pg8::DenseSched S{(const char*)(z + Z_CKV), (const char*)(wb + W_UKV), ZC, KVL, T / 256, NKV / 256, 1, KVL, G, bx};
              pg8::EpiBf16<0, false> E{(bf16*)(rg + R_KVR), NKV, STATP(l, ST_CKV), 1.0f / KVL, nullptr, nullptr, 0, 0};
              pg8::gemm_phase<pg8::EpiBf16<0, false>, pg8::DenseSched, true, false>(lds, KVL, ZC, KVL, S, E, 0); }
            conv_phase(z, (bf16*)(rg + R_XC), INP(I_CONVW) + (size_t)l * 4 * DRNN, INP(I_CONVB) + (size_t)l * DRNN, gtid, NGT);
            if (l == 0) { const float* mkg = INP(I_MKG); for (int ll = 0; ll < 2; ++ll) head128_norm_rows<false>((bf16*)(ws + WS_KVMEM) + (size_t)ll * 1024, nullptr, 2 * 1024, (bf16*)(ws + WS_KMEMN) + (size_t)ll * TM * DMA, mkg + ll * 128, TM, gw, NGW, lane); }
            SEAM(pb + 1);
        }
        if (PH_ON(3) && IN(pb + 2)) {
            WS_PTRS();
            float* cosT = (float*)(ws + WS_TAB);
            qk_post_phase((bf16*)(rg + R_Q), (const bf16*)(rg + R_KVR), (const bf16*)(rg + R_Z), (bf16*)(rg + R_KK), INP(I_AQG) + l * QKH, INP(I_AKG) + l * QKH, cosT, cosT + SEQ * 32, gw, NGW, lane);
            { pg8::GateSched S{(const char*)(rg + R_XC), (const char*)(wb + W_G), G, bx};
              pg8::EpiGates E{(const bf16*)(rg + R_XC), INP(I_BRG) + l * DRNN, INP(I_BIG) + l * DRNN, (float*)(ws + WS_TAB + 2 * MiB) + l * DRNN, (float*)(rg + R_AA), (float*)(rg + R_UU)};
              pg8::gemm_phase<pg8::EpiGates, pg8::GateSched, true, false>(lds, 256, DRNN, 256, S, E, 0); }
            SEAM(pb + 2);
        }
        if (PH_ON(4) && IN(pb + 3)) {
            WS_PTRS();
            float* sA = (float*)(ws + WS_SCAN2);
            for (int u = bx; u < 256; u += G) scan_pass1((const float*)(rg + R_AA), (const float*)(rg + R_UU), sA, sA + 512 * 1024, sA + 1024 * 1024, sA + 1024 * 1024 + 64 * 1024, (LAS f32x4*)lds, u, wave, lane);
            SEAM(pb + 3);
        }
        if (PH_ON(5) && IN(pb + 4)) {
            WS_PTRS();
            bf16* ymix = (bf16*)(rg + R_YMIX);
            {
                bf16* qbuf = (bf16*)(rg + R_Q); bf16* kk = (bf16*)(rg + R_KK); bf16* kvr = (bf16*)(rg + R_KVR); u64* ssq_ya = STATP(l, ST_YATT);
                const att::Strides<NQU, NQU, NKV, D> sd;
                for (int it = bx; it < 256; it += G) {
                    att::BlockRef cur = mla_ref(it, 0, qbuf, kk, kvr, ymix, ssq_ya);
                    att::Seam<12> S;
                    att::attn_prime<64>(cur, sd, (char*)lds_raw, S);
                    for (int pass = 0; pass < 2; ++pass) {
                        const att::BlockRef nxt = (pass == 0) ? mla_ref(it, 1, qbuf, kk, kvr, ymix, ssq_ya) : cur;
                        att::attn_block<64, true, true>(cur, nxt, sd, 0.07216878364870322f, (char*)lds_raw, S);
                        cur = nxt;
                    }
                }
            }
            { float* sA = (float*)(ws + WS_SCAN2);
              for (int u = bx; u < 256; u += G) scan_pass3((const float*)(rg + R_AA), (const float*)(rg + R_UU), sA, sA + 512 * 1024, sA + 1024 * 1024, sA + 1024 * 1024 + 64 * 1024, (const bf16*)(rg + R_Z), ymix, STATP(l, ST_YRNN), u, wave, lane); }
            SEAM(pb + 4);
        }
        if (PH_ON(6) && IN(pb + 5)) {
            WS_PTRS();
            pg8::DenseSched S{(const char*)(rg + R_YMIX), (const char*)(wb + W_OUT), D, D, T / 256, D / 256, 1, D, G, bx};
            pg8::EpiResid<true> E{(bf16*)(ws + WS_XB), STATP(l, ST_X1), STATP(l, ST_YATT), STATP(l, ST_YRNN)};
            pg8::gemm_phase<pg8::EpiResid<true>, pg8::DenseSched, true, true>(lds, D, D, D, S, E, 16);
            SEAM(pb + 5);
        }
        if (PH_ON(7) && IN(pb + 6)) {
            WS_PTRS();
            pg8::DenseSched S{(const char*)(ws + WS_XB), (const char*)(wb + W_MQ), D, D, T / 256, DMA / 256, 2, 1024, G, bx};
            pg8::EpiF32Slab E{(float*)(rg + R_QM), DMA, (size_t)T * DMA, STATP(l, ST_X1), 1.0f / D};
            pg8::gemm_phase<pg8::EpiF32Slab, pg8::DenseSched, true, false>(lds, 1024, D, D, S, E, 0);
            SEAM(pb + 6);
        }
        if (PH_ON(8) && IN(pb + 7)) {
            WS_PTRS();
            float* qm = (float*)(rg + R_QM);
            head128_norm_rows<true>(qm, qm + (size_t)T * DMA, DMA, (bf16*)(rg + R_QMN), INP(I_MQG) + l * 128, T, gw, NGW, lane);
            SEAM(pb + 7);
        }
        if (PH_ON(9) && IN(pb + 8)) {
            WS_PTRS();
            bf16* qmn = (bf16*)(rg + R_QMN); bf16* om = (bf16*)(rg + R_OM); bf16* kmemn = (bf16*)(ws + WS_KMEMN); bf16* kvmem = (bf16*)(ws + WS_KVMEM);
            const att::Strides<DMA, DMA, 2 * 1024, DMA> sd;
            for (int it = bx; it < 256; it += G) {
                const int h = it & 3, rb = it >> 2, b = rb >> 5;
                att::BlockRef c0;
                c0.Q = qmn + (size_t)rb * 256 * DMA + h * 128; c0.K = kmemn + ((size_t)l * TM + (size_t)b * NMEM) * DMA + h * 128;
                c0.V = kvmem + (size_t)l * 1024 + (size_t)b * NMEM * 2048 + 512 + h * 128; c0.O = om + (size_t)rb * 256 * DMA + h * 128; c0.ssq = nullptr; c0.P0 = 0; c0.nk = NMEM;
                att::Seam<8> S;
                att::attn_prime<0>(c0, sd, (char*)lds_raw, S);
                att::attn_block<0, false, false>(c0, c0, sd, 0.08838834764831845f, (char*)lds_raw, S);
            }
            SEAM(pb + 8);
        }
        if (PH_ON(10) && IN(pb + 9)) {
            WS_PTRS();
            pg8::DenseSched S{(const char*)(rg + R_OM), (const char*)(wb + W_MO), DMA, DMA, T / 256, D / 256, 1, DMA, G, bx};
            pg8::EpiResid<false> E{(bf16*)(ws + WS_XB), STATP(l, ST_X2), nullptr, nullptr};
            pg8::gemm_phase<pg8::EpiResid<false>, pg8::DenseSched, true, false>(lds, DMA, DMA, DMA, S, E, 0);
            SEAM(pb + 9);
        }
        if (PH_ON(11) && IN(pb + 10)) {
            WS_PTRS();
            pg8::DenseSched S{(const char*)(ws + WS_XB), (const char*)(wb + W_R), D, D, T / 256, 1, 4, 512, G, bx};
            pg8::EpiRouter E{(float*)(rg + R_AA)};
            pg8::gemm_phase<pg8::EpiRouter, pg8::DenseSched, true, false>(lds, 512, D, D, S, E, 0);
            SEAM(pb + 10);
        }
        if (PH_ON(12) && IN(pb + 11)) {
            WS_PTRS();
            unsigned* cnt = (unsigned*)(ws + WS_CTL) + CW_CNT + l * 64;
            for (int w = bx; w < 256; w += G) route_phase((const float*)(rg + R_AA), STATP(l, ST_X2), INP(I_BRGRP) + l * 4, INP(I_BREXP) + l * 32, (int*)(ws + WS_MOE), (float*)(ws + WS_MOE + 128 * 1024),
                                                          (int*)(ws + WS_MOE + 384 * 1024), cnt, (LAS int*)lds, w, tid);
            SEAM(pb + 11);
        }
        if (PH_ON(13) && IN(pb + 12)) {
            WS_PTRS();
            unsigned* cnt = (unsigned*)(ws + WS_CTL) + CW_CNT + l * 64;
            for (int w = bx; w < 256; w += G) dispatch_phase(cnt, (const int*)(ws + WS_MOE + 384 * 1024), (const int*)(ws + WS_MOE), (const float*)(ws + WS_MOE + 128 * 1024), STATP(l, ST_X2),
                                                             (int*)(ws + WS_MOE + 256 * 1024), (int*)(ws + WS_MOE + 512 * 1024), (float*)(ws + WS_MOE + 704 * 1024), (float*)(ws + WS_MOE + 896 * 1024), (LAS int*)lds, w, tid);
            SEAM(pb + 12);
        }
        if (PH_ON(14) && IN(pb + 13)) {
            WS_PTRS();
            const int nrt = build_rtab((unsigned*)(ws + WS_CTL) + CW_CNT + l * 64, lc, tid);
            { const int* slot_tok = (const int*)(ws + WS_MOE + 512 * 1024);
              for (int i = 0; i < 4; ++i) { const long L = (long)i * G + bx; if (L < (long)nrt * 4 && tid < 256) lc[LC_LTOK / 4 + i * 256 + tid] = slot_tok[lc[LC_RTAB / 4 + 2 * (int)(L >> 2) + 1] + tid]; }
              __syncthreads(); }
            pg8::MoeUpSched S{(const char*)(ws + WS_XB), (const char*)(wb + W_GU), (const LAS int*)(lc + LC_LTOK / 4), (const LAS int*)(lc + LC_RTAB / 4), nrt, G, bx};
            pg8::EpiSwiglu E{(bf16*)(rg + R_ACT), (const float*)(ws + WS_MOE + 896 * 1024)};
            pg8::gemm_phase<pg8::EpiSwiglu, pg8::MoeUpSched, true, false>(lds, D, D, D, S, E, 0);
            SEAM(pb + 13);
        }
        if (PH_ON(15) && IN(pb + 14)) {
            WS_PTRS();
            const int nrt = build_rtab((unsigned*)(ws + WS_CTL) + CW_CNT + l * 64, lc, tid);
            pg8::MoeDownSched S{(const char*)(rg + R_ACT), (const char*)(wb + W_D), (const LAS int*)(lc + LC_RTAB / 4), nrt, G, bx};
            pg8::EpiBf16<1, false> E{(bf16*)(rg + R_Y), D, (const float*)(ws + WS_MOE + 704 * 1024), 0.f, nullptr, nullptr, 0, 0};
            pg8::gemm_phase<pg8::EpiBf16<1, false>, pg8::MoeDownSched, true, false>(lds, DE, DE, DE, S, E, 0);
            SEAM(pb + 14);
        }
        if (PH_ON(16) && IN(pb + 15)) {
            WS_PTRS();
            const bool more = (l + 1 < DEPTH);
            combine_phase(probe ? (float*)(rg + R_AA) : out_ptr(), (const bf16*)(rg + R_Y), (const int*)(ws + WS_MOE + 256 * 1024), (bf16*)(ws + WS_XB), STATP((l + 1) % DEPTH, ST_X), !more, gw, NGW, lane);
            if (more) { LAS float* scr = (LAS float*)(lds + wave * 16384); convert_layer_weights(p, l + 1, scr, gw, NGW, lane, gtid, NGT); }
            SEAM(pb + 15);
        }
    }
#undef IN
#undef SEAM
}

#ifndef MK_SPLIT
#define MK_SPLIT 0
#endif
extern "C" void kernel_launch(void* const* d_in, const int* in_sizes, int n_in, void* d_out, int out_size, void* d_ws, size_t ws_size, hipStream_t stream) {
    static int grid = 0;
    if (grid == 0) {
        if (n_in != 36 || in_sizes[0] != T * D || out_size != T * D || ws_size < WS_END) {
            fprintf(stderr, "kernel_launch: unexpected shapes (n_in %d, in0 %d, out %d, ws %zu < %zu)\n", n_in, n_in > 0 ? in_sizes[0] : -1, out_size, ws_size, (size_t)WS_END); grid = -1; return; }
        int dev = 0, cus = 0, per_cu = 0;
        if (hipGetDevice(&dev) != hipSuccess || hipDeviceGetAttribute(&cus, hipDeviceAttributeMultiprocessorCount, dev) != hipSuccess) { grid = -1; return; }
        if (hipFuncSetAttribute((const void*)fwd_kernel, hipFuncAttributeMaxDynamicSharedMemorySize, LDS_BYTES) != hipSuccess) { fprintf(stderr, "kernel_launch: hipFuncSetAttribute failed\n"); grid = -1; return; }
        if (hipOccupancyMaxActiveBlocksPerMultiprocessor(&per_cu, (const void*)fwd_kernel, NTHREADS, LDS_BYTES) != hipSuccess || per_cu < 1)
            fprintf(stderr, "kernel_launch: occupancy query reports %d workgroups per CU\n", per_cu);
        (void)hipGetLastError();
        grid = cus;
    }
    if (grid < 0) return;
    if (hipMemsetAsync((char*)d_ws, 0, ZERO_BYTES, stream) != hipSuccess) return;
    Params a{};
    for (int i = 0; i < 36; ++i) a.in[i] = (const float*)d_in[i];
    a.out = (float*)d_out; a.ws = (unsigned char*)d_ws;
#if MK_SPLIT
    for (int ph = 0; ph < NPHASES; ++ph) { a.ph_lo = ph; a.ph_hi = ph + 1; hipLaunchKernelGGL(fwd_kernel, dim3(grid), dim3(NTHREADS), LDS_BYTES, stream, a); }
#else
    a.ph_lo = 0; a.ph_hi = NPHASES;
    hipLaunchKernelGGL(fwd_kernel, dim3(grid), dim3(NTHREADS), LDS_BYTES, stream, a);
#endif
#if defined(PROBE_PHASE)
    a.ph_lo = PROBE_PHASE; a.ph_hi = PROBE_PHASE + 1; a.probe = 1;
    for (int r = 0; r < PROBE_REPS; ++r) hipLaunchKernelGGL(fwd_kernel, dim3(grid), dim3(NTHREADS), LDS_BYTES, stream, a);
#endif
}
```

```cpp
#include <hip/hip_runtime.h>
#include <cstdio>
#include <cstdint>

#define GAS __attribute__((address_space(1)))
#define LAS __attribute__((address_space(3)))
typedef unsigned short bf16;
typedef short bf16x8 __attribute__((ext_vector_type(8)));
typedef short s16x4 __attribute__((ext_vector_type(4)));
typedef float f32x4 __attribute__((ext_vector_type(4)));
typedef float f32x2 __attribute__((ext_vector_type(2)));
typedef float f32x16 __attribute__((ext_vector_type(16)));
typedef unsigned u32x4 __attribute__((ext_vector_type(4)));
typedef unsigned u32x2 __attribute__((ext_vector_type(2)));

constexpr int NBATCH = 2, SEQ = 8192, T = NBATCH * SEQ, D = 2048, DEPTH = 2;
constexpr int NMEM = 256, TM = NBATCH * NMEM;
constexpr int QL = 512, KVL = 256, DRNN = 1024, DATT = 1024;
constexpr int NH = 8, QKH = 192, VH = 128;
constexpr int ZC = 3072;
constexpr int Z_CQ = 0, Z_CKV = 512, Z_XR = 768, Z_GATE = 1792, Z_KPE = 2816;
constexpr int NE = 32, DE = 512, NSLOT = 40960;
constexpr int NQU = NH * QKH;
constexpr int NKV = NH * 256;
constexpr int DMA = 512;
constexpr float EPS = 1e-6f;
constexpr int NWAVES = 8, NTHREADS = 512;

__device__ __forceinline__ unsigned f2bf(float f) { unsigned u = __builtin_bit_cast(unsigned, f); return (u + 0x7fffu + ((u >> 16) & 1u)) >> 16; }
__device__ __forceinline__ unsigned pk2(float lo, float hi) { return f2bf(lo) | (f2bf(hi) << 16); }
__device__ __forceinline__ float bf2f(unsigned short h) { return __builtin_bit_cast(float, (unsigned)h << 16); }
__device__ __forceinline__ float bflo(unsigned w) { return __builtin_bit_cast(float, w << 16); }
__device__ __forceinline__ float bfhi(unsigned w) { return __builtin_bit_cast(float, w & 0xffff0000u); }
__device__ __forceinline__ float bfround(float f) { return __builtin_bit_cast(float, f2bf(f) << 16); }
__device__ __forceinline__ unsigned cvt_pk_bf16(float lo, float hi) { unsigned r; asm volatile("v_cvt_pk_bf16_f32 %0, %1, %2" : "=v"(r) : "v"(lo), "v"(hi)); return r; }
__device__ __forceinline__ float wave_sum(float v) {
#pragma unroll
    for (int o = 1; o < 64; o <<= 1) v += __shfl_xor(v, o);
    return v;
}
typedef unsigned long long u64;
__device__ __forceinline__ float ssq_val(const u64* p, int row) { return (float)p[row] * (1.0f / 16777216.0f); }
__device__ __forceinline__ void ssq_add(u64* p, int row, float v) { atomicAdd(p + row, (u64)(v * 16777216.0f)); }
__device__ __forceinline__ void ssq_set(u64* p, int row, float v) { p[row] = (u64)(v * 16777216.0f); }
#define LDS_WAIT() asm volatile("s_waitcnt lgkmcnt(0)" ::: "memory")
#define VM_WAIT() asm volatile("s_waitcnt vmcnt(0)" ::: "memory")

#define XB_TMO      128
#define XB_XCNT(j)  (256  + 64 * (j))
#define XB_XSUB(j)  (1280 + 64 * (j))
#define XB_XGEN(j)  (2304 + 64 * (j))
#define XB_TOP      3328
#define XB_TOPGEN   3392
#define XCD_BAR_WORDS 3456
#define XB_SPIN_CAP (1u << 18)
__device__ __forceinline__ unsigned xb_ld(unsigned* p)              { return __hip_atomic_load(p, __ATOMIC_RELAXED, __HIP_MEMORY_SCOPE_AGENT); }
__device__ __forceinline__ unsigned xb_add(unsigned* p, unsigned v) { return __hip_atomic_fetch_add(p, v, __ATOMIC_RELAXED, __HIP_MEMORY_SCOPE_AGENT); }
__device__ __forceinline__ unsigned xb_xcc_id() { return (unsigned)__builtin_amdgcn_s_getreg((3 << 11) | 20) & 0xFu; }
#define XB_SPIN(cond, bar) do { unsigned _sp = 0; while (cond) { __builtin_amdgcn_s_sleep(1); \
    if ((++_sp & 255u) == 0u) { if (xb_ld(&(bar)[XB_TMO])) break; if (_sp > XB_SPIN_CAP) { atomicAdd(&(bar)[XB_TMO], 1u); break; } } } } while (0)
struct XcdBarrier { unsigned* bar; unsigned x; volatile LAS unsigned* st; };
__device__ __forceinline__ XcdBarrier xcd_barrier_post(unsigned* bar, volatile LAS unsigned* st) {
    XcdBarrier b; b.bar = bar; b.x = xb_xcc_id(); b.st = st;
    if (threadIdx.x == 0) (void)xb_add(&bar[XB_XCNT(b.x)], 1u);
    return b;
}
__device__ __forceinline__ void xcd_barrier_complete(unsigned* bar, unsigned x, unsigned& nloc, unsigned& nx) {
    const unsigned G = gridDim.x * gridDim.y * gridDim.z;
    unsigned sum, cnt, mine, sp = 0u;
    for (;;) {
        sum = 0u; cnt = 0u; mine = 0u;
#pragma unroll
        for (unsigned j = 0; j < 16; ++j) { const unsigned c = xb_ld(&bar[XB_XCNT(j)]); sum += c; cnt += (c > 0u) ? 1u : 0u; mine = (j == x) ? c : mine; }
        if (sum == G) break;
        __builtin_amdgcn_s_sleep(1);
        if ((++sp & 255u) == 0u) { if (xb_ld(&bar[XB_TMO])) break; if (sp > XB_SPIN_CAP) { atomicAdd(&bar[XB_TMO], 1u); break; } }
    }
    nloc = mine > 0u ? mine : 1u; nx = cnt > 0u ? cnt : 1u;
}
__device__ __forceinline__ void xcd_barrier(const XcdBarrier& b) {
    asm volatile("s_waitcnt vmcnt(0)" ::: "memory");
    __syncthreads();
    if (threadIdx.x == 0) {
        unsigned* bar = b.bar; unsigned bx_ = b.x; asm volatile("" : "+s"(bar), "+s"(bx_));
        __builtin_amdgcn_s_waitcnt(0);
        unsigned nloc = b.st[0], nx = b.st[1];
        if (nloc == 0u) { xcd_barrier_complete(bar, bx_, nloc, nx); b.st[0] = nloc; b.st[1] = nx; }
        const unsigned old = xb_add(&bar[XB_XSUB(bx_)], 1u);
        const unsigned gen = old / nloc;
        if (old + 1u == (gen + 1u) * nloc) {
            __builtin_amdgcn_fence(__ATOMIC_RELEASE, "agent");
            asm volatile("s_waitcnt vmcnt(0)" ::: "memory");
            const unsigned og = xb_add(&bar[XB_TOP], 1u);
            const unsigned tg = og / nx;
            if (og + 1u == (tg + 1u) * nx) xb_add(&bar[XB_TOPGEN], 1u);
            else XB_SPIN(xb_ld(&bar[XB_TOPGEN]) == tg, bar);
            __builtin_amdgcn_fence(__ATOMIC_ACQUIRE, "agent");
            xb_add(&bar[XB_XGEN(bx_)], 1u);
            asm volatile("s_waitcnt vmcnt(0)" ::: "memory");
        } else {
            XB_SPIN(xb_ld(&bar[XB_XGEN(bx_)]) == gen, bar);
            __builtin_amdgcn_fence(__ATOMIC_ACQUIRE, "agent");
            asm volatile("s_waitcnt vmcnt(0)" ::: "memory");
        }
    }
    __syncthreads();
}

namespace pg8 {
constexpr int BM = 256, BK = 64, HALF = 128, HTB = HALF * BK * 2, STAGE_BYTES = 8 * HTB, NXCD = 8, WGM = 8;
__host__ __device__ __forceinline__ int lds_byte(int r, int c) { const int st = (r >> 4) * 2 + (c >> 5), rr = r & 15, cc = c & 31, ob = rr * 64 + cc * 2; return st * 1024 + (ob ^ (((ob >> 9) & 1) << 5)); }
__host__ __device__ __forceinline__ void stage_rc(int b, int& R, int& C) { const int st = b / 1024, sb = b % 1024, swz = sb ^ (((sb >> 9) & 1) << 5); R = (st >> 1) * 16 + swz / 64; C = (st & 1) * 32 + (swz % 64) / 2; }
__host__ __device__ __forceinline__ int perm32(int rho) { const int n = rho >> 4, i = rho & 15; return 8 * (i >> 2) + 4 * n + (i & 3); }

struct Unit { const char* A; const char* B; int pm, pn, aux; };

__device__ __forceinline__ bool static_tile(int i, int G, int c, int nM, int nN, int& pm, int& pn) {
    const int nwg = nM * nN; const long L = (long)i * G + c; if (L >= nwg) return false;
    int wgid = (int)L; { const int q = nwg / NXCD, r = nwg % NXCD, xcd = wgid % NXCD, off = wgid / NXCD; wgid = (xcd < r ? xcd * (q + 1) : r * (q + 1) + (xcd - r) * q) + off; }
    const int nig = WGM * nN, gid = wgid / nig, fm = gid * WGM, gsz = (nM - fm) < WGM ? (nM - fm) : WGM;
    pm = fm + ((wgid % nig) % gsz); pn = (wgid % nig) / gsz; return true;
}

template <class Epi, class Sched, bool ALIGN_EPI, bool MID>
__device__ __forceinline__ void gemm_phase(LAS unsigned char* lds, const int K, const int lda, const int ldb, const Sched& S, const Epi& E, const int mid_t) {
    constexpr bool GATHER = Sched::GATHER;
    int tid = threadIdx.x; asm volatile("" : "+v"(tid)); const int wid = __builtin_amdgcn_readfirstlane(tid >> 6), lane = tid & 63, wr = wid >> 2, wc = wid & 3, fr = lane & 15, fq = lane >> 4;
    const int nt = K / BK;
    unsigned voffA[2], voffB[2];
#pragma unroll
    for (int i = 0; i < 2; ++i) { int R, C; stage_rc(tid * 16 + i * 8192, R, C); const int Rb = Epi::PERM ? ((R & ~31) + perm32(R & 31)) : R;
        voffA[i] = (unsigned)(R * lda + C) * 2u; voffB[i] = (unsigned)(Rb * ldb + C) * 2u; }
    const size_t kstep = (size_t)(BK * 2);
    const size_t hstepA = GATHER ? (size_t)0 : (size_t)HALF * lda * 2;
    const size_t hstepB = (size_t)HALF * ldb * 2;
    const unsigned ldsw = (unsigned)wid * 1024u;
    const int aoff = lds_byte(wr * 64 + fr, fq * 8), boff = lds_byte(wc * 32 + fr, fq * 8);
#define PG8_SA(b, h) (((b) * 2 + (h)) * HTB)
#define PG8_SB(b, h) ((4 + (b) * 2 + (h)) * HTB)
#define PG8_STAGE(bufoff, gbase, voff) do { _Pragma("unroll") for (int _i = 0; _i < 2; ++_i) \
        __builtin_amdgcn_global_load_lds((const unsigned*)((const char*)(gbase) + (voff)[_i]), (LAS unsigned*)(lds + (bufoff) + ldsw + _i * 8192), 16, 0, 0); } while (0)
#define PG8_LDA(dst, b, h) do { _Pragma("unroll") for (int m = 0; m < 4; ++m) _Pragma("unroll") for (int k = 0; k < 2; ++k) dst[m][k] = *(const LAS bf16x8*)(lds + PG8_SA(b, h) + aoff + m * 2048 + k * 1024); } while (0)
#define PG8_LDB(dst, b, h) do { _Pragma("unroll") for (int n = 0; n < 2; ++n) _Pragma("unroll") for (int k = 0; k < 2; ++k) dst[n][k] = *(const LAS bf16x8*)(lds + PG8_SB(b, h) + boff + n * 2048 + k * 1024); } while (0)
#define PG8_MMA(ai, bj, At, Bt) do { __builtin_amdgcn_s_setprio(1); _Pragma("unroll") for (int m = 0; m < 4; ++m) _Pragma("unroll") for (int n = 0; n < 2; ++n) _Pragma("unroll") for (int k = 0; k < 2; ++k) \
        acc[ai][bj][m][n] = __builtin_amdgcn_mfma_f32_16x16x32_bf16(Bt[n][k], At[m][k], acc[ai][bj][m][n], 0, 0, 0); __builtin_amdgcn_s_setprio(0); } while (0)
#define PG8_WAIT_V(n) asm volatile("s_waitcnt vmcnt(" #n ")" ::: "memory")
#define PG8_WAIT_L(n) asm volatile("s_waitcnt lgkmcnt(" #n ")" ::: "memory")
#define PG8_BAR __builtin_amdgcn_s_barrier()
#define PG8_SCHED __builtin_amdgcn_sched_barrier(0)
    Unit cur, nxt; int ui = 0;
    if (!S.next(0, cur)) return;
    f32x4 acc[2][2][4][2];
#pragma unroll
    for (int a = 0; a < 2; ++a)
#pragma unroll
        for (int b = 0; b < 2; ++b)
#pragma unroll
            for (int m = 0; m < 4; ++m)
#pragma unroll
                for (int n = 0; n < 2; ++n) acc[a][b][m][n] = (f32x4){0.f, 0.f, 0.f, 0.f};
    bf16x8 At[4][2], B0[2][2], B1[2][2];
    unsigned gA0[2], gA1[2], gN0[2], gN1[2];
    if constexpr (GATHER) {
#pragma unroll
        for (int i = 0; i < 2; ++i) { int R, C; stage_rc(tid * 16 + i * 8192, R, C); gA0[i] = S.arow(cur, R) + (unsigned)C * 2u; gA1[i] = S.arow(cur, HALF + R) + (unsigned)C * 2u; gN0[i] = gA0[i]; gN1[i] = gA1[i]; }
    }
#define PG8_STAGE_A(b, h, gbase, G0, G1) do { if constexpr (GATHER) { if ((h) == 0) PG8_STAGE(PG8_SA(b, h), gbase, G0); else PG8_STAGE(PG8_SA(b, h), gbase, G1); } \
        else PG8_STAGE(PG8_SA(b, h), (gbase) + (h) * hstepA, voffA); } while (0)
    const char* cA = cur.A; const char* cB = cur.B;
    PG8_STAGE(PG8_SB(0, 0), cB, voffB); PG8_STAGE(PG8_SB(0, 1), cB + hstepB, voffB); PG8_STAGE_A(0, 0, cA, gA0, gA1); PG8_STAGE_A(0, 1, cA, gA0, gA1);
    if (wr == 1) PG8_BAR;
    PG8_WAIT_V(2); PG8_BAR;
    PG8_STAGE(PG8_SB(1, 0), cB + kstep, voffB); PG8_STAGE_A(1, 0, cA + kstep, gA0, gA1); PG8_STAGE(PG8_SB(1, 1), cB + hstepB + kstep, voffB);
    PG8_WAIT_V(6); PG8_BAR;
    for (;;) {
        const bool has_next = S.next(ui + 1, nxt);
        const char* nA = has_next ? nxt.A : cA; const char* nB = has_next ? nxt.B : cB;
        if constexpr (GATHER) {
            if (has_next) {
#pragma unroll
                for (int i = 0; i < 2; ++i) { int R, C; stage_rc(tid * 16 + i * 8192, R, C); gN0[i] = S.arow(nxt, R) + (unsigned)C * 2u; gN1[i] = S.arow(nxt, HALF + R) + (unsigned)C * 2u; }
            }
        }
#pragma nounroll
        for (int t = 0; t < nt; t += 2) {
            const bool last = (t == nt - 2);
            if constexpr (MID) { if (t == mid_t) E.mid(acc, cur, wr, wc, fr, fq); }
            const char* a1 = cA + (size_t)(t + 1) * kstep;
            const char* a2 = last ? nA : cA + (size_t)(t + 2) * kstep; const char* b2 = last ? nB : cB + (size_t)(t + 2) * kstep;
            const char* a3 = a2 + kstep; const char* b3 = b2 + kstep;
            unsigned w0[2], w1[2];
            if constexpr (GATHER) {
#pragma unroll
                for (int i = 0; i < 2; ++i) { w0[i] = last ? gN0[i] : gA0[i]; w1[i] = last ? gN1[i] : gA1[i]; }
            }
            PG8_LDB(B0, 0, 0); PG8_LDB(B1, 0, 1); PG8_SCHED; PG8_LDA(At, 0, 0); PG8_STAGE_A(1, 1, a1, gA0, gA1);
            PG8_WAIT_V(8); PG8_WAIT_L(0); PG8_BAR; PG8_MMA(0, 0, At, B0); PG8_MMA(0, 1, At, B1); PG8_BAR; PG8_SCHED;
            PG8_LDA(At, 0, 1); PG8_STAGE(PG8_SB(0, 0), b2, voffB); PG8_STAGE(PG8_SB(0, 1), b2 + hstepB, voffB); PG8_STAGE_A(0, 0, a2, w0, w1);
            PG8_WAIT_V(8); PG8_WAIT_L(0); PG8_BAR; PG8_MMA(1, 0, At, B0); PG8_MMA(1, 1, At, B1); PG8_BAR; PG8_SCHED;
            PG8_LDB(B0, 1, 0); PG8_LDB(B1, 1, 1); PG8_SCHED; PG8_LDA(At, 1, 0); PG8_STAGE_A(0, 1, a2, w0, w1);
            PG8_WAIT_V(8); PG8_WAIT_L(0); PG8_BAR; PG8_MMA(0, 0, At, B0); PG8_MMA(0, 1, At, B1); PG8_BAR; PG8_SCHED;
            PG8_LDA(At, 1, 1); PG8_STAGE(PG8_SB(1, 0), b3, voffB); PG8_STAGE(PG8_SB(1, 1), b3 + hstepB, voffB); PG8_STAGE_A(1, 0, a3, w0, w1);
            PG8_WAIT_V(8); PG8_WAIT_L(0); PG8_BAR; PG8_MMA(1, 0, At, B0); PG8_MMA(1, 1, At, B1); PG8_BAR; PG8_SCHED;
        }
        if constexpr (ALIGN_EPI) { if (wr == 0) PG8_BAR; }
        E(acc, cur, wr, wc, fr, fq);
        if (!has_next) break;
#pragma unroll
        for (int a = 0; a < 2; ++a)
#pragma unroll
            for (int b = 0; b < 2; ++b)
#pragma unroll
                for (int m = 0; m < 4; ++m)
#pragma unroll
                    for (int n = 0; n < 2; ++n) acc[a][b][m][n] = (f32x4){0.f, 0.f, 0.f, 0.f};
        cur = nxt; cA = nA; cB = nB; ++ui;
        if constexpr (GATHER) {
#pragma unroll
            for (int i = 0; i < 2; ++i) { gA0[i] = gN0[i]; gA1[i] = gN1[i]; }
        }
        if constexpr (ALIGN_EPI) { if (wr == 1) PG8_BAR; }
    }
    PG8_WAIT_V(0);
    if constexpr (!ALIGN_EPI) { if (wr == 0) PG8_BAR; }
    PG8_BAR;
#undef PG8_SA
#undef PG8_SB
#undef PG8_STAGE
#undef PG8_STAGE_A
#undef PG8_LDA
#undef PG8_LDB
#undef PG8_MMA
#undef PG8_WAIT_V
#undef PG8_WAIT_L
#undef PG8_BAR
#undef PG8_SCHED
}
}
namespace pg8 {
struct DenseSched {
    static constexpr bool GATHER = false;
    const char* A; const char* B; int lda, ldb, nM, nN, nKS, Ksplit, G, c;
    __device__ __forceinline__ bool next(int i, Unit& u) const {
        int pm, pc; if (!static_tile(i, G, c, nM, nN * nKS, pm, pc)) return false;
        const int pn = pc / nKS, ks = pc - pn * nKS;
        u.pm = pm; u.pn = pn; u.aux = ks;
        u.A = A + ((size_t)pm * BM * lda + (size_t)ks * Ksplit) * 2;
        u.B = B + ((size_t)pn * BM * ldb + (size_t)ks * Ksplit) * 2;
        return true;
    }
    __device__ __forceinline__ unsigned arow(const Unit&, int r) const { return (unsigned)(r * lda) * 2u; }
};
struct GateSched {
    static constexpr bool GATHER = false;
    const char* A; const char* B; int G, c;
    __device__ __forceinline__ bool next(int i, Unit& u) const {
        int pm, pn; if (!static_tile(i, G, c, T / BM, 8, pm, pn)) return false;
        u.pm = pm; u.pn = pn; u.aux = 0;
        u.A = A + ((size_t)pm * BM * DRNN + (size_t)(pn >> 1) * 256) * 2;
        u.B = B + (size_t)pn * 256 * 256 * 2;
        return true;
    }
    __device__ __forceinline__ unsigned arow(const Unit&, int r) const { return (unsigned)(r * DRNN) * 2u; }
};
struct MoeUpSched {      static constexpr bool GATHER = true;
    const char* A; const char* B; const LAS int* ltok; const LAS int* rtab; int nrt, G, c;
    __device__ __forceinline__ bool next(int i, Unit& u) const {
        const long L = (long)i * G + c; if (L >= (long)nrt * 4) return false;
        const int rt = (int)(L >> 2), pn = (int)(L & 3); const int e = rtab[2 * rt], row0 = rtab[2 * rt + 1];
        u.pm = row0 >> 8; u.pn = pn; u.aux = i; u.A = A;
        u.B = B + ((size_t)e * 1024 * D + (size_t)pn * BM * D) * 2;
        return true;
    }
    __device__ __forceinline__ unsigned arow(const Unit& u, int r) const { return (unsigned)ltok[u.aux * BM + r] * (unsigned)(D * 2); }
};
struct MoeDownSched {    static constexpr bool GATHER = false;
    const char* A; const char* B; const LAS int* rtab; int nrt, G, c;
    __device__ __forceinline__ bool next(int i, Unit& u) const {
        const long L = (long)i * G + c; if (L >= (long)nrt * 8) return false;
        const int rt = (int)(L >> 3), pn = (int)(L & 7); const int e = rtab[2 * rt], row0 = rtab[2 * rt + 1];
        u.pm = row0 >> 8; u.pn = pn; u.aux = e;
        u.A = A + (size_t)row0 * DE * 2;
        u.B = B + ((size_t)e * D * DE + (size_t)pn * BM * DE) * 2;
        return true;
    }
    __device__ __forceinline__ unsigned arow(const Unit&, int r) const { return (unsigned)(r * DE) * 2u; }
};

__device__ __forceinline__ void unpack8x(u32x4 w, float* v) { v[0] = bflo(w.x); v[1] = bfhi(w.x); v[2] = bflo(w.y); v[3] = bfhi(w.y); v[4] = bflo(w.z); v[5] = bfhi(w.z); v[6] = bflo(w.w); v[7] = bfhi(w.w); }
__device__ __forceinline__ void epi_ids(int& wr, int& wc, int& fr, int& fq) { int t = threadIdx.x; asm volatile("" : "+v"(t)); const int wid = t >> 6, lane = t & 63; wr = wid >> 2; wc = wid & 3; fr = lane & 15; fq = lane >> 4; }
template <int MODE, bool STAT> struct EpiBf16 {
    static constexpr bool PERM = true;
    bf16* O; int ldc; const void* rs; float inv_n; u64* stat_a; u64* stat_b; int stat_pn_a, stat_pn_b;
    __device__ __forceinline__ void operator()(const f32x4 (&acc)[2][2][4][2], const Unit& u, int, int, int, int) const {
        int wr, wc, fr, fq; epi_ids(wr, wc, fr, fq);
        int row0 = u.pm * BM + wr * 64 + fr; asm volatile("" : "+v"(row0)); const int col0 = u.pn * BM + wc * 32 + 8 * fq;
        u64* st = nullptr; if (STAT) st = (u.pn < stat_pn_a) ? stat_a : ((u.pn < stat_pn_b) ? stat_b : nullptr);
        float scv[8];
#pragma unroll
        for (int i = 0; i < 8; ++i) { const int row = row0 + (i >> 2) * HALF + (i & 3) * 16; scv[i] = (MODE == 0) ? ssq_val((const u64*)rs, row) : ((MODE == 1) ? ((const float*)rs)[row] : 1.f); }
#pragma unroll
        for (int ai = 0; ai < 2; ++ai)
#pragma unroll
            for (int m = 0; m < 4; ++m) { const int row = row0 + ai * HALF + m * 16;
                float sc = scv[ai * 4 + m];
                if (MODE == 0) sc = 1.0f / sqrtf(sc * inv_n + EPS);
                bf16* rowp = O + (size_t)row * ldc + col0; float ss = 0.f;
#pragma unroll
                for (int bj = 0; bj < 2; ++bj) { const f32x4 v0 = acc[ai][bj][m][0] * sc, v1 = acc[ai][bj][m][1] * sc;
                    if (STAT) ss += (v0[0] * v0[0] + v0[1] * v0[1]) + (v0[2] * v0[2] + v0[3] * v0[3]) + (v1[0] * v1[0] + v1[1] * v1[1]) + (v1[2] * v1[2] + v1[3] * v1[3]);
                    u32x4 w; w.x = cvt_pk_bf16(v0[0], v0[1]); w.y = cvt_pk_bf16(v0[2], v0[3]); w.z = cvt_pk_bf16(v1[0], v1[1]); w.w = cvt_pk_bf16(v1[2], v1[3]);
                    *(u32x4*)(rowp + bj * HALF) = w; }
                if (STAT) { ss += __shfl_xor(ss, 16); ss += __shfl_xor(ss, 32); if (st != nullptr && fq == 0) ssq_add(st, row, ss); }
            }
    }
};
struct EpiF32Slab {
    static constexpr bool PERM = false;
    float* O; int ldc; size_t slab; const u64* rs; float inv_n;
    __device__ __forceinline__ void operator()(const f32x4 (&acc)[2][2][4][2], const Unit& u, int, int, int, int) const {
        int wr, wc, fr, fq; epi_ids(wr, wc, fr, fq);
        int row0 = u.pm * BM + wr * 64 + fr; asm volatile("" : "+v"(row0)); const int col0 = u.pn * BM + wc * 32 + 4 * fq; float* base = O + (size_t)u.aux * slab;
        float scv[8];
#pragma unroll
        for (int i = 0; i < 8; ++i) scv[i] = ssq_val(rs, row0 + (i >> 2) * HALF + (i & 3) * 16);
#pragma unroll
        for (int ai = 0; ai < 2; ++ai)
#pragma unroll
            for (int m = 0; m < 4; ++m) { const int row = row0 + ai * HALF + m * 16; const float sc = 1.0f / sqrtf(scv[ai * 4 + m] * inv_n + EPS);
                float* rowp = base + (size_t)row * ldc + col0;
#pragma unroll
                for (int bj = 0; bj < 2; ++bj)
#pragma unroll
                    for (int n = 0; n < 2; ++n) *(f32x4*)(rowp + bj * HALF + n * 16) = acc[ai][bj][m][n] * sc; }
    }
};
template <bool SCALE> struct EpiResid {
    static constexpr bool PERM = true;
    bf16* xb; u64* stat; const u64* ssq_a; const u64* ssq_b;
    __device__ __forceinline__ void mid(f32x4 (&acc)[2][2][4][2], const Unit& u, int, int, int, int) const {
        int wr, wc, fr, fq; epi_ids(wr, wc, fr, fq);
        int row0 = u.pm * BM + wr * 64 + fr; asm volatile("" : "+v"(row0));
        float sa[8], sb[8];
#pragma unroll
        for (int i = 0; i < 8; ++i) { const int row = row0 + (i >> 2) * HALF + (i & 3) * 16; sa[i] = ssq_val(ssq_a, row); sb[i] = ssq_val(ssq_b, row); }
#pragma unroll
        for (int ai = 0; ai < 2; ++ai)
#pragma unroll
            for (int m = 0; m < 4; ++m) {
                const float ra = 1.0f / sqrtf(sa[ai * 4 + m] * (1.0f / 1024.0f) + EPS), rb = 1.0f / sqrtf(sb[ai * 4 + m] * (1.0f / 1024.0f) + EPS); const float f = ra / rb;
#pragma unroll
                for (int bj = 0; bj < 2; ++bj)
#pragma unroll
                    for (int n = 0; n < 2; ++n) acc[ai][bj][m][n] = acc[ai][bj][m][n] * f; }
    }
    __device__ __forceinline__ void operator()(const f32x4 (&acc)[2][2][4][2], const Unit& u, int, int, int, int) const {
        int wr, wc, fr, fq; epi_ids(wr, wc, fr, fq);
        int row0 = u.pm * BM + wr * 64 + fr; asm volatile("" : "+v"(row0)); const int col0 = u.pn * BM + wc * 32 + 8 * fq;
        GAS bf16* xg = (GAS bf16*)xb;
        float sbv[8];
#pragma unroll
        for (int i = 0; i < 8; ++i) sbv[i] = SCALE ? ssq_val(ssq_b, row0 + (i >> 2) * HALF + (i & 3) * 16) : 0.f;
#pragma unroll
        for (int ai = 0; ai < 2; ++ai) {
            u32x4 xr[4][2];
#pragma unroll
            for (int m = 0; m < 4; ++m)
#pragma unroll
                for (int bj = 0; bj < 2; ++bj) xr[m][bj] = *(const GAS u32x4*)(xg + (unsigned)(row0 + ai * HALF + m * 16) * (unsigned)D + (unsigned)(col0 + bj * HALF));
#pragma unroll
            for (int m = 0; m < 4; ++m) { const int row = row0 + ai * HALF + m * 16;
                float sc = 1.f; if (SCALE) sc = 1.0f / sqrtf(sbv[ai * 4 + m] * (1.0f / 1024.0f) + EPS);
                const unsigned off = (unsigned)row * (unsigned)D + (unsigned)col0; float ss = 0.f;
#pragma unroll
                for (int bj = 0; bj < 2; ++bj) { float xv[8], v[8]; unpack8x(xr[m][bj], xv);
#pragma unroll
                    for (int n = 0; n < 2; ++n)
#pragma unroll
                        for (int j = 0; j < 4; ++j) { v[n * 4 + j] = xv[n * 4 + j] + acc[ai][bj][m][n][j] * sc; ss += v[n * 4 + j] * v[n * 4 + j]; }
                    u32x4 w; w.x = cvt_pk_bf16(v[0], v[1]); w.y = cvt_pk_bf16(v[2], v[3]); w.z = cvt_pk_bf16(v[4], v[5]); w.w = cvt_pk_bf16(v[6], v[7]);
                    *(GAS u32x4*)(xg + off + bj * HALF) = w; }
                ss += __shfl_xor(ss, 16); ss += __shfl_xor(ss, 32); if (fq == 0) ssq_add(stat, row, ss);
            }
            asm volatile("" ::: "memory"); __builtin_amdgcn_sched_barrier(0);
        }
    }
};
struct EpiGates {
    static constexpr bool PERM = false;
    const bf16* xc; const float* b_rg; const float* b_ig; const float* sp; bf16* la_out; bf16* u_out;
    __device__ __forceinline__ void operator()(const f32x4 (&acc)[2][2][4][2], const Unit& u, int, int, int, int) const {
        int wr, wc, fr, fq; epi_ids(wr, wc, fr, fq);
        const unsigned row0 = (unsigned)(u.pm * BM + wr * 64 + fr);
        const GAS bf16* xg = (const GAS bf16*)xc; GAS bf16* ag = (GAS bf16*)la_out; GAS bf16* ug = (GAS bf16*)u_out;
#pragma unroll
        for (int n = 0; n < 2; ++n) { const unsigned ch = (unsigned)(u.pn * 128 + wc * 32 + n * 16 + 4 * fq);
            const f32x4 br = *(const GAS f32x4*)((const GAS float*)b_rg + ch), bi = *(const GAS f32x4*)((const GAS float*)b_ig + ch), s4 = *(const GAS f32x4*)((const GAS float*)sp + ch);
            u32x2 xws[2][4];
#pragma unroll
            for (int ai = 0; ai < 2; ++ai)
#pragma unroll
                for (int m = 0; m < 4; ++m) xws[ai][m] = *(const GAS u32x2*)(xg + (row0 + (unsigned)(ai * HALF + m * 16)) * (unsigned)DRNN + ch);
#pragma unroll
            for (int ai = 0; ai < 2; ++ai)
#pragma unroll
                for (int m = 0; m < 4; ++m) { const unsigned off = (row0 + (unsigned)(ai * HALF + m * 16)) * (unsigned)DRNN + ch;
                    const u32x2 xw = xws[ai][m]; const float xv[4] = {bflo(xw.x), bfhi(xw.x), bflo(xw.y), bfhi(xw.y)};
                    const f32x4 pr = acc[ai][0][m][n] + br, pi = acc[ai][1][m][n] + bi; f32x4 av, uv;
#pragma unroll
                    for (int j = 0; j < 4; ++j) { const float r = __builtin_amdgcn_rcpf(1.0f + __expf(-pr[j])), ig = __builtin_amdgcn_rcpf(1.0f + __expf(-pi[j]));
                        const float la = bfround(-8.0f * r * s4[j]); const float a = __expf(la); const float x2 = 2.0f * la;
                        const float om = (x2 > -0.03125f) ? -x2 * (1.0f + x2 * (0.5f + x2 * (0.16666667f + x2 * 0.041666668f))) : 1.0f - a * a;
                        av[j] = la; uv[j] = __builtin_amdgcn_sqrtf(om) * (ig * xv[j]); }
                    u32x2 wa, wu; wa.x = cvt_pk_bf16(av[0], av[1]); wa.y = cvt_pk_bf16(av[2], av[3]); wu.x = cvt_pk_bf16(uv[0], uv[1]); wu.y = cvt_pk_bf16(uv[2], uv[3]);
                    *(GAS u32x2*)(ag + off) = wa; *(GAS u32x2*)(ug + off) = wu; }
        }
    }
};
struct EpiSwiglu {
    static constexpr bool PERM = true;
    bf16* O; const float* rs;
    __device__ __forceinline__ void operator()(const f32x4 (&acc)[2][2][4][2], const Unit& u, int, int, int, int) const {
        int wr, wc, fr, fq; epi_ids(wr, wc, fr, fq);
        int row0 = u.pm * BM + wr * 64 + fr; asm volatile("" : "+v"(row0)); const int col0 = u.pn * 128 + wc * 32 + 8 * fq;
        float scv[8];
#pragma unroll
        for (int i = 0; i < 8; ++i) scv[i] = rs[row0 + (i >> 2) * HALF + (i & 3) * 16];
#pragma unroll
        for (int ai = 0; ai < 2; ++ai)
#pragma unroll
            for (int m = 0; m < 4; ++m) { const int row = row0 + ai * HALF + m * 16; const float sc = scv[ai * 4 + m]; float h[8];
#pragma unroll
                for (int n = 0; n < 2; ++n)
#pragma unroll
                    for (int j = 0; j < 4; ++j) { const float g = acc[ai][0][m][n][j] * sc, up = acc[ai][1][m][n][j] * sc; h[n * 4 + j] = g / (1.0f + __expf(-g)) * up; }
                u32x4 w; w.x = cvt_pk_bf16(h[0], h[1]); w.y = cvt_pk_bf16(h[2], h[3]); w.z = cvt_pk_bf16(h[4], h[5]); w.w = cvt_pk_bf16(h[6], h[7]);
                *(u32x4*)(O + (size_t)row * DE + col0) = w; }
    }
};
struct EpiRouter {
    static constexpr bool PERM = false;
    float* O;
    __device__ __forceinline__ void operator()(const f32x4 (&acc)[2][2][4][2], const Unit& u, int, int, int, int) const {
        int wr, wc, fr, fq; epi_ids(wr, wc, fr, fq);
        if (wc >= 2) return;
        float* Os = O + (size_t)u.aux * ((size_t)T * 64);
        int row0 = u.pm * BM + wr * 64 + fr; asm volatile("" : "+v"(row0)); const int col0 = wc * 32 + 4 * fq;
#pragma unroll
        for (int ai = 0; ai < 2; ++ai)
#pragma unroll
            for (int m = 0; m < 4; ++m) { const int row = row0 + ai * HALF + m * 16;
#pragma unroll
                for (int n = 0; n < 2; ++n) *(f32x4*)(Os + (size_t)row * 64 + col0 + n * 16) = acc[ai][0][m][n]; }
    }
};
}
namespace att {
constexpr int NW = 8, QBLK = 32, KVBLK = 64, QB = NW * QBLK;
constexpr int SHM_V = KVBLK * 128 * 2, SHM_K = KVBLK * 128 * 2, SHM_R = KVBLK * 64 * 2;
constexpr int OFF_V = 0, OFF_K = 2 * SHM_V, OFF_R = OFF_K + 2 * SHM_K, OFF_WS = OFF_R + 2 * SHM_R, OFF_QR = OFF_WS + NW * 64 * 4, LDS_BYTES = OFF_QR + NW * 4 * 1024;
constexpr float THR = 8.f;

#define KSWZ(row, colB) ((row) * 256 + ((colB) ^ (((row) & 7) << 4)))
#define RSWZ(row, ch) ((row) * 128 + ((((ch) ^ (((row) >> 1) & 7))) << 4))
#define SBAR() __builtin_amdgcn_sched_barrier(0)
__device__ __forceinline__ int v_st(int k, int c) { const int kk = (k & ~0xC) | ((k & 4) << 1) | ((k & 8) >> 1); return ((kk >> 3) * 4 + (c >> 5)) * 512 + ((kk & 7) * 32 + (c & 31)) * 2; }
__device__ __forceinline__ int v_rd_base(int lane) { return ((lane & 3) << 3) | (((lane >> 2) & 3) << 6) | (((lane >> 4) & 1) << 5) | (((lane >> 5) & 1) << 8); }
constexpr int v_rd_off(int d0, int ks, int half) { return d0 * 512 + ks * 4096 + half * 2048; }
__device__ __forceinline__ int crow(int r, int hi) { return (r & 3) + 8 * (r >> 2) + 4 * hi; }
__device__ __forceinline__ unsigned cvtpk(float lo, float hi) { unsigned r; asm volatile("v_cvt_pk_bf16_f32 %0, %1, %2" : "=v"(r) : "v"(lo), "v"(hi)); return r; }
__device__ __forceinline__ bf16x8 load8(const bf16* p) { return *reinterpret_cast<const bf16x8*>(p); }

__device__ __forceinline__ void mask_tile(f32x16& p0, f32x16& p1, int dq) {
    const float NEG = -__builtin_inff();
#pragma unroll
    for (int r = 0; r < 16; ++r) {
        const int c = (r & 3) + 8 * (r >> 2);
        if (dq - c < 0) p0[r] = NEG;
        if (dq - c - 32 < 0) p1[r] = NEG;
    }
}
__device__ __forceinline__ void partialSM(f32x16& p0, f32x16& p1, float& m_reg, float& mn, float& alpha, const float SCALE) {
    float pmax = p0[0]; for (int r = 1; r < 16; ++r) pmax = fmaxf(pmax, p0[r]); for (int r = 0; r < 16; ++r) pmax = fmaxf(pmax, p1[r]);
    { auto rr = __builtin_amdgcn_permlane32_swap(__float_as_uint(pmax), __float_as_uint(pmax), false, false);
      pmax = fmaxf(__uint_as_float(rr[0]), __uint_as_float(rr[1])); }
    const float C2 = 1.4426950408889634f * SCALE;
    if (__builtin_expect(__all((pmax - m_reg) * SCALE <= THR), 1)) { mn = m_reg; alpha = 1.f; }
    else { mn = fmaxf(m_reg, pmax); alpha = __builtin_amdgcn_exp2f((m_reg - mn) * C2); m_reg = mn; }
    const float mnL = -mn * C2;
    for (int r = 0; r < 16; ++r) p0[r] = fmaf(p0[r], C2, mnL); for (int r = 0; r < 16; ++r) p1[r] = fmaf(p1[r], C2, mnL);
    for (int r = 0; r < 16; ++r) p0[r] = __builtin_amdgcn_exp2f(p0[r]);
}
__device__ __forceinline__ void finishSM(f32x16& p0, f32x16& p1, float alpha, float& l_reg, bf16x8& pa0, bf16x8& pa1, bf16x8& pa2, bf16x8& pa3) {
    for (int r = 0; r < 16; ++r) p1[r] = __builtin_amdgcn_exp2f(p1[r]);
    float ps = 0; for (int r = 0; r < 16; ++r) ps += p0[r]; for (int r = 0; r < 16; ++r) ps += p1[r];
    { auto rr = __builtin_amdgcn_permlane32_swap(__float_as_uint(ps), __float_as_uint(ps), false, false);
      ps = __uint_as_float(rr[0]) + __uint_as_float(rr[1]); }
    l_reg = l_reg * alpha + ps;
#define PK4(P, B_, OUT) do { unsigned a0 = cvtpk(P[B_+0], P[B_+1]), a1 = cvtpk(P[B_+2], P[B_+3]);                          \
        unsigned b0 = cvtpk(P[B_+4], P[B_+5]), b1 = cvtpk(P[B_+6], P[B_+7]);                                             \
        auto r0 = __builtin_amdgcn_permlane32_swap(a0, b0, false, false); auto r1 = __builtin_amdgcn_permlane32_swap(a1, b1, false, false); \
        u32x4 w = {r0[0], r1[0], r0[1], r1[1]}; OUT = *reinterpret_cast<bf16x8*>(&w); } while (0)
    PK4(p0, 0, pa0); PK4(p0, 8, pa1); PK4(p1, 0, pa2); PK4(p1, 8, pa3);
#undef PK4
}
template <int KB, int ROPE>
__device__ __forceinline__ void qkt(f32x16& p0, f32x16& p1, const char* lds, int r32_, int hi_, const bf16x8* qr, const char* qrl) {
    p0 = f32x16{}; p1 = f32x16{};
    int lane_ = r32_ | (hi_ << 5); asm volatile("" : "+v"(lane_)); const int r32 = lane_ & 31, hi = lane_ >> 5;
    const char* kb[4];
#pragma unroll
    for (int dd = 0; dd < 4; ++dd) kb[dd] = lds + OFF_K + KB * SHM_K + KSWZ(r32, (dd * 16 + hi * 8) * 2);
#pragma unroll
    for (int d0 = 0; d0 < 8; ++d0) { const char* a = kb[d0 & 3] + (d0 >> 2) * 128;
        bf16x8 b0 = *reinterpret_cast<const bf16x8*>(a);
        bf16x8 b1 = *reinterpret_cast<const bf16x8*>(a + 32 * 256);
        p0 = __builtin_amdgcn_mfma_f32_32x32x16_bf16(b0, qr[d0], p0, 0, 0, 0);
        p1 = __builtin_amdgcn_mfma_f32_32x32x16_bf16(b1, qr[d0], p1, 0, 0, 0); }
    if constexpr (ROPE > 0) {
#pragma unroll
        for (int d0 = 0; d0 < 4; ++d0) { const char* a = lds + OFF_R + KB * SHM_R + RSWZ(r32, d0 * 2 + hi);
            bf16x8 b0 = *reinterpret_cast<const bf16x8*>(a);
            bf16x8 b1 = *reinterpret_cast<const bf16x8*>(a + 32 * 128);
            const bf16x8 qf = *reinterpret_cast<const bf16x8*>(qrl + d0 * 1024);
            p0 = __builtin_amdgcn_mfma_f32_32x32x16_bf16(b0, qf, p0, 0, 0, 0);
            p1 = __builtin_amdgcn_mfma_f32_32x32x16_bf16(b1, qf, p1, 0, 0, 0); }
    }
}
template <int VB>
__device__ __forceinline__ void pv_tile(f32x16* o, int vb0, bf16x8 pa0, bf16x8 pa1, bf16x8 pa2, bf16x8 pa3) {
#define TRRD(dst, off) asm volatile("ds_read_b64_tr_b16 %0, %1 offset:%2" : "=&v"(dst) : "v"(vb0), "i"(off) : "memory")
#define PV_D0(d0) do { s16x4 l0, l1, l2, l3, h0, h1, h2, h3; constexpr int b_ = OFF_V + VB * SHM_V + v_rd_off(d0, 0, 0); \
        TRRD(l0, b_); TRRD(h0, b_ + 2048); TRRD(l1, b_ + 4096); TRRD(h1, b_ + 6144); TRRD(l2, b_ + 8192); TRRD(h2, b_ + 10240); TRRD(l3, b_ + 12288); TRRD(h3, b_ + 14336); \
        asm volatile("s_waitcnt lgkmcnt(0)" ::: "memory"); SBAR();   \
        o[d0] = __builtin_amdgcn_mfma_f32_32x32x16_bf16(pa0, (bf16x8){l0[0], l0[1], l0[2], l0[3], h0[0], h0[1], h0[2], h0[3]}, o[d0], 0, 0, 0);   \
        o[d0] = __builtin_amdgcn_mfma_f32_32x32x16_bf16(pa1, (bf16x8){l1[0], l1[1], l1[2], l1[3], h1[0], h1[1], h1[2], h1[3]}, o[d0], 0, 0, 0);   \
        o[d0] = __builtin_amdgcn_mfma_f32_32x32x16_bf16(pa2, (bf16x8){l2[0], l2[1], l2[2], l2[3], h2[0], h2[1], h2[2], h2[3]}, o[d0], 0, 0, 0);   \
        o[d0] = __builtin_amdgcn_mfma_f32_32x32x16_bf16(pa3, (bf16x8){l3[0], l3[1], l3[2], l3[3], h3[0], h3[1], h3[2], h3[3]}, o[d0], 0, 0, 0); } while (0)
    PV_D0(0); PV_D0(1); PV_D0(2); PV_D0(3);
#undef PV_D0
#undef TRRD
}

template <int LDQ, int LDK, int LDV, int LDO> struct Strides { static constexpr int ldq = LDQ, ldk = LDK, ldv = LDV, ldo = LDO; };
struct BlockRef { const bf16* Q; const bf16* K; const bf16* V; bf16* O; u64* ssq; int P0; int nk; };
template <int NQ> struct Seam { bf16x8 qr[8]; bf16x8 st_v0, st_v1, st_k0, st_k1, st_r; };

#define VMW() asm volatile("s_waitcnt vmcnt(0)" ::: "memory")
#define VMWN(n) asm volatile("s_waitcnt vmcnt(%0)" :: "i"(n) : "memory")
__device__ __forceinline__ int optid() { int t = threadIdx.x; asm volatile("" : "+v"(t)); return t; }
#define SLOAD_H(Kp, Vp, k0) do { const int t_ = optid(); const unsigned sr_ = t_ >> 4, sc_ = (t_ & 15) * 8, rr_ = t_ >> 3, rc_ = (t_ & 7) * 8;   \
                                 const bf16* kt_ = (Kp) + (size_t)(k0) * st.ldk; const bf16* vt_ = (Vp) + (size_t)(k0) * st.ldv;                    \
                                 S.st_v0 = load8(vt_ + (sr_ * st.ldv + sc_)); S.st_v1 = load8(vt_ + ((32 + sr_) * st.ldv + sc_));                   \
                                 S.st_k0 = load8(kt_ + (sr_ * st.ldk + sc_)); S.st_k1 = load8(kt_ + ((32 + sr_) * st.ldk + sc_));                   \
                                 if constexpr (ROPE > 0) S.st_r = load8(kt_ + (rr_ * st.ldk + 128 + rc_)); } while (0)
#define SWRITE_HK(bf) do { const int t_ = optid(); const int kws_ = KSWZ(t_ >> 4, (t_ & 15) * 16);                                                  \
                           *(bf16x8*)(lds + OFF_K + (bf) * SHM_K + kws_) = S.st_k0; *(bf16x8*)(lds + OFF_K + (bf) * SHM_K + kws_ + 32 * 256) = S.st_k1;   \
                           if constexpr (ROPE > 0) *(bf16x8*)(lds + OFF_R + (bf) * SHM_R + RSWZ(t_ >> 3, t_ & 7)) = S.st_r; } while (0)
#define SWRITE_HV(bf) do { const int t_ = optid(); const int sr_ = t_ >> 4, sc_ = (t_ & 15) * 8;                                                     \
                           *(bf16x8*)(lds + OFF_V + (bf) * SHM_V + v_st(sr_, sc_)) = S.st_v0; *(bf16x8*)(lds + OFF_V + (bf) * SHM_V + v_st(32 + sr_, sc_)) = S.st_v1; } while (0)
#define SWRITE_H(bf) do { SWRITE_HV(bf); SWRITE_HK(bf); } while (0)

template <int ROPE, class ST>
__device__ __forceinline__ void attn_prime(const BlockRef& cur, const ST& st, char* lds, Seam<8 + ROPE / 16>& S) {
    constexpr int NQ = 8 + ROPE / 16;
    int tid = threadIdx.x; asm volatile("" : "+v"(tid)); const int wid = __builtin_amdgcn_readfirstlane(tid >> 6), lane = tid & 63, r32 = lane & 31, hi = lane >> 5;
#pragma unroll
    for (int d0 = 0; d0 < 8; ++d0) S.qr[d0] = load8(cur.Q + (size_t)(wid * QBLK + r32) * st.ldq + d0 * 16 + hi * 8);
    if constexpr (ROPE > 0) {
#pragma unroll
        for (int d0 = 0; d0 < 4; ++d0) *(bf16x8*)(lds + OFF_QR + wid * 4096 + d0 * 1024 + lane * 16) = load8(cur.Q + (size_t)(wid * QBLK + r32) * st.ldq + 128 + d0 * 16 + hi * 8);
    }
    SLOAD_H(cur.K, cur.V, 0); VMW(); SWRITE_HK(0);
    __syncthreads();
}
template <int ROPE, bool CAUSAL, bool STAT, class ST>
__device__ __forceinline__ void attn_block(const BlockRef& cur, const BlockRef& nxt, const ST& st, const float SCALE, char* lds, Seam<8 + ROPE / 16>& S) {
    constexpr int NQ = 8 + ROPE / 16;
    int tid = threadIdx.x; asm volatile("" : "+v"(tid)); const int wid = __builtin_amdgcn_readfirstlane(tid >> 6), lane = tid & 63, r32 = lane & 31, hi = lane >> 5;
    const int NT = CAUSAL ? ((cur.P0 + QB - 1) / KVBLK + 1) : (cur.nk / KVBLK);
    const int qlo = cur.P0 + wid * QBLK, qm = qlo + r32 - 4 * hi;
    float* ws = (float*)(lds + OFF_WS) + wid * 64; float* li_l = ws, * al_l = ws + 32;
    float m_reg = -1e30f, l_reg = 0; f32x16 o[4] = {};
    const int vb0 = (int)(uintptr_t)lds + v_rd_base(lane);
    const bf16* Kh = cur.K; const bf16* Vh = cur.V;
    const char* qrl = lds + OFF_QR + wid * 4096 + lane * 16;
#define RESC(a) do { if (__any((a) < 1.f)) { if (hi == 0) al_l[r32] = (a); asm volatile("s_waitcnt lgkmcnt(0)" ::: "memory");              \
                     for (int d_ = 0; d_ < 4; ++d_) for (int r = 0; r < 16; ++r) o[d_][r] *= al_l[crow(r, hi)]; } } while (0)
#define KBASE(t) ((t) * KVBLK)
#define MASKT(P0_, P1_, t) do { if (CAUSAL) { const int kb_ = KBASE(t); if (kb_ + KVBLK - 1 > qlo) mask_tile(P0_, P1_, qm - kb_); } } while (0)
#define SEAM_K0() do { VMWN(8); SWRITE_HK(0); SBAR(); } while (0)
    f32x16 pA0, pA1, pB0, pB1; float mnA, mnB, alA, alB; bf16x8 pa0, pa1, pa2, pa3;
    SWRITE_HV(0); SBAR();
    if (NT > 1) { SLOAD_H(Kh, Vh, KBASE(1)); }
    SBAR(); qkt<0, ROPE>(pA0, pA1, lds, r32, hi, S.qr, qrl);
    MASKT(pA0, pA1, 0); partialSM(pA0, pA1, m_reg, mnA, alA, SCALE);
    if (NT > 1) { VMW(); SWRITE_H(1); }
    __syncthreads();
#define HALF_STEP(PX0, PX1, mnX, alX, PY0, PY1, alY, t, KB, VB, SB) do {                                                      \
        SBAR(); qkt<KB, ROPE>(PX0, PX1, lds, r32, hi, S.qr, qrl);                                                                  \
        finishSM(PY0, PY1, alY, l_reg, pa0, pa1, pa2, pa3); SBAR();                                                           \
        if ((t) + 1 < NT) { SLOAD_H(Kh, Vh, KBASE((t) + 1)); SBAR(); }                                                        \
        pv_tile<VB>(o, vb0, pa0, pa1, pa2, pa3); MASKT(PX0, PX1, (t)); partialSM(PX0, PX1, m_reg, mnX, alX, SCALE);           \
        __syncthreads();                                                                                                      \
        if ((t) + 1 < NT) { VMW(); SWRITE_H(SB); }                                                                            \
        RESC(alX); __syncthreads(); } while (0)
    for (int t = 1; t + 1 < NT; t += 2) {
        HALF_STEP(pB0, pB1, mnB, alB, pA0, pA1, alA, t, 1, 0, 0);
        HALF_STEP(pA0, pA1, mnA, alA, pB0, pB1, alB, t + 1, 0, 1, 1);
    }
    const bool even = (NT & 1) == 0;
    if (even) { SBAR(); qkt<1, ROPE>(pB0, pB1, lds, r32, hi, S.qr, qrl); SBAR(); }
    SLOAD_H(nxt.K, nxt.V, 0); SBAR();
#pragma unroll
    for (int d0 = 0; d0 < 8; ++d0) S.qr[d0] = load8(nxt.Q + (size_t)(wid * QBLK + r32) * st.ldq + d0 * 16 + hi * 8);
    SBAR();
    finishSM(pA0, pA1, alA, l_reg, pa0, pa1, pa2, pa3); SBAR();
    pv_tile<0>(o, vb0, pa0, pa1, pa2, pa3);
    if (even) { MASKT(pB0, pB1, NT - 1); partialSM(pB0, pB1, m_reg, mnB, alB, SCALE); __syncthreads(); RESC(alB);
        finishSM(pB0, pB1, alB, l_reg, pa0, pa1, pa2, pa3); SBAR(); pv_tile<1>(o, vb0, pa0, pa1, pa2, pa3); }
    SBAR(); SEAM_K0();
    if (hi == 0) li_l[r32] = l_reg; asm volatile("s_waitcnt lgkmcnt(0)" ::: "memory");
    float rli[16];
#pragma unroll
    for (int r = 0; r < 16; ++r) rli[r] = __builtin_amdgcn_rcpf(li_l[crow(r, hi)]);
    bf16* Ow = cur.O + (size_t)(wid * QBLK) * st.ldo;
#pragma unroll
    for (int r = 0; r < 16; ++r) { const int orow = crow(r, hi); float ss = 0.f;
#pragma unroll
        for (int d0 = 0; d0 < 4; ++d0) { const float v = o[d0][r] * rli[r]; ss += v * v;
            const float vn = __shfl_xor(v, 1);
            if ((r32 & 1) == 0) *(unsigned*)(Ow + (size_t)orow * st.ldo + d0 * 32 + r32) = cvtpk(v, vn); }
        if (STAT) { ss += __shfl_xor(ss, 1); ss += __shfl_xor(ss, 2); ss += __shfl_xor(ss, 4); ss += __shfl_xor(ss, 8); ss += __shfl_xor(ss, 16);
            if (r32 == 0) ssq_add(cur.ssq, wid * QBLK + orow, ss); } }
    if constexpr (ROPE > 0) {
#pragma unroll
        for (int d0 = 0; d0 < 4; ++d0) *(bf16x8*)(lds + OFF_QR + wid * 4096 + d0 * 1024 + lane * 16) = load8(nxt.Q + (size_t)(wid * QBLK + r32) * st.ldq + 128 + d0 * 16 + hi * 8);
    }
    __syncthreads();
#undef RESC
#undef KBASE
#undef MASKT
#undef SEAM_K0
#undef HALF_STEP
}
#undef VMW
#undef VMWN
#undef SLOAD_H
#undef SWRITE_HK
#undef SWRITE_HV
#undef SWRITE_H
}
constexpr size_t MiB = 1u << 20;
constexpr size_t WS_CTL = 0, WS_STAT = 1 * MiB, ZERO_BYTES = 3 * MiB;
constexpr size_t WS_TAB = 3 * MiB;
constexpr size_t WS_MEMB = 6 * MiB, WS_KVMEM = 8 * MiB, WS_KMEMN = 10 * MiB, WS_WMKV = 11 * MiB;
constexpr size_t WS_LOGIT = 20 * MiB, WS_MOE = 24 * MiB, WS_SCAN = 26 * MiB;
constexpr size_t WS_W = 28 * MiB;
constexpr size_t W_IN = 0, W_UQ = 12 * MiB, W_UKV = W_UQ + 3 * MiB / 2, W_G = W_UKV + MiB, W_OUT = W_G + MiB, W_MQ = W_OUT + 8 * MiB, W_MO = W_MQ + 2 * MiB, W_R = W_MO + 2 * MiB,
                 W_GU = W_R + MiB, W_D = W_GU + 128 * MiB, W_END = W_D + 64 * MiB;
constexpr size_t WS_XB = 250 * MiB, WS_R = 314 * MiB;
static_assert(WS_W + W_END <= WS_XB, "weights");
constexpr size_t R_Z = 0, R_Q = 96 * MiB, R_KVR = 144 * MiB, R_KK = 208 * MiB, R_XC = 256 * MiB, R_AA = 288 * MiB, R_UU = 352 * MiB, R_YMIX = 416 * MiB, R_END = 480 * MiB;
constexpr size_t R_QM = 0, R_QMN = 64 * MiB, R_OM = 80 * MiB;
constexpr size_t R_ACT = 0, R_Y = 40 * MiB;
constexpr size_t WS_SCAN2 = WS_R + R_END;
constexpr size_t WS_END = WS_SCAN2 + 6 * MiB;
constexpr int CW_BAR = 4096;
constexpr int CW_CNT = 16384;
enum { ST_X = 0, ST_CQ = 1, ST_CKV = 2, ST_YATT = 3, ST_YRNN = 4, ST_X1 = 5, ST_X2 = 6 };
constexpr int RING_BYTES = 131072, LDSCTL_OFF = RING_BYTES, LDS_BYTES = 147456;
constexpr int LC_BAR = 0, LC_NRT = 16, LC_RTAB = 64, LC_LTOK = 2048;

struct Params { const float* in[36]; float* out; unsigned char* ws; int ph_lo, ph_hi, probe, pad; };
static_assert(sizeof(Params) == 36 * 8 + 8 + 8 + 16, "Params layout");
typedef __attribute__((address_space(4))) const unsigned char kchar;
__device__ __forceinline__ kchar* karg_base() { kchar* ka = (kchar*)__builtin_amdgcn_kernarg_segment_ptr(); asm volatile("" : "+s"(ka)); return ka; }
__device__ __forceinline__ const float* in_ptr(const Params&, int i) { return (const float*)(*(GAS const float* const __attribute__((address_space(4)))*)(karg_base() + i * 8)); }
__device__ __forceinline__ float* out_ptr() { return (float*)(*(GAS float* const __attribute__((address_space(4)))*)(karg_base() + 288)); }
__device__ __forceinline__ unsigned char* ws_ptr() { return (unsigned char*)(*(GAS unsigned char* const __attribute__((address_space(4)))*)(karg_base() + 296)); }
__device__ __forceinline__ unsigned char* opaque_ptr(unsigned char*) { return ws_ptr(); }
enum { I_X = 0, I_MEM, I_MIXG, I_WIN, I_QLG, I_KVLG, I_WUQ, I_WUKV, I_AQG, I_AKG, I_CONVW, I_CONVB, I_WRG, I_BRG, I_WIG, I_BIG, I_LAM, I_AOG, I_ROG, I_WOUT, I_XNG, I_MNG, I_WMQ, I_WMK, I_WMV,
       I_MQG, I_MKG, I_WMO, I_MOEG, I_WRGRP, I_BRGRP, I_WREXP, I_BREXP, I_WEG, I_WEU, I_WED };

__device__ __forceinline__ int dmap(int map, int n) {
    if (map == 1) return n < 768 ? n : (n < 832 ? n + 2048 : n - 64);
    if (map == 2) return ((n >> 7) << 8) + (n & 127);
    if (map == 3) return ((n >> 7) << 8) + 128 + (n & 127);
    return n;
}
__device__ __forceinline__ void transpose_item(const float* W, int K, int Nsrc, bf16* WT, const float* gain, int map, LAS float* scr, int item, int lane) {
    const int nblk = Nsrc / 32, kb = item / nblk, nb = item % nblk, k0 = 64 * kb, n0 = 32 * nb;
    const GAS float* src = (const GAS float*)W + (size_t)(k0 + (lane >> 5)) * Nsrc + n0 + (lane & 31);
    float v[32];
#pragma unroll
    for (int i = 0; i < 32; ++i) v[i] = src[(size_t)(2 * i) * Nsrc];
    const int c = lane & 7; const int d0 = dmap(map, n0);
    f32x4 ga = (f32x4){1.f, 1.f, 1.f, 1.f}, gb = ga;
    if (gain) { ga = *(const GAS f32x4*)((const GAS float*)gain + k0 + 8 * c); gb = *(const GAS f32x4*)((const GAS float*)gain + k0 + 8 * c + 4); }
#pragma unroll
    for (int i = 0; i < 32; ++i) scr[(2 * i + (lane >> 5)) * 33 + (lane & 31)] = v[i];
    LDS_WAIT(); asm volatile("" ::: "memory");
#pragma unroll
    for (int j = 0; j < 4; ++j) { const int n = (lane >> 3) + 8 * j; const LAS float* s = scr + (8 * c) * 33 + n;
        u32x4 o; o.x = pk2(s[0 * 33] * ga[0], s[1 * 33] * ga[1]); o.y = pk2(s[2 * 33] * ga[2], s[3 * 33] * ga[3]); o.z = pk2(s[4 * 33] * gb[0], s[5 * 33] * gb[1]); o.w = pk2(s[6 * 33] * gb[2], s[7 * 33] * gb[3]);
        *(GAS u32x4*)((GAS bf16*)WT + (size_t)(d0 + n) * K + k0 + 8 * c) = o; }
    LDS_WAIT(); asm volatile("" ::: "memory");
}
__device__ __forceinline__ void convert_layer_weights(const Params& p, int l, LAS float* scr, int gw, int NGW, int lane, int gtid, int NGT) {
    unsigned char* wb = opaque_ptr(p.ws) + WS_W;
    constexpr int I0 = 32 * 90, I1 = 8 * 48, I2 = 4 * 64, I3 = 32 * 64, I4 = 32 * 16, I5 = 8 * 64, IE = 32 * 16, IEX = 32 * IE, ID = 8 * 64, IDX = 32 * ID;
    constexpr int NIT = I0 + I1 + I2 + I3 + I4 + I5 + 2 * IEX + IDX;
    for (int it = gw; it < NIT; it += NGW) {
        int r = it;
        if (r < I0) { transpose_item(in_ptr(p, I_WIN) + (size_t)l * D * 2880, D, 2880, (bf16*)(wb + W_IN), in_ptr(p, I_MIXG) + l * D, 1, scr, r, lane); continue; } r -= I0;
        if (r < I1) { transpose_item(in_ptr(p, I_WUQ) + (size_t)l * QL * NQU, QL, NQU, (bf16*)(wb + W_UQ), in_ptr(p, I_QLG) + l * QL, 0, scr, r, lane); continue; } r -= I1;
        if (r < I2) { transpose_item(in_ptr(p, I_WUKV) + (size_t)l * KVL * NKV, KVL, NKV, (bf16*)(wb + W_UKV), in_ptr(p, I_KVLG) + l * KVL, 0, scr, r, lane); continue; } r -= I2;
        if (r < I3) { const int k0 = 64 * (r / 64); const float* g = (k0 < 1024) ? (in_ptr(p, I_AOG) + l * 1024) : (in_ptr(p, I_ROG) + l * 1024 - 1024);
                      transpose_item(in_ptr(p, I_WOUT) + (size_t)l * D * D, D, D, (bf16*)(wb + W_OUT), g, 0, scr, r, lane); continue; } r -= I3;
        if (r < I4) { transpose_item(in_ptr(p, I_WMQ) + (size_t)l * D * DMA, D, DMA, (bf16*)(wb + W_MQ), in_ptr(p, I_XNG) + l * D, 0, scr, r, lane); continue; } r -= I4;
        if (r < I5) { transpose_item(in_ptr(p, I_WMO) + (size_t)l * DMA * D, DMA, D, (bf16*)(wb + W_MO), nullptr, 0, scr, r, lane); continue; } r -= I5;
        if (r < IEX) { const int e = r / IE; transpose_item(in_ptr(p, I_WEG) + ((size_t)l * NE + e) * D * DE, D, DE, (bf16*)(wb + W_GU) + (size_t)e * 1024 * D, in_ptr(p, I_MOEG) + l * D, 2, scr, r % IE, lane); continue; } r -= IEX;
        if (r < IEX) { const int e = r / IE; transpose_item(in_ptr(p, I_WEU) + ((size_t)l * NE + e) * D * DE, D, DE, (bf16*)(wb + W_GU) + (size_t)e * 1024 * D, in_ptr(p, I_MOEG) + l * D, 3, scr, r % IE, lane); continue; } r -= IEX;
        { const int e = r / ID; transpose_item(in_ptr(p, I_WED) + ((size_t)l * NE + e) * DE * D, DE, D, (bf16*)(wb + W_D) + (size_t)e * D * DE, nullptr, 0, scr, r % ID, lane); }
    }
    { u32x4* z = (u32x4*)((bf16*)(wb + W_IN) + (size_t)2880 * D); const int n16 = 192 * D * 2 / 16; for (int i = gtid; i < n16; i += NGT) z[i] = (u32x4){0u, 0u, 0u, 0u}; }
    { bf16* wr = (bf16*)(wb + W_R); const float* wg = in_ptr(p, I_WRGRP) + (size_t)l * D * 4; const float* we = in_ptr(p, I_WREXP) + (size_t)l * D * 32; const float* g = in_ptr(p, I_MOEG) + l * D;
      for (int i = gtid; i < 256 * D / 8; i += NGT) { const int n = i / (D / 8), k0 = (i % (D / 8)) * 8; float v[8];
#pragma unroll
          for (int j = 0; j < 8; ++j) { const int k = k0 + j; v[j] = n < 4 ? wg[k * 4 + n] * g[k] : (n < 36 ? we[k * 32 + (n - 4)] * g[k] : 0.f); }
          u32x4 o; o.x = pk2(v[0], v[1]); o.y = pk2(v[2], v[3]); o.z = pk2(v[4], v[5]); o.w = pk2(v[6], v[7]); *(u32x4*)(wr + (size_t)n * D + k0) = o; } }
    { bf16* wg = (bf16*)(wb + W_G); const float* wr = in_ptr(p, I_WRG) + (size_t)l * 8 * 128 * 128; const float* wi = in_ptr(p, I_WIG) + (size_t)l * 8 * 128 * 128;
      for (int i = gtid; i < 8 * 256 * 256 / 8; i += NGT) { const int n = i >> 13, j = (i >> 5) & 255, c0 = (i & 31) * 8; float v[8];
          const bool on = (c0 >> 7) == (n & 1); const float* src = (j < 128 ? wr : wi) + (size_t)n * 128 * 128 + (j & 127);
#pragma unroll
          for (int q = 0; q < 8; ++q) v[q] = on ? src[(size_t)((c0 & 127) + q) * 128] : 0.f;
          u32x4 o; o.x = pk2(v[0], v[1]); o.y = pk2(v[2], v[3]); o.z = pk2(v[4], v[5]); o.w = pk2(v[6], v[7]); *(u32x4*)(wg + (size_t)i * 8) = o; } }
}
__device__ __forceinline__ float row_to_bf16(const float* xrow, bf16* orow, int lane) {
    float ss = 0.f;
#pragma unroll
    for (int j = 0; j < 4; ++j) { const int c = lane * 8 + 512 * j; const f32x4 a = *(const f32x4*)(xrow + c), b = *(const f32x4*)(xrow + c + 4);
        ss += (a[0] * a[0] + a[1] * a[1]) + (a[2] * a[2] + a[3] * a[3]) + (b[0] * b[0] + b[1] * b[1]) + (b[2] * b[2] + b[3] * b[3]);
        u32x4 o; o.x = pk2(a[0], a[1]); o.y = pk2(a[2], a[3]); o.z = pk2(b[0], b[1]); o.w = pk2(b[2], b[3]); *(u32x4*)(orow + c) = o; }
    return wave_sum(ss);
}
__device__ __forceinline__ float gelu_tanh(float x) { const float y = 0.7978845608028654f * (x + 0.044715f * x * x * x); const float e = __expf(2.0f * y); const float th = 1.0f - 2.0f / (e + 1.0f); return 0.5f * x * (1.0f + th); }
__device__ __forceinline__ void unpack8(u32x4 w, float* v) { v[0] = bflo(w.x); v[1] = bfhi(w.x); v[2] = bflo(w.y); v[3] = bfhi(w.y); v[4] = bflo(w.z); v[5] = bfhi(w.z); v[6] = bflo(w.w); v[7] = bfhi(w.w); }
__device__ __forceinline__ u32x4 pack8f(const float* v) { u32x4 o; o.x = pk2(v[0], v[1]); o.y = pk2(v[2], v[3]); o.z = pk2(v[4], v[5]); o.w = pk2(v[6], v[7]); return o; }

__device__ __forceinline__ void conv_phase(const bf16* z, bf16* xc, const float* cw, const float* cb, int gtid, int NGT) {
    for (int it = gtid; it < (T / 16) * 128; it += NGT) {
        const int tb = it >> 7, cg = it & 127, row0 = tb * 16, s0 = row0 & (SEQ - 1), c0 = cg * 8;
        float w[4][8], b[8], p1[8], p2[8], p3[8];
#pragma unroll
        for (int j = 0; j < 4; ++j) { const f32x4 a = *(const f32x4*)(cw + j * DRNN + c0), bb = *(const f32x4*)(cw + j * DRNN + c0 + 4);
            w[j][0] = a[0]; w[j][1] = a[1]; w[j][2] = a[2]; w[j][3] = a[3]; w[j][4] = bb[0]; w[j][5] = bb[1]; w[j][6] = bb[2]; w[j][7] = bb[3]; }
        { const f32x4 a = *(const f32x4*)(cb + c0), bb = *(const f32x4*)(cb + c0 + 4); b[0] = a[0]; b[1] = a[1]; b[2] = a[2]; b[3] = a[3]; b[4] = bb[0]; b[5] = bb[1]; b[6] = bb[2]; b[7] = bb[3]; }
        const bf16* zp = z + (size_t)row0 * ZC + Z_XR + c0;
        if (s0 >= 1) unpack8(*(const u32x4*)(zp - (size_t)ZC), p1); else { for (int e = 0; e < 8; ++e) p1[e] = 0.f; }
        if (s0 >= 2) unpack8(*(const u32x4*)(zp - (size_t)2 * ZC), p2); else { for (int e = 0; e < 8; ++e) p2[e] = 0.f; }
        if (s0 >= 3) unpack8(*(const u32x4*)(zp - (size_t)3 * ZC), p3); else { for (int e = 0; e < 8; ++e) p3[e] = 0.f; }
#pragma unroll 4
        for (int r = 0; r < 16; ++r) { float cur[8], o[8]; unpack8(*(const u32x4*)(zp + (size_t)r * ZC), cur);
#pragma unroll
            for (int e = 0; e < 8; ++e) { o[e] = b[e] + w[3][e] * cur[e] + w[2][e] * p1[e] + w[1][e] * p2[e] + w[0][e] * p3[e]; p3[e] = p2[e]; p2[e] = p1[e]; p1[e] = cur[e]; }
            *(u32x4*)(xc + (size_t)(row0 + r) * DRNN + c0) = pack8f(o); }
    }
}
__device__ __forceinline__ void qk_post_phase(bf16* q, const bf16* kvr, const bf16* z, bf16* kk, const float* gq, const float* gk, const float* cosT, const float* sinT, int gw, int NGW, int lane) {
    const int h = lane >> 3, j = lane & 7;
    for (int row = gw; row < T; row += NGW) {
        const int s = row & (SEQ - 1);
        float cs[8], sn[8];
        { const int i0 = (j & 3) * 8; const f32x4 a = *(const f32x4*)(cosT + s * 32 + i0), b = *(const f32x4*)(cosT + s * 32 + i0 + 4), c = *(const f32x4*)(sinT + s * 32 + i0), d = *(const f32x4*)(sinT + s * 32 + i0 + 4);
          cs[0] = a[0]; cs[1] = a[1]; cs[2] = a[2]; cs[3] = a[3]; cs[4] = b[0]; cs[5] = b[1]; cs[6] = b[2]; cs[7] = b[3];
          sn[0] = c[0]; sn[1] = c[1]; sn[2] = c[2]; sn[3] = c[3]; sn[4] = d[0]; sn[5] = d[1]; sn[6] = d[2]; sn[7] = d[3]; }
#pragma unroll
        for (int which = 0; which < 2; ++which) {
            float v[3][8];
            if (which == 0) { bf16* qp = q + (size_t)row * NQU + h * QKH + j * 8;
#pragma unroll
                for (int i = 0; i < 3; ++i) unpack8(*(const u32x4*)(qp + 64 * i), v[i]); }
            else { const bf16* kp = kvr + (size_t)row * NKV + h * 256 + j * 8; unpack8(*(const u32x4*)kp, v[0]); unpack8(*(const u32x4*)(kp + 64), v[1]);
                   unpack8(*(const u32x4*)(z + (size_t)row * ZC + Z_KPE + j * 8), v[2]); }
            float ss = 0.f;
#pragma unroll
            for (int i = 0; i < 3; ++i)
#pragma unroll
                for (int e = 0; e < 8; ++e) ss += v[i][e] * v[i][e];
            ss += __shfl_xor(ss, 1); ss += __shfl_xor(ss, 2); ss += __shfl_xor(ss, 4);
            const float rstd = 1.0f / sqrtf(ss * (1.0f / 192.0f) + EPS);
            const float* g = which == 0 ? gq : gk;
#pragma unroll
            for (int i = 0; i < 3; ++i) { const f32x4 ga = *(const f32x4*)(g + 64 * i + j * 8), gb = *(const f32x4*)(g + 64 * i + j * 8 + 4);
                v[i][0] *= rstd * ga[0]; v[i][1] *= rstd * ga[1]; v[i][2] *= rstd * ga[2]; v[i][3] *= rstd * ga[3]; v[i][4] *= rstd * gb[0]; v[i][5] *= rstd * gb[1]; v[i][6] *= rstd * gb[2]; v[i][7] *= rstd * gb[3]; }
#pragma unroll
            for (int e = 0; e < 8; ++e) { const float mine = v[2][e], oth = __shfl_xor(mine, 4);
                v[2][e] = (j < 4) ? (mine * cs[e] - oth * sn[e]) : (oth * sn[e] + mine * cs[e]); }
            bf16* op = (which == 0 ? q + (size_t)row * NQU : kk + (size_t)row * NQU) + h * QKH + j * 8;
#pragma unroll
            for (int i = 0; i < 3; ++i) *(u32x4*)(op + 64 * i) = pack8f(v[i]);
        }
    }
}
template <bool F32IN>
__device__ __forceinline__ void head128_norm_rows(const void* in0, const float* in1, int ld_in, bf16* out, const float* g, int nrows, int gw, int NGW, int lane) {
    for (int row = gw; row < nrows; row += NGW) {
        float v[8];
        if (F32IN) { const float* a = (const float*)in0 + (size_t)row * ld_in + lane * 8; const float* b = in1 + (size_t)row * ld_in + lane * 8;
            const f32x4 a0 = *(const f32x4*)a, a1 = *(const f32x4*)(a + 4), b0 = *(const f32x4*)b, b1 = *(const f32x4*)(b + 4);
            v[0] = a0[0] + b0[0]; v[1] = a0[1] + b0[1]; v[2] = a0[2] + b0[2]; v[3] = a0[3] + b0[3]; v[4] = a1[0] + b1[0]; v[5] = a1[1] + b1[1]; v[6] = a1[2] + b1[2]; v[7] = a1[3] + b1[3]; }
        else unpack8(*(const u32x4*)((const bf16*)in0 + (size_t)row * ld_in + lane * 8), v);
        float ss = 0.f;
#pragma unroll
        for (int e = 0; e < 8; ++e) ss += v[e] * v[e];
        ss += __shfl_xor(ss, 1); ss += __shfl_xor(ss, 2); ss += __shfl_xor(ss, 4); ss += __shfl_xor(ss, 8);
        const float rstd = 1.0f / sqrtf(ss * (1.0f / 128.0f) + EPS);
        const int c = (lane * 8) & 127; const f32x4 ga = *(const f32x4*)(g + c), gb = *(const f32x4*)(g + c + 4);
        v[0] *= rstd * ga[0]; v[1] *= rstd * ga[1]; v[2] *= rstd * ga[2]; v[3] *= rstd * ga[3]; v[4] *= rstd * gb[0]; v[5] *= rstd * gb[1]; v[6] *= rstd * gb[2]; v[7] *= rstd * gb[3];
        *(u32x4*)(out + (size_t)row * DMA + lane * 8) = pack8f(v);
    }
}
__device__ __forceinline__ void scan_pass1(const bf16* aa, const bf16* uu, float* sA, float* sH, float* cA, float* cH, LAS f32x4* xch, int unit, int wave, int lane) {
    const int q = unit & 3, c = (unit >> 2) & 31, b = unit >> 7; const unsigned ch = (unsigned)(q * 256 + lane * 4);
    const GAS bf16* ap = (const GAS bf16*)aa + ((size_t)b * SEQ + (size_t)c * 256 + (size_t)wave * 32) * DRNN + ch;
    const GAS bf16* up = (const GAS bf16*)uu + ((size_t)b * SEQ + (size_t)c * 256 + (size_t)wave * 32) * DRNN + ch;
    f32x4 LA = (f32x4){0.f, 0.f, 0.f, 0.f}, H = (f32x4){0.f, 0.f, 0.f, 0.f};
    u32x2 av[32], uv[32];
#pragma unroll
    for (int s = 0; s < 32; ++s) { av[s] = *(const GAS u32x2*)(ap + (size_t)s * DRNN); uv[s] = *(const GAS u32x2*)(up + (size_t)s * DRNN); }
#pragma unroll
    for (int s = 0; s < 32; ++s) { const f32x4 la = (f32x4){bflo(av[s].x), bfhi(av[s].x), bflo(av[s].y), bfhi(av[s].y)}, u = (f32x4){bflo(uv[s].x), bfhi(uv[s].x), bflo(uv[s].y), bfhi(uv[s].y)};
        const f32x4 a = (f32x4){__expf(la[0]), __expf(la[1]), __expf(la[2]), __expf(la[3])}; H = a * H + u; LA = LA + la; }
    const f32x4 A = (f32x4){__expf(LA[0]), __expf(LA[1]), __expf(LA[2]), __expf(LA[3])};
    const size_t so = ((size_t)(b * 32 + c) * 8 + wave) * DRNN + ch;
    *(GAS f32x4*)((GAS float*)sA + so) = A; *(GAS f32x4*)((GAS float*)sH + so) = H;
    xch[(wave * 64 + lane) * 2] = A; xch[(wave * 64 + lane) * 2 + 1] = H;
    __syncthreads();
    if (wave == 0) { f32x4 Ac = (f32x4){1.f, 1.f, 1.f, 1.f}, Hc = (f32x4){0.f, 0.f, 0.f, 0.f};
#pragma unroll
        for (int w = 0; w < 8; ++w) { const f32x4 a = xch[(w * 64 + lane) * 2], h = xch[(w * 64 + lane) * 2 + 1]; Hc = a * Hc + h; Ac = Ac * a; }
        const size_t co = (size_t)(b * 32 + c) * DRNN + ch; *(GAS f32x4*)((GAS float*)cA + co) = Ac; *(GAS f32x4*)((GAS float*)cH + co) = Hc; }
    __syncthreads();
}
__device__ __forceinline__ void scan_pass3(const bf16* aa, const bf16* uu, const float* sA, const float* sH, const float* cA, const float* cH, const bf16* z, bf16* ymix, u64* ssq, int unit, int wave, int lane) {
    const int q = unit & 3, c = (unit >> 2) & 31, b = unit >> 7; const unsigned ch = (unsigned)(q * 256 + lane * 4);
    f32x4 h = (f32x4){0.f, 0.f, 0.f, 0.f};
    { const GAS float* ca = (const GAS float*)cA + (size_t)(b * 32) * DRNN + ch; const GAS float* chh = (const GAS float*)cH + (size_t)(b * 32) * DRNN + ch;
#pragma unroll 8
      for (int j = 0; j < c; ++j) { const f32x4 a = *(const GAS f32x4*)(ca + (size_t)j * DRNN), hh = *(const GAS f32x4*)(chh + (size_t)j * DRNN); h = a * h + hh; }
      const GAS float* sa = (const GAS float*)sA + (size_t)(b * 32 + c) * 8 * DRNN + ch; const GAS float* sh = (const GAS float*)sH + (size_t)(b * 32 + c) * 8 * DRNN + ch;
      for (int j = 0; j < wave; ++j) { const f32x4 a = *(const GAS f32x4*)(sa + (size_t)j * DRNN), hh = *(const GAS f32x4*)(sh + (size_t)j * DRNN); h = a * h + hh; } }
    const size_t row0 = (size_t)b * SEQ + (size_t)c * 256 + (size_t)wave * 32;
    const GAS bf16* ap = (const GAS bf16*)aa + row0 * DRNN + ch; const GAS bf16* up = (const GAS bf16*)uu + row0 * DRNN + ch;
    const GAS bf16* gp = (const GAS bf16*)z + row0 * ZC + Z_GATE + ch; GAS bf16* yp = (GAS bf16*)ymix + row0 * D + DATT + ch;
    const int rowsel = lane & 15;
#pragma unroll
    for (int hb = 0; hb < 2; ++hb) { u32x2 av[16], uv[16]; u32x2 gv[16]; float sq[16];
#pragma unroll
        for (int s = 0; s < 16; ++s) { av[s] = *(const GAS u32x2*)(ap + (size_t)(hb * 16 + s) * DRNN); uv[s] = *(const GAS u32x2*)(up + (size_t)(hb * 16 + s) * DRNN); gv[s] = *(const GAS u32x2*)(gp + (size_t)(hb * 16 + s) * ZC); }
#pragma unroll
        for (int s = 0; s < 16; ++s) { const f32x4 a = (f32x4){__expf(bflo(av[s].x)), __expf(bfhi(av[s].x)), __expf(bflo(av[s].y)), __expf(bfhi(av[s].y))}, u = (f32x4){bflo(uv[s].x), bfhi(uv[s].x), bflo(uv[s].y), bfhi(uv[s].y)}; h = a * h + u;
            const float y0 = h[0] * gelu_tanh(bflo(gv[s].x)), y1 = h[1] * gelu_tanh(bfhi(gv[s].x)), y2 = h[2] * gelu_tanh(bflo(gv[s].y)), y3 = h[3] * gelu_tanh(bfhi(gv[s].y));
            u32x2 o; o.x = pk2(y0, y1); o.y = pk2(y2, y3); *(GAS u32x2*)(yp + (size_t)(hb * 16 + s) * D) = o;
            sq[s] = (y0 * y0 + y1 * y1) + (y2 * y2 + y3 * y3); }
#pragma unroll
        for (int st = 0; st < 4; ++st) { const int n = 8 >> st; const bool up = (lane >> st) & 1;
#pragma unroll
            for (int i = 0; i < 8; ++i) if (i < n) { const float keep = up ? sq[2 * i + 1] : sq[2 * i], give = up ? sq[2 * i] : sq[2 * i + 1]; sq[i] = keep + __shfl_xor(give, 1 << st); } }
        float tot = sq[0]; tot += __shfl_xor(tot, 16); tot += __shfl_xor(tot, 32);
        if (lane < 16) ssq_add(ssq, (int)(row0 + hb * 16 + rowsel), tot); }
}
__device__ __forceinline__ void route_phase(const float* logits, const u64* ssq_x2, const float* bg, const float* be, int* tok_e, float* tok_w, int* whist, unsigned* cnt, LAS int* hist, int wg, int tid) {
    if (tid < 32) hist[tid] = 0;
    __syncthreads();
    if (tid < 64) { const int t = wg * 64 + tid; const float rs = 1.0f / sqrtf(ssq_val(ssq_x2, t) * (1.0f / D) + EPS); const float* lq = logits + (size_t)t * 64;
#define LSUM(i) ((lq[(i)] + lq[(size_t)T * 64 + (i)]) + (lq[(size_t)2 * T * 64 + (i)] + lq[(size_t)3 * T * 64 + (i)]))
        float lg[4]; int g = 0; float mx = -3.0e38f;
#pragma unroll
        for (int i = 0; i < 4; ++i) { lg[i] = LSUM(i) * rs + bg[i]; if (lg[i] > mx) { mx = lg[i]; g = i; } }
        float den = 0.f;
#pragma unroll
        for (int i = 0; i < 4; ++i) den += __expf(lg[i] - mx);
        const float gw = 1.0f / den;
        float l1 = -3.0e38f, l2 = -3.0e38f; int j1 = 0, j2 = 0;
        for (int i = 0; i < 8; ++i) { const float v = LSUM(4 + g * 8 + i) * rs + be[g * 8 + i];
            if (v > l1) { l2 = l1; j2 = j1; l1 = v; j1 = i; } else if (v > l2) { l2 = v; j2 = i; } }
        const float w1 = 1.0f / (1.0f + __expf(l2 - l1)), w2 = 1.0f - w1;
        const int e1 = g * 8 + j1, e2 = g * 8 + j2;
        tok_e[t * 2] = e1; tok_e[t * 2 + 1] = e2; tok_w[t * 2] = gw * w1; tok_w[t * 2 + 1] = gw * w2;
        __hip_atomic_fetch_add(hist + e1, 1, __ATOMIC_RELAXED, __HIP_MEMORY_SCOPE_WORKGROUP); __hip_atomic_fetch_add(hist + e2, 1, __ATOMIC_RELAXED, __HIP_MEMORY_SCOPE_WORKGROUP);
    }
#undef LSUM
    __syncthreads();
    if (tid < 32) { const int c = hist[tid]; whist[wg * 32 + tid] = c; if (c) atomicAdd(cnt + tid, (unsigned)c); }
}
__device__ __forceinline__ void dispatch_phase(const unsigned* cnt, const int* whist, const int* tok_e, const float* tok_w, const u64* ssq_x2, int* tok_slot, int* slot_tok, float* slot_w, float* slot_rs,
                                               LAS int* sc, int wg, int tid) {
    if (tid == 0) { int seg = 0; for (int e = 0; e < 32; ++e) { sc[e] = seg; seg += (((int)cnt[e] + 255) >> 8) << 8; } }
    { const int e = tid & 31, part = tid >> 5; int s = 0; for (int w = part; w < wg; w += 16) s += whist[w * 32 + e]; sc[64 + tid] = s; }
    if (tid < 128) sc[640 + tid] = tok_e[(wg * 64) * 2 + tid];
    __syncthreads();
    if (tid < 32) { int s = sc[tid]; for (int p = 0; p < 16; ++p) s += sc[64 + p * 32 + tid]; sc[32 + tid] = s; }
    __syncthreads();
    if (tid < 128) { const int e = sc[640 + tid]; int rank = 0; for (int j = 0; j < tid; ++j) rank += (sc[640 + j] == e) ? 1 : 0;
        const int slot = sc[32 + e] + rank; const int t = wg * 64 + (tid >> 1);
        slot_tok[slot] = t; slot_w[slot] = tok_w[(wg * 64) * 2 + tid]; slot_rs[slot] = 1.0f / sqrtf(ssq_val(ssq_x2, t) * (1.0f / D) + EPS); tok_slot[(wg * 64) * 2 + tid] = slot; }
    if (wg < 32) { const int c = (int)cnt[wg], lo = sc[wg] + c, hi = sc[wg] + (((c + 255) >> 8) << 8);
        for (int s = lo + tid; s < hi; s += NTHREADS) { slot_tok[s] = 0; slot_w[s] = 0.f; slot_rs[s] = 0.f; } }
    __syncthreads();
}
__device__ __forceinline__ int build_rtab(const unsigned* cnt, LAS int* lc, int tid) {
    if (tid == 0) { int seg = 0, k = 0; for (int e = 0; e < 32; ++e) { const int nt = ((int)cnt[e] + 255) >> 8; for (int r = 0; r < nt; ++r) { lc[LC_RTAB / 4 + 2 * k] = e; lc[LC_RTAB / 4 + 2 * k + 1] = seg + r * 256; ++k; } seg += nt * 256; } lc[LC_NRT / 4] = k; }
    __syncthreads();
    return lc[LC_NRT / 4];
}
__device__ __forceinline__ void combine_phase(float* out, const bf16* Y, const int* tok_slot, bf16* xb, u64* ssq_next, bool last, int gw, int NGW, int lane) {
    for (int row = gw; row < T; row += NGW) {
        const int s0 = tok_slot[row * 2], s1 = tok_slot[row * 2 + 1]; float ss = 0.f;
#pragma unroll
        for (int j = 0; j < 4; ++j) { const int c = lane * 8 + 512 * j; float x0[8], y0[8], y1[8], v[8];
            unpack8(*(const u32x4*)(xb + (size_t)row * D + c), x0); unpack8(*(const u32x4*)(Y + (size_t)s0 * D + c), y0); unpack8(*(const u32x4*)(Y + (size_t)s1 * D + c), y1);
#pragma unroll
            for (int e = 0; e < 8; ++e) { v[e] = x0[e] + y0[e] + y1[e]; ss += v[e] * v[e]; }
            if (last) { float* op = out + (size_t)row * D + c; *(f32x4*)op = (f32x4){v[0], v[1], v[2], v[3]}; *(f32x4*)(op + 4) = (f32x4){v[4], v[5], v[6], v[7]}; }
            else *(u32x4*)(xb + (size_t)row * D + c) = pack8f(v); }
        ss = wave_sum(ss); if (!last && lane == 0) ssq_set(ssq_next, row, ss);
    }
}
constexpr int NPL = 16, NPHASES = 1 + DEPTH * NPL;
__device__ __forceinline__ att::BlockRef mla_ref(int it, int pass, bf16* qbuf, bf16* kk, bf16* kvr, bf16* ymix, u64* ssq_ya) {
    const int bh = (it & 7) * 2 + ((it >> 3) >> 4), y = (it >> 3) & 15, b = bh >> 3, h = bh & 7; const int qb = pass ? y : 31 - y;   const size_t r0 = (size_t)b * SEQ;
    att::BlockRef c; c.K = kk + r0 * NQU + h * QKH; c.V = kvr + r0 * NKV + h * 256 + 128; c.nk = SEQ;
    c.Q = qbuf + (r0 + (size_t)qb * 256) * NQU + h * QKH; c.O = ymix + (r0 + (size_t)qb * 256) * D + h * VH; c.ssq = ssq_ya + r0 + qb * 256; c.P0 = qb * 256; return c;
}
#ifndef PH_MASK
#define PH_MASK 0x1ffff
#endif
#define PH_ON(j) (((PH_MASK) >> (j)) & 1)
__global__ void __launch_bounds__(NTHREADS, 2) fwd_kernel(Params p) {
    extern __shared__ __attribute__((aligned(16))) unsigned char lds_raw[];
    LAS unsigned char* lds = (LAS unsigned char*)lds_raw;
    LAS int* lc = (LAS int*)(lds + LDSCTL_OFF);
    const int G = gridDim.x, bx = blockIdx.x;
    const int NGW = G * NWAVES, NGT = G * NTHREADS;
    if (threadIdx.x < 64) lc[threadIdx.x] = 0;
    __syncthreads();
    XcdBarrier bar = xcd_barrier_post((unsigned*)(ws_ptr() + WS_CTL) + CW_BAR, (volatile LAS unsigned*)(lds + LDSCTL_OFF + LC_BAR));
    const int lo = p.ph_lo, hi = p.ph_hi; const bool probe = p.probe != 0;
#define IN(k) (lo <= (k) && (k) < hi)
#define SEAM(k) do { if ((k) + 1 < hi) xcd_barrier(bar); } while (0)
#define WS_PTRS() unsigned char* ws = opaque_ptr(p.ws); unsigned char* wb = ws + WS_W; unsigned char* rg = ws + WS_R; (void)wb; (void)rg; \
    int tid = threadIdx.x; asm volatile("" : "+v"(tid)); const int lane = tid & 63, wave = __builtin_amdgcn_readfirstlane(tid >> 6); \
    const int gw = bx * NWAVES + wave, gtid = bx * NTHREADS + tid; (void)lane; (void)gw; (void)gtid
#define INP(i) in_ptr(p, (i))
#define STATP(l, k) ((u64*)(ws + WS_STAT) + (size_t)((l) * 7 + (k)) * 16384)

    if (PH_ON(0) && IN(0)) {
        WS_PTRS();
        float* cosT = (float*)(ws + WS_TAB); float* sinT = cosT + SEQ * 32; float* spT = (float*)(ws + WS_TAB + 2 * MiB); u64* ssq_mem = (u64*)(spT + 2 * 1024);
        bf16* memb = (bf16*)(ws + WS_MEMB); bf16* wmkv = (bf16*)(ws + WS_WMKV); bf16* xb = (bf16*)(ws + WS_XB);
        LAS float* scr = (LAS float*)(lds + wave * 16384);
        convert_layer_weights(p, 0, scr, gw, NGW, lane, gtid, NGT);
        for (int it = gw; it < 2 * 2 * 32 * 16; it += NGW) { const int l = it / (2 * 512), r = it % (2 * 512), kv = r / 512, item = r % 512;
            transpose_item(INP(kv ? I_WMV : I_WMK) + (size_t)l * D * DMA, D, DMA, wmkv + (size_t)l * 1024 * D + (size_t)kv * 512 * D, INP(I_MNG) + l * D, 0, scr, item, lane); }
        for (int i = gtid; i < SEQ * 32; i += NGT) { const int t = i >> 5, k = i & 31; const float inv = exp2f(-(float)k * (13.287712379549449f / 32.0f)); float s, c; sincosf((float)t * inv, &s, &c); cosT[i] = c; sinT[i] = s; }
        { const float* lam = INP(I_LAM); for (int i = gtid; i < 2 * 1024; i += NGT) spT[i] = log1pf(expf(-lam[i])); }
        u64* ssq_x0 = STATP(0, ST_X);
        { const float* x = INP(I_X); for (int row = gw; row < T; row += NGW) { const float ss = row_to_bf16(x + (size_t)row * D, xb + (size_t)row * D, lane); if (lane == 0) ssq_set(ssq_x0, row, ss); } }
        { const float* m = INP(I_MEM); for (int row = gw; row < TM; row += NGW) { const float ss = row_to_bf16(m + (size_t)row * D, memb + (size_t)row * D, lane); if (lane == 0) ssq_set(ssq_mem, row, ss); } }
        SEAM(0);
    }

    for (int l = 0; l < DEPTH; ++l) {
        const int pb = 1 + l * NPL;

        if (PH_ON(1) && IN(pb + 0)) {
            WS_PTRS();
            { pg8::DenseSched S{(const char*)(ws + WS_XB), (const char*)(wb + W_IN), D, D, T / 256, ZC / 256, 1, D, G, bx};
              pg8::EpiBf16<0, true> E{(bf16*)(rg + R_Z), ZC, STATP(l, ST_X), 1.0f / D, STATP(l, ST_CQ), STATP(l, ST_CKV), 2, 3};
              pg8::gemm_phase<pg8::EpiBf16<0, true>, pg8::DenseSched, true, false>(lds, D, D, D, S, E, 0); }
            if (l == 0) {
                pg8::DenseSched S{(const char*)(ws + WS_MEMB), (const char*)(ws + WS_WMKV), D, D, TM / 256, 2 * 1024 / 256, 1, D, G, bx};
                pg8::EpiBf16<0, false> E{(bf16*)(ws + WS_KVMEM), 2 * 1024, (const void*)((float*)(ws + WS_TAB + 2 * MiB) + 2 * 1024), 1.0f / D, nullptr, nullptr, 0, 0};
                pg8::gemm_phase<pg8::EpiBf16<0, false>, pg8::DenseSched, true, false>(lds, D, D, D, S, E, 0);
            }
            SEAM(pb + 0);
        }
        if (PH_ON(2) && IN(pb + 1)) {
            WS_PTRS();
            bf16* z = (bf16*)(rg + R_Z);
            { pg8::DenseSched S{(const char*)(z + Z_CQ), (const char*)(wb + W_UQ), ZC, QL, T / 256, NQU / 256, 1, QL, G, bx};
              pg8::EpiBf16<0, false> E{(bf16*)(rg + R_Q), NQU, STATP(l, ST_CQ), 1.0f / QL, nullptr, nullptr, 0, 0};
              pg8::gemm_phase<pg8::EpiBf16<0, false>, pg8::DenseSched, true, false>(lds, QL, ZC, QL, S, E, 0); }
            { pg8::DenseSched S{(const char*)(z + Z_CKV), (const char*)(wb + W_UKV), ZC, KVL, T / 256, NKV / 256, 1, KVL, G, bx};
              pg8::EpiBf16<0, false> E{(bf16*)(rg + R_KVR), NKV, STATP(l, ST_CKV), 1.0f / KVL, nullptr, nullptr, 0, 0};
              pg8::gemm_phase<pg8::EpiBf16<0, false>, pg8::DenseSched, true, false>(lds, KVL, ZC, KVL, S, E, 0); }
            conv_phase(z, (bf16*)(rg + R_XC), INP(I_CONVW) + (size_t)l * 4 * DRNN, INP(I_CONVB) + (size_t)l * DRNN, gtid, NGT);
            if (l == 0) { const float* mkg = INP(I_MKG); for (int ll = 0; ll < 2; ++ll) head128_norm_rows<false>((bf16*)(ws + WS_KVMEM) + (size_t)ll * 1024, nullptr, 2 * 1024, (bf16*)(ws + WS_KMEMN) + (size_t)ll * TM * DMA, mkg + ll * 128, TM, gw, NGW, lane); }
            SEAM(pb + 1);
        }
        if (PH_ON(3) && IN(pb + 2)) {
            WS_PTRS();
            float* cosT = (float*)(ws + WS_TAB);
            qk_post_phase((bf16*)(rg + R_Q), (const bf16*)(rg + R_KVR), (const bf16*)(rg + R_Z), (bf16*)(rg + R_KK), INP(I_AQG) + l * QKH, INP(I_AKG) + l * QKH, cosT, cosT + SEQ * 32, gw, NGW, lane);
            { pg8::GateSched S{(const char*)(rg + R_XC), (const char*)(wb + W_G), G, bx};
              pg8::EpiGates E{(const bf16*)(rg + R_XC), INP(I_BRG) + l * DRNN, INP(I_BIG) + l * DRNN, (float*)(ws + WS_TAB + 2 * MiB) + l * DRNN, (bf16*)(rg + R_AA), (bf16*)(rg + R_UU)};
              pg8::gemm_phase<pg8::EpiGates, pg8::GateSched, true, false>(lds, 256, DRNN, 256, S, E, 0); }
            SEAM(pb + 2);
        }
        if (PH_ON(4) && IN(pb + 3)) {
            WS_PTRS();
            float* sA = (float*)(ws + WS_SCAN2);
            for (int u = bx; u < 256; u += G) scan_pass1((const bf16*)(rg + R_AA), (const bf16*)(rg + R_UU), sA, sA + 512 * 1024, sA + 1024 * 1024, sA + 1024 * 1024 + 64 * 1024, (LAS f32x4*)lds, u, wave, lane);
            SEAM(pb + 3);
        }
        if (PH_ON(5) && IN(pb + 4)) {
            WS_PTRS();
            bf16* ymix = (bf16*)(rg + R_YMIX);
            {
                bf16* qbuf = (bf16*)(rg + R_Q); bf16* kk = (bf16*)(rg + R_KK); bf16* kvr = (bf16*)(rg + R_KVR); u64* ssq_ya = STATP(l, ST_YATT);
                const att::Strides<NQU, NQU, NKV, D> sd;
                for (int it = bx; it < 256; it += G) {
                    att::BlockRef cur = mla_ref(it, 0, qbuf, kk, kvr, ymix, ssq_ya);
                    att::Seam<12> S;
                    att::attn_prime<64>(cur, sd, (char*)lds_raw, S);
                    for (int pass = 0; pass < 2; ++pass) {
                        const att::BlockRef nxt = (pass == 0) ? mla_ref(it, 1, qbuf, kk, kvr, ymix, ssq_ya) : cur;
                        att::attn_block<64, true, true>(cur, nxt, sd, 0.07216878364870322f, (char*)lds_raw, S);
                        cur = nxt;
                    }
                }
            }
            { float* sA = (float*)(ws + WS_SCAN2);
              for (int u = bx; u < 256; u += G) scan_pass3((const bf16*)(rg + R_AA), (const bf16*)(rg + R_UU), sA, sA + 512 * 1024, sA + 1024 * 1024, sA + 1024 * 1024 + 64 * 1024, (const bf16*)(rg + R_Z), ymix, STATP(l, ST_YRNN), u, wave, lane); }
            SEAM(pb + 4);
        }
        if (PH_ON(6) && IN(pb + 5)) {
            WS_PTRS();
            pg8::DenseSched S{(const char*)(rg + R_YMIX), (const char*)(wb + W_OUT), D, D, T / 256, D / 256, 1, D, G, bx};
            pg8::EpiResid<true> E{(bf16*)(ws + WS_XB), STATP(l, ST_X1), STATP(l, ST_YATT), STATP(l, ST_YRNN)};
            pg8::gemm_phase<pg8::EpiResid<true>, pg8::DenseSched, true, true>(lds, D, D, D, S, E, 16);
            SEAM(pb + 5);
        }
        if (PH_ON(7) && IN(pb + 6)) {
            WS_PTRS();
            pg8::DenseSched S{(const char*)(ws + WS_XB), (const char*)(wb + W_MQ), D, D, T / 256, DMA / 256, 2, 1024, G, bx};
            pg8::EpiF32Slab E{(float*)(rg + R_QM), DMA, (size_t)T * DMA, STATP(l, ST_X1), 1.0f / D};
            pg8::gemm_phase<pg8::EpiF32Slab, pg8::DenseSched, true, false>(lds, 1024, D, D, S, E, 0);
            SEAM(pb + 6);
        }
        if (PH_ON(8) && IN(pb + 7)) {
            WS_PTRS();
            float* qm = (float*)(rg + R_QM);
            head128_norm_rows<true>(qm, qm + (size_t)T * DMA, DMA, (bf16*)(rg + R_QMN), INP(I_MQG) + l * 128, T, gw, NGW, lane);
            SEAM(pb + 7);
        }
        if (PH_ON(9) && IN(pb + 8)) {
            WS_PTRS();
            bf16* qmn = (bf16*)(rg + R_QMN); bf16* om = (bf16*)(rg + R_OM); bf16* kmemn = (bf16*)(ws + WS_KMEMN); bf16* kvmem = (bf16*)(ws + WS_KVMEM);
            const att::Strides<DMA, DMA, 2 * 1024, DMA> sd;
            for (int it = bx; it < 256; it += G) {
                const int h = it & 3, rb = it >> 2, b = rb >> 5;
                att::BlockRef c0;
                c0.Q = qmn + (size_t)rb * 256 * DMA + h * 128; c0.K = kmemn + ((size_t)l * TM + (size_t)b * NMEM) * DMA + h * 128;
                c0.V = kvmem + (size_t)l * 1024 + (size_t)b * NMEM * 2048 + 512 + h * 128; c0.O = om + (size_t)rb * 256 * DMA + h * 128; c0.ssq = nullptr; c0.P0 = 0; c0.nk = NMEM;
                att::Seam<8> S;
                att::attn_prime<0>(c0, sd, (char*)lds_raw, S);
                att::attn_block<0, false, false>(c0, c0, sd, 0.08838834764831845f, (char*)lds_raw, S);
            }
            SEAM(pb + 8);
        }
        if (PH_ON(10) && IN(pb + 9)) {
            WS_PTRS();
            pg8::DenseSched S{(const char*)(rg + R_OM), (const char*)(wb + W_MO), DMA, DMA, T / 256, D / 256, 1, DMA, G, bx};
            pg8::EpiResid<false> E{(bf16*)(ws + WS_XB), STATP(l, ST_X2), nullptr, nullptr};
            pg8::gemm_phase<pg8::EpiResid<false>, pg8::DenseSched, true, false>(lds, DMA, DMA, DMA, S, E, 0);
            SEAM(pb + 9);
        }
        if (PH_ON(11) && IN(pb + 10)) {
            WS_PTRS();
            pg8::DenseSched S{(const char*)(ws + WS_XB), (const char*)(wb + W_R), D, D, T / 256, 1, 4, 512, G, bx};
            pg8::EpiRouter E{(float*)(rg + R_AA)};
            pg8::gemm_phase<pg8::EpiRouter, pg8::DenseSched, true, false>(lds, 512, D, D, S, E, 0);
            SEAM(pb + 10);
        }
        if (PH_ON(12) && IN(pb + 11)) {
            WS_PTRS();
            unsigned* cnt = (unsigned*)(ws + WS_CTL) + CW_CNT + l * 64;
            for (int w = bx; w < 256; w += G) route_phase((const float*)(rg + R_AA), STATP(l, ST_X2), INP(I_BRGRP) + l * 4, INP(I_BREXP) + l * 32, (int*)(ws + WS_MOE), (float*)(ws + WS_MOE + 128 * 1024),
                                                          (int*)(ws + WS_MOE + 384 * 1024), cnt, (LAS int*)lds, w, tid);
            SEAM(pb + 11);
        }
        if (PH_ON(13) && IN(pb + 12)) {
            WS_PTRS();
            unsigned* cnt = (unsigned*)(ws + WS_CTL) + CW_CNT + l * 64;
            for (int w = bx; w < 256; w += G) dispatch_phase(cnt, (const int*)(ws + WS_MOE + 384 * 1024), (const int*)(ws + WS_MOE), (const float*)(ws + WS_MOE + 128 * 1024), STATP(l, ST_X2),
                                                             (int*)(ws + WS_MOE + 256 * 1024), (int*)(ws + WS_MOE + 512 * 1024), (float*)(ws + WS_MOE + 704 * 1024), (float*)(ws + WS_MOE + 896 * 1024), (LAS int*)lds, w, tid);
            SEAM(pb + 12);
        }
        if (PH_ON(14) && IN(pb + 13)) {
            WS_PTRS();
            const int nrt = build_rtab((unsigned*)(ws + WS_CTL) + CW_CNT + l * 64, lc, tid);
            { const int* slot_tok = (const int*)(ws + WS_MOE + 512 * 1024);
              for (int i = 0; i < 4; ++i) { const long L = (long)i * G + bx; if (L < (long)nrt * 4 && tid < 256) lc[LC_LTOK / 4 + i * 256 + tid] = slot_tok[lc[LC_RTAB / 4 + 2 * (int)(L >> 2) + 1] + tid]; }
              __syncthreads(); }
            pg8::MoeUpSched S{(const char*)(ws + WS_XB), (const char*)(wb + W_GU), (const LAS int*)(lc + LC_LTOK / 4), (const LAS int*)(lc + LC_RTAB / 4), nrt, G, bx};
            pg8::EpiSwiglu E{(bf16*)(rg + R_ACT), (const float*)(ws + WS_MOE + 896 * 1024)};
            pg8::gemm_phase<pg8::EpiSwiglu, pg8::MoeUpSched, true, false>(lds, D, D, D, S, E, 0);
            SEAM(pb + 13);
        }
        if (PH_ON(15) && IN(pb + 14)) {
            WS_PTRS();
            const int nrt = build_rtab((unsigned*)(ws + WS_CTL) + CW_CNT + l * 64, lc, tid);
            pg8::MoeDownSched S{(const char*)(rg + R_ACT), (const char*)(wb + W_D), (const LAS int*)(lc + LC_RTAB / 4), nrt, G, bx};
            pg8::EpiBf16<1, false> E{(bf16*)(rg + R_Y), D, (const float*)(ws + WS_MOE + 704 * 1024), 0.f, nullptr, nullptr, 0, 0};
            pg8::gemm_phase<pg8::EpiBf16<1, false>, pg8::MoeDownSched, true, false>(lds, DE, DE, DE, S, E, 0);
            SEAM(pb + 14);
        }
        if (PH_ON(16) && IN(pb + 15)) {
            WS_PTRS();
            const bool more = (l + 1 < DEPTH);
            combine_phase(probe ? (float*)(rg + R_AA) : out_ptr(), (const bf16*)(rg + R_Y), (const int*)(ws + WS_MOE + 256 * 1024), (bf16*)(ws + WS_XB), STATP((l + 1) % DEPTH, ST_X), !more, gw, NGW, lane);
            if (more) { LAS float* scr = (LAS float*)(lds + wave * 16384); convert_layer_weights(p, l + 1, scr, gw, NGW, lane, gtid, NGT); }
            SEAM(pb + 15);
        }
    }
#undef IN
#undef SEAM
}

#ifndef MK_SPLIT
#define MK_SPLIT 0
#endif
extern "C" void kernel_launch(void* const* d_in, const int* in_sizes, int n_in, void* d_out, int out_size, void* d_ws, size_t ws_size, hipStream_t stream) {
    static int grid = 0;
    if (grid == 0) {
        if (n_in != 36 || in_sizes[0] != T * D || out_size != T * D || ws_size < WS_END) {
            fprintf(stderr, "kernel_launch: unexpected shapes (n_in %d, in0 %d, out %d, ws %zu < %zu)\n", n_in, n_in > 0 ? in_sizes[0] : -1, out_size, ws_size, (size_t)WS_END); grid = -1; return; }
        int dev = 0, cus = 0, per_cu = 0;
        if (hipGetDevice(&dev) != hipSuccess || hipDeviceGetAttribute(&cus, hipDeviceAttributeMultiprocessorCount, dev) != hipSuccess) { grid = -1; return; }
        if (hipFuncSetAttribute((const void*)fwd_kernel, hipFuncAttributeMaxDynamicSharedMemorySize, LDS_BYTES) != hipSuccess) { fprintf(stderr, "kernel_launch: hipFuncSetAttribute failed\n"); grid = -1; return; }
        if (hipOccupancyMaxActiveBlocksPerMultiprocessor(&per_cu, (const void*)fwd_kernel, NTHREADS, LDS_BYTES) != hipSuccess || per_cu < 1)
            fprintf(stderr, "kernel_launch: occupancy query reports %d workgroups per CU\n", per_cu);
        (void)hipGetLastError();
        grid = cus;
    }
    if (grid < 0) return;
    if (hipMemsetAsync((char*)d_ws, 0, ZERO_BYTES, stream) != hipSuccess) return;
    Params a{};
    for (int i = 0; i < 36; ++i) a.in[i] = (const float*)d_in[i];
    a.out = (float*)d_out; a.ws = (unsigned char*)d_ws;
#if MK_SPLIT
    for (int ph = 0; ph < NPHASES; ++ph) { a.ph_lo = ph; a.ph_hi = ph + 1; hipLaunchKernelGGL(fwd_kernel, dim3(grid), dim3(NTHREADS), LDS_BYTES, stream, a); }
#else
    a.ph_lo = 0; a.ph_hi = NPHASES;
    hipLaunchKernelGGL(fwd_kernel, dim3(grid), dim3(NTHREADS), LDS_BYTES, stream, a);
#endif
#if defined(PROBE_PHASE)
    a.ph_lo = PROBE_PHASE; a.ph_hi = PROBE_PHASE + 1; a.probe = 1;
    for (int r = 0; r < PROBE_REPS; ++r) hipLaunchKernelGGL(fwd_kernel, dim3(grid), dim3(NTHREADS), LDS_BYTES, stream, a);
#endif
}
```
